# Optimizing an MI355X kernel written in HIP

```python
import math
import jax, jax.numpy as jnp
from jax import lax
import numpy as np

D_MODEL = 1024
BATCH = 2
SEQ = 8192
DEPTH = 2

GRID_W = 64
Q_BLOCK = 128
NORM_EPS = 1e-6
ROPE_THETA = 10000.0

HY_D = 256
HY_ORDER = 2
HY_EMB = 33
HY_BANDS = (HY_EMB - 1) // 2
HY_FILTER_HIDDEN = 64
HY_DECAY_TARGET = 1e-2
HY_FAST_DECAY_PCT = 0.3
HY_SLOW_DECAY_PCT = 1.5

GQA_HEADS = 8
GQA_KV_HEADS = 2
GQA_HEAD_DIM = 64

MLA_HEADS = 4
MLA_Q_RANK = 256
MLA_KV_RANK = 128
MLA_NOPE_DIM = 64
MLA_ROPE_DIM = 32
MLA_V_DIM = 64

D_MIX = HY_D + GQA_HEADS * GQA_HEAD_DIM + MLA_HEADS * MLA_V_DIM

D_FF = 2816

IN_SPLITS = ((HY_ORDER + 1) * HY_D, GQA_HEADS * GQA_HEAD_DIM, GQA_KV_HEADS * GQA_HEAD_DIM,
             GQA_KV_HEADS * GQA_HEAD_DIM, MLA_Q_RANK, MLA_KV_RANK, MLA_ROPE_DIM)
D_IN = 1952

kernel_name = 'hybrid_hyena_gqa_mla_encoder'

F32 = jnp.float32


def rms_norm(x, g):
    xf = x.astype(F32)
    y = xf * lax.rsqrt(jnp.mean(xf * xf, axis=-1, keepdims=True) + NORM_EPS)
    return (y * g.astype(F32)).astype(x.dtype)


def dwconv3(x, w, b):
    xp = jnp.pad(x, ((0, 0), (1, 1), (0, 0)))
    return xp[:, :-2] * w[0] + xp[:, 1:-1] * w[1] + xp[:, 2:] * w[2] + b


def axial_rope_tables(row_idx, col_idx, rot_dim):
    n_axis = rot_dim // 4
    inv = ROPE_THETA ** (-jnp.arange(n_axis, dtype=F32) / n_axis)
    ang = jnp.concatenate([row_idx[:, None].astype(F32) * inv,
                           col_idx[:, None].astype(F32) * inv], axis=-1)
    return jnp.cos(ang), jnp.sin(ang)


def apply_rope(x, cos, sin):
    x1, x2 = jnp.split(x.astype(F32), 2, axis=-1)
    return jnp.concatenate([x1 * cos - x2 * sin, x1 * sin + x2 * cos], axis=-1).astype(x.dtype)


def hyena_position_features(L):
    t = jnp.linspace(0.0, 1.0, L, dtype=F32)[:, None]
    w = 2.0 * math.pi * jnp.arange(L, dtype=F32)[:, None] / L
    f = jnp.linspace(1e-4, HY_BANDS - 1, HY_BANDS, dtype=F32)[None, :]
    z = jnp.concatenate([t, jnp.cos(f * w), -jnp.sin(f * w)], axis=-1)
    max_decay = math.log(HY_DECAY_TARGET) / HY_FAST_DECAY_PCT
    min_decay = math.log(HY_DECAY_TARGET) / HY_SLOW_DECAY_PCT
    deltas = jnp.linspace(min_decay, max_decay, HY_D, dtype=F32)
    window = jnp.exp(-t * jnp.abs(deltas)[None, :])
    return z, window


def hyena_filters(z, window, w1, b1, f1, w2, b2, f2, w3):
    h = jnp.sin(f1.astype(F32) * (z @ w1.astype(F32) + b1.astype(F32)))
    h = jnp.sin(f2.astype(F32) * (h @ w2.astype(F32) + b2.astype(F32)))
    h = (h @ w3.astype(F32)).reshape(-1, HY_ORDER, 2, HY_D)
    return h * window[:, None, None, :]


def bidir_fftconv(u, h_fwd, h_bwd, skip):
    L = u.shape[1]
    k = jnp.concatenate([h_fwd, h_bwd[::-1]], axis=0)
    uf = jnp.fft.rfft(u.astype(F32), n=2 * L, axis=1)
    kf = jnp.fft.rfft(k, axis=0)
    y = jnp.fft.irfft(uf * kf[None], n=2 * L, axis=1)[:, :L]
    return (y + u.astype(F32) * skip.astype(F32)).astype(u.dtype)


def hyena_mixer(u, conv_w, conv_b, filters, skip):
    uc = dwconv3(u, conv_w, conv_b)
    v, x1, x2 = jnp.split(uc, 3, axis=-1)
    z = v
    for i, gate in enumerate((x1, x2)):
        z = gate * bidir_fftconv(z, filters[:, i, 0], filters[:, i, 1], skip[i])
    return z


def gqa_attention(q, k, v, scale):
    B, L, Hq, d = q.shape
    Hkv = k.shape[2]
    G = Hq // Hkv
    nb = L // Q_BLOCK
    qb = q.reshape(B, nb, Q_BLOCK, Hkv, G, d).transpose(1, 0, 3, 4, 2, 5)

    def one_block(qi):
        s = jnp.einsum('bkgqd,bskd->bkgqs', qi, k, preferred_element_type=F32) * scale
        p = jax.nn.softmax(s, axis=-1).astype(v.dtype)
        return jnp.einsum('bkgqs,bskd->bkgqd', p, v)

    o = lax.map(one_block, qb)
    return o.transpose(1, 0, 4, 2, 3, 5).reshape(B, L, Hq * d)


def mla_attention(q_nope, q_pe, k_nope, k_pe, v, scale):
    B, L, H, dn = q_nope.shape
    dr = q_pe.shape[-1]
    dv = v.shape[-1]
    nb = L // Q_BLOCK
    qn = q_nope.reshape(B, nb, Q_BLOCK, H, dn).transpose(1, 0, 3, 2, 4)
    qr = q_pe.reshape(B, nb, Q_BLOCK, H, dr).transpose(1, 0, 3, 2, 4)

    def one_block(args):
        qn_i, qr_i = args
        s = (jnp.einsum('bhqd,bshd->bhqs', qn_i, k_nope, preferred_element_type=F32)
             + jnp.einsum('bhqr,bsr->bhqs', qr_i, k_pe, preferred_element_type=F32)) * scale
        p = jax.nn.softmax(s, axis=-1).astype(v.dtype)
        return jnp.einsum('bhqs,bshd->bhqd', p, v)

    o = lax.map(one_block, (qn, qr))
    return o.transpose(1, 0, 3, 2, 4).reshape(B, L, H * dv)


def setup_inputs(seed: int = 0) -> dict:
    key = jax.random.key(seed)
    ks = jax.random.split(key, 30)

    def nrm(k, shape, scale):
        return jax.random.normal(k, shape, F32) * scale

    def gain(k, n):
        return 1.0 + 0.05 * jax.random.normal(k, (DEPTH, n), F32)

    hy_cols = (HY_ORDER + 1) * HY_D
    return {
        'x': nrm(ks[0], (BATCH, SEQ, D_MODEL), 1.0),
        'mix_pre_norm': gain(ks[1], D_MODEL),
        'w_in': nrm(ks[2], (DEPTH, D_MODEL, D_IN), D_MODEL ** -0.5),
        'hy_conv_w': nrm(ks[3], (DEPTH, 3, hy_cols), 3 ** -0.5),
        'hy_conv_b': nrm(ks[4], (DEPTH, hy_cols), 0.01),
        'hy_filt_w1': nrm(ks[5], (DEPTH, HY_EMB, HY_FILTER_HIDDEN), HY_EMB ** -0.5),
        'hy_filt_b1': nrm(ks[6], (DEPTH, HY_FILTER_HIDDEN), 0.1),
        'hy_filt_freq1': gain(ks[7], HY_FILTER_HIDDEN),
        'hy_filt_w2': nrm(ks[8], (DEPTH, HY_FILTER_HIDDEN, HY_FILTER_HIDDEN), HY_FILTER_HIDDEN ** -0.5),
        'hy_filt_b2': nrm(ks[9], (DEPTH, HY_FILTER_HIDDEN), 0.1),
        'hy_filt_freq2': gain(ks[10], HY_FILTER_HIDDEN),
        'hy_filt_w3': nrm(ks[11], (DEPTH, HY_FILTER_HIDDEN, HY_ORDER * 2 * HY_D), HY_FILTER_HIDDEN ** -0.5),
        'hy_skip': nrm(ks[12], (DEPTH, HY_ORDER, HY_D), 0.5),
        'gqa_q_norm': gain(ks[13], GQA_HEAD_DIM),
        'gqa_k_norm': gain(ks[14], GQA_HEAD_DIM),
        'mla_q_a_norm': gain(ks[15], MLA_Q_RANK),
        'mla_w_uq': nrm(ks[16], (DEPTH, MLA_Q_RANK, MLA_HEADS * (MLA_NOPE_DIM + MLA_ROPE_DIM)), MLA_Q_RANK ** -0.5),
        'mla_kv_a_norm': gain(ks[17], MLA_KV_RANK),
        'mla_w_ukv': nrm(ks[18], (DEPTH, MLA_KV_RANK, MLA_HEADS * (MLA_NOPE_DIM + MLA_V_DIM)), MLA_KV_RANK ** -0.5),
        'hy_out_norm': gain(ks[19], HY_D),
        'gqa_out_norm': gain(ks[20], GQA_HEADS * GQA_HEAD_DIM),
        'mla_out_norm': gain(ks[21], MLA_HEADS * MLA_V_DIM),
        'w_out': nrm(ks[22], (DEPTH, D_MIX, D_MODEL), D_MIX ** -0.5),
        'mix_post_norm': gain(ks[23], D_MODEL),
        'ffn_pre_norm': gain(ks[24], D_MODEL),
        'w_up': nrm(ks[25], (DEPTH, D_MODEL, 2 * D_FF), D_MODEL ** -0.5),
        'ffn_conv_w': nrm(ks[26], (DEPTH, 3, 2 * D_FF), 3 ** -0.5),
        'ffn_conv_b': nrm(ks[27], (DEPTH, 2 * D_FF), 0.01),
        'w_down': nrm(ks[28], (DEPTH, D_FF, D_MODEL), D_FF ** -0.5),
        'ffn_post_norm': gain(ks[29], D_MODEL),
    }


def reference(x, mix_pre_norm, w_in, hy_conv_w, hy_conv_b, hy_filt_w1, hy_filt_b1, hy_filt_freq1,
              hy_filt_w2, hy_filt_b2, hy_filt_freq2, hy_filt_w3, hy_skip, gqa_q_norm, gqa_k_norm,
              mla_q_a_norm, mla_w_uq, mla_kv_a_norm, mla_w_ukv, hy_out_norm, gqa_out_norm,
              mla_out_norm, w_out, mix_post_norm, ffn_pre_norm, w_up, ffn_conv_w, ffn_conv_b,
              w_down, ffn_post_norm):
    B, L, _ = x.shape
    rows = L // GRID_W
    row_idx = jnp.broadcast_to(jnp.arange(rows)[:, None], (rows, GRID_W)).reshape(L)
    col_idx = jnp.broadcast_to(jnp.arange(GRID_W)[None, :], (rows, GRID_W)).reshape(L)

    cos_g, sin_g = axial_rope_tables(row_idx, col_idx, GQA_HEAD_DIM)
    cos_m, sin_m = axial_rope_tables(row_idx, col_idx, MLA_ROPE_DIM)
    z_pos, window = hyena_position_features(L)
    offsets = [int(o) for o in np.cumsum(IN_SPLITS)[:-1]]

    for l in range(DEPTH):
        h = rms_norm(x, mix_pre_norm[l])
        proj = h @ w_in[l]
        hy_in, gq, gk, gv, mq, mkv, mkr = jnp.split(proj, offsets, axis=-1)

        filters = hyena_filters(z_pos, window, hy_filt_w1[l], hy_filt_b1[l], hy_filt_freq1[l],
                                hy_filt_w2[l], hy_filt_b2[l], hy_filt_freq2[l], hy_filt_w3[l])
        y_hy = hyena_mixer(hy_in, hy_conv_w[l], hy_conv_b[l], filters, hy_skip[l])

        q = rms_norm(gq.reshape(B, L, GQA_HEADS, GQA_HEAD_DIM), gqa_q_norm[l])
        k = rms_norm(gk.reshape(B, L, GQA_KV_HEADS, GQA_HEAD_DIM), gqa_k_norm[l])
        q = apply_rope(q, cos_g[:, None, :], sin_g[:, None, :])
        k = apply_rope(k, cos_g[:, None, :], sin_g[:, None, :])
        v = gv.reshape(B, L, GQA_KV_HEADS, GQA_HEAD_DIM)
        y_gqa = gqa_attention(q, k, v, GQA_HEAD_DIM ** -0.5)

        cq = rms_norm(mq, mla_q_a_norm[l])
        qm = (cq @ mla_w_uq[l]).reshape(B, L, MLA_HEADS, MLA_NOPE_DIM + MLA_ROPE_DIM)
        q_nope, q_pe = jnp.split(qm, [MLA_NOPE_DIM], axis=-1)
        q_pe = apply_rope(q_pe, cos_m[:, None, :], sin_m[:, None, :])
        ckv = rms_norm(mkv, mla_kv_a_norm[l])
        kv = (ckv @ mla_w_ukv[l]).reshape(B, L, MLA_HEADS, MLA_NOPE_DIM + MLA_V_DIM)
        k_nope, v_m = jnp.split(kv, [MLA_NOPE_DIM], axis=-1)
        k_pe = apply_rope(mkr, cos_m, sin_m)
        y_mla = mla_attention(q_nope, q_pe, k_nope, k_pe, v_m,
                              (MLA_NOPE_DIM + MLA_ROPE_DIM) ** -0.5)

        groups = jnp.concatenate([rms_norm(y_hy, hy_out_norm[l]),
                                  rms_norm(y_gqa, gqa_out_norm[l]),
                                  rms_norm(y_mla, mla_out_norm[l])], axis=-1)
        x = x + rms_norm(groups @ w_out[l], mix_post_norm[l])

        h = rms_norm(x, ffn_pre_norm[l])
        up = dwconv3(h @ w_up[l], ffn_conv_w[l], ffn_conv_b[l])
        gate, val = jnp.split(up, 2, axis=-1)
        f = (jax.nn.gelu(gate, approximate=True) * val) @ w_down[l]
        x = x + rms_norm(f, ffn_post_norm[l])
    return x
```

```cpp
#include <hip/hip_runtime.h>
#include <hip/hip_cooperative_groups.h>
#include <cstdio>
#include <cstdint>
namespace cg = cooperative_groups;

typedef unsigned short bf16_t;
typedef short bf16x8 __attribute__((ext_vector_type(8)));
typedef float f32x4 __attribute__((ext_vector_type(4)));
typedef float f32x16 __attribute__((ext_vector_type(16)));
typedef unsigned u32x2 __attribute__((ext_vector_type(2)));
typedef unsigned u32x4 __attribute__((ext_vector_type(4)));

#define DI __device__ __forceinline__
constexpr int L_ = 8192, T_ = 16384, NTHR = 512;
constexpr size_t MiB = 1u << 20;
constexpr size_t O_WIN = 0, O_WUQ = 8 * MiB, O_WUKV = 8 * MiB + 384 * 1024, O_RQ = 8 * MiB + 640 * 1024, O_RKV = 8 * MiB + 704 * 1024;
constexpr size_t O_WOUT = 9 * MiB, O_WUP = 13 * MiB, O_WDOWN = 35 * MiB, O_H2 = 46 * MiB;
constexpr size_t O_R1 = 50 * MiB;
constexpr size_t O_HYT = 114 * MiB;
constexpr size_t O_PROJB = 162 * MiB;
constexpr size_t O_HYOUT = 186 * MiB;
constexpr size_t O_QG = 199 * MiB, O_KG = 215 * MiB, O_VGT = 219 * MiB, O_QM = 223 * MiB, O_KM = 235 * MiB, O_VMT = 247 * MiB;
constexpr size_t O_XN = 223 * MiB;
constexpr size_t LDS_BYTES = 150 * 1024;

struct Params { const float* in[30]; float* out; unsigned char* ws; };

DI bf16_t f2bf(float x) { unsigned u = __float_as_uint(x); u += 0x7fffu + ((u >> 16) & 1u); return (bf16_t)(u >> 16); }
DI float bf2f(bf16_t v) { return __uint_as_float(((unsigned)v) << 16); }
DI unsigned pack2(float lo, float hi) { return (unsigned)f2bf(lo) | ((unsigned)f2bf(hi) << 16); }
DI float wave_sum(float v) {
#pragma unroll
    for (int o = 32; o >= 1; o >>= 1) v += __shfl_xor(v, o);
    return v;
}
DI int tid_fresh() { int t = threadIdx.x; asm volatile("" : "+v"(t)); return t; }
DI int perm16(int t) { return (t & ~15) | (t & 3) | (((t >> 3) & 1) << 2) | (((t >> 2) & 1) << 3); }

DI void convT(unsigned char* lds, const float* __restrict__ W, int K, int N, int Npad, const float* __restrict__ gain, bf16_t* __restrict__ dst, int mode) {
    float* tile = (float*)lds;
    const int tid = tid_fresh();
    const int nkt = K >> 6, nnt = Npad >> 6;
    for (int u = blockIdx.x; u < nkt * nnt; u += gridDim.x) {
        const int kt = u % nkt, ntile = u / nkt;
        const int k0 = kt * 64, n0 = ntile * 64;
        int src0 = n0;
        if (mode == 1) { const int jt = n0 >> 7, half = (n0 >> 6) & 1; src0 = half ? 2816 + 64 * jt : 64 * jt; }
        const bool valid = (mode == 1) || (n0 < N);
#pragma unroll
        for (int i = 0; i < 8; ++i) {
            const int kk = (tid >> 6) + 8 * i, nn = tid & 63;
            float v = 0.f;
            if (valid && (src0 + nn) < N) v = W[(size_t)(k0 + kk) * N + src0 + nn] * (gain ? gain[k0 + kk] : 1.0f);
            tile[kk * 65 + nn] = v;
        }
        __syncthreads();
        {
            const int nn = tid >> 3, kb = (tid & 7) * 8;
            u32x4 w;
            w.x = pack2(tile[(kb + 0) * 65 + nn], tile[(kb + 1) * 65 + nn]);
            w.y = pack2(tile[(kb + 2) * 65 + nn], tile[(kb + 3) * 65 + nn]);
            w.z = pack2(tile[(kb + 4) * 65 + nn], tile[(kb + 5) * 65 + nn]);
            w.w = pack2(tile[(kb + 6) * 65 + nn], tile[(kb + 7) * 65 + nn]);
            *(u32x4*)(dst + (size_t)(n0 + nn) * K + k0 + kb) = w;
        }
        __syncthreads();
    }
}

DI void hy_h2_phase(unsigned char* lds, const Params& p) {
    float* zs = (float*)lds;
    float* h1s = zs + 8 * 36;
    const int tid = tid_fresh(), rr = tid >> 6, j = tid & 63;
    float* h2 = (float*)(p.ws + O_H2);
    for (int u = blockIdx.x; u < 2 * (L_ / 8); u += gridDim.x) {
        const int l = u / (L_ / 8), t = (u % (L_ / 8)) * 8 + rr;
        if (j < 16) {
            const float w = 2.0f * 3.14159265358979323846f * (float)t / (float)L_;
            const float f = 1e-4f + (15.0f - 1e-4f) * (float)j / 15.0f;
            const float a = f * w;
            zs[rr * 36 + 1 + j] = cosf(a);
            zs[rr * 36 + 17 + j] = -sinf(a);
            if (j == 0) zs[rr * 36] = (float)t / (float)(L_ - 1);
        }
        __syncthreads();
        {
            const float* w1 = p.in[5] + (size_t)l * 33 * 64;
            float s = p.in[6][l * 64 + j];
#pragma unroll
            for (int e = 0; e < 33; ++e) s += zs[rr * 36 + e] * w1[e * 64 + j];
            h1s[rr * 64 + j] = sinf(p.in[7][l * 64 + j] * s);
        }
        __syncthreads();
        {
            const float* w2 = p.in[8] + (size_t)l * 64 * 64;
            float s = p.in[9][l * 64 + j];
#pragma unroll 8
            for (int e = 0; e < 64; ++e) s += h1s[rr * 64 + e] * w2[e * 64 + j];
            h2[((size_t)l * L_ + t) * 64 + j] = sinf(p.in[10][l * 64 + j] * s);
        }
        __syncthreads();
    }
}

DI void rownorm_phase(const float* __restrict__ x, bf16_t* __restrict__ xn) {
    const int tid_ = tid_fresh(); const int lane = tid_ & 63, wid = tid_ >> 6;
    for (int row = blockIdx.x * 8 + wid; row < T_; row += gridDim.x * 8) {
        const float* xr = x + (size_t)row * 1024;
        f32x4 v[4]; float ss = 0.f;
#pragma unroll
        for (int i = 0; i < 4; ++i) { v[i] = *(const f32x4*)(xr + i * 256 + lane * 4); ss += v[i][0] * v[i][0] + v[i][1] * v[i][1] + v[i][2] * v[i][2] + v[i][3] * v[i][3]; }
        ss = wave_sum(ss);
        const float r = rsqrtf(ss * (1.0f / 1024.0f) + 1e-6f);
#pragma unroll
        for (int i = 0; i < 4; ++i) { u32x2 w; w.x = pack2(v[i][0] * r, v[i][1] * r); w.y = pack2(v[i][2] * r, v[i][3] * r); *(u32x2*)(xn + (size_t)row * 1024 + i * 256 + lane * 4) = w; }
    }
}

DI void resid_phase(const float* __restrict__ y, const float* __restrict__ xres, const float* __restrict__ g, float* __restrict__ xout, bf16_t* __restrict__ xn, bool want_xn) {
    const int tid_ = tid_fresh(); const int lane = tid_ & 63, wid = tid_ >> 6;
    for (int row = blockIdx.x * 8 + wid; row < T_; row += gridDim.x * 8) {
        const size_t ro = (size_t)row * 1024;
        f32x4 v[4]; float ss = 0.f;
#pragma unroll
        for (int i = 0; i < 4; ++i) { v[i] = *(const f32x4*)(y + ro + i * 256 + lane * 4); ss += v[i][0] * v[i][0] + v[i][1] * v[i][1] + v[i][2] * v[i][2] + v[i][3] * v[i][3]; }
        ss = wave_sum(ss);
        const float r = rsqrtf(ss * (1.0f / 1024.0f) + 1e-6f);
        float s2 = 0.f;
#pragma unroll
        for (int i = 0; i < 4; ++i) {
            const f32x4 xr = *(const f32x4*)(xres + ro + i * 256 + lane * 4);
            const f32x4 gg = *(const f32x4*)(g + i * 256 + lane * 4);
            v[i] = xr + v[i] * r * gg;
            s2 += v[i][0] * v[i][0] + v[i][1] * v[i][1] + v[i][2] * v[i][2] + v[i][3] * v[i][3];
            *(f32x4*)(xout + ro + i * 256 + lane * 4) = v[i];
        }
        if (want_xn) {
            s2 = wave_sum(s2);
            const float r2 = rsqrtf(s2 * (1.0f / 1024.0f) + 1e-6f);
#pragma unroll
            for (int i = 0; i < 4; ++i) { u32x2 w; w.x = pack2(v[i][0] * r2, v[i][1] * r2); w.y = pack2(v[i][2] * r2, v[i][3] * r2); *(u32x2*)(xn + ro + i * 256 + lane * 4) = w; }
        }
    }
}

DI int swz128(int row, int chunk) { return row * 128 + ((chunk ^ ((row >> 1) & 7)) << 4); }

template <bool OVL, class Epi>
DI void gemm_phase(unsigned char* lds, const bf16_t* __restrict__ A, int lda, const bf16_t* __restrict__ Bt, int K, int nMt, int nNt, const Epi& epi) {
    const int tid = tid_fresh(), lane = tid & 63, wid = tid >> 6, wm = wid & 3, wn = wid >> 2;
    const int r16 = lane & 15, q4 = lane >> 4;
    const int nk = K >> 6;
    const int srow = tid >> 3, sc = tid & 7;
    const int sbase = srow * 128 + ((sc ^ ((srow >> 1) & 7)) << 4);
    const int xr = (r16 >> 1) & 7;
    const int ab0 = (64 * wm + r16) * 128 + ((q4 ^ xr) << 4), ab1 = (64 * wm + r16) * 128 + (((4 + q4) ^ xr) << 4);
    const int bb0 = 32768 + (64 * wn + r16) * 128 + ((q4 ^ xr) << 4), bb1 = 32768 + (64 * wn + r16) * 128 + (((4 + q4) ^ xr) << 4);
    for (int u = blockIdx.x; u < nMt * nNt; u += gridDim.x) {
        const int um = u % nMt, un = u / nMt;
        const bf16_t* ap[4]; bool av[4]; const bf16_t* bp[2];
        int t0 = 0, bb = 0;
        if (OVL) { bb = um / 33; t0 = 254 * (um % 33) - 1; }
#pragma unroll
        for (int i = 0; i < 4; ++i) {
            const int row = srow + 64 * i;
            if (OVL) { const int t = t0 + row; av[i] = (t >= 0) && (t < L_); ap[i] = A + (av[i] ? (size_t)((bb * L_ + t) * lda + sc * 8) : (size_t)0); }
            else { av[i] = true; ap[i] = A + (size_t)((um * 256 + row) * lda + sc * 8); }
        }
#pragma unroll
        for (int i = 0; i < 2; ++i) bp[i] = Bt + (size_t)((un * 128 + srow + 64 * i) * K + sc * 8);
        u32x4 ra[4], rb[2];
        f32x4 acc[4][4];
#pragma unroll
        for (int a = 0; a < 4; ++a)
#pragma unroll
            for (int b = 0; b < 4; ++b) acc[a][b] = (f32x4){0.f, 0.f, 0.f, 0.f};
#define G_LOAD() do { _Pragma("unroll") for (int i = 0; i < 4; ++i) { ra[i] = av[i] ? *(const u32x4*)(ap[i]) : (u32x4){0u, 0u, 0u, 0u}; ap[i] += 64; } \
                      _Pragma("unroll") for (int i = 0; i < 2; ++i) { rb[i] = *(const u32x4*)(bp[i]); bp[i] += 64; } } while (0)
#define G_STORE(buf) do { _Pragma("unroll") for (int i = 0; i < 4; ++i) *(u32x4*)(lds + (buf) * 49152 + sbase + i * 8192) = ra[i]; \
                          _Pragma("unroll") for (int i = 0; i < 2; ++i) *(u32x4*)(lds + (buf) * 49152 + 32768 + sbase + i * 8192) = rb[i]; } while (0)
        G_LOAD();
        G_STORE(0);
        __syncthreads();
#pragma unroll 1
        for (int kt = 0; kt < nk; ++kt) {
            const int cur = kt & 1;
            if (kt + 1 < nk) G_LOAD();
            const unsigned char* lb = lds + cur * 49152;
#pragma unroll
            for (int ks = 0; ks < 2; ++ks) {
                bf16x8 af[4], bfr[4];
#pragma unroll
                for (int mt = 0; mt < 4; ++mt) af[mt] = *(const bf16x8*)(lb + (ks ? ab1 : ab0) + mt * 2048);
#pragma unroll
                for (int nt = 0; nt < 4; ++nt) bfr[nt] = *(const bf16x8*)(lb + (ks ? bb1 : bb0) + nt * 2048);
#pragma unroll
                for (int mt = 0; mt < 4; ++mt)
#pragma unroll
                    for (int nt = 0; nt < 4; ++nt) acc[mt][nt] = __builtin_amdgcn_mfma_f32_16x16x32_bf16(bfr[nt], af[mt], acc[mt][nt], 0, 0, 0);
            }
            if (kt + 1 < nk) G_STORE(cur ^ 1);
            __syncthreads();
        }
        int r16e = r16, q4e = q4;
        asm volatile("" : "+v"(r16e), "+v"(q4e));
        if constexpr (Epi::STAGED) {
            epi.staged(lds, acc, um, un, wm, wn, r16e, q4e);
        } else {
#pragma unroll
            for (int mt = 0; mt < 4; ++mt) { epi.row(um * 256 + 64 * wm + 16 * mt + r16e, un * 128 + 64 * wn, q4e, acc[mt]); asm volatile("" ::: "memory"); }
        }
    }
#undef G_LOAD
#undef G_STORE
}

struct EpiIn {
    static constexpr bool STAGED = true;
    float* hyT; bf16_t* projb;
    DI void staged(unsigned char* lds, const f32x4 (&acc)[4][4], int um, int un, int wm, int wn, int r16, int q4) const {
        if (un < 6) {
            float* st = (float*)lds + (wm + 4 * wn) * (64 * 65);
#pragma unroll
            for (int mt = 0; mt < 4; ++mt)
#pragma unroll
                for (int nt = 0; nt < 4; ++nt)
#pragma unroll
                    for (int i = 0; i < 4; ++i) st[(16 * nt + 4 * q4 + i) * 65 + 16 * mt + r16] = acc[mt][nt][i];
            asm volatile("s_waitcnt lgkmcnt(0)" ::: "memory");
            const int lane = r16 + 16 * q4;
            float* dst = hyT + (size_t)(un * 128 + 64 * wn) * T_ + um * 256 + 64 * wm + lane;
#pragma unroll 4
            for (int n = 0; n < 64; ++n) dst[(size_t)n * T_] = st[n * 65 + lane];
            __syncthreads();
        } else {
#pragma unroll
            for (int mt = 0; mt < 4; ++mt) {
                const int tok = um * 256 + 64 * wm + 16 * mt + r16;
#pragma unroll
                for (int nt = 0; nt < 4; ++nt) {
                    const int col = un * 128 + 64 * wn + 16 * nt + 4 * q4;
                    if (col < 1952) {
                        u32x2 w; w.x = pack2(acc[mt][nt][0], acc[mt][nt][1]); w.y = pack2(acc[mt][nt][2], acc[mt][nt][3]);
                        *(u32x2*)(projb + (unsigned)(tok * 1184 + (col - 768))) = w;
                    }
                }
            }
        }
    }
};
struct EpiF32 {
    static constexpr bool STAGED = false;
    float* C; int ldc;
    DI void row(int tok, int colbase, int q4, const f32x4 (&a)[4]) const {
#pragma unroll
        for (int nt = 0; nt < 4; ++nt) *(f32x4*)(C + (size_t)tok * ldc + colbase + 16 * nt + 4 * q4) = a[nt];
    }
};
struct EpiUq {
    static constexpr bool STAGED = false;
    bf16_t* Qm; const float* rq; float sc;
    DI void row(int tok, int colbase, int q4, const f32x4 (&a)[4]) const {
        const float r = rq[tok] * sc;
        const int b = tok >> 13, t = tok & (L_ - 1);
#pragma unroll
        for (int nt = 0; nt < 4; ++nt) {
            const int col = colbase + 16 * nt + 4 * q4;
            if (col >= 384) continue;
            const int head = col / 96, j = col - head * 96;
            bf16_t* dst = Qm + ((size_t)(b * 4 + head) * L_ + t) * 96;
            if (j < 64) {
                u32x2 w; w.x = pack2(a[nt][0] * r, a[nt][1] * r); w.y = pack2(a[nt][2] * r, a[nt][3] * r);
                *(u32x2*)(dst + j) = w;
            } else if (j < 80) {
                if (nt < 3) {
                    const int p0 = j - 64;
                    float o1[4], o2[4];
#pragma unroll
                    for (int i = 0; i < 4; ++i) {
                        const int pp = p0 + i;
                        const float inv = __expf(-(float)(pp & 7) * (9.210340371976184f / 8.0f));
                        const float ang = (float)((pp < 8) ? (t >> 6) : (t & 63)) * inv;
                        float sn, cs; sincosf(ang, &sn, &cs);
                        const float x1 = a[nt][i] * r, x2 = a[(nt < 3) ? nt + 1 : 3][i] * r;
                        o1[i] = x1 * cs - x2 * sn; o2[i] = x1 * sn + x2 * cs;
                    }
                    u32x2 w; w.x = pack2(o1[0], o1[1]); w.y = pack2(o1[2], o1[3]);
                    *(u32x2*)(dst + j) = w;
                    w.x = pack2(o2[0], o2[1]); w.y = pack2(o2[2], o2[3]);
                    *(u32x2*)(dst + j + 16) = w;
                }
            }
        }
    }
};
struct EpiUkv {
    static constexpr bool STAGED = false;
    bf16_t* Km; bf16_t* VmT; const float* rkv;
    DI void row(int tok, int colbase, int q4, const f32x4 (&a)[4]) const {
        const float r = rkv[tok];
        const int b = tok >> 13, t = tok & (L_ - 1);
#pragma unroll
        for (int nt = 0; nt < 4; ++nt) {
            const int col = colbase + 16 * nt + 4 * q4;
            const int head = col >> 7, j = col & 127;
            if (j < 64) {
                u32x2 w; w.x = pack2(a[nt][0] * r, a[nt][1] * r); w.y = pack2(a[nt][2] * r, a[nt][3] * r);
                *(u32x2*)(Km + ((size_t)(b * 4 + head) * L_ + t) * 96 + j) = w;
            } else {
#pragma unroll
                for (int i = 0; i < 4; ++i) VmT[((size_t)(b * 4 + head) * 64 + (j - 64 + i)) * L_ + perm16(t)] = f2bf(a[nt][i] * r);
            }
        }
    }
};
DI float gelu_tanh(float x) {
    const float u = 0.7978845608028654f * (x + 0.044715f * x * x * x);
    const float e = __expf(2.0f * u);
    const float th = 1.0f - 2.0f / (e + 1.0f);
    return 0.5f * x * (1.0f + th);
}
struct EpiUp {
    static constexpr bool STAGED = true;
    bf16_t* act; const float* cw; const float* cb;
    DI void staged(unsigned char* lds, const f32x4 (&acc)[4][4], int um, int un, int wm, int wn, int r16, int q4) const {
        float* st = (float*)lds;
#pragma unroll
        for (int mt = 0; mt < 4; ++mt)
#pragma unroll
            for (int nt = 0; nt < 4; ++nt) *(f32x4*)(st + (64 * wm + 16 * mt + r16) * 132 + 64 * wn + 16 * nt + 4 * q4) = acc[mt][nt];
        __syncthreads();
        const int tid = tid_fresh(), j = tid & 63, seg = tid >> 6;
        const int ch = 64 * un + j;
        const float g0 = cw[ch], g1 = cw[5632 + ch], g2 = cw[2 * 5632 + ch], gb = cb[ch];
        const float v0 = cw[2816 + ch], v1 = cw[5632 + 2816 + ch], v2 = cw[2 * 5632 + 2816 + ch], vb = cb[2816 + ch];
        const int bb = um / 33, t0 = 254 * (um % 33) - 1;
        const int r0 = 32 * seg;
        float gp = (r0 >= 1) ? st[(r0 - 1) * 132 + j] : 0.f, vp = (r0 >= 1) ? st[(r0 - 1) * 132 + 64 + j] : 0.f;
        float gc = st[r0 * 132 + j], vc = st[r0 * 132 + 64 + j];
#pragma unroll 4
        for (int i = 0; i < 32; ++i) {
            const int r = r0 + i;
            const float gn = (r + 1 <= 255) ? st[(r + 1) * 132 + j] : 0.f, vn = (r + 1 <= 255) ? st[(r + 1) * 132 + 64 + j] : 0.f;
            const int t = t0 + r;
            if (r >= 1 && r <= 254 && t < L_) {
                const float cg = g0 * gp + g1 * gc + g2 * gn + gb;
                const float cv = v0 * vp + v1 * vc + v2 * vn + vb;
                act[(size_t)(bb * L_ + t) * 2816 + ch] = f2bf(gelu_tanh(cg) * cv);
            }
            gp = gc; gc = gn; vp = vc; vc = vn;
        }
        __syncthreads();
    }
};

DI void prep_phase(const Params& p, int l) {
    const int tid_ = tid_fresh(); const int lane = tid_ & 63, wid = tid_ >> 6;
    const bf16_t* projb = (const bf16_t*)(p.ws + O_PROJB);
    bf16_t* Qg = (bf16_t*)(p.ws + O_QG); bf16_t* Kg = (bf16_t*)(p.ws + O_KG); bf16_t* VgT = (bf16_t*)(p.ws + O_VGT);
    bf16_t* Km = (bf16_t*)(p.ws + O_KM);
    float* rq = (float*)(p.ws + O_RQ); float* rkv = (float*)(p.ws + O_RKV);
    const float* gq = p.in[13] + l * 64; const float* gk = p.in[14] + l * 64;
    const int hd = lane >> 3, sub = lane & 7;
    float gq1[4], gq2[4], gk1[4], gk2[4];
#pragma unroll
    for (int i = 0; i < 4; ++i) { gq1[i] = gq[4 * sub + i]; gq2[i] = gq[32 + 4 * sub + i]; gk1[i] = gk[4 * sub + i]; gk2[i] = gk[32 + 4 * sub + i]; }
    const float qscale = 0.125f * 1.4426950408889634f;
    for (int tok = blockIdx.x * 8 + wid; tok < T_; tok += gridDim.x * 8) {
        const int b = tok >> 13, t = tok & (L_ - 1);
        const bf16_t* pr = projb + (size_t)tok * 1184;
        float cs[4], sn[4];
#pragma unroll
        for (int i = 0; i < 4; ++i) {
            const int pp = 4 * sub + i;
            const float inv = __expf(-(float)(pp & 15) * (9.210340371976184f / 16.0f));
            const float ang = (float)((pp < 16) ? (t >> 6) : (t & 63)) * inv;
            sincosf(ang, &sn[i], &cs[i]);
        }
        {
            const u32x2 w1 = *(const u32x2*)(pr + hd * 64 + 4 * sub), w2 = *(const u32x2*)(pr + hd * 64 + 32 + 4 * sub);
            float x1[4] = {bf2f((bf16_t)(w1.x & 0xffff)), bf2f((bf16_t)(w1.x >> 16)), bf2f((bf16_t)(w1.y & 0xffff)), bf2f((bf16_t)(w1.y >> 16))};
            float x2[4] = {bf2f((bf16_t)(w2.x & 0xffff)), bf2f((bf16_t)(w2.x >> 16)), bf2f((bf16_t)(w2.y & 0xffff)), bf2f((bf16_t)(w2.y >> 16))};
            float ss = 0.f;
#pragma unroll
            for (int i = 0; i < 4; ++i) ss += x1[i] * x1[i] + x2[i] * x2[i];
            ss += __shfl_xor(ss, 1); ss += __shfl_xor(ss, 2); ss += __shfl_xor(ss, 4);
            const float r = rsqrtf(ss * (1.0f / 64.0f) + 1e-6f);
            float o1[4], o2[4];
#pragma unroll
            for (int i = 0; i < 4; ++i) { const float a = x1[i] * r * gq1[i], c = x2[i] * r * gq2[i]; o1[i] = (a * cs[i] - c * sn[i]) * qscale; o2[i] = (a * sn[i] + c * cs[i]) * qscale; }
            bf16_t* dst = Qg + ((size_t)(b * 8 + hd) * L_ + t) * 64;
            u32x2 w; w.x = pack2(o1[0], o1[1]); w.y = pack2(o1[2], o1[3]); *(u32x2*)(dst + 4 * sub) = w;
            w.x = pack2(o2[0], o2[1]); w.y = pack2(o2[2], o2[3]); *(u32x2*)(dst + 32 + 4 * sub) = w;
        }
        if (lane < 16) {
            const u32x2 w1 = *(const u32x2*)(pr + 512 + hd * 64 + 4 * sub), w2 = *(const u32x2*)(pr + 512 + hd * 64 + 32 + 4 * sub);
            float x1[4] = {bf2f((bf16_t)(w1.x & 0xffff)), bf2f((bf16_t)(w1.x >> 16)), bf2f((bf16_t)(w1.y & 0xffff)), bf2f((bf16_t)(w1.y >> 16))};
            float x2[4] = {bf2f((bf16_t)(w2.x & 0xffff)), bf2f((bf16_t)(w2.x >> 16)), bf2f((bf16_t)(w2.y & 0xffff)), bf2f((bf16_t)(w2.y >> 16))};
            float ss = 0.f;
#pragma unroll
            for (int i = 0; i < 4; ++i) ss += x1[i] * x1[i] + x2[i] * x2[i];
            ss += __shfl_xor(ss, 1); ss += __shfl_xor(ss, 2); ss += __shfl_xor(ss, 4);
            const float r = rsqrtf(ss * (1.0f / 64.0f) + 1e-6f);
            float o1[4], o2[4];
#pragma unroll
            for (int i = 0; i < 4; ++i) { const float a = x1[i] * r * gk1[i], c = x2[i] * r * gk2[i]; o1[i] = a * cs[i] - c * sn[i]; o2[i] = a * sn[i] + c * cs[i]; }
            bf16_t* dst = Kg + ((size_t)(b * 2 + hd) * L_ + t) * 64;
            u32x2 w; w.x = pack2(o1[0], o1[1]); w.y = pack2(o1[2], o1[3]); *(u32x2*)(dst + 4 * sub) = w;
            w.x = pack2(o2[0], o2[1]); w.y = pack2(o2[2], o2[3]); *(u32x2*)(dst + 32 + 4 * sub) = w;
        }
        {
            const unsigned w = *(const unsigned*)(pr + 640 + 2 * lane);
            const int c0 = 2 * lane, kh = c0 >> 6, d = c0 & 63;
            bf16_t* dst = VgT + ((size_t)(b * 2 + kh) * 64 + d) * L_ + perm16(t);
            dst[0] = (bf16_t)(w & 0xffff); dst[L_] = (bf16_t)(w >> 16);
        }
        {
            const u32x2 w = *(const u32x2*)(pr + 768 + 4 * lane);
            const float a0 = bf2f((bf16_t)(w.x & 0xffff)), a1 = bf2f((bf16_t)(w.x >> 16)), a2 = bf2f((bf16_t)(w.y & 0xffff)), a3 = bf2f((bf16_t)(w.y >> 16));
            float ss = wave_sum(a0 * a0 + a1 * a1 + a2 * a2 + a3 * a3);
            if (lane == 0) rq[tok] = rsqrtf(ss * (1.0f / 256.0f) + 1e-6f);
        }
        {
            const unsigned w = *(const unsigned*)(pr + 1024 + 2 * lane);
            const float a0 = bf2f((bf16_t)(w & 0xffff)), a1 = bf2f((bf16_t)(w >> 16));
            float ss = wave_sum(a0 * a0 + a1 * a1);
            if (lane == 0) rkv[tok] = rsqrtf(ss * (1.0f / 128.0f) + 1e-6f);
        }
        if (lane < 16) {
            const float x1 = bf2f(pr[1152 + lane]), x2 = bf2f(pr[1152 + 16 + lane]);
            const float inv = __expf(-(float)(lane & 7) * (9.210340371976184f / 8.0f));
            const float ang = (float)((lane < 8) ? (t >> 6) : (t & 63)) * inv;
            float s1, c1; sincosf(ang, &s1, &c1);
            const bf16_t o1 = f2bf(x1 * c1 - x2 * s1), o2 = f2bf(x1 * s1 + x2 * c1);
#pragma unroll
            for (int hh = 0; hh < 4; ++hh) { bf16_t* dst = Km + ((size_t)(b * 4 + hh) * L_ + t) * 96 + 64; dst[lane] = o1; dst[16 + lane] = o2; }
        }
    }
}

template <int DQK> DI int kswz(int row, int chunk) {
    if (DQK == 64) return row * 128 + ((chunk ^ ((row >> 1) & 7)) << 4);
    else return row * 192 + ((chunk ^ ((row >> 2) & 3)) << 4);
}
template <int DQK>
DI void attn_unit(unsigned char* lds, const bf16_t* __restrict__ Qp, const bf16_t* __restrict__ Kp, const bf16_t* __restrict__ VTp, bf16_t* __restrict__ Yp  ) {
    constexpr int NS = DQK / 16, NC = DQK / 8, KB = 64 * DQK * 2, KVB = KB + 8192;
    const int tid = tid_fresh(), lane = tid & 63, w = tid >> 6, r = lane & 31, h = lane >> 5;
    bf16x8 qf[NS];
#pragma unroll
    for (int s = 0; s < NS; ++s) qf[s] = *(const bf16x8*)(Qp + (size_t)(32 * w + r) * DQK + 16 * s + 8 * h);
    f32x16 o0, o1;
#pragma unroll
    for (int i = 0; i < 16; ++i) { o0[i] = 0.f; o1[i] = 0.f; }
    float m = -1e30f, lsum = 0.f;
    const int k_row0 = tid / NC, k_c0 = tid % NC;
    const int k_row1 = (tid + 512) / NC, k_c1 = (tid + 512) % NC;
    const bool k_two = (DQK == 96) && (tid < 256);
    const int v_row = tid >> 3, v_c = tid & 7;
    u32x4 rk0, rk1, rv;
    rk1 = (u32x4){0u, 0u, 0u, 0u};
#define A_LOAD(kt) do { rk0 = *(const u32x4*)(Kp + (size_t)((kt) * 64 + k_row0) * DQK + k_c0 * 8); \
                        if (k_two) rk1 = *(const u32x4*)(Kp + (size_t)((kt) * 64 + k_row1) * DQK + k_c1 * 8); \
                        rv = *(const u32x4*)(VTp + (size_t)v_row * L_ + (kt) * 64 + v_c * 8); } while (0)
#define A_STORE(buf) do { *(u32x4*)(lds + (buf) * KVB + kswz<DQK>(k_row0, k_c0)) = rk0; \
                          if (k_two) *(u32x4*)(lds + (buf) * KVB + kswz<DQK>(k_row1, k_c1)) = rk1; \
                          *(u32x4*)(lds + (buf) * KVB + KB + swz128(v_row, v_c)) = rv; } while (0)
    A_LOAD(0);
    A_STORE(0);
    __syncthreads();
    constexpr int NKT = L_ / 64;
#pragma unroll 1
    for (int kt = 0; kt < NKT; ++kt) {
        const int cur = kt & 1;
        if (kt + 1 < NKT) A_LOAD(kt + 1);
        const unsigned char* lk = lds + cur * KVB;
        const unsigned char* lv = lk + KB;
        f32x16 s0, s1;
#pragma unroll
        for (int i = 0; i < 16; ++i) { s0[i] = 0.f; s1[i] = 0.f; }
#pragma unroll
        for (int s = 0; s < NS; ++s) {
            const bf16x8 k0 = *(const bf16x8*)(lk + kswz<DQK>(r, 2 * s + h));
            const bf16x8 k1 = *(const bf16x8*)(lk + kswz<DQK>(32 + r, 2 * s + h));
            s0 = __builtin_amdgcn_mfma_f32_32x32x16_bf16(k0, qf[s], s0, 0, 0, 0);
            s1 = __builtin_amdgcn_mfma_f32_32x32x16_bf16(k1, qf[s], s1, 0, 0, 0);
        }
        float mx = s0[0];
#pragma unroll
        for (int i = 1; i < 16; ++i) mx = fmaxf(mx, s0[i]);
#pragma unroll
        for (int i = 0; i < 16; ++i) mx = fmaxf(mx, s1[i]);
        mx = fmaxf(mx, __shfl_xor(mx, 32));
        const float mn = fmaxf(m, mx);
        const float alpha = __builtin_amdgcn_exp2f(m - mn);
        m = mn;
        float ps = 0.f;
#pragma unroll
        for (int i = 0; i < 16; ++i) { s0[i] = __builtin_amdgcn_exp2f(s0[i] - mn); ps += s0[i]; }
#pragma unroll
        for (int i = 0; i < 16; ++i) { s1[i] = __builtin_amdgcn_exp2f(s1[i] - mn); ps += s1[i]; }
        lsum = lsum * alpha + ps;
#pragma unroll
        for (int i = 0; i < 16; ++i) { o0[i] *= alpha; o1[i] *= alpha; }
#pragma unroll
        for (int sub = 0; sub < 2; ++sub)
#pragma unroll
            for (int s2 = 0; s2 < 2; ++s2) {
                u32x4 pw;
                if (sub == 0) { pw.x = pack2(s0[8 * s2 + 0], s0[8 * s2 + 1]); pw.y = pack2(s0[8 * s2 + 2], s0[8 * s2 + 3]); pw.z = pack2(s0[8 * s2 + 4], s0[8 * s2 + 5]); pw.w = pack2(s0[8 * s2 + 6], s0[8 * s2 + 7]); }
                else          { pw.x = pack2(s1[8 * s2 + 0], s1[8 * s2 + 1]); pw.y = pack2(s1[8 * s2 + 2], s1[8 * s2 + 3]); pw.z = pack2(s1[8 * s2 + 4], s1[8 * s2 + 5]); pw.w = pack2(s1[8 * s2 + 6], s1[8 * s2 + 7]); }
                const bf16x8 pf = __builtin_bit_cast(bf16x8, pw);
                const bf16x8 vf0 = *(const bf16x8*)(lv + swz128(r, 4 * sub + 2 * s2 + h));
                const bf16x8 vf1 = *(const bf16x8*)(lv + swz128(32 + r, 4 * sub + 2 * s2 + h));
                o0 = __builtin_amdgcn_mfma_f32_32x32x16_bf16(vf0, pf, o0, 0, 0, 0);
                o1 = __builtin_amdgcn_mfma_f32_32x32x16_bf16(vf1, pf, o1, 0, 0, 0);
            }
        if (kt + 1 < NKT) A_STORE(cur ^ 1);
        __syncthreads();
    }
#undef A_LOAD
#undef A_STORE
    const float lt = lsum + __shfl_xor(lsum, 32);
    const float inv = 1.0f / lt;
    bf16_t* yr = Yp + (size_t)(32 * w + r) * 768;
#pragma unroll
    for (int g = 0; g < 4; ++g) {
        u32x2 wv; wv.x = pack2(o0[4 * g] * inv, o0[4 * g + 1] * inv); wv.y = pack2(o0[4 * g + 2] * inv, o0[4 * g + 3] * inv);
        *(u32x2*)(yr + 8 * g + 4 * h) = wv;
        wv.x = pack2(o1[4 * g] * inv, o1[4 * g + 1] * inv); wv.y = pack2(o1[4 * g + 2] * inv, o1[4 * g + 3] * inv);
        *(u32x2*)(yr + 32 + 8 * g + 4 * h) = wv;
    }
}

DI int pa(int e) { return e + (e >> 4); }
DI float2 cmul(float2 a, float2 b) { return make_float2(a.x * b.x - a.y * b.y, a.x * b.y + a.y * b.x); }
DI float2 cadd(float2 a, float2 b) { return make_float2(a.x + b.x, a.y + b.y); }
DI float2 csub(float2 a, float2 b) { return make_float2(a.x - b.x, a.y - b.y); }
template <bool INV> DI void dft4(float2& a, float2& b, float2& c, float2& d) {
    const float2 t0 = cadd(a, c), t1 = csub(a, c), t2 = cadd(b, d), t3 = csub(b, d);
    const float2 jt3 = INV ? make_float2(-t3.y, t3.x) : make_float2(t3.y, -t3.x);
    a = cadd(t0, t2); c = csub(t0, t2); b = cadd(t1, jt3); d = csub(t1, jt3);
}
template <bool INV> DI float2 tw16(float2 v, int k) {
    const float c1 = 0.9238795325112867f, s1 = 0.3826834323650898f, c2 = 0.7071067811865476f;
    float wr = 1.f, wi = 0.f;
    switch (k) {
        case 0: wr = 1.f; wi = 0.f; break;
        case 1: wr = c1; wi = -s1; break;
        case 2: wr = c2; wi = -c2; break;
        case 3: wr = s1; wi = -c1; break;
        case 4: wr = 0.f; wi = -1.f; break;
        case 6: wr = -c2; wi = -c2; break;
        case 9: wr = -c1; wi = s1; break;
        default: break;
    }
    if (INV) wi = -wi;
    return make_float2(v.x * wr - v.y * wi, v.x * wi + v.y * wr);
}
template <bool INV> DI void dft16(float2 (&x)[16]) {
#pragma unroll
    for (int b = 0; b < 4; ++b) dft4<INV>(x[b], x[b + 4], x[b + 8], x[b + 12]);
#pragma unroll
    for (int b = 1; b < 4; ++b)
#pragma unroll
        for (int pq = 1; pq < 4; ++pq) x[b + 4 * pq] = tw16<INV>(x[b + 4 * pq], b * pq);
#pragma unroll
    for (int pq = 0; pq < 4; ++pq) dft4<INV>(x[4 * pq], x[4 * pq + 1], x[4 * pq + 2], x[4 * pq + 3]);
#pragma unroll
    for (int a = 0; a < 4; ++a)
#pragma unroll
        for (int b = a + 1; b < 4; ++b) { const float2 tmp = x[4 * a + b]; x[4 * a + b] = x[4 * b + a]; x[4 * b + a] = tmp; }
}
template <bool INV> DI void pass_a(float2* Z, const float2* T1, int tid) {
#pragma unroll
    for (int i = 0; i < 8; ++i) {
        const int j = tid + 512 * i;
        float2 x0 = Z[pa(j)], x1 = Z[pa(j + 4096)], x2 = Z[pa(j + 8192)], x3 = Z[pa(j + 12288)];
        float2 w1 = tw16<false>(T1[j & 1023], i >> 1);
        if (INV) w1.y = -w1.y;
        const float2 w2 = cmul(w1, w1), w3 = cmul(w2, w1);
        if (!INV) { dft4<false>(x0, x1, x2, x3); x1 = cmul(x1, w1); x2 = cmul(x2, w2); x3 = cmul(x3, w3); }
        else { x1 = cmul(x1, w1); x2 = cmul(x2, w2); x3 = cmul(x3, w3); dft4<true>(x0, x1, x2, x3); }
        Z[pa(j)] = x0; Z[pa(j + 4096)] = x1; Z[pa(j + 8192)] = x2; Z[pa(j + 12288)] = x3;
    }
}
template <bool INV, int LS, int TS> DI void pass16(float2* Z, const float2* T1, int tid) {
#pragma unroll 1
    for (int i = 0; i < 2; ++i) {
        const int id = tid + 512 * i, j = id & ((1 << LS) - 1), base = (id >> LS) << (LS + 4);
        float2 x[16];
#pragma unroll
        for (int mm = 0; mm < 16; ++mm) x[mm] = Z[pa(base + j + (mm << LS))];
        float2 w1 = T1[j << TS];
        if (INV) w1.y = -w1.y;
        if (!INV) dft16<false>(x);
        float2 wq = w1;
#pragma unroll
        for (int qq = 1; qq < 16; ++qq) { x[qq] = cmul(x[qq], wq); wq = cmul(wq, w1); }
        if (INV) dft16<true>(x);
#pragma unroll
        for (int mm = 0; mm < 16; ++mm) Z[pa(base + j + (mm << LS))] = x[mm];
    }
}
DI void pass_d_store(const float2* Z, float2* __restrict__ Kf, int tid, float scale) {
#pragma unroll 1
    for (int i = 0; i < 2; ++i) {
        const int id = tid + 512 * i, base = id * 16;
        float2 x[16];
#pragma unroll
        for (int mm = 0; mm < 16; ++mm) x[mm] = Z[pa(base + mm)];
        dft16<false>(x);
#pragma unroll
        for (int mm = 0; mm < 16; mm += 2) *(f32x4*)(Kf + base + mm) = (f32x4){x[mm].x * scale, x[mm].y * scale, x[mm + 1].x * scale, x[mm + 1].y * scale};
    }
}
DI void pass_d_mul(float2* Z, const float2* __restrict__ Kf, int tid) {
#pragma unroll 1
    for (int i = 0; i < 2; ++i) {
        const int id = tid + 512 * i, base = id * 16;
        float2 x[16];
#pragma unroll
        for (int mm = 0; mm < 16; ++mm) x[mm] = Z[pa(base + mm)];
        dft16<false>(x);
#pragma unroll
        for (int mm = 0; mm < 16; mm += 2) {
            const f32x4 kk = *(const f32x4*)(Kf + base + mm);
            x[mm] = cmul(x[mm], make_float2(kk[0], kk[1])); x[mm + 1] = cmul(x[mm + 1], make_float2(kk[2], kk[3]));
        }
        dft16<true>(x);
#pragma unroll
        for (int mm = 0; mm < 16; ++mm) Z[pa(base + mm)] = x[mm];
    }
}
DI void fft_conv(float2* Z, const float2* T1, const float2* Kf, int tid) {
    pass_a<false>(Z, T1, tid); __syncthreads();
    pass16<false, 8, 2>(Z, T1, tid); __syncthreads();
    pass16<false, 4, 6>(Z, T1, tid); __syncthreads();
    pass_d_mul(Z, Kf, tid); __syncthreads();
    pass16<true, 4, 6>(Z, T1, tid); __syncthreads();
    pass16<true, 8, 2>(Z, T1, tid); __syncthreads();
    pass_a<true>(Z, T1, tid); __syncthreads();
}

DI void hyena_unit(unsigned char* lds, const Params& p, int l, int c) {
    float2* Z = (float2*)lds;
    float2* T1 = (float2*)(lds + 139264);
    float* w3s = (float*)(lds + 139264 + 8192);
    const int tid = tid_fresh();
    const float* h2 = (const float*)(p.ws + O_H2) + (size_t)l * L_ * 64;
    const float* hyT = (const float*)(p.ws + O_HYT);
    float2* Kf0 = (float2*)(p.ws + O_R1) + (size_t)blockIdx.x * 32768;
    float2* Kf1 = Kf0 + 16384;
    bf16_t* hyout = (bf16_t*)(p.ws + O_HYOUT) + (size_t)c * T_;
    for (int k = tid; k < 1024; k += NTHR) { float sn, cs; sincospif((float)k * (1.0f / 8192.0f), &sn, &cs); T1[k] = make_float2(cs, -sn); }
    if (tid < 256) { const int cc = tid >> 6, j = tid & 63; w3s[cc * 64 + j] = p.in[11][((size_t)l * 64 + j) * 1024 + cc * 256 + c]; }
    __syncthreads();
    {
        const float min_decay = -4.605170185988091f / 1.5f, max_decay = -4.605170185988091f / 0.3f;
        const float dlt = fabsf(min_decay + (max_decay - min_decay) * (float)c / 255.0f);
#pragma unroll 1
        for (int o = 0; o < 2; ++o) {
            const float* wf = w3s + (2 * o) * 64;
            const float* wb = w3s + (2 * o + 1) * 64;
#pragma unroll 1
            for (int t = tid; t < L_; t += NTHR) {
                const float* hr = h2 + (size_t)t * 64;
                float d0 = 0.f, d1 = 0.f;
#pragma unroll
                for (int jj = 0; jj < 16; ++jj) {
                    const f32x4 hv = *(const f32x4*)(hr + 4 * jj);
#pragma unroll
                    for (int e = 0; e < 4; ++e) { d0 += hv[e] * wf[4 * jj + e]; d1 += hv[e] * wb[4 * jj + e]; }
                }
                const float win = expf(-((float)t / (float)(L_ - 1)) * dlt);
                Z[pa(t)] = make_float2(d0 * win, 0.f); Z[pa(16383 - t)] = make_float2(d1 * win, 0.f);
            }
            __syncthreads();
            pass_a<false>(Z, T1, tid); __syncthreads();
            pass16<false, 8, 2>(Z, T1, tid); __syncthreads();
            pass16<false, 4, 6>(Z, T1, tid); __syncthreads();
            pass_d_store(Z, o ? Kf1 : Kf0, tid, 1.0f / 16384.0f); __syncthreads();
        }
    }
    const float* cw = p.in[3] + (size_t)l * 3 * 768; const float* cb = p.in[4] + (size_t)l * 768;
    const float* skip = p.in[12] + (size_t)l * 2 * 256;
    float2* z1buf = Kf0;
    const float vw0 = cw[c], vw1 = cw[768 + c], vw2 = cw[1536 + c], vbb = cb[c];
    const float* uv = hyT + (size_t)c * T_;
#pragma unroll 2
    for (int t = tid; t < L_; t += NTHR) {
        float vv[2];
#pragma unroll
        for (int b = 0; b < 2; ++b) {
            const float* ub = uv + b * L_;
            const float um = (t > 0) ? ub[t - 1] : 0.f, uc = ub[t], up = (t < L_ - 1) ? ub[t + 1] : 0.f;
            vv[b] = vw0 * um + vw1 * uc + vw2 * up + vbb;
        }
        Z[pa(t)] = make_float2(vv[0], vv[1]); Z[pa(t + L_)] = make_float2(0.f, 0.f);
    }
    __syncthreads();
    __threadfence();
    fft_conv(Z, T1, Kf0, tid);
    {
        const int ch = 256 + c;
        const float w0 = cw[ch], w1 = cw[768 + ch], w2 = cw[1536 + ch], bb = cb[ch], sk = skip[c];
        const float* u0 = hyT + (size_t)ch * T_;
#pragma unroll 2
        for (int t = tid; t < L_; t += NTHR) {
            const float2 y = Z[pa(t)];
            float zz[2];
#pragma unroll
            for (int b = 0; b < 2; ++b) {
                const float* ub = u0 + b * L_;
                const float um = (t > 0) ? ub[t - 1] : 0.f, uc = ub[t], up = (t < L_ - 1) ? ub[t + 1] : 0.f;
                const float g = w0 * um + w1 * uc + w2 * up + bb;
                const float* vb = uv + b * L_;
                const float vm = (t > 0) ? vb[t - 1] : 0.f, vc = vb[t], vp = (t < L_ - 1) ? vb[t + 1] : 0.f;
                const float v = vw0 * vm + vw1 * vc + vw2 * vp + vbb;
                zz[b] = g * ((b ? y.y : y.x) + sk * v);
            }
            const float2 z1 = make_float2(zz[0], zz[1]);
            Z[pa(t)] = z1; Z[pa(t + L_)] = make_float2(0.f, 0.f);
            z1buf[t] = z1;
        }
    }
    __syncthreads();
    fft_conv(Z, T1, Kf1, tid);
    {
        const int ch = 512 + c;
        const float w0 = cw[ch], w1 = cw[768 + ch], w2 = cw[1536 + ch], bb = cb[ch], sk = skip[256 + c];
        const float* u0 = hyT + (size_t)ch * T_;
#pragma unroll 2
        for (int t = tid; t < L_; t += NTHR) {
            const float2 y = Z[pa(t)];
            const float2 z1 = z1buf[t];
#pragma unroll
            for (int b = 0; b < 2; ++b) {
                const float* ub = u0 + b * L_;
                const float um = (t > 0) ? ub[t - 1] : 0.f, uc = ub[t], up = (t < L_ - 1) ? ub[t + 1] : 0.f;
                const float g = w0 * um + w1 * uc + w2 * up + bb;
                hyout[b * L_ + t] = f2bf(g * ((b ? y.y : y.x) + sk * (b ? z1.y : z1.x)));
            }
        }
    }
    __syncthreads();
}

DI void groups_phase(unsigned char* lds, const Params& p) {
    bf16_t* tile = (bf16_t*)lds;
    const int tid = tid_fresh(), lane = tid & 63, wid = tid >> 6;
    const bf16_t* hyout = (const bf16_t*)(p.ws + O_HYOUT);
    const bf16_t* Y = (const bf16_t*)(p.ws + O_PROJB);
    bf16_t* G = (bf16_t*)(p.ws + O_HYT);
    for (int u = blockIdx.x; u < T_ / 64; u += gridDim.x) {
        const int tok0 = u * 64;
        {
            const int c = tid >> 1, hf = tid & 1;
            const u32x4* src = (const u32x4*)(hyout + (size_t)c * T_ + tok0 + hf * 32);
#pragma unroll
            for (int i = 0; i < 4; ++i) {
                const u32x4 v = src[i];
                unsigned* d = (unsigned*)(tile + c * 66 + hf * 32 + i * 8);
                d[0] = v.x; d[1] = v.y; d[2] = v.z; d[3] = v.w;
            }
        }
        __syncthreads();
#pragma unroll 1
        for (int i = 0; i < 8; ++i) {
            const int tl = wid * 8 + i, tok = tok0 + tl;
            float hv[4]; float sh = 0.f;
#pragma unroll
            for (int k = 0; k < 4; ++k) { hv[k] = bf2f(tile[(lane + 64 * k) * 66 + tl]); sh += hv[k] * hv[k]; }
            sh = wave_sum(sh);
            const float rh = rsqrtf(sh * (1.0f / 256.0f) + 1e-6f);
            bf16_t* gr = G + (size_t)tok * 1024;
#pragma unroll
            for (int k = 0; k < 4; ++k) gr[lane + 64 * k] = f2bf(hv[k] * rh);
            const bf16_t* yr = Y + (size_t)tok * 768;
            {
                const u32x4 v = *(const u32x4*)(yr + lane * 8);
                float a[8] = {bf2f((bf16_t)(v.x & 0xffff)), bf2f((bf16_t)(v.x >> 16)), bf2f((bf16_t)(v.y & 0xffff)), bf2f((bf16_t)(v.y >> 16)),
                              bf2f((bf16_t)(v.z & 0xffff)), bf2f((bf16_t)(v.z >> 16)), bf2f((bf16_t)(v.w & 0xffff)), bf2f((bf16_t)(v.w >> 16))};
                float ss = 0.f;
#pragma unroll
                for (int k = 0; k < 8; ++k) ss += a[k] * a[k];
                ss = wave_sum(ss);
                const float rr = rsqrtf(ss * (1.0f / 512.0f) + 1e-6f);
                u32x4 w; w.x = pack2(a[0] * rr, a[1] * rr); w.y = pack2(a[2] * rr, a[3] * rr); w.z = pack2(a[4] * rr, a[5] * rr); w.w = pack2(a[6] * rr, a[7] * rr);
                *(u32x4*)(gr + 256 + lane * 8) = w;
            }
            {
                const u32x2 v = *(const u32x2*)(yr + 512 + lane * 4);
                float a[4] = {bf2f((bf16_t)(v.x & 0xffff)), bf2f((bf16_t)(v.x >> 16)), bf2f((bf16_t)(v.y & 0xffff)), bf2f((bf16_t)(v.y >> 16))};
                float ss = wave_sum(a[0] * a[0] + a[1] * a[1] + a[2] * a[2] + a[3] * a[3]);
                const float rr = rsqrtf(ss * (1.0f / 256.0f) + 1e-6f);
                u32x2 w; w.x = pack2(a[0] * rr, a[1] * rr); w.y = pack2(a[2] * rr, a[3] * rr);
                *(u32x2*)(gr + 768 + lane * 4) = w;
            }
        }
        __syncthreads();
    }
}

extern __shared__ __attribute__((aligned(16))) unsigned char smem[];

__global__ void __launch_bounds__(512) fwd_megakernel(Params p) {
    cg::grid_group grid = cg::this_grid();
    unsigned char* lds = smem;
    unsigned char* ws = p.ws;
#pragma unroll 1
    for (int l = 0; l < 2; ++l) {
        convT(lds, p.in[2] + (size_t)l * 1024 * 1952, 1024, 1952, 2048, p.in[1] + l * 1024, (bf16_t*)(ws + O_WIN) + (size_t)l * 2048 * 1024, 0);
        convT(lds, p.in[16] + (size_t)l * 256 * 384, 256, 384, 384, p.in[15] + l * 256, (bf16_t*)(ws + O_WUQ) + (size_t)l * 384 * 256, 0);
        convT(lds, p.in[18] + (size_t)l * 128 * 512, 128, 512, 512, p.in[17] + l * 128, (bf16_t*)(ws + O_WUKV) + (size_t)l * 512 * 128, 0);
        convT(lds, p.in[25] + (size_t)l * 1024 * 5632, 1024, 5632, 5632, p.in[24] + l * 1024, (bf16_t*)(ws + O_WUP) + (size_t)l * 5632 * 1024, 1);
        convT(lds, p.in[28] + (size_t)l * 2816 * 1024, 2816, 1024, 1024, nullptr, (bf16_t*)(ws + O_WDOWN) + (size_t)l * 1024 * 2816, 0);
    }
    {
        float* tile = (float*)lds;
        const int tid = tid_fresh();
        for (int u = blockIdx.x; u < 2 * 16 * 16; u += gridDim.x) {
            const int l = u >> 8, kt = (u & 255) & 15, ntile = (u & 255) >> 4;
            const int k0 = kt * 64, n0 = ntile * 64;
            const float* W = p.in[22] + (size_t)l * 1024 * 1024;
            bf16_t* dst = (bf16_t*)(ws + O_WOUT) + (size_t)l * 1024 * 1024;
#pragma unroll
            for (int i = 0; i < 8; ++i) {
                const int kk = (tid >> 6) + 8 * i, nn = tid & 63, k = k0 + kk;
                const float g = (k < 256) ? p.in[19][l * 256 + k] : (k < 768) ? p.in[20][l * 512 + k - 256] : p.in[21][l * 256 + k - 768];
                tile[kk * 65 + nn] = W[(size_t)k * 1024 + n0 + nn] * g;
            }
            __syncthreads();
            {
                const int nn = tid >> 3, kb = (tid & 7) * 8;
                u32x4 w;
                w.x = pack2(tile[(kb + 0) * 65 + nn], tile[(kb + 1) * 65 + nn]);
                w.y = pack2(tile[(kb + 2) * 65 + nn], tile[(kb + 3) * 65 + nn]);
                w.z = pack2(tile[(kb + 4) * 65 + nn], tile[(kb + 5) * 65 + nn]);
                w.w = pack2(tile[(kb + 6) * 65 + nn], tile[(kb + 7) * 65 + nn]);
                *(u32x4*)(dst + (size_t)(n0 + nn) * 1024 + k0 + kb) = w;
            }
            __syncthreads();
        }
    }
    hy_h2_phase(lds, p);
    rownorm_phase(p.in[0], (bf16_t*)(ws + O_XN));
    grid.sync();

#pragma unroll 1
    for (int l = 0; l < 2; ++l) {
        {
            EpiIn e; e.hyT = (float*)(ws + O_HYT); e.projb = (bf16_t*)(ws + O_PROJB);
            gemm_phase<false>(lds, (const bf16_t*)(ws + O_XN), 1024, (const bf16_t*)(ws + O_WIN) + (size_t)l * 2048 * 1024, 1024, 64, 16, e);
        }
        grid.sync();
        prep_phase(p, l);
        grid.sync();
        {
            EpiUq e; e.Qm = (bf16_t*)(ws + O_QM); e.rq = (const float*)(ws + O_RQ); e.sc = 0.10206207261596577f * 1.4426950408889634f;
            gemm_phase<false>(lds, (const bf16_t*)(ws + O_PROJB) + 768, 1184, (const bf16_t*)(ws + O_WUQ) + (size_t)l * 384 * 256, 256, 64, 3, e);
            EpiUkv e2; e2.Km = (bf16_t*)(ws + O_KM); e2.VmT = (bf16_t*)(ws + O_VMT); e2.rkv = (const float*)(ws + O_RKV);
            gemm_phase<false>(lds, (const bf16_t*)(ws + O_PROJB) + 1024, 1184, (const bf16_t*)(ws + O_WUKV) + (size_t)l * 512 * 128, 128, 64, 4, e2);
        }
        grid.sync();
        for (int c = blockIdx.x; c < 256; c += gridDim.x) hyena_unit(lds, p, l, c);
        for (int u = blockIdx.x; u < 512; u += gridDim.x) {
            const int qt = u & 31, hh = (u >> 5) & 7, b = u >> 8, hk = hh >> 2;
            attn_unit<64>(lds, (const bf16_t*)(ws + O_QG) + ((size_t)(b * 8 + hh) * L_ + qt * 256) * 64,
                          (const bf16_t*)(ws + O_KG) + (size_t)(b * 2 + hk) * L_ * 64,
                          (const bf16_t*)(ws + O_VGT) + (size_t)(b * 2 + hk) * 64 * L_,
                          (bf16_t*)(ws + O_PROJB) + (size_t)(b * L_ + qt * 256) * 768 + hh * 64);
        }
        for (int u = blockIdx.x; u < 256; u += gridDim.x) {
            const int qt = u & 31, hh = (u >> 5) & 3, b = u >> 7;
            attn_unit<96>(lds, (const bf16_t*)(ws + O_QM) + ((size_t)(b * 4 + hh) * L_ + qt * 256) * 96,
                          (const bf16_t*)(ws + O_KM) + (size_t)(b * 4 + hh) * L_ * 96,
                          (const bf16_t*)(ws + O_VMT) + (size_t)(b * 4 + hh) * 64 * L_,
                          (bf16_t*)(ws + O_PROJB) + (size_t)(b * L_ + qt * 256) * 768 + 512 + hh * 64);
        }
        grid.sync();
        groups_phase(lds, p);
        grid.sync();
        {
            EpiF32 e; e.C = (float*)(ws + O_R1); e.ldc = 1024;
            gemm_phase<false>(lds, (const bf16_t*)(ws + O_HYT), 1024, (const bf16_t*)(ws + O_WOUT) + (size_t)l * 1024 * 1024, 1024, 64, 8, e);
        }
        grid.sync();
        resid_phase((const float*)(ws + O_R1), l == 0 ? p.in[0] : p.out, p.in[23] + l * 1024, p.out, (bf16_t*)(ws + O_XN), true);
        grid.sync();
        {
            EpiUp e; e.act = (bf16_t*)(ws + O_HYT); e.cw = p.in[26] + (size_t)l * 3 * 5632; e.cb = p.in[27] + (size_t)l * 5632;
            gemm_phase<true>(lds, (const bf16_t*)(ws + O_XN), 1024, (const bf16_t*)(ws + O_WUP) + (size_t)l * 5632 * 1024, 1024, 66, 44, e);
        }
        grid.sync();
        {
            EpiF32 e; e.C = (float*)(ws + O_R1); e.ldc = 1024;
            gemm_phase<false>(lds, (const bf16_t*)(ws + O_HYT), 2816, (const bf16_t*)(ws + O_WDOWN) + (size_t)l * 1024 * 2816, 2816, 64, 8, e);
        }
        grid.sync();
        resid_phase((const float*)(ws + O_R1), p.out, p.in[29] + l * 1024, p.out, (bf16_t*)(ws + O_XN), l == 0);
        if (l == 0) grid.sync();
    }
}

extern "C" void kernel_launch(void* const* d_in, const int* in_sizes, int n_in,
                              void* d_out, int out_size, void* d_ws, size_t ws_size,
                              hipStream_t stream) {
    static int grid_blocks = 0;
    if (!grid_blocks) {
        int dev = 0, cus = 0, per_cu = 0;
        (void)hipGetDevice(&dev);
        (void)hipDeviceGetAttribute(&cus, hipDeviceAttributeMultiprocessorCount, dev);
        (void)hipFuncSetAttribute((const void*)fwd_megakernel, hipFuncAttributeMaxDynamicSharedMemorySize, (int)LDS_BYTES);
        (void)hipOccupancyMaxActiveBlocksPerMultiprocessor(&per_cu, fwd_megakernel, NTHR, LDS_BYTES);
        if (per_cu < 1) per_cu = 1;
        grid_blocks = cus;
        if (grid_blocks > 256) grid_blocks = 256;
    }
    Params p{};
    for (int i = 0; i < 30; ++i) p.in[i] = (const float*)d_in[i];
    p.out = (float*)d_out; p.ws = (unsigned char*)d_ws;
    void* args[] = {&p};
    hipError_t e = hipLaunchCooperativeKernel((void*)fwd_megakernel, dim3(grid_blocks), dim3(NTHR), args, LDS_BYTES, stream);
    if (e != hipSuccess) fprintf(stderr, "cooperative launch failed: %s (grid %d)\n", hipGetErrorString(e), grid_blocks);
}
```

```cpp
#include <hip/hip_runtime.h>
#include <hip/hip_cooperative_groups.h>
#include <cstdio>
#include <cstdint>
namespace cg = cooperative_groups;

typedef unsigned short bf16_t;
typedef short bf16x8 __attribute__((ext_vector_type(8)));
typedef float f32x4 __attribute__((ext_vector_type(4)));
typedef float f32x16 __attribute__((ext_vector_type(16)));
typedef unsigned u32x2 __attribute__((ext_vector_type(2)));
typedef unsigned u32x4 __attribute__((ext_vector_type(4)));

#define DI __device__ __forceinline__
constexpr int L_ = 8192, T_ = 16384, NTHR = 512;
constexpr size_t MiB = 1u << 20;
constexpr size_t O_WIN = 0, O_WUQ = 8 * MiB, O_WUKV = 8 * MiB + 384 * 1024, O_RQ = 8 * MiB + 640 * 1024, O_RKV = 8 * MiB + 704 * 1024;
constexpr size_t O_WOUT = 9 * MiB, O_WUP = 13 * MiB, O_WDOWN = 35 * MiB, O_H2 = 46 * MiB;
constexpr size_t O_R1 = 50 * MiB;
constexpr size_t O_HYT = 114 * MiB;
constexpr size_t O_PROJB = 162 * MiB;
constexpr size_t O_HYOUT = 186 * MiB;
constexpr size_t O_QG = 199 * MiB, O_KG = 215 * MiB, O_VGT = 219 * MiB, O_QM = 223 * MiB, O_KM = 235 * MiB, O_VMT = 247 * MiB;
constexpr size_t O_XN = 223 * MiB;
constexpr size_t LDS_BYTES = 150 * 1024;

struct Params { const float* in[30]; float* out; unsigned char* ws; };

typedef __bf16 bf16v2_t __attribute__((ext_vector_type(2)));
typedef float f32v2_t __attribute__((ext_vector_type(2)));
DI bf16_t f2bf(float x) { const __bf16 b = (__bf16)x; return __builtin_bit_cast(bf16_t, b); }
DI float bf2f(bf16_t v) { return __uint_as_float(((unsigned)v) << 16); }
DI unsigned pack2(float lo, float hi) { const f32v2_t v = {lo, hi}; const bf16v2_t b = __builtin_convertvector(v, bf16v2_t); return __builtin_bit_cast(unsigned, b); }
DI float wave_sum(float v) {
#pragma unroll
    for (int o = 32; o >= 1; o >>= 1) v += __shfl_xor(v, o);
    return v;
}
DI int tid_fresh() { int t = threadIdx.x; asm volatile("" : "+v"(t)); return t; }
DI int perm16(int t) { return (t & ~15) | (t & 3) | (((t >> 3) & 1) << 2) | (((t >> 2) & 1) << 3); }

DI void convT(unsigned char* lds, const float* __restrict__ W, int K, int N, int Npad, const float* __restrict__ gain, bf16_t* __restrict__ dst, int mode) {
    float* tile = (float*)lds;
    const int tid = tid_fresh();
    const int nkt = K >> 6, nnt = Npad >> 6;
    for (int u = blockIdx.x; u < nkt * nnt; u += gridDim.x) {
        const int kt = u % nkt, ntile = u / nkt;
        const int k0 = kt * 64, n0 = ntile * 64;
        int src0 = n0;
        if (mode == 1) { const int jt = n0 >> 7, half = (n0 >> 6) & 1; src0 = half ? 2816 + 64 * jt : 64 * jt; }
        const bool valid = (mode == 1) || (n0 < N);
#pragma unroll
        for (int i = 0; i < 8; ++i) {
            const int kk = (tid >> 6) + 8 * i, nn = tid & 63;
            float v = 0.f;
            if (valid && (src0 + nn) < N) v = W[(size_t)(k0 + kk) * N + src0 + nn] * (gain ? gain[k0 + kk] : 1.0f);
            tile[kk * 65 + nn] = v;
        }
        __syncthreads();
        {
            const int nn = tid >> 3, kb = (tid & 7) * 8;
            u32x4 w;
            w.x = pack2(tile[(kb + 0) * 65 + nn], tile[(kb + 1) * 65 + nn]);
            w.y = pack2(tile[(kb + 2) * 65 + nn], tile[(kb + 3) * 65 + nn]);
            w.z = pack2(tile[(kb + 4) * 65 + nn], tile[(kb + 5) * 65 + nn]);
            w.w = pack2(tile[(kb + 6) * 65 + nn], tile[(kb + 7) * 65 + nn]);
            *(u32x4*)(dst + (size_t)(n0 + nn) * K + k0 + kb) = w;
        }
        __syncthreads();
    }
}

DI void hy_h2_phase(unsigned char* lds, const Params& p) {
    float* zs = (float*)lds;
    float* h1s = zs + 8 * 36;
    const int tid = tid_fresh(), rr = tid >> 6, j = tid & 63;
    float* h2 = (float*)(p.ws + O_H2);
    for (int u = blockIdx.x; u < 2 * (L_ / 8); u += gridDim.x) {
        const int l = u / (L_ / 8), t = (u % (L_ / 8)) * 8 + rr;
        if (j < 16) {
            const float w = 2.0f * 3.14159265358979323846f * (float)t / (float)L_;
            const float f = 1e-4f + (15.0f - 1e-4f) * (float)j / 15.0f;
            const float a = f * w;
            zs[rr * 36 + 1 + j] = cosf(a);
            zs[rr * 36 + 17 + j] = -sinf(a);
            if (j == 0) zs[rr * 36] = (float)t / (float)(L_ - 1);
        }
        __syncthreads();
        {
            const float* w1 = p.in[5] + (size_t)l * 33 * 64;
            float s = p.in[6][l * 64 + j];
#pragma unroll
            for (int e = 0; e < 33; ++e) s += zs[rr * 36 + e] * w1[e * 64 + j];
            h1s[rr * 64 + j] = sinf(p.in[7][l * 64 + j] * s);
        }
        __syncthreads();
        {
            const float* w2 = p.in[8] + (size_t)l * 64 * 64;
            float s = p.in[9][l * 64 + j];
#pragma unroll 8
            for (int e = 0; e < 64; ++e) s += h1s[rr * 64 + e] * w2[e * 64 + j];
            h2[((size_t)l * L_ + t) * 64 + j] = sinf(p.in[10][l * 64 + j] * s);
        }
        __syncthreads();
    }
}

DI void rownorm_phase(const float* __restrict__ x, bf16_t* __restrict__ xn) {
    const int tid_ = tid_fresh(); const int lane = tid_ & 63, wid = tid_ >> 6;
    for (int row = blockIdx.x * 8 + wid; row < T_; row += gridDim.x * 8) {
        const float* xr = x + (size_t)row * 1024;
        f32x4 v[4]; float ss = 0.f;
#pragma unroll
        for (int i = 0; i < 4; ++i) { v[i] = *(const f32x4*)(xr + i * 256 + lane * 4); ss += v[i][0] * v[i][0] + v[i][1] * v[i][1] + v[i][2] * v[i][2] + v[i][3] * v[i][3]; }
        ss = wave_sum(ss);
        const float r = rsqrtf(ss * (1.0f / 1024.0f) + 1e-6f);
#pragma unroll
        for (int i = 0; i < 4; ++i) { u32x2 w; w.x = pack2(v[i][0] * r, v[i][1] * r); w.y = pack2(v[i][2] * r, v[i][3] * r); *(u32x2*)(xn + (size_t)row * 1024 + i * 256 + lane * 4) = w; }
    }
}

DI void resid_phase(const float* __restrict__ y, const float* __restrict__ xres, const float* __restrict__ g, float* __restrict__ xout, bf16_t* __restrict__ xn, bool want_xn) {
    const int tid_ = tid_fresh(); const int lane = tid_ & 63, wid = tid_ >> 6;
    for (int row = blockIdx.x * 8 + wid; row < T_; row += gridDim.x * 8) {
        const size_t ro = (size_t)row * 1024;
        f32x4 v[4]; float ss = 0.f;
#pragma unroll
        for (int i = 0; i < 4; ++i) { v[i] = *(const f32x4*)(y + ro + i * 256 + lane * 4); ss += v[i][0] * v[i][0] + v[i][1] * v[i][1] + v[i][2] * v[i][2] + v[i][3] * v[i][3]; }
        ss = wave_sum(ss);
        const float r = rsqrtf(ss * (1.0f / 1024.0f) + 1e-6f);
        float s2 = 0.f;
#pragma unroll
        for (int i = 0; i < 4; ++i) {
            const f32x4 xr = *(const f32x4*)(xres + ro + i * 256 + lane * 4);
            const f32x4 gg = *(const f32x4*)(g + i * 256 + lane * 4);
            v[i] = xr + v[i] * r * gg;
            s2 += v[i][0] * v[i][0] + v[i][1] * v[i][1] + v[i][2] * v[i][2] + v[i][3] * v[i][3];
            *(f32x4*)(xout + ro + i * 256 + lane * 4) = v[i];
        }
        if (want_xn) {
            s2 = wave_sum(s2);
            const float r2 = rsqrtf(s2 * (1.0f / 1024.0f) + 1e-6f);
#pragma unroll
            for (int i = 0; i < 4; ++i) { u32x2 w; w.x = pack2(v[i][0] * r2, v[i][1] * r2); w.y = pack2(v[i][2] * r2, v[i][3] * r2); *(u32x2*)(xn + ro + i * 256 + lane * 4) = w; }
        }
    }
}

DI int swz128(int row, int chunk) { return row * 128 + ((chunk ^ ((row >> 1) & 7)) << 4); }

template <bool OVL, class Epi>
DI void gemm_phase(unsigned char* lds, const bf16_t* __restrict__ A, int lda, const bf16_t* __restrict__ Bt, int K, int nMt, int nNt, const Epi& epi) {
    const int tid = tid_fresh(), lane = tid & 63, wid = tid >> 6, wm = wid & 3, wn = wid >> 2;
    const int r16 = lane & 15, q4 = lane >> 4;
    const int nk = K >> 6;
    const int srow = tid >> 3, sc = tid & 7;
    const int sbase = srow * 128 + ((sc ^ ((srow >> 1) & 7)) << 4);
    const int xr = (r16 >> 1) & 7;
    const int ab0 = (64 * wm + r16) * 128 + ((q4 ^ xr) << 4), ab1 = (64 * wm + r16) * 128 + (((4 + q4) ^ xr) << 4);
    const int bb0 = 32768 + (64 * wn + r16) * 128 + ((q4 ^ xr) << 4), bb1 = 32768 + (64 * wn + r16) * 128 + (((4 + q4) ^ xr) << 4);
    for (int u = blockIdx.x; u < nMt * nNt; u += gridDim.x) {
        const int um = u % nMt, un = u / nMt;
        const bf16_t* ap[4]; bool av[4]; const bf16_t* bp[2];
        int t0 = 0, bb = 0;
        if (OVL) { bb = um / 33; t0 = 254 * (um % 33) - 1; }
#pragma unroll
        for (int i = 0; i < 4; ++i) {
            const int row = srow + 64 * i;
            if (OVL) { const int t = t0 + row; av[i] = (t >= 0) && (t < L_); ap[i] = A + (av[i] ? (size_t)((bb * L_ + t) * lda + sc * 8) : (size_t)0); }
            else { av[i] = true; ap[i] = A + (size_t)((um * 256 + row) * lda + sc * 8); }
        }
#pragma unroll
        for (int i = 0; i < 2; ++i) bp[i] = Bt + (size_t)((un * 128 + srow + 64 * i) * K + sc * 8);
        u32x4 ra[4], rb[2];
        f32x4 acc[4][4];
#pragma unroll
        for (int a = 0; a < 4; ++a)
#pragma unroll
            for (int b = 0; b < 4; ++b) acc[a][b] = (f32x4){0.f, 0.f, 0.f, 0.f};
#define G_LOAD() do { _Pragma("unroll") for (int i = 0; i < 4; ++i) { ra[i] = av[i] ? *(const u32x4*)(ap[i]) : (u32x4){0u, 0u, 0u, 0u}; ap[i] += 64; } \
                      _Pragma("unroll") for (int i = 0; i < 2; ++i) { rb[i] = *(const u32x4*)(bp[i]); bp[i] += 64; } } while (0)
#define G_STORE(buf) do { _Pragma("unroll") for (int i = 0; i < 4; ++i) *(u32x4*)(lds + (buf) * 49152 + sbase + i * 8192) = ra[i]; \
                          _Pragma("unroll") for (int i = 0; i < 2; ++i) *(u32x4*)(lds + (buf) * 49152 + 32768 + sbase + i * 8192) = rb[i]; } while (0)
        G_LOAD();
        G_STORE(0);
        __syncthreads();
#pragma unroll 1
        for (int kt = 0; kt < nk; ++kt) {
            const int cur = kt & 1;
            if (kt + 1 < nk) G_LOAD();
            const unsigned char* lb = lds + cur * 49152;
#pragma unroll
            for (int ks = 0; ks < 2; ++ks) {
                bf16x8 af[4], bfr[4];
#pragma unroll
                for (int mt = 0; mt < 4; ++mt) af[mt] = *(const bf16x8*)(lb + (ks ? ab1 : ab0) + mt * 2048);
#pragma unroll
                for (int nt = 0; nt < 4; ++nt) bfr[nt] = *(const bf16x8*)(lb + (ks ? bb1 : bb0) + nt * 2048);
#pragma unroll
                for (int mt = 0; mt < 4; ++mt)
#pragma unroll
                    for (int nt = 0; nt < 4; ++nt) acc[mt][nt] = __builtin_amdgcn_mfma_f32_16x16x32_bf16(bfr[nt], af[mt], acc[mt][nt], 0, 0, 0);
            }
            if (kt + 1 < nk) G_STORE(cur ^ 1);
            __syncthreads();
        }
        int r16e = r16, q4e = q4;
        asm volatile("" : "+v"(r16e), "+v"(q4e));
        if constexpr (Epi::STAGED) {
            epi.staged(lds, acc, um, un, wm, wn, r16e, q4e);
        } else {
#pragma unroll
            for (int mt = 0; mt < 4; ++mt) { epi.row(um * 256 + 64 * wm + 16 * mt + r16e, un * 128 + 64 * wn, q4e, acc[mt]); asm volatile("" ::: "memory"); }
        }
    }
#undef G_LOAD
#undef G_STORE
}

struct EpiIn {
    static constexpr bool STAGED = true;
    float* hyT; bf16_t* projb;
    DI void staged(unsigned char* lds, const f32x4 (&acc)[4][4], int um, int un, int wm, int wn, int r16, int q4) const {
        if (un < 6) {
            float* st = (float*)lds + (wm + 4 * wn) * (64 * 65);
#pragma unroll
            for (int mt = 0; mt < 4; ++mt)
#pragma unroll
                for (int nt = 0; nt < 4; ++nt)
#pragma unroll
                    for (int i = 0; i < 4; ++i) st[(16 * nt + 4 * q4 + i) * 65 + 16 * mt + r16] = acc[mt][nt][i];
            asm volatile("s_waitcnt lgkmcnt(0)" ::: "memory");
            const int lane = r16 + 16 * q4;
            float* dst = hyT + (size_t)(un * 128 + 64 * wn) * T_ + um * 256 + 64 * wm + lane;
#pragma unroll 4
            for (int n = 0; n < 64; ++n) dst[(size_t)n * T_] = st[n * 65 + lane];
            __syncthreads();
        } else {
#pragma unroll
            for (int mt = 0; mt < 4; ++mt) {
                const int tok = um * 256 + 64 * wm + 16 * mt + r16;
#pragma unroll
                for (int nt = 0; nt < 4; ++nt) {
                    const int col = un * 128 + 64 * wn + 16 * nt + 4 * q4;
                    if (col < 1952) {
                        u32x2 w; w.x = pack2(acc[mt][nt][0], acc[mt][nt][1]); w.y = pack2(acc[mt][nt][2], acc[mt][nt][3]);
                        *(u32x2*)(projb + (unsigned)(tok * 1184 + (col - 768))) = w;
                    }
                }
            }
        }
    }
};
struct EpiF32 {
    static constexpr bool STAGED = false;
    float* C; int ldc;
    DI void row(int tok, int colbase, int q4, const f32x4 (&a)[4]) const {
#pragma unroll
        for (int nt = 0; nt < 4; ++nt) *(f32x4*)(C + (size_t)tok * ldc + colbase + 16 * nt + 4 * q4) = a[nt];
    }
};
struct EpiUq {
    static constexpr bool STAGED = false;
    bf16_t* Qm; const float* rq; float sc;
    DI void row(int tok, int colbase, int q4, const f32x4 (&a)[4]) const {
        const float r = rq[tok] * sc;
        const int b = tok >> 13, t = tok & (L_ - 1);
#pragma unroll
        for (int nt = 0; nt < 4; ++nt) {
            const int col = colbase + 16 * nt + 4 * q4;
            if (col >= 384) continue;
            const int head = col / 96, j = col - head * 96;
            bf16_t* dst = Qm + ((size_t)(b * 4 + head) * L_ + t) * 96;
            if (j < 64) {
                u32x2 w; w.x = pack2(a[nt][0] * r, a[nt][1] * r); w.y = pack2(a[nt][2] * r, a[nt][3] * r);
                *(u32x2*)(dst + j) = w;
            } else if (j < 80) {
                if (nt < 3) {
                    const int p0 = j - 64;
                    float o1[4], o2[4];
#pragma unroll
                    for (int i = 0; i < 4; ++i) {
                        const int pp = p0 + i;
                        const float inv = __expf(-(float)(pp & 7) * (9.210340371976184f / 8.0f));
                        const float ang = (float)((pp < 8) ? (t >> 6) : (t & 63)) * inv;
                        float sn, cs; sincosf(ang, &sn, &cs);
                        const float x1 = a[nt][i] * r, x2 = a[(nt < 3) ? nt + 1 : 3][i] * r;
                        o1[i] = x1 * cs - x2 * sn; o2[i] = x1 * sn + x2 * cs;
                    }
                    u32x2 w; w.x = pack2(o1[0], o1[1]); w.y = pack2(o1[2], o1[3]);
                    *(u32x2*)(dst + j) = w;
                    w.x = pack2(o2[0], o2[1]); w.y = pack2(o2[2], o2[3]);
                    *(u32x2*)(dst + j + 16) = w;
                }
            }
        }
    }
};
struct EpiUkv {
    static constexpr bool STAGED = false;
    bf16_t* Km; bf16_t* VmT; const float* rkv;
    DI void row(int tok, int colbase, int q4, const f32x4 (&a)[4]) const {
        const float r = rkv[tok];
        const int b = tok >> 13, t = tok & (L_ - 1);
#pragma unroll
        for (int nt = 0; nt < 4; ++nt) {
            const int col = colbase + 16 * nt + 4 * q4;
            const int head = col >> 7, j = col & 127;
            if (j < 64) {
                u32x2 w; w.x = pack2(a[nt][0] * r, a[nt][1] * r); w.y = pack2(a[nt][2] * r, a[nt][3] * r);
                *(u32x2*)(Km + ((size_t)(b * 4 + head) * L_ + t) * 96 + j) = w;
            } else {
#pragma unroll
                for (int i = 0; i < 4; ++i) VmT[((size_t)(b * 4 + head) * 64 + (j - 64 + i)) * L_ + perm16(t)] = f2bf(a[nt][i] * r);
            }
        }
    }
};
DI float gelu_tanh(float x) {
    const float u = 0.7978845608028654f * (x + 0.044715f * x * x * x);
    const float e = __expf(2.0f * u);
    const float th = 1.0f - 2.0f / (e + 1.0f);
    return 0.5f * x * (1.0f + th);
}
struct EpiUp {
    static constexpr bool STAGED = true;
    bf16_t* act; const float* cw; const float* cb;
    DI void staged(unsigned char* lds, const f32x4 (&acc)[4][4], int um, int un, int wm, int wn, int r16, int q4) const {
        float* st = (float*)lds;
#pragma unroll
        for (int mt = 0; mt < 4; ++mt)
#pragma unroll
            for (int nt = 0; nt < 4; ++nt) *(f32x4*)(st + (64 * wm + 16 * mt + r16) * 132 + 64 * wn + 16 * nt + 4 * q4) = acc[mt][nt];
        __syncthreads();
        const int tid = tid_fresh(), j = tid & 63, seg = tid >> 6;
        const int ch = 64 * un + j;
        const float g0 = cw[ch], g1 = cw[5632 + ch], g2 = cw[2 * 5632 + ch], gb = cb[ch];
        const float v0 = cw[2816 + ch], v1 = cw[5632 + 2816 + ch], v2 = cw[2 * 5632 + 2816 + ch], vb = cb[2816 + ch];
        const int bb = um / 33, t0 = 254 * (um % 33) - 1;
        const int r0 = 32 * seg;
        float gp = (r0 >= 1) ? st[(r0 - 1) * 132 + j] : 0.f, vp = (r0 >= 1) ? st[(r0 - 1) * 132 + 64 + j] : 0.f;
        float gc = st[r0 * 132 + j], vc = st[r0 * 132 + 64 + j];
#pragma unroll 4
        for (int i = 0; i < 32; ++i) {
            const int r = r0 + i;
            const float gn = (r + 1 <= 255) ? st[(r + 1) * 132 + j] : 0.f, vn = (r + 1 <= 255) ? st[(r + 1) * 132 + 64 + j] : 0.f;
            const int t = t0 + r;
            if (r >= 1 && r <= 254 && t < L_) {
                const float cg = g0 * gp + g1 * gc + g2 * gn + gb;
                const float cv = v0 * vp + v1 * vc + v2 * vn + vb;
                act[(size_t)(bb * L_ + t) * 2816 + ch] = f2bf(gelu_tanh(cg) * cv);
            }
            gp = gc; gc = gn; vp = vc; vc = vn;
        }
        __syncthreads();
    }
};

DI void prep_phase(const Params& p, int l) {
    const int tid_ = tid_fresh(); const int lane = tid_ & 63, wid = tid_ >> 6;
    const bf16_t* projb = (const bf16_t*)(p.ws + O_PROJB);
    bf16_t* Qg = (bf16_t*)(p.ws + O_QG); bf16_t* Kg = (bf16_t*)(p.ws + O_KG); bf16_t* VgT = (bf16_t*)(p.ws + O_VGT);
    bf16_t* Km = (bf16_t*)(p.ws + O_KM);
    float* rq = (float*)(p.ws + O_RQ); float* rkv = (float*)(p.ws + O_RKV);
    const float* gq = p.in[13] + l * 64; const float* gk = p.in[14] + l * 64;
    const int hd = lane >> 3, sub = lane & 7;
    float gq1[4], gq2[4], gk1[4], gk2[4];
#pragma unroll
    for (int i = 0; i < 4; ++i) { gq1[i] = gq[4 * sub + i]; gq2[i] = gq[32 + 4 * sub + i]; gk1[i] = gk[4 * sub + i]; gk2[i] = gk[32 + 4 * sub + i]; }
    const float qscale = 0.125f * 1.4426950408889634f;
    for (int tok = blockIdx.x * 8 + wid; tok < T_; tok += gridDim.x * 8) {
        const int b = tok >> 13, t = tok & (L_ - 1);
        const bf16_t* pr = projb + (size_t)tok * 1184;
        float cs[4], sn[4];
#pragma unroll
        for (int i = 0; i < 4; ++i) {
            const int pp = 4 * sub + i;
            const float inv = __expf(-(float)(pp & 15) * (9.210340371976184f / 16.0f));
            const float ang = (float)((pp < 16) ? (t >> 6) : (t & 63)) * inv;
            sincosf(ang, &sn[i], &cs[i]);
        }
        {
            const u32x2 w1 = *(const u32x2*)(pr + hd * 64 + 4 * sub), w2 = *(const u32x2*)(pr + hd * 64 + 32 + 4 * sub);
            float x1[4] = {bf2f((bf16_t)(w1.x & 0xffff)), bf2f((bf16_t)(w1.x >> 16)), bf2f((bf16_t)(w1.y & 0xffff)), bf2f((bf16_t)(w1.y >> 16))};
            float x2[4] = {bf2f((bf16_t)(w2.x & 0xffff)), bf2f((bf16_t)(w2.x >> 16)), bf2f((bf16_t)(w2.y & 0xffff)), bf2f((bf16_t)(w2.y >> 16))};
            float ss = 0.f;
#pragma unroll
            for (int i = 0; i < 4; ++i) ss += x1[i] * x1[i] + x2[i] * x2[i];
            ss += __shfl_xor(ss, 1); ss += __shfl_xor(ss, 2); ss += __shfl_xor(ss, 4);
            const float r = rsqrtf(ss * (1.0f / 64.0f) + 1e-6f);
            float o1[4], o2[4];
#pragma unroll
            for (int i = 0; i < 4; ++i) { const float a = x1[i] * r * gq1[i], c = x2[i] * r * gq2[i]; o1[i] = (a * cs[i] - c * sn[i]) * qscale; o2[i] = (a * sn[i] + c * cs[i]) * qscale; }
            bf16_t* dst = Qg + ((size_t)(b * 8 + hd) * L_ + t) * 64;
            u32x2 w; w.x = pack2(o1[0], o1[1]); w.y = pack2(o1[2], o1[3]); *(u32x2*)(dst + 4 * sub) = w;
            w.x = pack2(o2[0], o2[1]); w.y = pack2(o2[2], o2[3]); *(u32x2*)(dst + 32 + 4 * sub) = w;
        }
        if (lane < 16) {
            const u32x2 w1 = *(const u32x2*)(pr + 512 + hd * 64 + 4 * sub), w2 = *(const u32x2*)(pr + 512 + hd * 64 + 32 + 4 * sub);
            float x1[4] = {bf2f((bf16_t)(w1.x & 0xffff)), bf2f((bf16_t)(w1.x >> 16)), bf2f((bf16_t)(w1.y & 0xffff)), bf2f((bf16_t)(w1.y >> 16))};
            float x2[4] = {bf2f((bf16_t)(w2.x & 0xffff)), bf2f((bf16_t)(w2.x >> 16)), bf2f((bf16_t)(w2.y & 0xffff)), bf2f((bf16_t)(w2.y >> 16))};
            float ss = 0.f;
#pragma unroll
            for (int i = 0; i < 4; ++i) ss += x1[i] * x1[i] + x2[i] * x2[i];
            ss += __shfl_xor(ss, 1); ss += __shfl_xor(ss, 2); ss += __shfl_xor(ss, 4);
            const float r = rsqrtf(ss * (1.0f / 64.0f) + 1e-6f);
            float o1[4], o2[4];
#pragma unroll
            for (int i = 0; i < 4; ++i) { const float a = x1[i] * r * gk1[i], c = x2[i] * r * gk2[i]; o1[i] = a * cs[i] - c * sn[i]; o2[i] = a * sn[i] + c * cs[i]; }
            bf16_t* dst = Kg + ((size_t)(b * 2 + hd) * L_ + t) * 64;
            u32x2 w; w.x = pack2(o1[0], o1[1]); w.y = pack2(o1[2], o1[3]); *(u32x2*)(dst + 4 * sub) = w;
            w.x = pack2(o2[0], o2[1]); w.y = pack2(o2[2], o2[3]); *(u32x2*)(dst + 32 + 4 * sub) = w;
        }
        {
            const unsigned w = *(const unsigned*)(pr + 640 + 2 * lane);
            const int c0 = 2 * lane, kh = c0 >> 6, d = c0 & 63;
            bf16_t* dst = VgT + ((size_t)(b * 2 + kh) * 64 + d) * L_ + perm16(t);
            dst[0] = (bf16_t)(w & 0xffff); dst[L_] = (bf16_t)(w >> 16);
        }
        {
            const u32x2 w = *(const u32x2*)(pr + 768 + 4 * lane);
            const float a0 = bf2f((bf16_t)(w.x & 0xffff)), a1 = bf2f((bf16_t)(w.x >> 16)), a2 = bf2f((bf16_t)(w.y & 0xffff)), a3 = bf2f((bf16_t)(w.y >> 16));
            float ss = wave_sum(a0 * a0 + a1 * a1 + a2 * a2 + a3 * a3);
            if (lane == 0) rq[tok] = rsqrtf(ss * (1.0f / 256.0f) + 1e-6f);
        }
        {
            const unsigned w = *(const unsigned*)(pr + 1024 + 2 * lane);
            const float a0 = bf2f((bf16_t)(w & 0xffff)), a1 = bf2f((bf16_t)(w >> 16));
            float ss = wave_sum(a0 * a0 + a1 * a1);
            if (lane == 0) rkv[tok] = rsqrtf(ss * (1.0f / 128.0f) + 1e-6f);
        }
        if (lane < 16) {
            const float x1 = bf2f(pr[1152 + lane]), x2 = bf2f(pr[1152 + 16 + lane]);
            const float inv = __expf(-(float)(lane & 7) * (9.210340371976184f / 8.0f));
            const float ang = (float)((lane < 8) ? (t >> 6) : (t & 63)) * inv;
            float s1, c1; sincosf(ang, &s1, &c1);
            const bf16_t o1 = f2bf(x1 * c1 - x2 * s1), o2 = f2bf(x1 * s1 + x2 * c1);
#pragma unroll
            for (int hh = 0; hh < 4; ++hh) { bf16_t* dst = Km + ((size_t)(b * 4 + hh) * L_ + t) * 96 + 64; dst[lane] = o1; dst[16 + lane] = o2; }
        }
    }
}

template <int DQK> DI int kswz(int row, int chunk) {
    if (DQK == 64) return row * 128 + ((chunk ^ ((row >> 1) & 7)) << 4);
    else return row * 192 + ((chunk ^ ((row >> 2) & 3)) << 4);
}
template <int DQK>
DI void attn_unit(unsigned char* lds, const bf16_t* __restrict__ Qp, const bf16_t* __restrict__ Kp, const bf16_t* __restrict__ VTp, bf16_t* __restrict__ Yp  ) {
    constexpr int NS = DQK / 16, NC = DQK / 8, KB = 64 * DQK * 2, KVB = KB + 8192;
    const int tid = tid_fresh(), lane = tid & 63, w = tid >> 6, r = lane & 31, h = lane >> 5;
    bf16x8 qf[NS];
#pragma unroll
    for (int s = 0; s < NS; ++s) qf[s] = *(const bf16x8*)(Qp + (size_t)(32 * w + r) * DQK + 16 * s + 8 * h);
    f32x16 o0, o1;
#pragma unroll
    for (int i = 0; i < 16; ++i) { o0[i] = 0.f; o1[i] = 0.f; }
    float m = 0.f, lsum = 0.f;
    const int k_row0 = tid / NC, k_c0 = tid % NC;
    const int k_row1 = (tid + 512) / NC, k_c1 = (tid + 512) % NC;
    const bool k_two = (DQK == 96) && (tid < 256);
    const int v_row = tid >> 3, v_c = tid & 7;
    u32x4 rk0, rk1, rv;
    rk1 = (u32x4){0u, 0u, 0u, 0u};
#define A_LOAD(kt) do { rk0 = *(const u32x4*)(Kp + (size_t)((kt) * 64 + k_row0) * DQK + k_c0 * 8); \
                        if (k_two) rk1 = *(const u32x4*)(Kp + (size_t)((kt) * 64 + k_row1) * DQK + k_c1 * 8); \
                        rv = *(const u32x4*)(VTp + (size_t)v_row * L_ + (kt) * 64 + v_c * 8); } while (0)
#define A_STORE(buf) do { *(u32x4*)(lds + (buf) * KVB + kswz<DQK>(k_row0, k_c0)) = rk0; \
                          if (k_two) *(u32x4*)(lds + (buf) * KVB + kswz<DQK>(k_row1, k_c1)) = rk1; \
                          *(u32x4*)(lds + (buf) * KVB + KB + swz128(v_row, v_c)) = rv; } while (0)
    A_LOAD(0);
    A_STORE(0);
    __syncthreads();
    constexpr int NKT = L_ / 64;
#pragma unroll 1
    for (int kt = 0; kt < NKT; ++kt) {
        const int cur = kt & 1;
        if (kt + 1 < NKT) A_LOAD(kt + 1);
        const unsigned char* lk = lds + cur * KVB;
        const unsigned char* lv = lk + KB;
        f32x16 s0, s1;
        const float negm = -m;
#pragma unroll
        for (int i = 0; i < 16; ++i) { s0[i] = negm; s1[i] = negm; }
#pragma unroll
        for (int s = 0; s < NS; ++s) {
            const bf16x8 k0 = *(const bf16x8*)(lk + kswz<DQK>(r, 2 * s + h));
            const bf16x8 k1 = *(const bf16x8*)(lk + kswz<DQK>(32 + r, 2 * s + h));
            s0 = __builtin_amdgcn_mfma_f32_32x32x16_bf16(k0, qf[s], s0, 0, 0, 0);
            s1 = __builtin_amdgcn_mfma_f32_32x32x16_bf16(k1, qf[s], s1, 0, 0, 0);
        }
        float mx = fmaxf(fmaxf(s0[0], s0[1]), s0[2]);
#pragma unroll
        for (int i = 3; i < 15; i += 2) mx = fmaxf(fmaxf(mx, s0[i]), s0[i + 1]);
        mx = fmaxf(mx, s0[15]);
#pragma unroll
        for (int i = 0; i < 16; i += 2) mx = fmaxf(fmaxf(mx, s1[i]), s1[i + 1]);
        mx = fmaxf(mx, __shfl_xor(mx, 32));
        if (kt == 0 || __any(mx > 8.0f)) {
            const float dm = (kt == 0) ? mx : fmaxf(mx, 0.f);
            const float alpha = (kt == 0) ? 0.f : __builtin_amdgcn_exp2f(-dm);
            m += dm;
            lsum *= alpha;
#pragma unroll
            for (int i = 0; i < 16; ++i) { o0[i] *= alpha; o1[i] *= alpha; s0[i] -= dm; s1[i] -= dm; }
        }
        float ps = 0.f;
#pragma unroll
        for (int i = 0; i < 16; ++i) { s0[i] = __builtin_amdgcn_exp2f(s0[i]); ps += s0[i]; }
#pragma unroll
        for (int i = 0; i < 16; ++i) { s1[i] = __builtin_amdgcn_exp2f(s1[i]); ps += s1[i]; }
        lsum += ps;
#pragma unroll
        for (int sub = 0; sub < 2; ++sub)
#pragma unroll
            for (int s2 = 0; s2 < 2; ++s2) {
                u32x4 pw;
                if (sub == 0) { pw.x = pack2(s0[8 * s2 + 0], s0[8 * s2 + 1]); pw.y = pack2(s0[8 * s2 + 2], s0[8 * s2 + 3]); pw.z = pack2(s0[8 * s2 + 4], s0[8 * s2 + 5]); pw.w = pack2(s0[8 * s2 + 6], s0[8 * s2 + 7]); }
                else          { pw.x = pack2(s1[8 * s2 + 0], s1[8 * s2 + 1]); pw.y = pack2(s1[8 * s2 + 2], s1[8 * s2 + 3]); pw.z = pack2(s1[8 * s2 + 4], s1[8 * s2 + 5]); pw.w = pack2(s1[8 * s2 + 6], s1[8 * s2 + 7]); }
                const bf16x8 pf = __builtin_bit_cast(bf16x8, pw);
                const bf16x8 vf0 = *(const bf16x8*)(lv + swz128(r, 4 * sub + 2 * s2 + h));
                const bf16x8 vf1 = *(const bf16x8*)(lv + swz128(32 + r, 4 * sub + 2 * s2 + h));
                o0 = __builtin_amdgcn_mfma_f32_32x32x16_bf16(vf0, pf, o0, 0, 0, 0);
                o1 = __builtin_amdgcn_mfma_f32_32x32x16_bf16(vf1, pf, o1, 0, 0, 0);
            }
        if (kt + 1 < NKT) A_STORE(cur ^ 1);
        __syncthreads();
    }
#undef A_LOAD
#undef A_STORE
    const float lt = lsum + __shfl_xor(lsum, 32);
    const float inv = 1.0f / lt;
    bf16_t* yr = Yp + (size_t)(32 * w + r) * 768;
#pragma unroll
    for (int g = 0; g < 4; ++g) {
        u32x2 wv; wv.x = pack2(o0[4 * g] * inv, o0[4 * g + 1] * inv); wv.y = pack2(o0[4 * g + 2] * inv, o0[4 * g + 3] * inv);
        *(u32x2*)(yr + 8 * g + 4 * h) = wv;
        wv.x = pack2(o1[4 * g] * inv, o1[4 * g + 1] * inv); wv.y = pack2(o1[4 * g + 2] * inv, o1[4 * g + 3] * inv);
        *(u32x2*)(yr + 32 + 8 * g + 4 * h) = wv;
    }
}

DI int pa(int e) { return e + (e >> 4); }
DI float2 cmul(float2 a, float2 b) { return make_float2(a.x * b.x - a.y * b.y, a.x * b.y + a.y * b.x); }
DI float2 cadd(float2 a, float2 b) { return make_float2(a.x + b.x, a.y + b.y); }
DI float2 csub(float2 a, float2 b) { return make_float2(a.x - b.x, a.y - b.y); }
template <bool INV> DI void dft4(float2& a, float2& b, float2& c, float2& d) {
    const float2 t0 = cadd(a, c), t1 = csub(a, c), t2 = cadd(b, d), t3 = csub(b, d);
    const float2 jt3 = INV ? make_float2(-t3.y, t3.x) : make_float2(t3.y, -t3.x);
    a = cadd(t0, t2); c = csub(t0, t2); b = cadd(t1, jt3); d = csub(t1, jt3);
}
template <bool INV> DI float2 tw16(float2 v, int k) {
    const float c1 = 0.9238795325112867f, s1 = 0.3826834323650898f, c2 = 0.7071067811865476f;
    float wr = 1.f, wi = 0.f;
    switch (k) {
        case 0: wr = 1.f; wi = 0.f; break;
        case 1: wr = c1; wi = -s1; break;
        case 2: wr = c2; wi = -c2; break;
        case 3: wr = s1; wi = -c1; break;
        case 4: wr = 0.f; wi = -1.f; break;
        case 6: wr = -c2; wi = -c2; break;
        case 9: wr = -c1; wi = s1; break;
        default: break;
    }
    if (INV) wi = -wi;
    return make_float2(v.x * wr - v.y * wi, v.x * wi + v.y * wr);
}
template <bool INV> DI void dft16(float2 (&x)[16]) {
#pragma unroll
    for (int b = 0; b < 4; ++b) dft4<INV>(x[b], x[b + 4], x[b + 8], x[b + 12]);
#pragma unroll
    for (int b = 1; b < 4; ++b)
#pragma unroll
        for (int pq = 1; pq < 4; ++pq) x[b + 4 * pq] = tw16<INV>(x[b + 4 * pq], b * pq);
#pragma unroll
    for (int pq = 0; pq < 4; ++pq) dft4<INV>(x[4 * pq], x[4 * pq + 1], x[4 * pq + 2], x[4 * pq + 3]);
#pragma unroll
    for (int a = 0; a < 4; ++a)
#pragma unroll
        for (int b = a + 1; b < 4; ++b) { const float2 tmp = x[4 * a + b]; x[4 * a + b] = x[4 * b + a]; x[4 * b + a] = tmp; }
}
template <bool INV> DI void pass_a(float2* Z, const float2* T1, int tid) {
#pragma unroll
    for (int i = 0; i < 8; ++i) {
        const int j = tid + 512 * i;
        float2 x0 = Z[pa(j)], x1 = Z[pa(j + 4096)], x2 = Z[pa(j + 8192)], x3 = Z[pa(j + 12288)];
        float2 w1 = tw16<false>(T1[j & 1023], i >> 1);
        if (INV) w1.y = -w1.y;
        const float2 w2 = cmul(w1, w1), w3 = cmul(w2, w1);
        if (!INV) { dft4<false>(x0, x1, x2, x3); x1 = cmul(x1, w1); x2 = cmul(x2, w2); x3 = cmul(x3, w3); }
        else { x1 = cmul(x1, w1); x2 = cmul(x2, w2); x3 = cmul(x3, w3); dft4<true>(x0, x1, x2, x3); }
        Z[pa(j)] = x0; Z[pa(j + 4096)] = x1; Z[pa(j + 8192)] = x2; Z[pa(j + 12288)] = x3;
    }
}
template <bool INV, int LS, int TS> DI void pass16(float2* Z, const float2* T1, int tid) {
#pragma unroll 1
    for (int i = 0; i < 2; ++i) {
        const int id = tid + 512 * i, j = id & ((1 << LS) - 1), base = (id >> LS) << (LS + 4);
        float2 x[16];
#pragma unroll
        for (int mm = 0; mm < 16; ++mm) x[mm] = Z[pa(base + j + (mm << LS))];
        float2 w1 = T1[j << TS];
        if (INV) w1.y = -w1.y;
        if (!INV) dft16<false>(x);
        float2 wq = w1;
#pragma unroll
        for (int qq = 1; qq < 16; ++qq) { x[qq] = cmul(x[qq], wq); wq = cmul(wq, w1); }
        if (INV) dft16<true>(x);
#pragma unroll
        for (int mm = 0; mm < 16; ++mm) Z[pa(base + j + (mm << LS))] = x[mm];
    }
}
DI void pass_d_store(const float2* Z, float2* __restrict__ Kf, int tid, float scale) {
#pragma unroll 1
    for (int i = 0; i < 2; ++i) {
        const int id = tid + 512 * i, base = id * 16;
        float2 x[16];
#pragma unroll
        for (int mm = 0; mm < 16; ++mm) x[mm] = Z[pa(base + mm)];
        dft16<false>(x);
#pragma unroll
        for (int mm = 0; mm < 16; mm += 2) *(f32x4*)(Kf + base + mm) = (f32x4){x[mm].x * scale, x[mm].y * scale, x[mm + 1].x * scale, x[mm + 1].y * scale};
    }
}
DI void pass_d_mul(float2* Z, const float2* __restrict__ Kf, int tid) {
#pragma unroll 1
    for (int i = 0; i < 2; ++i) {
        const int id = tid + 512 * i, base = id * 16;
        float2 x[16];
#pragma unroll
        for (int mm = 0; mm < 16; ++mm) x[mm] = Z[pa(base + mm)];
        dft16<false>(x);
#pragma unroll
        for (int mm = 0; mm < 16; mm += 2) {
            const f32x4 kk = *(const f32x4*)(Kf + base + mm);
            x[mm] = cmul(x[mm], make_float2(kk[0], kk[1])); x[mm + 1] = cmul(x[mm + 1], make_float2(kk[2], kk[3]));
        }
        dft16<true>(x);
#pragma unroll
        for (int mm = 0; mm < 16; ++mm) Z[pa(base + mm)] = x[mm];
    }
}
DI void fft_conv(float2* Z, const float2* T1, const float2* Kf, int tid) {
    pass_a<false>(Z, T1, tid); __syncthreads();
    pass16<false, 8, 2>(Z, T1, tid); __syncthreads();
    pass16<false, 4, 6>(Z, T1, tid); __syncthreads();
    pass_d_mul(Z, Kf, tid); __syncthreads();
    pass16<true, 4, 6>(Z, T1, tid); __syncthreads();
    pass16<true, 8, 2>(Z, T1, tid); __syncthreads();
    pass_a<true>(Z, T1, tid); __syncthreads();
}

DI void hyena_unit(unsigned char* lds, const Params& p, int l, int c) {
    float2* Z = (float2*)lds;
    float2* T1 = (float2*)(lds + 139264);
    float* w3s = (float*)(lds + 139264 + 8192);
    const int tid = tid_fresh();
    const float* h2 = (const float*)(p.ws + O_H2) + (size_t)l * L_ * 64;
    const float* hyT = (const float*)(p.ws + O_HYT);
    float2* Kf0 = (float2*)(p.ws + O_R1) + (size_t)blockIdx.x * 32768;
    float2* Kf1 = Kf0 + 16384;
    bf16_t* hyout = (bf16_t*)(p.ws + O_HYOUT) + (size_t)c * T_;
    for (int k = tid; k < 1024; k += NTHR) { float sn, cs; sincospif((float)k * (1.0f / 8192.0f), &sn, &cs); T1[k] = make_float2(cs, -sn); }
    if (tid < 256) { const int cc = tid >> 6, j = tid & 63; w3s[cc * 64 + j] = p.in[11][((size_t)l * 64 + j) * 1024 + cc * 256 + c]; }
    __syncthreads();
    {
        const float min_decay = -4.605170185988091f / 1.5f, max_decay = -4.605170185988091f / 0.3f;
        const float dlt = fabsf(min_decay + (max_decay - min_decay) * (float)c / 255.0f);
#pragma unroll 1
        for (int o = 0; o < 2; ++o) {
            const float* wf = w3s + (2 * o) * 64;
            const float* wb = w3s + (2 * o + 1) * 64;
#pragma unroll 1
            for (int t = tid; t < L_; t += NTHR) {
                const float* hr = h2 + (size_t)t * 64;
                float d0 = 0.f, d1 = 0.f;
#pragma unroll
                for (int jj = 0; jj < 16; ++jj) {
                    const f32x4 hv = *(const f32x4*)(hr + 4 * jj);
#pragma unroll
                    for (int e = 0; e < 4; ++e) { d0 += hv[e] * wf[4 * jj + e]; d1 += hv[e] * wb[4 * jj + e]; }
                }
                const float win = expf(-((float)t / (float)(L_ - 1)) * dlt);
                Z[pa(t)] = make_float2(d0 * win, 0.f); Z[pa(16383 - t)] = make_float2(d1 * win, 0.f);
            }
            __syncthreads();
            pass_a<false>(Z, T1, tid); __syncthreads();
            pass16<false, 8, 2>(Z, T1, tid); __syncthreads();
            pass16<false, 4, 6>(Z, T1, tid); __syncthreads();
            pass_d_store(Z, o ? Kf1 : Kf0, tid, 1.0f / 16384.0f); __syncthreads();
        }
    }
    const float* cw = p.in[3] + (size_t)l * 3 * 768; const float* cb = p.in[4] + (size_t)l * 768;
    const float* skip = p.in[12] + (size_t)l * 2 * 256;
    float2* z1buf = Kf0;
    const float vw0 = cw[c], vw1 = cw[768 + c], vw2 = cw[1536 + c], vbb = cb[c];
    const float* uv = hyT + (size_t)c * T_;
#pragma unroll 2
    for (int t = tid; t < L_; t += NTHR) {
        float vv[2];
#pragma unroll
        for (int b = 0; b < 2; ++b) {
            const float* ub = uv + b * L_;
            const float um = (t > 0) ? ub[t - 1] : 0.f, uc = ub[t], up = (t < L_ - 1) ? ub[t + 1] : 0.f;
            vv[b] = vw0 * um + vw1 * uc + vw2 * up + vbb;
        }
        Z[pa(t)] = make_float2(vv[0], vv[1]); Z[pa(t + L_)] = make_float2(0.f, 0.f);
    }
    __syncthreads();
    __threadfence();
    fft_conv(Z, T1, Kf0, tid);
    {
        const int ch = 256 + c;
        const float w0 = cw[ch], w1 = cw[768 + ch], w2 = cw[1536 + ch], bb = cb[ch], sk = skip[c];
        const float* u0 = hyT + (size_t)ch * T_;
#pragma unroll 2
        for (int t = tid; t < L_; t += NTHR) {
            const float2 y = Z[pa(t)];
            float zz[2];
#pragma unroll
            for (int b = 0; b < 2; ++b) {
                const float* ub = u0 + b * L_;
                const float um = (t > 0) ? ub[t - 1] : 0.f, uc = ub[t], up = (t < L_ - 1) ? ub[t + 1] : 0.f;
                const float g = w0 * um + w1 * uc + w2 * up + bb;
                const float* vb = uv + b * L_;
                const float vm = (t > 0) ? vb[t - 1] : 0.f, vc = vb[t], vp = (t < L_ - 1) ? vb[t + 1] : 0.f;
                const float v = vw0 * vm + vw1 * vc + vw2 * vp + vbb;
                zz[b] = g * ((b ? y.y : y.x) + sk * v);
            }
            const float2 z1 = make_float2(zz[0], zz[1]);
            Z[pa(t)] = z1; Z[pa(t + L_)] = make_float2(0.f, 0.f);
            z1buf[t] = z1;
        }
    }
    __syncthreads();
    fft_conv(Z, T1, Kf1, tid);
    {
        const int ch = 512 + c;
        const float w0 = cw[ch], w1 = cw[768 + ch], w2 = cw[1536 + ch], bb = cb[ch], sk = skip[256 + c];
        const float* u0 = hyT + (size_t)ch * T_;
#pragma unroll 2
        for (int t = tid; t < L_; t += NTHR) {
            const float2 y = Z[pa(t)];
            const float2 z1 = z1buf[t];
#pragma unroll
            for (int b = 0; b < 2; ++b) {
                const float* ub = u0 + b * L_;
                const float um = (t > 0) ? ub[t - 1] : 0.f, uc = ub[t], up = (t < L_ - 1) ? ub[t + 1] : 0.f;
                const float g = w0 * um + w1 * uc + w2 * up + bb;
                hyout[b * L_ + t] = f2bf(g * ((b ? y.y : y.x) + sk * (b ? z1.y : z1.x)));
            }
        }
    }
    __syncthreads();
}

DI void groups_phase(unsigned char* lds, const Params& p) {
    bf16_t* tile = (bf16_t*)lds;
    const int tid = tid_fresh(), lane = tid & 63, wid = tid >> 6;
    const bf16_t* hyout = (const bf16_t*)(p.ws + O_HYOUT);
    const bf16_t* Y = (const bf16_t*)(p.ws + O_PROJB);
    bf16_t* G = (bf16_t*)(p.ws + O_HYT);
    for (int u = blockIdx.x; u < T_ / 64; u += gridDim.x) {
        const int tok0 = u * 64;
        {
            const int c = tid >> 1, hf = tid & 1;
            const u32x4* src = (const u32x4*)(hyout + (size_t)c * T_ + tok0 + hf * 32);
#pragma unroll
            for (int i = 0; i < 4; ++i) {
                const u32x4 v = src[i];
                unsigned* d = (unsigned*)(tile + c * 66 + hf * 32 + i * 8);
                d[0] = v.x; d[1] = v.y; d[2] = v.z; d[3] = v.w;
            }
        }
        __syncthreads();
#pragma unroll 1
        for (int i = 0; i < 8; ++i) {
            const int tl = wid * 8 + i, tok = tok0 + tl;
            float hv[4]; float sh = 0.f;
#pragma unroll
            for (int k = 0; k < 4; ++k) { hv[k] = bf2f(tile[(lane + 64 * k) * 66 + tl]); sh += hv[k] * hv[k]; }
            sh = wave_sum(sh);
            const float rh = rsqrtf(sh * (1.0f / 256.0f) + 1e-6f);
            bf16_t* gr = G + (size_t)tok * 1024;
#pragma unroll
            for (int k = 0; k < 4; ++k) gr[lane + 64 * k] = f2bf(hv[k] * rh);
            const bf16_t* yr = Y + (size_t)tok * 768;
            {
                const u32x4 v = *(const u32x4*)(yr + lane * 8);
                float a[8] = {bf2f((bf16_t)(v.x & 0xffff)), bf2f((bf16_t)(v.x >> 16)), bf2f((bf16_t)(v.y & 0xffff)), bf2f((bf16_t)(v.y >> 16)),
                              bf2f((bf16_t)(v.z & 0xffff)), bf2f((bf16_t)(v.z >> 16)), bf2f((bf16_t)(v.w & 0xffff)), bf2f((bf16_t)(v.w >> 16))};
                float ss = 0.f;
#pragma unroll
                for (int k = 0; k < 8; ++k) ss += a[k] * a[k];
                ss = wave_sum(ss);
                const float rr = rsqrtf(ss * (1.0f / 512.0f) + 1e-6f);
                u32x4 w; w.x = pack2(a[0] * rr, a[1] * rr); w.y = pack2(a[2] * rr, a[3] * rr); w.z = pack2(a[4] * rr, a[5] * rr); w.w = pack2(a[6] * rr, a[7] * rr);
                *(u32x4*)(gr + 256 + lane * 8) = w;
            }
            {
                const u32x2 v = *(const u32x2*)(yr + 512 + lane * 4);
                float a[4] = {bf2f((bf16_t)(v.x & 0xffff)), bf2f((bf16_t)(v.x >> 16)), bf2f((bf16_t)(v.y & 0xffff)), bf2f((bf16_t)(v.y >> 16))};
                float ss = wave_sum(a[0] * a[0] + a[1] * a[1] + a[2] * a[2] + a[3] * a[3]);
                const float rr = rsqrtf(ss * (1.0f / 256.0f) + 1e-6f);
                u32x2 w; w.x = pack2(a[0] * rr, a[1] * rr); w.y = pack2(a[2] * rr, a[3] * rr);
                *(u32x2*)(gr + 768 + lane * 4) = w;
            }
        }
        __syncthreads();
    }
}

extern __shared__ __attribute__((aligned(16))) unsigned char smem[];

__global__ void __launch_bounds__(512) fwd_megakernel(Params p) {
    cg::grid_group grid = cg::this_grid();
    unsigned char* lds = smem;
    unsigned char* ws = p.ws;
#pragma unroll 1
    for (int l = 0; l < 2; ++l) {
        convT(lds, p.in[2] + (size_t)l * 1024 * 1952, 1024, 1952, 2048, p.in[1] + l * 1024, (bf16_t*)(ws + O_WIN) + (size_t)l * 2048 * 1024, 0);
        convT(lds, p.in[16] + (size_t)l * 256 * 384, 256, 384, 384, p.in[15] + l * 256, (bf16_t*)(ws + O_WUQ) + (size_t)l * 384 * 256, 0);
        convT(lds, p.in[18] + (size_t)l * 128 * 512, 128, 512, 512, p.in[17] + l * 128, (bf16_t*)(ws + O_WUKV) + (size_t)l * 512 * 128, 0);
        convT(lds, p.in[25] + (size_t)l * 1024 * 5632, 1024, 5632, 5632, p.in[24] + l * 1024, (bf16_t*)(ws + O_WUP) + (size_t)l * 5632 * 1024, 1);
        convT(lds, p.in[28] + (size_t)l * 2816 * 1024, 2816, 1024, 1024, nullptr, (bf16_t*)(ws + O_WDOWN) + (size_t)l * 1024 * 2816, 0);
    }
    {
        float* tile = (float*)lds;
        const int tid = tid_fresh();
        for (int u = blockIdx.x; u < 2 * 16 * 16; u += gridDim.x) {
            const int l = u >> 8, kt = (u & 255) & 15, ntile = (u & 255) >> 4;
            const int k0 = kt * 64, n0 = ntile * 64;
            const float* W = p.in[22] + (size_t)l * 1024 * 1024;
            bf16_t* dst = (bf16_t*)(ws + O_WOUT) + (size_t)l * 1024 * 1024;
#pragma unroll
            for (int i = 0; i < 8; ++i) {
                const int kk = (tid >> 6) + 8 * i, nn = tid & 63, k = k0 + kk;
                const float g = (k < 256) ? p.in[19][l * 256 + k] : (k < 768) ? p.in[20][l * 512 + k - 256] : p.in[21][l * 256 + k - 768];
                tile[kk * 65 + nn] = W[(size_t)k * 1024 + n0 + nn] * g;
            }
            __syncthreads();
            {
                const int nn = tid >> 3, kb = (tid & 7) * 8;
                u32x4 w;
                w.x = pack2(tile[(kb + 0) * 65 + nn], tile[(kb + 1) * 65 + nn]);
                w.y = pack2(tile[(kb + 2) * 65 + nn], tile[(kb + 3) * 65 + nn]);
                w.z = pack2(tile[(kb + 4) * 65 + nn], tile[(kb + 5) * 65 + nn]);
                w.w = pack2(tile[(kb + 6) * 65 + nn], tile[(kb + 7) * 65 + nn]);
                *(u32x4*)(dst + (size_t)(n0 + nn) * 1024 + k0 + kb) = w;
            }
            __syncthreads();
        }
    }
    hy_h2_phase(lds, p);
    rownorm_phase(p.in[0], (bf16_t*)(ws + O_XN));
    grid.sync();

#pragma unroll 1
    for (int l = 0; l < 2; ++l) {
        {
            EpiIn e; e.hyT = (float*)(ws + O_HYT); e.projb = (bf16_t*)(ws + O_PROJB);
            gemm_phase<false>(lds, (const bf16_t*)(ws + O_XN), 1024, (const bf16_t*)(ws + O_WIN) + (size_t)l * 2048 * 1024, 1024, 64, 16, e);
        }
        grid.sync();
        prep_phase(p, l);
        grid.sync();
        {
            EpiUq e; e.Qm = (bf16_t*)(ws + O_QM); e.rq = (const float*)(ws + O_RQ); e.sc = 0.10206207261596577f * 1.4426950408889634f;
            gemm_phase<false>(lds, (const bf16_t*)(ws + O_PROJB) + 768, 1184, (const bf16_t*)(ws + O_WUQ) + (size_t)l * 384 * 256, 256, 64, 3, e);
            EpiUkv e2; e2.Km = (bf16_t*)(ws + O_KM); e2.VmT = (bf16_t*)(ws + O_VMT); e2.rkv = (const float*)(ws + O_RKV);
            gemm_phase<false>(lds, (const bf16_t*)(ws + O_PROJB) + 1024, 1184, (const bf16_t*)(ws + O_WUKV) + (size_t)l * 512 * 128, 128, 64, 4, e2);
        }
        grid.sync();
        for (int c = blockIdx.x; c < 256; c += gridDim.x) hyena_unit(lds, p, l, c);
        for (int u = blockIdx.x; u < 512; u += gridDim.x) {
            const int qt = u & 31, hh = (u >> 5) & 7, b = u >> 8, hk = hh >> 2;
            attn_unit<64>(lds, (const bf16_t*)(ws + O_QG) + ((size_t)(b * 8 + hh) * L_ + qt * 256) * 64,
                          (const bf16_t*)(ws + O_KG) + (size_t)(b * 2 + hk) * L_ * 64,
                          (const bf16_t*)(ws + O_VGT) + (size_t)(b * 2 + hk) * 64 * L_,
                          (bf16_t*)(ws + O_PROJB) + (size_t)(b * L_ + qt * 256) * 768 + hh * 64);
        }
        for (int u = blockIdx.x; u < 256; u += gridDim.x) {
            const int qt = u & 31, hh = (u >> 5) & 3, b = u >> 7;
            attn_unit<96>(lds, (const bf16_t*)(ws + O_QM) + ((size_t)(b * 4 + hh) * L_ + qt * 256) * 96,
                          (const bf16_t*)(ws + O_KM) + (size_t)(b * 4 + hh) * L_ * 96,
                          (const bf16_t*)(ws + O_VMT) + (size_t)(b * 4 + hh) * 64 * L_,
                          (bf16_t*)(ws + O_PROJB) + (size_t)(b * L_ + qt * 256) * 768 + 512 + hh * 64);
        }
        grid.sync();
        groups_phase(lds, p);
        grid.sync();
        {
            EpiF32 e; e.C = (float*)(ws + O_R1); e.ldc = 1024;
            gemm_phase<false>(lds, (const bf16_t*)(ws + O_HYT), 1024, (const bf16_t*)(ws + O_WOUT) + (size_t)l * 1024 * 1024, 1024, 64, 8, e);
        }
        grid.sync();
        resid_phase((const float*)(ws + O_R1), l == 0 ? p.in[0] : p.out, p.in[23] + l * 1024, p.out, (bf16_t*)(ws + O_XN), true);
        grid.sync();
        {
            EpiUp e; e.act = (bf16_t*)(ws + O_HYT); e.cw = p.in[26] + (size_t)l * 3 * 5632; e.cb = p.in[27] + (size_t)l * 5632;
            gemm_phase<true>(lds, (const bf16_t*)(ws + O_XN), 1024, (const bf16_t*)(ws + O_WUP) + (size_t)l * 5632 * 1024, 1024, 66, 44, e);
        }
        grid.sync();
        {
            EpiF32 e; e.C = (float*)(ws + O_R1); e.ldc = 1024;
            gemm_phase<false>(lds, (const bf16_t*)(ws + O_HYT), 2816, (const bf16_t*)(ws + O_WDOWN) + (size_t)l * 1024 * 2816, 2816, 64, 8, e);
        }
        grid.sync();
        resid_phase((const float*)(ws + O_R1), p.out, p.in[29] + l * 1024, p.out, (bf16_t*)(ws + O_XN), l == 0);
        if (l == 0) grid.sync();
    }
}

extern "C" void kernel_launch(void* const* d_in, const int* in_sizes, int n_in,
                              void* d_out, int out_size, void* d_ws, size_t ws_size,
                              hipStream_t stream) {
    static int grid_blocks = 0;
    if (!grid_blocks) {
        int dev = 0, cus = 0, per_cu = 0;
        (void)hipGetDevice(&dev);
        (void)hipDeviceGetAttribute(&cus, hipDeviceAttributeMultiprocessorCount, dev);
        (void)hipFuncSetAttribute((const void*)fwd_megakernel, hipFuncAttributeMaxDynamicSharedMemorySize, (int)LDS_BYTES);
        (void)hipOccupancyMaxActiveBlocksPerMultiprocessor(&per_cu, fwd_megakernel, NTHR, LDS_BYTES);
        if (per_cu < 1) per_cu = 1;
        grid_blocks = cus;
        if (grid_blocks > 256) grid_blocks = 256;
    }
    Params p{};
    for (int i = 0; i < 30; ++i) p.in[i] = (const float*)d_in[i];
    p.out = (float*)d_out; p.ws = (unsigned char*)d_ws;
    void* args[] = {&p};
    hipError_t e = hipLaunchCooperativeKernel((void*)fwd_megakernel, dim3(grid_blocks), dim3(NTHR), args, LDS_BYTES, stream);
    if (e != hipSuccess) fprintf(stderr, "cooperative launch failed: %s (grid %d)\n", hipGetErrorString(e), grid_blocks);
}
```

```cpp
#include <hip/hip_runtime.h>
#include <hip/hip_cooperative_groups.h>
#include <cstdio>
#include <cstdint>
namespace cg = cooperative_groups;

typedef unsigned short bf16_t;
typedef short bf16x8 __attribute__((ext_vector_type(8)));
typedef float f32x4 __attribute__((ext_vector_type(4)));
typedef float f32x16 __attribute__((ext_vector_type(16)));
typedef unsigned u32x2 __attribute__((ext_vector_type(2)));
typedef unsigned u32x4 __attribute__((ext_vector_type(4)));

#define DI __device__ __forceinline__
#ifndef REP_ATTN
#define REP_ATTN 1
#endif
#ifndef REP_HY
#define REP_HY 1
#endif
#ifndef REP_GEMM
#define REP_GEMM 1
#endif
#ifndef REP_PRO
#define REP_PRO 1
#endif
#ifndef REP_SYNC
#define REP_SYNC 1
#endif
#define XSYNC() do { _Pragma("unroll 1") for (int r_ = 0; r_ < REP_SYNC; ++r_) xcd_barrier(xb); } while (0)
#ifndef REP_EW
#define REP_EW 1
#endif
constexpr int L_ = 8192, T_ = 16384, NTHR = 512;
constexpr size_t MiB = 1u << 20;
constexpr size_t O_WIN = 0, O_WUQ = 8 * MiB, O_WUKV = 8 * MiB + 384 * 1024, O_RQ = 8 * MiB + 640 * 1024, O_RKV = 8 * MiB + 704 * 1024;
constexpr size_t O_BAR = 8 * MiB + 768 * 1024;
constexpr size_t O_WOUT = 9 * MiB, O_WUP = 13 * MiB, O_WDOWN = 35 * MiB, O_H2 = 46 * MiB;
constexpr size_t O_R1 = 50 * MiB;
constexpr size_t O_HYT = 114 * MiB;
constexpr size_t O_PROJB = 162 * MiB;
constexpr size_t O_HYOUT = 186 * MiB;
constexpr size_t O_QG = 199 * MiB, O_KG = 215 * MiB, O_VGT = 219 * MiB, O_QM = 223 * MiB, O_KM = 235 * MiB, O_VMT = 247 * MiB;
constexpr size_t O_XN = 223 * MiB;
constexpr size_t LDS_BYTES = 150 * 1024;

struct Params { const float* in[30]; float* out; unsigned char* ws; };

typedef __bf16 bf16v2_t __attribute__((ext_vector_type(2)));
typedef float f32v2_t __attribute__((ext_vector_type(2)));
DI bf16_t f2bf(float x) { const __bf16 b = (__bf16)x; return __builtin_bit_cast(bf16_t, b); }
DI float bf2f(bf16_t v) { return __uint_as_float(((unsigned)v) << 16); }
DI unsigned pack2(float lo, float hi) { const f32v2_t v = {lo, hi}; const bf16v2_t b = __builtin_convertvector(v, bf16v2_t); return __builtin_bit_cast(unsigned, b); }
DI float wave_sum(float v) {
#pragma unroll
    for (int o = 32; o >= 1; o >>= 1) v += __shfl_xor(v, o);
    return v;
}
DI int tid_fresh() { int t = threadIdx.x; asm volatile("" : "+v"(t)); return t; }
DI int perm16(int t) { return (t & ~15) | (t & 3) | (((t >> 3) & 1) << 2) | (((t >> 2) & 1) << 3); }

DI void convT(unsigned char* lds, const float* __restrict__ W, int K, int N, int Npad, const float* __restrict__ gain, bf16_t* __restrict__ dst, int mode) {
    float* tile = (float*)lds;
    const int tid = tid_fresh();
    const int nkt = K >> 6, nnt = Npad >> 6;
    for (int u = blockIdx.x; u < nkt * nnt; u += gridDim.x) {
        const int kt = u % nkt, ntile = u / nkt;
        const int k0 = kt * 64, n0 = ntile * 64;
        int src0 = n0;
        if (mode == 1) { const int jt = n0 >> 7, half = (n0 >> 6) & 1; src0 = half ? 2816 + 64 * jt : 64 * jt; }
        const bool valid = (mode == 1) || (n0 < N);
#pragma unroll
        for (int i = 0; i < 8; ++i) {
            const int kk = (tid >> 6) + 8 * i, nn = tid & 63;
            float v = 0.f;
            if (valid && (src0 + nn) < N) v = W[(size_t)(k0 + kk) * N + src0 + nn] * (gain ? gain[k0 + kk] : 1.0f);
            tile[kk * 65 + nn] = v;
        }
        __syncthreads();
        {
            const int nn = tid >> 3, kb = (tid & 7) * 8;
            u32x4 w;
            w.x = pack2(tile[(kb + 0) * 65 + nn], tile[(kb + 1) * 65 + nn]);
            w.y = pack2(tile[(kb + 2) * 65 + nn], tile[(kb + 3) * 65 + nn]);
            w.z = pack2(tile[(kb + 4) * 65 + nn], tile[(kb + 5) * 65 + nn]);
            w.w = pack2(tile[(kb + 6) * 65 + nn], tile[(kb + 7) * 65 + nn]);
            *(u32x4*)(dst + (size_t)(n0 + nn) * K + k0 + kb) = w;
        }
        __syncthreads();
    }
}

DI void hy_h2_phase(unsigned char* lds, const Params& p) {
    float* zs = (float*)lds;
    float* h1s = zs + 8 * 36;
    const int tid = tid_fresh(), rr = tid >> 6, j = tid & 63;
    float* h2 = (float*)(p.ws + O_H2);
    for (int u = blockIdx.x; u < 2 * (L_ / 8); u += gridDim.x) {
        const int l = u / (L_ / 8), t = (u % (L_ / 8)) * 8 + rr;
        if (j < 16) {
            const float w = 2.0f * 3.14159265358979323846f * (float)t / (float)L_;
            const float f = 1e-4f + (15.0f - 1e-4f) * (float)j / 15.0f;
            const float a = f * w;
            zs[rr * 36 + 1 + j] = cosf(a);
            zs[rr * 36 + 17 + j] = -sinf(a);
            if (j == 0) zs[rr * 36] = (float)t / (float)(L_ - 1);
        }
        __syncthreads();
        {
            const float* w1 = p.in[5] + (size_t)l * 33 * 64;
            float s = p.in[6][l * 64 + j];
#pragma unroll
            for (int e = 0; e < 33; ++e) s += zs[rr * 36 + e] * w1[e * 64 + j];
            h1s[rr * 64 + j] = sinf(p.in[7][l * 64 + j] * s);
        }
        __syncthreads();
        {
            const float* w2 = p.in[8] + (size_t)l * 64 * 64;
            float s = p.in[9][l * 64 + j];
#pragma unroll 8
            for (int e = 0; e < 64; ++e) s += h1s[rr * 64 + e] * w2[e * 64 + j];
            h2[((size_t)l * L_ + t) * 64 + j] = sinf(p.in[10][l * 64 + j] * s);
        }
        __syncthreads();
    }
}

DI void rownorm_phase(const float* __restrict__ x, bf16_t* __restrict__ xn) {
    const int tid_ = tid_fresh(); const int lane = tid_ & 63, wid = tid_ >> 6;
    for (int row = blockIdx.x * 8 + wid; row < T_; row += gridDim.x * 8) {
        const float* xr = x + (size_t)row * 1024;
        f32x4 v[4]; float ss = 0.f;
#pragma unroll
        for (int i = 0; i < 4; ++i) { v[i] = *(const f32x4*)(xr + i * 256 + lane * 4); ss += v[i][0] * v[i][0] + v[i][1] * v[i][1] + v[i][2] * v[i][2] + v[i][3] * v[i][3]; }
        ss = wave_sum(ss);
        const float r = rsqrtf(ss * (1.0f / 1024.0f) + 1e-6f);
#pragma unroll
        for (int i = 0; i < 4; ++i) { u32x2 w; w.x = pack2(v[i][0] * r, v[i][1] * r); w.y = pack2(v[i][2] * r, v[i][3] * r); *(u32x2*)(xn + (size_t)row * 1024 + i * 256 + lane * 4) = w; }
    }
}

DI void resid_phase(const float* __restrict__ y, const float* __restrict__ xres, const float* __restrict__ g, float* __restrict__ xout, bf16_t* __restrict__ xn, bool want_xn) {
    const int tid_ = tid_fresh(); const int lane = tid_ & 63, wid = tid_ >> 6;
    for (int row = blockIdx.x * 8 + wid; row < T_; row += gridDim.x * 8) {
        const size_t ro = (size_t)row * 1024;
        f32x4 v[4]; float ss = 0.f;
#pragma unroll
        for (int i = 0; i < 4; ++i) { v[i] = *(const f32x4*)(y + ro + i * 256 + lane * 4); ss += v[i][0] * v[i][0] + v[i][1] * v[i][1] + v[i][2] * v[i][2] + v[i][3] * v[i][3]; }
        ss = wave_sum(ss);
        const float r = rsqrtf(ss * (1.0f / 1024.0f) + 1e-6f);
        float s2 = 0.f;
#pragma unroll
        for (int i = 0; i < 4; ++i) {
            const f32x4 xr = *(const f32x4*)(xres + ro + i * 256 + lane * 4);
            const f32x4 gg = *(const f32x4*)(g + i * 256 + lane * 4);
            v[i] = xr + v[i] * r * gg;
            s2 += v[i][0] * v[i][0] + v[i][1] * v[i][1] + v[i][2] * v[i][2] + v[i][3] * v[i][3];
            *(f32x4*)(xout + ro + i * 256 + lane * 4) = v[i];
        }
        if (want_xn) {
            s2 = wave_sum(s2);
            const float r2 = rsqrtf(s2 * (1.0f / 1024.0f) + 1e-6f);
#pragma unroll
            for (int i = 0; i < 4; ++i) { u32x2 w; w.x = pack2(v[i][0] * r2, v[i][1] * r2); w.y = pack2(v[i][2] * r2, v[i][3] * r2); *(u32x2*)(xn + ro + i * 256 + lane * 4) = w; }
        }
    }
}

DI int swz128(int row, int chunk) { return row * 128 + ((chunk ^ ((row >> 1) & 7)) << 4); }

template <bool OVL, class Epi>
DI void gemm_phase(unsigned char* lds, const bf16_t* __restrict__ A, int lda, const bf16_t* __restrict__ Bt, int K, int nMt, int nNt, const Epi& epi) {
    const int tid = tid_fresh(), lane = tid & 63, wid = tid >> 6, wm = wid & 3, wn = wid >> 2;
    const int r16 = lane & 15, q4 = lane >> 4;
    const int nk = K >> 6;
    const int srow = tid >> 3, sc = tid & 7;
    const int sbase = srow * 128 + ((sc ^ ((srow >> 1) & 7)) << 4);
    const int xr = (r16 >> 1) & 7;
    const int ab0 = (64 * wm + r16) * 128 + ((q4 ^ xr) << 4), ab1 = (64 * wm + r16) * 128 + (((4 + q4) ^ xr) << 4);
    const int bb0 = 32768 + (64 * wn + r16) * 128 + ((q4 ^ xr) << 4), bb1 = 32768 + (64 * wn + r16) * 128 + (((4 + q4) ^ xr) << 4);
#pragma unroll 1
    for (int rep = 0; rep < REP_GEMM; ++rep)
    for (int u = blockIdx.x; u < nMt * nNt; u += gridDim.x) {
        const int um = u % nMt, un = u / nMt;
        const bf16_t* ap[4]; bool av[4]; const bf16_t* bp[2];
        int t0 = 0, bb = 0;
        if (OVL) { bb = um / 33; t0 = 254 * (um % 33) - 1; }
#pragma unroll
        for (int i = 0; i < 4; ++i) {
            const int row = srow + 64 * i;
            if (OVL) { const int t = t0 + row; av[i] = (t >= 0) && (t < L_); ap[i] = A + (av[i] ? (size_t)((bb * L_ + t) * lda + sc * 8) : (size_t)0); }
            else { av[i] = true; ap[i] = A + (size_t)((um * 256 + row) * lda + sc * 8); }
        }
#pragma unroll
        for (int i = 0; i < 2; ++i) bp[i] = Bt + (size_t)((un * 128 + srow + 64 * i) * K + sc * 8);
        u32x4 ra[4], rb[2];
        f32x4 acc[4][4];
#pragma unroll
        for (int a = 0; a < 4; ++a)
#pragma unroll
            for (int b = 0; b < 4; ++b) acc[a][b] = (f32x4){0.f, 0.f, 0.f, 0.f};
#define G_LOAD() do { _Pragma("unroll") for (int i = 0; i < 4; ++i) { ra[i] = av[i] ? *(const u32x4*)(ap[i]) : (u32x4){0u, 0u, 0u, 0u}; ap[i] += 64; } \
                      _Pragma("unroll") for (int i = 0; i < 2; ++i) { rb[i] = *(const u32x4*)(bp[i]); bp[i] += 64; } } while (0)
#define G_STORE(buf) do { _Pragma("unroll") for (int i = 0; i < 4; ++i) *(u32x4*)(lds + (buf) * 49152 + sbase + i * 8192) = ra[i]; \
                          _Pragma("unroll") for (int i = 0; i < 2; ++i) *(u32x4*)(lds + (buf) * 49152 + 32768 + sbase + i * 8192) = rb[i]; } while (0)
        G_LOAD();
        G_STORE(0);
        __syncthreads();
#pragma unroll 1
        for (int kt = 0; kt < nk; ++kt) {
            const int cur = kt & 1;
            if (kt + 1 < nk) G_LOAD();
            const unsigned char* lb = lds + cur * 49152;
#pragma unroll
            for (int ks = 0; ks < 2; ++ks) {
                bf16x8 af[4], bfr[4];
#pragma unroll
                for (int mt = 0; mt < 4; ++mt) af[mt] = *(const bf16x8*)(lb + (ks ? ab1 : ab0) + mt * 2048);
#pragma unroll
                for (int nt = 0; nt < 4; ++nt) bfr[nt] = *(const bf16x8*)(lb + (ks ? bb1 : bb0) + nt * 2048);
#pragma unroll
                for (int mt = 0; mt < 4; ++mt)
#pragma unroll
                    for (int nt = 0; nt < 4; ++nt) acc[mt][nt] = __builtin_amdgcn_mfma_f32_16x16x32_bf16(bfr[nt], af[mt], acc[mt][nt], 0, 0, 0);
            }
            if (kt + 1 < nk) G_STORE(cur ^ 1);
            __syncthreads();
        }
        int r16e = r16, q4e = q4;
        asm volatile("" : "+v"(r16e), "+v"(q4e));
        if constexpr (Epi::STAGED) {
            epi.staged(lds, acc, um, un, wm, wn, r16e, q4e);
        } else {
#pragma unroll
            for (int mt = 0; mt < 4; ++mt) { epi.row(um * 256 + 64 * wm + 16 * mt + r16e, un * 128 + 64 * wn, q4e, acc[mt]); asm volatile("" ::: "memory"); }
        }
    }
#undef G_LOAD
#undef G_STORE
}

struct EpiIn {
    static constexpr bool STAGED = true;
    float* hyT; bf16_t* projb;
    DI void staged(unsigned char* lds, const f32x4 (&acc)[4][4], int um, int un, int wm, int wn, int r16, int q4) const {
        if (un < 6) {
            float* st = (float*)lds + (wm + 4 * wn) * (64 * 65);
#pragma unroll
            for (int mt = 0; mt < 4; ++mt)
#pragma unroll
                for (int nt = 0; nt < 4; ++nt)
#pragma unroll
                    for (int i = 0; i < 4; ++i) st[(16 * nt + 4 * q4 + i) * 65 + 16 * mt + r16] = acc[mt][nt][i];
            asm volatile("s_waitcnt lgkmcnt(0)" ::: "memory");
            const int lane = r16 + 16 * q4;
            float* dst = hyT + (size_t)(un * 128 + 64 * wn) * T_ + um * 256 + 64 * wm + lane;
#pragma unroll 4
            for (int n = 0; n < 64; ++n) dst[(size_t)n * T_] = st[n * 65 + lane];
            __syncthreads();
        } else {
#pragma unroll
            for (int mt = 0; mt < 4; ++mt) {
                const int tok = um * 256 + 64 * wm + 16 * mt + r16;
#pragma unroll
                for (int nt = 0; nt < 4; ++nt) {
                    const int col = un * 128 + 64 * wn + 16 * nt + 4 * q4;
                    if (col < 1952) {
                        u32x2 w; w.x = pack2(acc[mt][nt][0], acc[mt][nt][1]); w.y = pack2(acc[mt][nt][2], acc[mt][nt][3]);
                        *(u32x2*)(projb + (unsigned)(tok * 1184 + (col - 768))) = w;
                    }
                }
            }
        }
    }
};
struct EpiF32 {
    static constexpr bool STAGED = false;
    float* C; int ldc;
    DI void row(int tok, int colbase, int q4, const f32x4 (&a)[4]) const {
#pragma unroll
        for (int nt = 0; nt < 4; ++nt) *(f32x4*)(C + (size_t)tok * ldc + colbase + 16 * nt + 4 * q4) = a[nt];
    }
};
struct EpiUq {
    static constexpr bool STAGED = false;
    bf16_t* Qm; const float* rq; float sc;
    DI void row(int tok, int colbase, int q4, const f32x4 (&a)[4]) const {
        const float r = rq[tok] * sc;
        const int b = tok >> 13, t = tok & (L_ - 1);
#pragma unroll
        for (int nt = 0; nt < 4; ++nt) {
            const int col = colbase + 16 * nt + 4 * q4;
            if (col >= 384) continue;
            const int head = col / 96, j = col - head * 96;
            bf16_t* dst = Qm + ((size_t)(b * 4 + head) * L_ + t) * 96;
            if (j < 64) {
                u32x2 w; w.x = pack2(a[nt][0] * r, a[nt][1] * r); w.y = pack2(a[nt][2] * r, a[nt][3] * r);
                *(u32x2*)(dst + j) = w;
            } else if (j < 80) {
                if (nt < 3) {
                    const int p0 = j - 64;
                    float o1[4], o2[4];
#pragma unroll
                    for (int i = 0; i < 4; ++i) {
                        const int pp = p0 + i;
                        const float inv = __expf(-(float)(pp & 7) * (9.210340371976184f / 8.0f));
                        const float ang = (float)((pp < 8) ? (t >> 6) : (t & 63)) * inv;
                        float sn, cs; sincosf(ang, &sn, &cs);
                        const float x1 = a[nt][i] * r, x2 = a[(nt < 3) ? nt + 1 : 3][i] * r;
                        o1[i] = x1 * cs - x2 * sn; o2[i] = x1 * sn + x2 * cs;
                    }
                    u32x2 w; w.x = pack2(o1[0], o1[1]); w.y = pack2(o1[2], o1[3]);
                    *(u32x2*)(dst + j) = w;
                    w.x = pack2(o2[0], o2[1]); w.y = pack2(o2[2], o2[3]);
                    *(u32x2*)(dst + j + 16) = w;
                }
            }
        }
    }
};
struct EpiUkv {
    static constexpr bool STAGED = false;
    bf16_t* Km; bf16_t* VmT; const float* rkv;
    DI void row(int tok, int colbase, int q4, const f32x4 (&a)[4]) const {
        const float r = rkv[tok];
        const int b = tok >> 13, t = tok & (L_ - 1);
#pragma unroll
        for (int nt = 0; nt < 4; ++nt) {
            const int col = colbase + 16 * nt + 4 * q4;
            const int head = col >> 7, j = col & 127;
            if (j < 64) {
                u32x2 w; w.x = pack2(a[nt][0] * r, a[nt][1] * r); w.y = pack2(a[nt][2] * r, a[nt][3] * r);
                *(u32x2*)(Km + ((size_t)(b * 4 + head) * L_ + t) * 96 + j) = w;
            } else {
#pragma unroll
                for (int i = 0; i < 4; ++i) VmT[((size_t)(b * 4 + head) * 64 + (j - 64 + i)) * L_ + perm16(t)] = f2bf(a[nt][i] * r);
            }
        }
    }
};
DI float gelu_tanh(float x) {
    const float u = 0.7978845608028654f * (x + 0.044715f * x * x * x);
    const float e = __expf(2.0f * u);
    const float th = 1.0f - 2.0f / (e + 1.0f);
    return 0.5f * x * (1.0f + th);
}
struct EpiUp {
    static constexpr bool STAGED = true;
    bf16_t* act; const float* cw; const float* cb;
    DI void staged(unsigned char* lds, const f32x4 (&acc)[4][4], int um, int un, int wm, int wn, int r16, int q4) const {
        float* st = (float*)lds;
#pragma unroll
        for (int mt = 0; mt < 4; ++mt)
#pragma unroll
            for (int nt = 0; nt < 4; ++nt) *(f32x4*)(st + (64 * wm + 16 * mt + r16) * 132 + 64 * wn + 16 * nt + 4 * q4) = acc[mt][nt];
        __syncthreads();
        const int tid = tid_fresh(), j = tid & 63, seg = tid >> 6;
        const int ch = 64 * un + j;
        const float g0 = cw[ch], g1 = cw[5632 + ch], g2 = cw[2 * 5632 + ch], gb = cb[ch];
        const float v0 = cw[2816 + ch], v1 = cw[5632 + 2816 + ch], v2 = cw[2 * 5632 + 2816 + ch], vb = cb[2816 + ch];
        const int bb = um / 33, t0 = 254 * (um % 33) - 1;
        const int r0 = 32 * seg;
        float gp = (r0 >= 1) ? st[(r0 - 1) * 132 + j] : 0.f, vp = (r0 >= 1) ? st[(r0 - 1) * 132 + 64 + j] : 0.f;
        float gc = st[r0 * 132 + j], vc = st[r0 * 132 + 64 + j];
#pragma unroll 4
        for (int i = 0; i < 32; ++i) {
            const int r = r0 + i;
            const float gn = (r + 1 <= 255) ? st[(r + 1) * 132 + j] : 0.f, vn = (r + 1 <= 255) ? st[(r + 1) * 132 + 64 + j] : 0.f;
            const int t = t0 + r;
            if (r >= 1 && r <= 254 && t < L_) {
                const float cg = g0 * gp + g1 * gc + g2 * gn + gb;
                const float cv = v0 * vp + v1 * vc + v2 * vn + vb;
                act[(size_t)(bb * L_ + t) * 2816 + ch] = f2bf(gelu_tanh(cg) * cv);
            }
            gp = gc; gc = gn; vp = vc; vc = vn;
        }
        __syncthreads();
    }
};

DI void prep_phase(const Params& p, int l) {
    const int tid_ = tid_fresh(); const int lane = tid_ & 63, wid = tid_ >> 6;
    const bf16_t* projb = (const bf16_t*)(p.ws + O_PROJB);
    bf16_t* Qg = (bf16_t*)(p.ws + O_QG); bf16_t* Kg = (bf16_t*)(p.ws + O_KG); bf16_t* VgT = (bf16_t*)(p.ws + O_VGT);
    bf16_t* Km = (bf16_t*)(p.ws + O_KM);
    float* rq = (float*)(p.ws + O_RQ); float* rkv = (float*)(p.ws + O_RKV);
    const float* gq = p.in[13] + l * 64; const float* gk = p.in[14] + l * 64;
    const int hd = lane >> 3, sub = lane & 7;
    float gq1[4], gq2[4], gk1[4], gk2[4];
#pragma unroll
    for (int i = 0; i < 4; ++i) { gq1[i] = gq[4 * sub + i]; gq2[i] = gq[32 + 4 * sub + i]; gk1[i] = gk[4 * sub + i]; gk2[i] = gk[32 + 4 * sub + i]; }
    const float qscale = 0.125f * 1.4426950408889634f;
    for (int tok = blockIdx.x * 8 + wid; tok < T_; tok += gridDim.x * 8) {
        const int b = tok >> 13, t = tok & (L_ - 1);
        const bf16_t* pr = projb + (size_t)tok * 1184;
        float cs[4], sn[4];
#pragma unroll
        for (int i = 0; i < 4; ++i) {
            const int pp = 4 * sub + i;
            const float inv = __expf(-(float)(pp & 15) * (9.210340371976184f / 16.0f));
            const float ang = (float)((pp < 16) ? (t >> 6) : (t & 63)) * inv;
            sincosf(ang, &sn[i], &cs[i]);
        }
        {
            const u32x2 w1 = *(const u32x2*)(pr + hd * 64 + 4 * sub), w2 = *(const u32x2*)(pr + hd * 64 + 32 + 4 * sub);
            float x1[4] = {bf2f((bf16_t)(w1.x & 0xffff)), bf2f((bf16_t)(w1.x >> 16)), bf2f((bf16_t)(w1.y & 0xffff)), bf2f((bf16_t)(w1.y >> 16))};
            float x2[4] = {bf2f((bf16_t)(w2.x & 0xffff)), bf2f((bf16_t)(w2.x >> 16)), bf2f((bf16_t)(w2.y & 0xffff)), bf2f((bf16_t)(w2.y >> 16))};
            float ss = 0.f;
#pragma unroll
            for (int i = 0; i < 4; ++i) ss += x1[i] * x1[i] + x2[i] * x2[i];
            ss += __shfl_xor(ss, 1); ss += __shfl_xor(ss, 2); ss += __shfl_xor(ss, 4);
            const float r = rsqrtf(ss * (1.0f / 64.0f) + 1e-6f);
            float o1[4], o2[4];
#pragma unroll
            for (int i = 0; i < 4; ++i) { const float a = x1[i] * r * gq1[i], c = x2[i] * r * gq2[i]; o1[i] = (a * cs[i] - c * sn[i]) * qscale; o2[i] = (a * sn[i] + c * cs[i]) * qscale; }
            bf16_t* dst = Qg + ((size_t)(b * 8 + hd) * L_ + t) * 64;
            u32x2 w; w.x = pack2(o1[0], o1[1]); w.y = pack2(o1[2], o1[3]); *(u32x2*)(dst + 4 * sub) = w;
            w.x = pack2(o2[0], o2[1]); w.y = pack2(o2[2], o2[3]); *(u32x2*)(dst + 32 + 4 * sub) = w;
        }
        if (lane < 16) {
            const u32x2 w1 = *(const u32x2*)(pr + 512 + hd * 64 + 4 * sub), w2 = *(const u32x2*)(pr + 512 + hd * 64 + 32 + 4 * sub);
            float x1[4] = {bf2f((bf16_t)(w1.x & 0xffff)), bf2f((bf16_t)(w1.x >> 16)), bf2f((bf16_t)(w1.y & 0xffff)), bf2f((bf16_t)(w1.y >> 16))};
            float x2[4] = {bf2f((bf16_t)(w2.x & 0xffff)), bf2f((bf16_t)(w2.x >> 16)), bf2f((bf16_t)(w2.y & 0xffff)), bf2f((bf16_t)(w2.y >> 16))};
            float ss = 0.f;
#pragma unroll
            for (int i = 0; i < 4; ++i) ss += x1[i] * x1[i] + x2[i] * x2[i];
            ss += __shfl_xor(ss, 1); ss += __shfl_xor(ss, 2); ss += __shfl_xor(ss, 4);
            const float r = rsqrtf(ss * (1.0f / 64.0f) + 1e-6f);
            float o1[4], o2[4];
#pragma unroll
            for (int i = 0; i < 4; ++i) { const float a = x1[i] * r * gk1[i], c = x2[i] * r * gk2[i]; o1[i] = a * cs[i] - c * sn[i]; o2[i] = a * sn[i] + c * cs[i]; }
            bf16_t* dst = Kg + ((size_t)(b * 2 + hd) * L_ + t) * 64;
            u32x2 w; w.x = pack2(o1[0], o1[1]); w.y = pack2(o1[2], o1[3]); *(u32x2*)(dst + 4 * sub) = w;
            w.x = pack2(o2[0], o2[1]); w.y = pack2(o2[2], o2[3]); *(u32x2*)(dst + 32 + 4 * sub) = w;
        }
        {
            const unsigned w = *(const unsigned*)(pr + 640 + 2 * lane);
            const int c0 = 2 * lane, kh = c0 >> 6, d = c0 & 63;
            bf16_t* dst = VgT + ((size_t)(b * 2 + kh) * 64 + d) * L_ + perm16(t);
            dst[0] = (bf16_t)(w & 0xffff); dst[L_] = (bf16_t)(w >> 16);
        }
        {
            const u32x2 w = *(const u32x2*)(pr + 768 + 4 * lane);
            const float a0 = bf2f((bf16_t)(w.x & 0xffff)), a1 = bf2f((bf16_t)(w.x >> 16)), a2 = bf2f((bf16_t)(w.y & 0xffff)), a3 = bf2f((bf16_t)(w.y >> 16));
            float ss = wave_sum(a0 * a0 + a1 * a1 + a2 * a2 + a3 * a3);
            if (lane == 0) rq[tok] = rsqrtf(ss * (1.0f / 256.0f) + 1e-6f);
        }
        {
            const unsigned w = *(const unsigned*)(pr + 1024 + 2 * lane);
            const float a0 = bf2f((bf16_t)(w & 0xffff)), a1 = bf2f((bf16_t)(w >> 16));
            float ss = wave_sum(a0 * a0 + a1 * a1);
            if (lane == 0) rkv[tok] = rsqrtf(ss * (1.0f / 128.0f) + 1e-6f);
        }
        if (lane < 16) {
            const float x1 = bf2f(pr[1152 + lane]), x2 = bf2f(pr[1152 + 16 + lane]);
            const float inv = __expf(-(float)(lane & 7) * (9.210340371976184f / 8.0f));
            const float ang = (float)((lane < 8) ? (t >> 6) : (t & 63)) * inv;
            float s1, c1; sincosf(ang, &s1, &c1);
            const bf16_t o1 = f2bf(x1 * c1 - x2 * s1), o2 = f2bf(x1 * s1 + x2 * c1);
#pragma unroll
            for (int hh = 0; hh < 4; ++hh) { bf16_t* dst = Km + ((size_t)(b * 4 + hh) * L_ + t) * 96 + 64; dst[lane] = o1; dst[16 + lane] = o2; }
        }
    }
}

template <int DQK> DI int kswz(int row, int chunk) {
    if (DQK == 64) return row * 128 + ((chunk ^ ((row >> 1) & 7)) << 4);
    else return row * 192 + ((chunk ^ ((row >> 2) & 3)) << 4);
}
template <int DQK>
DI void attn_unit(unsigned char* lds, const bf16_t* __restrict__ Qp, const bf16_t* __restrict__ Kp, const bf16_t* __restrict__ VTp, bf16_t* __restrict__ Yp  ) {
    constexpr int NS = DQK / 16, NC = DQK / 8, KB = 64 * DQK * 2, KVB = KB + 8192;
    const int tid = tid_fresh(), lane = tid & 63, w = tid >> 6, r = lane & 31, h = lane >> 5;
    bf16x8 qf[NS];
#pragma unroll
    for (int s = 0; s < NS; ++s) qf[s] = *(const bf16x8*)(Qp + (size_t)(32 * w + r) * DQK + 16 * s + 8 * h);
    f32x16 o0, o1;
#pragma unroll
    for (int i = 0; i < 16; ++i) { o0[i] = 0.f; o1[i] = 0.f; }
    float m = 0.f, lsum = 0.f;
    const int k_row0 = tid / NC, k_c0 = tid % NC;
    const int k_row1 = (tid + 512) / NC, k_c1 = (tid + 512) % NC;
    const bool k_two = (DQK == 96) && (tid < 256);
    const int v_row = tid >> 3, v_c = tid & 7;
    u32x4 rkA0, rkA1, rvA, rkB0, rkB1, rvB;
    rkA1 = (u32x4){0u, 0u, 0u, 0u}; rkB1 = rkA1;
#define A_LOAD(kt, R0, R1, RV) do { R0 = *(const u32x4*)(Kp + (size_t)((kt) * 64 + k_row0) * DQK + k_c0 * 8); \
                        if (k_two) R1 = *(const u32x4*)(Kp + (size_t)((kt) * 64 + k_row1) * DQK + k_c1 * 8); \
                        RV = *(const u32x4*)(VTp + (size_t)v_row * L_ + (kt) * 64 + v_c * 8); } while (0)
#define A_STORE(buf, R0, R1, RV) do { *(u32x4*)(lds + (buf) * KVB + kswz<DQK>(k_row0, k_c0)) = R0; \
                          if (k_two) *(u32x4*)(lds + (buf) * KVB + kswz<DQK>(k_row1, k_c1)) = R1; \
                          *(u32x4*)(lds + (buf) * KVB + KB + swz128(v_row, v_c)) = RV; } while (0)
    A_LOAD(0, rkA0, rkA1, rvA);
    A_LOAD(1, rkB0, rkB1, rvB);
    A_STORE(0, rkA0, rkA1, rvA);
    __syncthreads();
    constexpr int NKT = L_ / 64;
#pragma unroll 1
    for (int kt2 = 0; kt2 < NKT; kt2 += 2) {
#pragma unroll
      for (int cur = 0; cur < 2; ++cur) {
        const int kt = kt2 + cur;
        if (kt + 2 < NKT) { if (cur == 0) A_LOAD(kt + 2, rkA0, rkA1, rvA); else A_LOAD(kt + 2, rkB0, rkB1, rvB); }
        const unsigned char* lk = lds + cur * KVB;
        const unsigned char* lv = lk + KB;
        f32x16 s0, s1;
        const float negm = -m;
#pragma unroll
        for (int i = 0; i < 16; ++i) { s0[i] = negm; s1[i] = negm; }
#pragma unroll
        for (int s = 0; s < NS; ++s) {
            const bf16x8 k0 = *(const bf16x8*)(lk + kswz<DQK>(r, 2 * s + h));
            const bf16x8 k1 = *(const bf16x8*)(lk + kswz<DQK>(32 + r, 2 * s + h));
            s0 = __builtin_amdgcn_mfma_f32_32x32x16_bf16(k0, qf[s], s0, 0, 0, 0);
            s1 = __builtin_amdgcn_mfma_f32_32x32x16_bf16(k1, qf[s], s1, 0, 0, 0);
        }
        float mx = fmaxf(fmaxf(s0[0], s0[1]), s0[2]);
#pragma unroll
        for (int i = 3; i < 15; i += 2) mx = fmaxf(fmaxf(mx, s0[i]), s0[i + 1]);
        mx = fmaxf(mx, s0[15]);
#pragma unroll
        for (int i = 0; i < 16; i += 2) mx = fmaxf(fmaxf(mx, s1[i]), s1[i + 1]);
        mx = fmaxf(mx, __shfl_xor(mx, 32));
        if (kt == 0 || __any(mx > 8.0f)) {
            const float dm = (kt == 0) ? mx : fmaxf(mx, 0.f);
            const float alpha = (kt == 0) ? 0.f : __builtin_amdgcn_exp2f(-dm);
            m += dm;
            lsum *= alpha;
#pragma unroll
            for (int i = 0; i < 16; ++i) { o0[i] *= alpha; o1[i] *= alpha; s0[i] -= dm; s1[i] -= dm; }
        }
        float ps = 0.f;
#pragma unroll
        for (int i = 0; i < 16; ++i) { s0[i] = __builtin_amdgcn_exp2f(s0[i]); ps += s0[i]; }
#pragma unroll
        for (int i = 0; i < 16; ++i) { s1[i] = __builtin_amdgcn_exp2f(s1[i]); ps += s1[i]; }
        lsum += ps;
#pragma unroll
        for (int sub = 0; sub < 2; ++sub)
#pragma unroll
            for (int s2 = 0; s2 < 2; ++s2) {
                u32x4 pw;
                if (sub == 0) { pw.x = pack2(s0[8 * s2 + 0], s0[8 * s2 + 1]); pw.y = pack2(s0[8 * s2 + 2], s0[8 * s2 + 3]); pw.z = pack2(s0[8 * s2 + 4], s0[8 * s2 + 5]); pw.w = pack2(s0[8 * s2 + 6], s0[8 * s2 + 7]); }
                else          { pw.x = pack2(s1[8 * s2 + 0], s1[8 * s2 + 1]); pw.y = pack2(s1[8 * s2 + 2], s1[8 * s2 + 3]); pw.z = pack2(s1[8 * s2 + 4], s1[8 * s2 + 5]); pw.w = pack2(s1[8 * s2 + 6], s1[8 * s2 + 7]); }
                const bf16x8 pf = __builtin_bit_cast(bf16x8, pw);
                const bf16x8 vf0 = *(const bf16x8*)(lv + swz128(r, 4 * sub + 2 * s2 + h));
                const bf16x8 vf1 = *(const bf16x8*)(lv + swz128(32 + r, 4 * sub + 2 * s2 + h));
                o0 = __builtin_amdgcn_mfma_f32_32x32x16_bf16(vf0, pf, o0, 0, 0, 0);
                o1 = __builtin_amdgcn_mfma_f32_32x32x16_bf16(vf1, pf, o1, 0, 0, 0);
            }
        if (kt + 1 < NKT) { if (cur == 0) A_STORE(1, rkB0, rkB1, rvB); else A_STORE(0, rkA0, rkA1, rvA); }
        __syncthreads();
      }
    }
#undef A_LOAD
#undef A_STORE
    const float lt = lsum + __shfl_xor(lsum, 32);
    const float inv = 1.0f / lt;
    bf16_t* yr = Yp + (size_t)(32 * w + r) * 768;
#pragma unroll
    for (int g = 0; g < 4; ++g) {
        u32x2 wv; wv.x = pack2(o0[4 * g] * inv, o0[4 * g + 1] * inv); wv.y = pack2(o0[4 * g + 2] * inv, o0[4 * g + 3] * inv);
        *(u32x2*)(yr + 8 * g + 4 * h) = wv;
        wv.x = pack2(o1[4 * g] * inv, o1[4 * g + 1] * inv); wv.y = pack2(o1[4 * g + 2] * inv, o1[4 * g + 3] * inv);
        *(u32x2*)(yr + 32 + 8 * g + 4 * h) = wv;
    }
}

DI int pa(int e) { return e + (e >> 4); }
DI float2 cmul(float2 a, float2 b) { return make_float2(a.x * b.x - a.y * b.y, a.x * b.y + a.y * b.x); }
DI float2 cadd(float2 a, float2 b) { return make_float2(a.x + b.x, a.y + b.y); }
DI float2 csub(float2 a, float2 b) { return make_float2(a.x - b.x, a.y - b.y); }
template <bool INV> DI void dft4(float2& a, float2& b, float2& c, float2& d) {
    const float2 t0 = cadd(a, c), t1 = csub(a, c), t2 = cadd(b, d), t3 = csub(b, d);
    const float2 jt3 = INV ? make_float2(-t3.y, t3.x) : make_float2(t3.y, -t3.x);
    a = cadd(t0, t2); c = csub(t0, t2); b = cadd(t1, jt3); d = csub(t1, jt3);
}
template <bool INV> DI float2 tw16(float2 v, int k) {
    const float c1 = 0.9238795325112867f, s1 = 0.3826834323650898f, c2 = 0.7071067811865476f;
    float wr = 1.f, wi = 0.f;
    switch (k) {
        case 0: wr = 1.f; wi = 0.f; break;
        case 1: wr = c1; wi = -s1; break;
        case 2: wr = c2; wi = -c2; break;
        case 3: wr = s1; wi = -c1; break;
        case 4: wr = 0.f; wi = -1.f; break;
        case 6: wr = -c2; wi = -c2; break;
        case 9: wr = -c1; wi = s1; break;
        default: break;
    }
    if (INV) wi = -wi;
    return make_float2(v.x * wr - v.y * wi, v.x * wi + v.y * wr);
}
template <bool INV> DI void dft16(float2 (&x)[16]) {
#pragma unroll
    for (int b = 0; b < 4; ++b) dft4<INV>(x[b], x[b + 4], x[b + 8], x[b + 12]);
#pragma unroll
    for (int b = 1; b < 4; ++b)
#pragma unroll
        for (int pq = 1; pq < 4; ++pq) x[b + 4 * pq] = tw16<INV>(x[b + 4 * pq], b * pq);
#pragma unroll
    for (int pq = 0; pq < 4; ++pq) dft4<INV>(x[4 * pq], x[4 * pq + 1], x[4 * pq + 2], x[4 * pq + 3]);
#pragma unroll
    for (int a = 0; a < 4; ++a)
#pragma unroll
        for (int b = a + 1; b < 4; ++b) { const float2 tmp = x[4 * a + b]; x[4 * a + b] = x[4 * b + a]; x[4 * b + a] = tmp; }
}
template <bool INV> DI void pass_a(float2* Z, const float2* T1, int tid) {
#pragma unroll
    for (int i = 0; i < 8; ++i) {
        const int j = tid + 512 * i;
        float2 x0 = Z[pa(j)], x1 = Z[pa(j + 4096)], x2 = Z[pa(j + 8192)], x3 = Z[pa(j + 12288)];
        float2 w1 = tw16<false>(T1[j & 1023], i >> 1);
        if (INV) w1.y = -w1.y;
        const float2 w2 = cmul(w1, w1), w3 = cmul(w2, w1);
        if (!INV) { dft4<false>(x0, x1, x2, x3); x1 = cmul(x1, w1); x2 = cmul(x2, w2); x3 = cmul(x3, w3); }
        else { x1 = cmul(x1, w1); x2 = cmul(x2, w2); x3 = cmul(x3, w3); dft4<true>(x0, x1, x2, x3); }
        Z[pa(j)] = x0; Z[pa(j + 4096)] = x1; Z[pa(j + 8192)] = x2; Z[pa(j + 12288)] = x3;
    }
}
template <bool INV, int LS, int TS> DI void pass16(float2* Z, const float2* T1, int tid) {
#pragma unroll 1
    for (int i = 0; i < 2; ++i) {
        const int id = tid + 512 * i, j = id & ((1 << LS) - 1), base = (id >> LS) << (LS + 4);
        float2 x[16];
#pragma unroll
        for (int mm = 0; mm < 16; ++mm) x[mm] = Z[pa(base + j + (mm << LS))];
        float2 w1 = T1[j << TS];
        if (INV) w1.y = -w1.y;
        if (!INV) dft16<false>(x);
        float2 wq = w1;
#pragma unroll
        for (int qq = 1; qq < 16; ++qq) { x[qq] = cmul(x[qq], wq); wq = cmul(wq, w1); }
        if (INV) dft16<true>(x);
#pragma unroll
        for (int mm = 0; mm < 16; ++mm) Z[pa(base + j + (mm << LS))] = x[mm];
    }
}
DI void pass_d_store(const float2* Z, float2* __restrict__ Kf, int tid, float scale) {
#pragma unroll 1
    for (int i = 0; i < 2; ++i) {
        const int id = tid + 512 * i, base = id * 16;
        float2 x[16];
#pragma unroll
        for (int mm = 0; mm < 16; ++mm) x[mm] = Z[pa(base + mm)];
        dft16<false>(x);
#pragma unroll
        for (int mm = 0; mm < 16; mm += 2) *(f32x4*)(Kf + base + mm) = (f32x4){x[mm].x * scale, x[mm].y * scale, x[mm + 1].x * scale, x[mm + 1].y * scale};
    }
}
DI void pass_d_mul(float2* Z, const float2* __restrict__ Kf, int tid) {
#pragma unroll 1
    for (int i = 0; i < 2; ++i) {
        const int id = tid + 512 * i, base = id * 16;
        float2 x[16];
#pragma unroll
        for (int mm = 0; mm < 16; ++mm) x[mm] = Z[pa(base + mm)];
        dft16<false>(x);
#pragma unroll
        for (int mm = 0; mm < 16; mm += 2) {
            const f32x4 kk = *(const f32x4*)(Kf + base + mm);
            x[mm] = cmul(x[mm], make_float2(kk[0], kk[1])); x[mm + 1] = cmul(x[mm + 1], make_float2(kk[2], kk[3]));
        }
        dft16<true>(x);
#pragma unroll
        for (int mm = 0; mm < 16; ++mm) Z[pa(base + mm)] = x[mm];
    }
}
DI void fft_conv(float2* Z, const float2* T1, const float2* Kf, int tid) {
    pass_a<false>(Z, T1, tid); __syncthreads();
    pass16<false, 8, 2>(Z, T1, tid); __syncthreads();
    pass16<false, 4, 6>(Z, T1, tid); __syncthreads();
    pass_d_mul(Z, Kf, tid); __syncthreads();
    pass16<true, 4, 6>(Z, T1, tid); __syncthreads();
    pass16<true, 8, 2>(Z, T1, tid); __syncthreads();
    pass_a<true>(Z, T1, tid); __syncthreads();
}

DI void hyena_unit(unsigned char* lds, const Params& p, int l, int c) {
    float2* Z = (float2*)lds;
    float2* T1 = (float2*)(lds + 139264);
    float* w3s = (float*)(lds + 139264 + 8192);
    const int tid = tid_fresh();
    const float* h2 = (const float*)(p.ws + O_H2) + (size_t)l * L_ * 64;
    const float* hyT = (const float*)(p.ws + O_HYT);
    float2* Kf0 = (float2*)(p.ws + O_R1) + (size_t)blockIdx.x * 32768;
    float2* Kf1 = Kf0 + 16384;
    bf16_t* hyout = (bf16_t*)(p.ws + O_HYOUT) + (size_t)c * T_;
    for (int k = tid; k < 1024; k += NTHR) { float sn, cs; sincospif((float)k * (1.0f / 8192.0f), &sn, &cs); T1[k] = make_float2(cs, -sn); }
    if (tid < 256) { const int cc = tid >> 6, j = tid & 63; w3s[cc * 64 + j] = p.in[11][((size_t)l * 64 + j) * 1024 + cc * 256 + c]; }
    __syncthreads();
    {
        const float min_decay = -4.605170185988091f / 1.5f, max_decay = -4.605170185988091f / 0.3f;
        const float dlt = fabsf(min_decay + (max_decay - min_decay) * (float)c / 255.0f);
#pragma unroll 1
        for (int o = 0; o < 2; ++o) {
            const float* wf = w3s + (2 * o) * 64;
            const float* wb = w3s + (2 * o + 1) * 64;
#pragma unroll 1
            for (int t = tid; t < L_; t += NTHR) {
                const float* hr = h2 + (size_t)t * 64;
                float d0 = 0.f, d1 = 0.f;
#pragma unroll
                for (int jj = 0; jj < 16; ++jj) {
                    const f32x4 hv = *(const f32x4*)(hr + 4 * jj);
#pragma unroll
                    for (int e = 0; e < 4; ++e) { d0 += hv[e] * wf[4 * jj + e]; d1 += hv[e] * wb[4 * jj + e]; }
                }
                const float win = expf(-((float)t / (float)(L_ - 1)) * dlt);
                Z[pa(t)] = make_float2(d0 * win, 0.f); Z[pa(16383 - t)] = make_float2(d1 * win, 0.f);
            }
            __syncthreads();
            pass_a<false>(Z, T1, tid); __syncthreads();
            pass16<false, 8, 2>(Z, T1, tid); __syncthreads();
            pass16<false, 4, 6>(Z, T1, tid); __syncthreads();
            pass_d_store(Z, o ? Kf1 : Kf0, tid, 1.0f / 16384.0f); __syncthreads();
        }
    }
    const float* cw = p.in[3] + (size_t)l * 3 * 768; const float* cb = p.in[4] + (size_t)l * 768;
    const float* skip = p.in[12] + (size_t)l * 2 * 256;
    float2* z1buf = Kf0;
    const float vw0 = cw[c], vw1 = cw[768 + c], vw2 = cw[1536 + c], vbb = cb[c];
    const float* uv = hyT + (size_t)c * T_;
#pragma unroll 2
    for (int t = tid; t < L_; t += NTHR) {
        float vv[2];
#pragma unroll
        for (int b = 0; b < 2; ++b) {
            const float* ub = uv + b * L_;
            const float um = (t > 0) ? ub[t - 1] : 0.f, uc = ub[t], up = (t < L_ - 1) ? ub[t + 1] : 0.f;
            vv[b] = vw0 * um + vw1 * uc + vw2 * up + vbb;
        }
        Z[pa(t)] = make_float2(vv[0], vv[1]); Z[pa(t + L_)] = make_float2(0.f, 0.f);
    }
    __syncthreads();
    __threadfence();
    fft_conv(Z, T1, Kf0, tid);
    {
        const int ch = 256 + c;
        const float w0 = cw[ch], w1 = cw[768 + ch], w2 = cw[1536 + ch], bb = cb[ch], sk = skip[c];
        const float* u0 = hyT + (size_t)ch * T_;
#pragma unroll 2
        for (int t = tid; t < L_; t += NTHR) {
            const float2 y = Z[pa(t)];
            float zz[2];
#pragma unroll
            for (int b = 0; b < 2; ++b) {
                const float* ub = u0 + b * L_;
                const float um = (t > 0) ? ub[t - 1] : 0.f, uc = ub[t], up = (t < L_ - 1) ? ub[t + 1] : 0.f;
                const float g = w0 * um + w1 * uc + w2 * up + bb;
                const float* vb = uv + b * L_;
                const float vm = (t > 0) ? vb[t - 1] : 0.f, vc = vb[t], vp = (t < L_ - 1) ? vb[t + 1] : 0.f;
                const float v = vw0 * vm + vw1 * vc + vw2 * vp + vbb;
                zz[b] = g * ((b ? y.y : y.x) + sk * v);
            }
            const float2 z1 = make_float2(zz[0], zz[1]);
            Z[pa(t)] = z1; Z[pa(t + L_)] = make_float2(0.f, 0.f);
            z1buf[t] = z1;
        }
    }
    __syncthreads();
    fft_conv(Z, T1, Kf1, tid);
    {
        const int ch = 512 + c;
        const float w0 = cw[ch], w1 = cw[768 + ch], w2 = cw[1536 + ch], bb = cb[ch], sk = skip[256 + c];
        const float* u0 = hyT + (size_t)ch * T_;
#pragma unroll 2
        for (int t = tid; t < L_; t += NTHR) {
            const float2 y = Z[pa(t)];
            const float2 z1 = z1buf[t];
#pragma unroll
            for (int b = 0; b < 2; ++b) {
                const float* ub = u0 + b * L_;
                const float um = (t > 0) ? ub[t - 1] : 0.f, uc = ub[t], up = (t < L_ - 1) ? ub[t + 1] : 0.f;
                const float g = w0 * um + w1 * uc + w2 * up + bb;
                hyout[b * L_ + t] = f2bf(g * ((b ? y.y : y.x) + sk * (b ? z1.y : z1.x)));
            }
        }
    }
    __syncthreads();
}

DI void groups_phase(unsigned char* lds, const Params& p) {
    bf16_t* tile = (bf16_t*)lds;
    const int tid = tid_fresh(), lane = tid & 63, wid = tid >> 6;
    const bf16_t* hyout = (const bf16_t*)(p.ws + O_HYOUT);
    const bf16_t* Y = (const bf16_t*)(p.ws + O_PROJB);
    bf16_t* G = (bf16_t*)(p.ws + O_HYT);
    for (int u = blockIdx.x; u < T_ / 64; u += gridDim.x) {
        const int tok0 = u * 64;
        {
            const int c = tid >> 1, hf = tid & 1;
            const u32x4* src = (const u32x4*)(hyout + (size_t)c * T_ + tok0 + hf * 32);
#pragma unroll
            for (int i = 0; i < 4; ++i) {
                const u32x4 v = src[i];
                unsigned* d = (unsigned*)(tile + c * 66 + hf * 32 + i * 8);
                d[0] = v.x; d[1] = v.y; d[2] = v.z; d[3] = v.w;
            }
        }
        __syncthreads();
#pragma unroll 1
        for (int i = 0; i < 8; ++i) {
            const int tl = wid * 8 + i, tok = tok0 + tl;
            float hv[4]; float sh = 0.f;
#pragma unroll
            for (int k = 0; k < 4; ++k) { hv[k] = bf2f(tile[(lane + 64 * k) * 66 + tl]); sh += hv[k] * hv[k]; }
            sh = wave_sum(sh);
            const float rh = rsqrtf(sh * (1.0f / 256.0f) + 1e-6f);
            bf16_t* gr = G + (size_t)tok * 1024;
#pragma unroll
            for (int k = 0; k < 4; ++k) gr[lane + 64 * k] = f2bf(hv[k] * rh);
            const bf16_t* yr = Y + (size_t)tok * 768;
            {
                const u32x4 v = *(const u32x4*)(yr + lane * 8);
                float a[8] = {bf2f((bf16_t)(v.x & 0xffff)), bf2f((bf16_t)(v.x >> 16)), bf2f((bf16_t)(v.y & 0xffff)), bf2f((bf16_t)(v.y >> 16)),
                              bf2f((bf16_t)(v.z & 0xffff)), bf2f((bf16_t)(v.z >> 16)), bf2f((bf16_t)(v.w & 0xffff)), bf2f((bf16_t)(v.w >> 16))};
                float ss = 0.f;
#pragma unroll
                for (int k = 0; k < 8; ++k) ss += a[k] * a[k];
                ss = wave_sum(ss);
                const float rr = rsqrtf(ss * (1.0f / 512.0f) + 1e-6f);
                u32x4 w; w.x = pack2(a[0] * rr, a[1] * rr); w.y = pack2(a[2] * rr, a[3] * rr); w.z = pack2(a[4] * rr, a[5] * rr); w.w = pack2(a[6] * rr, a[7] * rr);
                *(u32x4*)(gr + 256 + lane * 8) = w;
            }
            {
                const u32x2 v = *(const u32x2*)(yr + 512 + lane * 4);
                float a[4] = {bf2f((bf16_t)(v.x & 0xffff)), bf2f((bf16_t)(v.x >> 16)), bf2f((bf16_t)(v.y & 0xffff)), bf2f((bf16_t)(v.y >> 16))};
                float ss = wave_sum(a[0] * a[0] + a[1] * a[1] + a[2] * a[2] + a[3] * a[3]);
                const float rr = rsqrtf(ss * (1.0f / 256.0f) + 1e-6f);
                u32x2 w; w.x = pack2(a[0] * rr, a[1] * rr); w.y = pack2(a[2] * rr, a[3] * rr);
                *(u32x2*)(gr + 768 + lane * 4) = w;
            }
        }
        __syncthreads();
    }
}


#define XB_TMO      128
#define XB_XCNT(j)  (256  + 64 * (j))
#define XB_XSUB(j)  (1280 + 64 * (j))
#define XB_XGEN(j)  (2304 + 64 * (j))
#define XB_TOP      3328
#define XB_TOPGEN   3392
#define XCD_BAR_WORDS 3456
#define XB_SPIN_CAP (1u << 22)
#define LAS __attribute__((address_space(3)))
DI unsigned xb_ld(unsigned* p)              { return __hip_atomic_load(p, __ATOMIC_RELAXED, __HIP_MEMORY_SCOPE_AGENT); }
DI unsigned xb_add(unsigned* p, unsigned v) { return __hip_atomic_fetch_add(p, v, __ATOMIC_RELAXED, __HIP_MEMORY_SCOPE_AGENT); }
DI unsigned xb_xcc_id() { return (unsigned)__builtin_amdgcn_s_getreg((3 << 11) | 20) & 0xFu; }
#define XB_SPIN(cond, bar) do { unsigned _sp = 0; while (cond) { __builtin_amdgcn_s_sleep(1); \
    if ((++_sp & 255u) == 0u) { if (xb_ld(&(bar)[XB_TMO])) break; if (_sp > XB_SPIN_CAP) { atomicAdd(&(bar)[XB_TMO], 1u); break; } } } } while (0)
struct XcdBarrier { unsigned* bar; unsigned x; volatile LAS unsigned* st; };
DI XcdBarrier xcd_barrier_post(unsigned* bar, volatile LAS unsigned* st) {
    XcdBarrier b; b.bar = bar; b.x = xb_xcc_id(); b.st = st;
    if (threadIdx.x == 0) (void)xb_add(&bar[XB_XCNT(b.x)], 1u);
    return b;
}
DI void xcd_barrier_complete(unsigned* bar, unsigned x, unsigned& nloc, unsigned& nx) {
    const unsigned G = gridDim.x * gridDim.y * gridDim.z;
    unsigned sum, cnt, mine, sp = 0u;
    for (;;) {
        sum = 0u; cnt = 0u; mine = 0u;
#pragma unroll
        for (unsigned j = 0; j < 16; ++j) { const unsigned c = xb_ld(&bar[XB_XCNT(j)]); sum += c; cnt += (c > 0u) ? 1u : 0u; mine = (j == x) ? c : mine; }
        if (sum == G) break;
        __builtin_amdgcn_s_sleep(1);
        if ((++sp & 255u) == 0u) { if (xb_ld(&bar[XB_TMO])) break; if (sp > XB_SPIN_CAP) { atomicAdd(&bar[XB_TMO], 1u); break; } }
    }
    nloc = mine > 0u ? mine : 1u; nx = cnt > 0u ? cnt : 1u;
}
DI void xcd_barrier(const XcdBarrier& b) {
    asm volatile("s_waitcnt vmcnt(0)" ::: "memory");
    __syncthreads();
    if (threadIdx.x == 0) {
        unsigned* bar = b.bar;
        __builtin_amdgcn_s_waitcnt(0);
        unsigned nloc = b.st[0], nx = b.st[1];
        if (nloc == 0u) { xcd_barrier_complete(bar, b.x, nloc, nx); b.st[0] = nloc; b.st[1] = nx; }
        const unsigned old = xb_add(&bar[XB_XSUB(b.x)], 1u);
        const unsigned gen = old / nloc;
        if (old + 1u == (gen + 1u) * nloc) {
            __builtin_amdgcn_fence(__ATOMIC_RELEASE, "agent");
            asm volatile("s_waitcnt vmcnt(0)" ::: "memory");
            const unsigned og = xb_add(&bar[XB_TOP], 1u);
            const unsigned tg = og / nx;
            if (og + 1u == (tg + 1u) * nx) xb_add(&bar[XB_TOPGEN], 1u);
            else XB_SPIN(xb_ld(&bar[XB_TOPGEN]) == tg, bar);
            __builtin_amdgcn_fence(__ATOMIC_ACQUIRE, "agent");
            xb_add(&bar[XB_XGEN(b.x)], 1u);
            asm volatile("s_waitcnt vmcnt(0)" ::: "memory");
        } else {
            XB_SPIN(xb_ld(&bar[XB_XGEN(b.x)]) == gen, bar);
            __builtin_amdgcn_fence(__ATOMIC_ACQUIRE, "agent");
            asm volatile("s_waitcnt vmcnt(0)" ::: "memory");
        }
    }
    __syncthreads();
}

extern __shared__ __attribute__((aligned(16))) unsigned char smem[];

__global__ void __launch_bounds__(512) fwd_megakernel(Params p) {
    cg::grid_group grid = cg::this_grid();
    unsigned char* lds = smem;
    unsigned char* ws = p.ws;
    unsigned* bar = (unsigned*)(ws + O_BAR);
    volatile LAS unsigned* xb_st = (volatile LAS unsigned*)(smem + LDS_BYTES - 16);
    if (threadIdx.x < 4) xb_st[threadIdx.x] = 0u;
    if (blockIdx.x == 0) for (int i = threadIdx.x; i < XCD_BAR_WORDS; i += NTHR) bar[i] = 0u;
    __syncthreads();
#pragma unroll 1
    for (int l2 = 0; l2 < 2 * REP_PRO; ++l2) { const int l = l2 & 1;
        convT(lds, p.in[2] + (size_t)l * 1024 * 1952, 1024, 1952, 2048, p.in[1] + l * 1024, (bf16_t*)(ws + O_WIN) + (size_t)l * 2048 * 1024, 0);
        convT(lds, p.in[16] + (size_t)l * 256 * 384, 256, 384, 384, p.in[15] + l * 256, (bf16_t*)(ws + O_WUQ) + (size_t)l * 384 * 256, 0);
        convT(lds, p.in[18] + (size_t)l * 128 * 512, 128, 512, 512, p.in[17] + l * 128, (bf16_t*)(ws + O_WUKV) + (size_t)l * 512 * 128, 0);
        convT(lds, p.in[25] + (size_t)l * 1024 * 5632, 1024, 5632, 5632, p.in[24] + l * 1024, (bf16_t*)(ws + O_WUP) + (size_t)l * 5632 * 1024, 1);
        convT(lds, p.in[28] + (size_t)l * 2816 * 1024, 2816, 1024, 1024, nullptr, (bf16_t*)(ws + O_WDOWN) + (size_t)l * 1024 * 2816, 0);
    }
    {
        float* tile = (float*)lds;
        const int tid = tid_fresh();
        for (int u = blockIdx.x; u < 2 * 16 * 16; u += gridDim.x) {
            const int l = u >> 8, kt = (u & 255) & 15, ntile = (u & 255) >> 4;
            const int k0 = kt * 64, n0 = ntile * 64;
            const float* W = p.in[22] + (size_t)l * 1024 * 1024;
            bf16_t* dst = (bf16_t*)(ws + O_WOUT) + (size_t)l * 1024 * 1024;
#pragma unroll
            for (int i = 0; i < 8; ++i) {
                const int kk = (tid >> 6) + 8 * i, nn = tid & 63, k = k0 + kk;
                const float g = (k < 256) ? p.in[19][l * 256 + k] : (k < 768) ? p.in[20][l * 512 + k - 256] : p.in[21][l * 256 + k - 768];
                tile[kk * 65 + nn] = W[(size_t)k * 1024 + n0 + nn] * g;
            }
            __syncthreads();
            {
                const int nn = tid >> 3, kb = (tid & 7) * 8;
                u32x4 w;
                w.x = pack2(tile[(kb + 0) * 65 + nn], tile[(kb + 1) * 65 + nn]);
                w.y = pack2(tile[(kb + 2) * 65 + nn], tile[(kb + 3) * 65 + nn]);
                w.z = pack2(tile[(kb + 4) * 65 + nn], tile[(kb + 5) * 65 + nn]);
                w.w = pack2(tile[(kb + 6) * 65 + nn], tile[(kb + 7) * 65 + nn]);
                *(u32x4*)(dst + (size_t)(n0 + nn) * 1024 + k0 + kb) = w;
            }
            __syncthreads();
        }
    }
    hy_h2_phase(lds, p);
    rownorm_phase(p.in[0], (bf16_t*)(ws + O_XN));
    grid.sync();
    const XcdBarrier xb = xcd_barrier_post(bar, xb_st);


#pragma unroll 1
    for (int l = 0; l < 2; ++l) {
        {
            EpiIn e; e.hyT = (float*)(ws + O_HYT); e.projb = (bf16_t*)(ws + O_PROJB);
            gemm_phase<false>(lds, (const bf16_t*)(ws + O_XN), 1024, (const bf16_t*)(ws + O_WIN) + (size_t)l * 2048 * 1024, 1024, 64, 16, e);
        }
        XSYNC();
#pragma unroll 1
        for (int rep = 0; rep < REP_EW; ++rep) prep_phase(p, l);
        XSYNC();
        {
            EpiUq e; e.Qm = (bf16_t*)(ws + O_QM); e.rq = (const float*)(ws + O_RQ); e.sc = 0.10206207261596577f * 1.4426950408889634f;
            gemm_phase<false>(lds, (const bf16_t*)(ws + O_PROJB) + 768, 1184, (const bf16_t*)(ws + O_WUQ) + (size_t)l * 384 * 256, 256, 64, 3, e);
            EpiUkv e2; e2.Km = (bf16_t*)(ws + O_KM); e2.VmT = (bf16_t*)(ws + O_VMT); e2.rkv = (const float*)(ws + O_RKV);
            gemm_phase<false>(lds, (const bf16_t*)(ws + O_PROJB) + 1024, 1184, (const bf16_t*)(ws + O_WUKV) + (size_t)l * 512 * 128, 128, 64, 4, e2);
        }
        XSYNC();
#pragma unroll 1
        for (int rep = 0; rep < REP_HY; ++rep)
        for (int c = blockIdx.x; c < 256; c += gridDim.x) hyena_unit(lds, p, l, c);
#pragma unroll 1
        for (int rep = 0; rep < REP_ATTN; ++rep)
        for (int u = blockIdx.x; u < 512; u += gridDim.x) {
            const int qt = u & 31, hh = (u >> 5) & 7, b = u >> 8, hk = hh >> 2;
            attn_unit<64>(lds, (const bf16_t*)(ws + O_QG) + ((size_t)(b * 8 + hh) * L_ + qt * 256) * 64,
                          (const bf16_t*)(ws + O_KG) + (size_t)(b * 2 + hk) * L_ * 64,
                          (const bf16_t*)(ws + O_VGT) + (size_t)(b * 2 + hk) * 64 * L_,
                          (bf16_t*)(ws + O_PROJB) + (size_t)(b * L_ + qt * 256) * 768 + hh * 64);
        }
#pragma unroll 1
        for (int rep = 0; rep < REP_ATTN; ++rep)
        for (int u = blockIdx.x; u < 256; u += gridDim.x) {
            const int qt = u & 31, hh = (u >> 5) & 3, b = u >> 7;
            attn_unit<96>(lds, (const bf16_t*)(ws + O_QM) + ((size_t)(b * 4 + hh) * L_ + qt * 256) * 96,
                          (const bf16_t*)(ws + O_KM) + (size_t)(b * 4 + hh) * L_ * 96,
                          (const bf16_t*)(ws + O_VMT) + (size_t)(b * 4 + hh) * 64 * L_,
                          (bf16_t*)(ws + O_PROJB) + (size_t)(b * L_ + qt * 256) * 768 + 512 + hh * 64);
        }
        XSYNC();
#pragma unroll 1
        for (int rep = 0; rep < REP_EW; ++rep) groups_phase(lds, p);
        XSYNC();
        {
            EpiF32 e; e.C = (float*)(ws + O_R1); e.ldc = 1024;
            gemm_phase<false>(lds, (const bf16_t*)(ws + O_HYT), 1024, (const bf16_t*)(ws + O_WOUT) + (size_t)l * 1024 * 1024, 1024, 64, 8, e);
        }
        XSYNC();
        resid_phase((const float*)(ws + O_R1), l == 0 ? p.in[0] : p.out, p.in[23] + l * 1024, p.out, (bf16_t*)(ws + O_XN), true);
        XSYNC();
        {
            EpiUp e; e.act = (bf16_t*)(ws + O_HYT); e.cw = p.in[26] + (size_t)l * 3 * 5632; e.cb = p.in[27] + (size_t)l * 5632;
            gemm_phase<true>(lds, (const bf16_t*)(ws + O_XN), 1024, (const bf16_t*)(ws + O_WUP) + (size_t)l * 5632 * 1024, 1024, 66, 44, e);
        }
        XSYNC();
        {
            EpiF32 e; e.C = (float*)(ws + O_R1); e.ldc = 1024;
            gemm_phase<false>(lds, (const bf16_t*)(ws + O_HYT), 2816, (const bf16_t*)(ws + O_WDOWN) + (size_t)l * 1024 * 2816, 2816, 64, 8, e);
        }
        XSYNC();
        resid_phase((const float*)(ws + O_R1), p.out, p.in[29] + l * 1024, p.out, (bf16_t*)(ws + O_XN), l == 0);
        if (l == 0) XSYNC();
    }
}

extern "C" void kernel_launch(void* const* d_in, const int* in_sizes, int n_in,
                              void* d_out, int out_size, void* d_ws, size_t ws_size,
                              hipStream_t stream) {
    static int grid_blocks = 0;
    if (!grid_blocks) {
        int dev = 0, cus = 0, per_cu = 0;
        (void)hipGetDevice(&dev);
        (void)hipDeviceGetAttribute(&cus, hipDeviceAttributeMultiprocessorCount, dev);
        (void)hipFuncSetAttribute((const void*)fwd_megakernel, hipFuncAttributeMaxDynamicSharedMemorySize, (int)LDS_BYTES);
        (void)hipOccupancyMaxActiveBlocksPerMultiprocessor(&per_cu, fwd_megakernel, NTHR, LDS_BYTES);
        if (per_cu < 1) per_cu = 1;
        grid_blocks = cus;
        if (grid_blocks > 256) grid_blocks = 256;
    }
    Params p{};
    for (int i = 0; i < 30; ++i) p.in[i] = (const float*)d_in[i];
    p.out = (float*)d_out; p.ws = (unsigned char*)d_ws;
    void* args[] = {&p};
    hipError_t e = hipLaunchCooperativeKernel((void*)fwd_megakernel, dim3(grid_blocks), dim3(NTHR), args, LDS_BYTES, stream);
    if (e != hipSuccess) fprintf(stderr, "cooperative launch failed: %s (grid %d)\n", hipGetErrorString(e), grid_blocks);
}
```

```cpp
#include <hip/hip_runtime.h>
#include <hip/hip_cooperative_groups.h>
#include <cstdio>
#include <cstdint>
namespace cg = cooperative_groups;

typedef unsigned short bf16_t;
typedef short bf16x8 __attribute__((ext_vector_type(8)));
typedef float f32x4 __attribute__((ext_vector_type(4)));
typedef float f32x16 __attribute__((ext_vector_type(16)));
typedef unsigned u32x2 __attribute__((ext_vector_type(2)));
typedef unsigned u32x4 __attribute__((ext_vector_type(4)));

#define DI __device__ __forceinline__
#ifndef REP_ATTN
#define REP_ATTN 1
#endif
#ifndef REP_HY
#define REP_HY 1
#endif
#ifndef REP_GEMM
#define REP_GEMM 1
#endif
#ifndef REP_PRO
#define REP_PRO 1
#endif
#ifndef REP_SYNC
#define REP_SYNC 1
#endif
#define XSYNC() do { _Pragma("unroll 1") for (int r_ = 0; r_ < REP_SYNC; ++r_) xcd_barrier(xb); } while (0)
#ifndef REP_EW
#define REP_EW 1
#endif
constexpr int L_ = 8192, T_ = 16384, NTHR = 512;
constexpr size_t MiB = 1u << 20;
constexpr size_t O_WIN = 0, O_WUQ = 8 * MiB, O_WUKV = 8 * MiB + 384 * 1024, O_RQ = 8 * MiB + 640 * 1024, O_RKV = 8 * MiB + 704 * 1024;
constexpr size_t O_BAR = 8 * MiB + 768 * 1024;
constexpr size_t O_WOUT = 9 * MiB, O_WUP = 13 * MiB, O_WDOWN = 35 * MiB, O_H2 = 46 * MiB;
constexpr size_t O_R1 = 50 * MiB;
constexpr size_t O_HYT = 114 * MiB;
constexpr size_t O_PROJB = 162 * MiB;
constexpr size_t O_HYOUT = 186 * MiB;
constexpr size_t O_QG = 199 * MiB, O_KG = 215 * MiB, O_VGT = 219 * MiB, O_QM = 223 * MiB, O_KM = 235 * MiB, O_VMT = 247 * MiB;
constexpr size_t O_XN = 223 * MiB;
constexpr size_t LDS_BYTES = 150 * 1024;

struct Params { const float* in[30]; float* out; unsigned char* ws; };

typedef __bf16 bf16v2_t __attribute__((ext_vector_type(2)));
typedef float f32v2_t __attribute__((ext_vector_type(2)));
DI bf16_t f2bf(float x) { const __bf16 b = (__bf16)x; return __builtin_bit_cast(bf16_t, b); }
DI float bf2f(bf16_t v) { return __uint_as_float(((unsigned)v) << 16); }
DI unsigned pack2(float lo, float hi) { const f32v2_t v = {lo, hi}; const bf16v2_t b = __builtin_convertvector(v, bf16v2_t); return __builtin_bit_cast(unsigned, b); }
DI float wave_sum(float v) {
#pragma unroll
    for (int o = 32; o >= 1; o >>= 1) v += __shfl_xor(v, o);
    return v;
}
DI int tid_fresh() { int t = threadIdx.x; asm volatile("" : "+v"(t)); return t; }
DI int perm16(int t) { return (t & ~15) | (t & 3) | (((t >> 3) & 1) << 2) | (((t >> 2) & 1) << 3); }

DI void convT(unsigned char* lds, const float* __restrict__ W, int K, int N, int Npad, const float* __restrict__ gain, bf16_t* __restrict__ dst, int mode) {
    float* tile = (float*)lds;
    const int tid = tid_fresh();
    const int nkt = K >> 6, nnt = Npad >> 6;
    for (int u = blockIdx.x; u < nkt * nnt; u += gridDim.x) {
        const int kt = u % nkt, ntile = u / nkt;
        const int k0 = kt * 64, n0 = ntile * 64;
        int src0 = n0;
        if (mode == 1) { const int jt = n0 >> 7, half = (n0 >> 6) & 1; src0 = half ? 2816 + 64 * jt : 64 * jt; }
        const bool valid = (mode == 1) || (n0 < N);
#pragma unroll
        for (int i = 0; i < 8; ++i) {
            const int kk = (tid >> 6) + 8 * i, nn = tid & 63;
            float v = 0.f;
            if (valid && (src0 + nn) < N) v = W[(size_t)(k0 + kk) * N + src0 + nn] * (gain ? gain[k0 + kk] : 1.0f);
            tile[kk * 65 + nn] = v;
        }
        __syncthreads();
        {
            const int nn = tid >> 3, kb = (tid & 7) * 8;
            u32x4 w;
            w.x = pack2(tile[(kb + 0) * 65 + nn], tile[(kb + 1) * 65 + nn]);
            w.y = pack2(tile[(kb + 2) * 65 + nn], tile[(kb + 3) * 65 + nn]);
            w.z = pack2(tile[(kb + 4) * 65 + nn], tile[(kb + 5) * 65 + nn]);
            w.w = pack2(tile[(kb + 6) * 65 + nn], tile[(kb + 7) * 65 + nn]);
            *(u32x4*)(dst + (size_t)(n0 + nn) * K + k0 + kb) = w;
        }
        __syncthreads();
    }
}

DI void hy_h2_phase(unsigned char* lds, const Params& p) {
    float* zs = (float*)lds;
    float* h1s = zs + 8 * 36;
    const int tid = tid_fresh(), rr = tid >> 6, j = tid & 63;
    float* h2 = (float*)(p.ws + O_H2);
    for (int u = blockIdx.x; u < 2 * (L_ / 8); u += gridDim.x) {
        const int l = u / (L_ / 8), t = (u % (L_ / 8)) * 8 + rr;
        if (j < 16) {
            const float w = 2.0f * 3.14159265358979323846f * (float)t / (float)L_;
            const float f = 1e-4f + (15.0f - 1e-4f) * (float)j / 15.0f;
            const float a = f * w;
            zs[rr * 36 + 1 + j] = cosf(a);
            zs[rr * 36 + 17 + j] = -sinf(a);
            if (j == 0) zs[rr * 36] = (float)t / (float)(L_ - 1);
        }
        __syncthreads();
        {
            const float* w1 = p.in[5] + (size_t)l * 33 * 64;
            float s = p.in[6][l * 64 + j];
#pragma unroll
            for (int e = 0; e < 33; ++e) s += zs[rr * 36 + e] * w1[e * 64 + j];
            h1s[rr * 64 + j] = sinf(p.in[7][l * 64 + j] * s);
        }
        __syncthreads();
        {
            const float* w2 = p.in[8] + (size_t)l * 64 * 64;
            float s = p.in[9][l * 64 + j];
#pragma unroll 8
            for (int e = 0; e < 64; ++e) s += h1s[rr * 64 + e] * w2[e * 64 + j];
            h2[((size_t)l * L_ + t) * 64 + j] = sinf(p.in[10][l * 64 + j] * s);
        }
        __syncthreads();
    }
}


DI void ft_phase(unsigned char* lds, const Params& p, int l) {
    float* hs = (float*)lds;
    const int tid = tid_fresh();
    const float* h2 = (const float*)(p.ws + O_H2) + (size_t)l * L_ * 64;
    const float* w3 = p.in[11] + (size_t)l * 64 * 1024;
    const int c = tid & 255, dir = tid >> 8;
    const float min_decay = -4.605170185988091f / 1.5f, max_decay = -4.605170185988091f / 0.3f;
    const float dlt = fabsf(min_decay + (max_decay - min_decay) * (float)c / 255.0f);
    for (int u = blockIdx.x; u < L_ / 32; u += gridDim.x) {
        const int t0 = u * 32;
        *(f32x4*)(hs + tid * 4) = *(const f32x4*)(h2 + (size_t)t0 * 64 + tid * 4);
        __syncthreads();
#pragma unroll 1
        for (int o = 0; o < 2; ++o) {
            float wa[64];
#pragma unroll
            for (int j = 0; j < 64; ++j) wa[j] = w3[j * 1024 + o * 512 + tid];
            float* dstA = (float*)(p.ws + O_R1 + (size_t)c * 262144 + 131072) + (2 * o + dir) * L_ + t0;
#pragma unroll 1
            for (int tt = 0; tt < 32; tt += 4) {
                f32x4 ra;
#pragma unroll
                for (int e = 0; e < 4; ++e) {
                    const float* hr = hs + (tt + e) * 64;
                    float da = 0.f;
#pragma unroll
                    for (int jj = 0; jj < 16; ++jj) {
                        const f32x4 hv = *(const f32x4*)(hr + 4 * jj);
#pragma unroll
                        for (int k = 0; k < 4; ++k) da += hv[k] * wa[4 * jj + k];
                    }
                    const float win = expf(-((float)(t0 + tt + e) / (float)(L_ - 1)) * dlt);
                    ra[e] = da * win;
                    asm volatile("" ::: "memory");
                }
                *(f32x4*)(dstA + tt) = ra;
            }
        }
        __syncthreads();
    }
}

DI void rownorm_phase(const float* __restrict__ x, bf16_t* __restrict__ xn) {
    const int tid_ = tid_fresh(); const int lane = tid_ & 63, wid = tid_ >> 6;
    for (int row = blockIdx.x * 8 + wid; row < T_; row += gridDim.x * 8) {
        const float* xr = x + (size_t)row * 1024;
        f32x4 v[4]; float ss = 0.f;
#pragma unroll
        for (int i = 0; i < 4; ++i) { v[i] = *(const f32x4*)(xr + i * 256 + lane * 4); ss += v[i][0] * v[i][0] + v[i][1] * v[i][1] + v[i][2] * v[i][2] + v[i][3] * v[i][3]; }
        ss = wave_sum(ss);
        const float r = rsqrtf(ss * (1.0f / 1024.0f) + 1e-6f);
#pragma unroll
        for (int i = 0; i < 4; ++i) { u32x2 w; w.x = pack2(v[i][0] * r, v[i][1] * r); w.y = pack2(v[i][2] * r, v[i][3] * r); *(u32x2*)(xn + (size_t)row * 1024 + i * 256 + lane * 4) = w; }
    }
}

DI void resid_phase(const float* __restrict__ y, const float* __restrict__ xres, const float* __restrict__ g, float* __restrict__ xout, bf16_t* __restrict__ xn, bool want_xn) {
    const int tid_ = tid_fresh(); const int lane = tid_ & 63, wid = tid_ >> 6;
    for (int row = blockIdx.x * 8 + wid; row < T_; row += gridDim.x * 8) {
        const size_t ro = (size_t)row * 1024;
        f32x4 v[4]; float ss = 0.f;
#pragma unroll
        for (int i = 0; i < 4; ++i) { v[i] = *(const f32x4*)(y + ro + i * 256 + lane * 4); ss += v[i][0] * v[i][0] + v[i][1] * v[i][1] + v[i][2] * v[i][2] + v[i][3] * v[i][3]; }
        ss = wave_sum(ss);
        const float r = rsqrtf(ss * (1.0f / 1024.0f) + 1e-6f);
        float s2 = 0.f;
#pragma unroll
        for (int i = 0; i < 4; ++i) {
            const f32x4 xr = *(const f32x4*)(xres + ro + i * 256 + lane * 4);
            const f32x4 gg = *(const f32x4*)(g + i * 256 + lane * 4);
            v[i] = xr + v[i] * r * gg;
            s2 += v[i][0] * v[i][0] + v[i][1] * v[i][1] + v[i][2] * v[i][2] + v[i][3] * v[i][3];
            *(f32x4*)(xout + ro + i * 256 + lane * 4) = v[i];
        }
        if (want_xn) {
            s2 = wave_sum(s2);
            const float r2 = rsqrtf(s2 * (1.0f / 1024.0f) + 1e-6f);
#pragma unroll
            for (int i = 0; i < 4; ++i) { u32x2 w; w.x = pack2(v[i][0] * r2, v[i][1] * r2); w.y = pack2(v[i][2] * r2, v[i][3] * r2); *(u32x2*)(xn + ro + i * 256 + lane * 4) = w; }
        }
    }
}

DI int swz128(int row, int chunk) { return row * 128 + ((chunk ^ ((row >> 1) & 7)) << 4); }

template <bool OVL, class Epi>
DI void gemm_phase(unsigned char* lds, const bf16_t* __restrict__ A, int lda, const bf16_t* __restrict__ Bt, int K, int nMt, int nNt, const Epi& epi) {
    typedef __attribute__((address_space(3))) unsigned char lds_uc;
    lds_uc* ldsl = (lds_uc*)lds;
    const int tid = tid_fresh(), lane = tid & 63, wid = tid >> 6, wm = wid & 3, wn = wid >> 2;
    const int r16 = lane & 15, q4 = lane >> 4;
    const int nk = K >> 6;
    const int xr = (r16 >> 1) & 7;
    const int ab0 = (64 * wm + r16) * 128 + ((q4 ^ xr) << 4), ab1 = (64 * wm + r16) * 128 + (((4 + q4) ^ xr) << 4);
    const int bb0 = 32768 + (64 * wn + r16) * 128 + ((q4 ^ xr) << 4), bb1 = 32768 + (64 * wn + r16) * 128 + (((4 + q4) ^ xr) << 4);
#pragma unroll 1
    for (int rep = 0; rep < REP_GEMM; ++rep)
    for (int u = blockIdx.x; u < nMt * nNt; u += gridDim.x) {
        const int um = u % nMt, un = u / nMt;
        const bf16_t* ap[4]; const bf16_t* bp[2];
        int t0 = 0, bb = 0;
        if (OVL) { bb = um / 33; t0 = 254 * (um % 33) - 1; }
#pragma unroll
        for (int i = 0; i < 4; ++i) {
            const int P = (wid * 4 + i) * 64 + lane, row = P >> 3, c = (P & 7) ^ ((row >> 1) & 7);
            int grow;
            if (OVL) { int t = t0 + row; t = t < 0 ? 0 : (t > L_ - 1 ? L_ - 1 : t); grow = bb * L_ + t; }
            else grow = um * 256 + row;
            ap[i] = A + (size_t)grow * lda + c * 8;
        }
#pragma unroll
        for (int i = 0; i < 2; ++i) {
            const int P = (wid * 2 + i) * 64 + lane, row = P >> 3, c = (P & 7) ^ ((row >> 1) & 7);
            bp[i] = Bt + (size_t)(un * 128 + row) * K + c * 8;
        }
        f32x4 acc[4][4];
#pragma unroll
        for (int a = 0; a < 4; ++a)
#pragma unroll
            for (int b = 0; b < 4; ++b) acc[a][b] = (f32x4){0.f, 0.f, 0.f, 0.f};
#define G_ISSUE(bufoff) do { _Pragma("unroll") for (int i = 0; i < 4; ++i) { __builtin_amdgcn_global_load_lds((const unsigned*)ap[i], (__attribute__((address_space(3))) unsigned*)(ldsl + (bufoff) + (wid * 4 + i) * 1024), 16, 0, 0); ap[i] += 64; } \
                             _Pragma("unroll") for (int i = 0; i < 2; ++i) { __builtin_amdgcn_global_load_lds((const unsigned*)bp[i], (__attribute__((address_space(3))) unsigned*)(ldsl + (bufoff) + 32768 + (wid * 2 + i) * 1024), 16, 0, 0); bp[i] += 64; } } while (0)
        __syncthreads();
        G_ISSUE(0);
        if (nk > 1) G_ISSUE(49152);
        int cb = 0, nb = 2 * 49152;
#pragma unroll 1
        for (int kt = 0; kt < nk; ++kt) {
            if (kt + 1 < nk) asm volatile("s_waitcnt vmcnt(6)" ::: "memory"); else asm volatile("s_waitcnt vmcnt(0)" ::: "memory");
            __builtin_amdgcn_s_barrier();
            asm volatile("" ::: "memory");
            if (kt + 2 < nk) G_ISSUE(nb);
            const unsigned char* lb = lds + cb;
            bf16x8 af0[4], bf0[4], af1[4], bf1[4];
            af0[0] = *(const bf16x8*)(lb + ab0);
#pragma unroll
            for (int nt = 0; nt < 4; ++nt) bf0[nt] = *(const bf16x8*)(lb + bb0 + nt * 2048);
#pragma unroll
            for (int mt = 1; mt < 4; ++mt) af0[mt] = *(const bf16x8*)(lb + ab0 + mt * 2048);
            af1[0] = *(const bf16x8*)(lb + ab1);
#pragma unroll
            for (int nt = 0; nt < 4; ++nt) bf1[nt] = *(const bf16x8*)(lb + bb1 + nt * 2048);
#pragma unroll
            for (int mt = 1; mt < 4; ++mt) af1[mt] = *(const bf16x8*)(lb + ab1 + mt * 2048);
            __builtin_amdgcn_sched_barrier(0);
#pragma unroll
            for (int mt = 0; mt < 4; ++mt)
#pragma unroll
                for (int nt = 0; nt < 4; ++nt) acc[mt][nt] = __builtin_amdgcn_mfma_f32_16x16x32_bf16(bf0[nt], af0[mt], acc[mt][nt], 0, 0, 0);
#pragma unroll
            for (int mt = 0; mt < 4; ++mt)
#pragma unroll
                for (int nt = 0; nt < 4; ++nt) acc[mt][nt] = __builtin_amdgcn_mfma_f32_16x16x32_bf16(bf1[nt], af1[mt], acc[mt][nt], 0, 0, 0);
            __builtin_amdgcn_sched_barrier(0);
            asm volatile("" ::: "memory");
            cb = (cb == 2 * 49152) ? 0 : cb + 49152;
            nb = (nb == 2 * 49152) ? 0 : nb + 49152;
        }
        if constexpr (Epi::STAGED) __syncthreads();
        int r16e = r16, q4e = q4;
        asm volatile("" : "+v"(r16e), "+v"(q4e));
        if constexpr (Epi::STAGED) {
            epi.staged(lds, acc, um, un, wm, wn, r16e, q4e);
        } else {
#pragma unroll
            for (int mt = 0; mt < 4; ++mt) { epi.row(um * 256 + 64 * wm + 16 * mt + r16e, un * 128 + 64 * wn, q4e, acc[mt]); asm volatile("" ::: "memory"); }
        }
    }
#undef G_ISSUE
}

struct EpiIn {
    static constexpr bool STAGED = true;
    float* hyT; bf16_t* projb;
    DI void staged(unsigned char* lds, const f32x4 (&acc)[4][4], int um, int un, int wm, int wn, int r16, int q4) const {
        if (un < 6) {
            float* st = (float*)lds + (wm + 4 * wn) * (64 * 65);
#pragma unroll
            for (int mt = 0; mt < 4; ++mt)
#pragma unroll
                for (int nt = 0; nt < 4; ++nt)
#pragma unroll
                    for (int i = 0; i < 4; ++i) st[(16 * nt + 4 * q4 + i) * 65 + 16 * mt + r16] = acc[mt][nt][i];
            asm volatile("s_waitcnt lgkmcnt(0)" ::: "memory");
            const int lane = r16 + 16 * q4;
            float* dst = hyT + (size_t)(un * 128 + 64 * wn) * T_ + um * 256 + 64 * wm + lane;
#pragma unroll 4
            for (int n = 0; n < 64; ++n) dst[(size_t)n * T_] = st[n * 65 + lane];
            __syncthreads();
        } else {
#pragma unroll
            for (int mt = 0; mt < 4; ++mt) {
                const int tok = um * 256 + 64 * wm + 16 * mt + r16;
#pragma unroll
                for (int nt = 0; nt < 4; ++nt) {
                    const int col = un * 128 + 64 * wn + 16 * nt + 4 * q4;
                    if (col < 1952) {
                        u32x2 w; w.x = pack2(acc[mt][nt][0], acc[mt][nt][1]); w.y = pack2(acc[mt][nt][2], acc[mt][nt][3]);
                        *(u32x2*)(projb + (unsigned)(tok * 1184 + (col - 768))) = w;
                    }
                }
            }
        }
    }
};
struct EpiF32 {
    static constexpr bool STAGED = false;
    float* C; int ldc;
    DI void row(int tok, int colbase, int q4, const f32x4 (&a)[4]) const {
#pragma unroll
        for (int nt = 0; nt < 4; ++nt) *(f32x4*)(C + (size_t)tok * ldc + colbase + 16 * nt + 4 * q4) = a[nt];
    }
};
struct EpiUq {
    static constexpr bool STAGED = false;
    bf16_t* Qm; const float* rq; float sc;
    DI void row(int tok, int colbase, int q4, const f32x4 (&a)[4]) const {
        const float r = rq[tok] * sc;
        const int b = tok >> 13, t = tok & (L_ - 1);
#pragma unroll
        for (int nt = 0; nt < 4; ++nt) {
            const int col = colbase + 16 * nt + 4 * q4;
            if (col >= 384) continue;
            const int head = col / 96, j = col - head * 96;
            bf16_t* dst = Qm + ((size_t)(b * 4 + head) * L_ + t) * 96;
            if (j < 64) {
                u32x2 w; w.x = pack2(a[nt][0] * r, a[nt][1] * r); w.y = pack2(a[nt][2] * r, a[nt][3] * r);
                *(u32x2*)(dst + j) = w;
            } else if (j < 80) {
                if (nt < 3) {
                    const int p0 = j - 64;
                    float o1[4], o2[4];
#pragma unroll
                    for (int i = 0; i < 4; ++i) {
                        const int pp = p0 + i;
                        const float inv = __expf(-(float)(pp & 7) * (9.210340371976184f / 8.0f));
                        const float ang = (float)((pp < 8) ? (t >> 6) : (t & 63)) * inv;
                        float sn, cs; sincosf(ang, &sn, &cs);
                        const float x1 = a[nt][i] * r, x2 = a[(nt < 3) ? nt + 1 : 3][i] * r;
                        o1[i] = x1 * cs - x2 * sn; o2[i] = x1 * sn + x2 * cs;
                    }
                    u32x2 w; w.x = pack2(o1[0], o1[1]); w.y = pack2(o1[2], o1[3]);
                    *(u32x2*)(dst + j) = w;
                    w.x = pack2(o2[0], o2[1]); w.y = pack2(o2[2], o2[3]);
                    *(u32x2*)(dst + j + 16) = w;
                }
            }
        }
    }
};
struct EpiUkv {
    static constexpr bool STAGED = false;
    bf16_t* Km; bf16_t* VmT; const float* rkv;
    DI void row(int tok, int colbase, int q4, const f32x4 (&a)[4]) const {
        const float r = rkv[tok];
        const int b = tok >> 13, t = tok & (L_ - 1);
#pragma unroll
        for (int nt = 0; nt < 4; ++nt) {
            const int col = colbase + 16 * nt + 4 * q4;
            const int head = col >> 7, j = col & 127;
            if (j < 64) {
                u32x2 w; w.x = pack2(a[nt][0] * r, a[nt][1] * r); w.y = pack2(a[nt][2] * r, a[nt][3] * r);
                *(u32x2*)(Km + ((size_t)(b * 4 + head) * L_ + t) * 96 + j) = w;
            } else {
#pragma unroll
                for (int i = 0; i < 4; ++i) VmT[((size_t)(b * 4 + head) * 64 + (j - 64 + i)) * L_ + perm16(t)] = f2bf(a[nt][i] * r);
            }
        }
    }
};
DI float gelu_tanh(float x) {
    const float u = 0.7978845608028654f * (x + 0.044715f * x * x * x);
    const float e = __expf(2.0f * u);
    const float th = 1.0f - 2.0f / (e + 1.0f);
    return 0.5f * x * (1.0f + th);
}
struct EpiUp {
    static constexpr bool STAGED = true;
    bf16_t* act; const float* cw; const float* cb;
    DI void staged(unsigned char* lds, const f32x4 (&acc)[4][4], int um, int un, int wm, int wn, int r16, int q4) const {
        float* st = (float*)lds;
#pragma unroll
        for (int mt = 0; mt < 4; ++mt)
#pragma unroll
            for (int nt = 0; nt < 4; ++nt) *(f32x4*)(st + (64 * wm + 16 * mt + r16) * 132 + 64 * wn + 16 * nt + 4 * q4) = acc[mt][nt];
        __syncthreads();
        const int tid = tid_fresh(), j = tid & 63, seg = tid >> 6;
        const int ch = 64 * un + j;
        const float g0 = cw[ch], g1 = cw[5632 + ch], g2 = cw[2 * 5632 + ch], gb = cb[ch];
        const float v0 = cw[2816 + ch], v1 = cw[5632 + 2816 + ch], v2 = cw[2 * 5632 + 2816 + ch], vb = cb[2816 + ch];
        const int bb = um / 33, t0 = 254 * (um % 33) - 1;
        const int r0 = 32 * seg;
#define UPV(rr, cc) ((((rr) >= 0) && ((rr) <= 255) && (t0 + (rr) >= 0) && (t0 + (rr) < L_)) ? st[(rr) * 132 + (cc)] : 0.f)
        float gp = UPV(r0 - 1, j), vp = UPV(r0 - 1, 64 + j);
        float gc = UPV(r0, j), vc = UPV(r0, 64 + j);
#pragma unroll 4
        for (int i = 0; i < 32; ++i) {
            const int r = r0 + i;
            const float gn = UPV(r + 1, j), vn = UPV(r + 1, 64 + j);
            const int t = t0 + r;
            if (r >= 1 && r <= 254 && t < L_) {
                const float cg = g0 * gp + g1 * gc + g2 * gn + gb;
                const float cv = v0 * vp + v1 * vc + v2 * vn + vb;
                act[(size_t)(bb * L_ + t) * 2816 + ch] = f2bf(gelu_tanh(cg) * cv);
            }
            gp = gc; gc = gn; vp = vc; vc = vn;
        }
#undef UPV
        __syncthreads();
    }
};

DI void prep_phase(const Params& p, int l) {
    const int tid_ = tid_fresh(); const int lane = tid_ & 63, wid = tid_ >> 6;
    const bf16_t* projb = (const bf16_t*)(p.ws + O_PROJB);
    bf16_t* Qg = (bf16_t*)(p.ws + O_QG); bf16_t* Kg = (bf16_t*)(p.ws + O_KG); bf16_t* VgT = (bf16_t*)(p.ws + O_VGT);
    bf16_t* Km = (bf16_t*)(p.ws + O_KM);
    float* rq = (float*)(p.ws + O_RQ); float* rkv = (float*)(p.ws + O_RKV);
    const float* gq = p.in[13] + l * 64; const float* gk = p.in[14] + l * 64;
    const int hd = lane >> 3, sub = lane & 7;
    float gq1[4], gq2[4], gk1[4], gk2[4];
#pragma unroll
    for (int i = 0; i < 4; ++i) { gq1[i] = gq[4 * sub + i]; gq2[i] = gq[32 + 4 * sub + i]; gk1[i] = gk[4 * sub + i]; gk2[i] = gk[32 + 4 * sub + i]; }
    const float qscale = 0.125f * 1.4426950408889634f;
    for (int tok = blockIdx.x * 8 + wid; tok < T_; tok += gridDim.x * 8) {
        const int b = tok >> 13, t = tok & (L_ - 1);
        const bf16_t* pr = projb + (size_t)tok * 1184;
        float cs[4], sn[4];
#pragma unroll
        for (int i = 0; i < 4; ++i) {
            const int pp = 4 * sub + i;
            const float inv = __expf(-(float)(pp & 15) * (9.210340371976184f / 16.0f));
            const float ang = (float)((pp < 16) ? (t >> 6) : (t & 63)) * inv;
            sincosf(ang, &sn[i], &cs[i]);
        }
        {
            const u32x2 w1 = *(const u32x2*)(pr + hd * 64 + 4 * sub), w2 = *(const u32x2*)(pr + hd * 64 + 32 + 4 * sub);
            float x1[4] = {bf2f((bf16_t)(w1.x & 0xffff)), bf2f((bf16_t)(w1.x >> 16)), bf2f((bf16_t)(w1.y & 0xffff)), bf2f((bf16_t)(w1.y >> 16))};
            float x2[4] = {bf2f((bf16_t)(w2.x & 0xffff)), bf2f((bf16_t)(w2.x >> 16)), bf2f((bf16_t)(w2.y & 0xffff)), bf2f((bf16_t)(w2.y >> 16))};
            float ss = 0.f;
#pragma unroll
            for (int i = 0; i < 4; ++i) ss += x1[i] * x1[i] + x2[i] * x2[i];
            ss += __shfl_xor(ss, 1); ss += __shfl_xor(ss, 2); ss += __shfl_xor(ss, 4);
            const float r = rsqrtf(ss * (1.0f / 64.0f) + 1e-6f);
            float o1[4], o2[4];
#pragma unroll
            for (int i = 0; i < 4; ++i) { const float a = x1[i] * r * gq1[i], c = x2[i] * r * gq2[i]; o1[i] = (a * cs[i] - c * sn[i]) * qscale; o2[i] = (a * sn[i] + c * cs[i]) * qscale; }
            bf16_t* dst = Qg + ((size_t)(b * 8 + hd) * L_ + t) * 64;
            u32x2 w; w.x = pack2(o1[0], o1[1]); w.y = pack2(o1[2], o1[3]); *(u32x2*)(dst + 4 * sub) = w;
            w.x = pack2(o2[0], o2[1]); w.y = pack2(o2[2], o2[3]); *(u32x2*)(dst + 32 + 4 * sub) = w;
        }
        if (lane < 16) {
            const u32x2 w1 = *(const u32x2*)(pr + 512 + hd * 64 + 4 * sub), w2 = *(const u32x2*)(pr + 512 + hd * 64 + 32 + 4 * sub);
            float x1[4] = {bf2f((bf16_t)(w1.x & 0xffff)), bf2f((bf16_t)(w1.x >> 16)), bf2f((bf16_t)(w1.y & 0xffff)), bf2f((bf16_t)(w1.y >> 16))};
            float x2[4] = {bf2f((bf16_t)(w2.x & 0xffff)), bf2f((bf16_t)(w2.x >> 16)), bf2f((bf16_t)(w2.y & 0xffff)), bf2f((bf16_t)(w2.y >> 16))};
            float ss = 0.f;
#pragma unroll
            for (int i = 0; i < 4; ++i) ss += x1[i] * x1[i] + x2[i] * x2[i];
            ss += __shfl_xor(ss, 1); ss += __shfl_xor(ss, 2); ss += __shfl_xor(ss, 4);
            const float r = rsqrtf(ss * (1.0f / 64.0f) + 1e-6f);
            float o1[4], o2[4];
#pragma unroll
            for (int i = 0; i < 4; ++i) { const float a = x1[i] * r * gk1[i], c = x2[i] * r * gk2[i]; o1[i] = a * cs[i] - c * sn[i]; o2[i] = a * sn[i] + c * cs[i]; }
            bf16_t* dst = Kg + ((size_t)(b * 2 + hd) * L_ + t) * 64;
            u32x2 w; w.x = pack2(o1[0], o1[1]); w.y = pack2(o1[2], o1[3]); *(u32x2*)(dst + 4 * sub) = w;
            w.x = pack2(o2[0], o2[1]); w.y = pack2(o2[2], o2[3]); *(u32x2*)(dst + 32 + 4 * sub) = w;
        }
        {
            const unsigned w = *(const unsigned*)(pr + 640 + 2 * lane);
            const int c0 = 2 * lane, kh = c0 >> 6, d = c0 & 63;
            bf16_t* dst = VgT + ((size_t)(b * 2 + kh) * 64 + d) * L_ + perm16(t);
            dst[0] = (bf16_t)(w & 0xffff); dst[L_] = (bf16_t)(w >> 16);
        }
        {
            const u32x2 w = *(const u32x2*)(pr + 768 + 4 * lane);
            const float a0 = bf2f((bf16_t)(w.x & 0xffff)), a1 = bf2f((bf16_t)(w.x >> 16)), a2 = bf2f((bf16_t)(w.y & 0xffff)), a3 = bf2f((bf16_t)(w.y >> 16));
            float ss = wave_sum(a0 * a0 + a1 * a1 + a2 * a2 + a3 * a3);
            if (lane == 0) rq[tok] = rsqrtf(ss * (1.0f / 256.0f) + 1e-6f);
        }
        {
            const unsigned w = *(const unsigned*)(pr + 1024 + 2 * lane);
            const float a0 = bf2f((bf16_t)(w & 0xffff)), a1 = bf2f((bf16_t)(w >> 16));
            float ss = wave_sum(a0 * a0 + a1 * a1);
            if (lane == 0) rkv[tok] = rsqrtf(ss * (1.0f / 128.0f) + 1e-6f);
        }
        if (lane < 16) {
            const float x1 = bf2f(pr[1152 + lane]), x2 = bf2f(pr[1152 + 16 + lane]);
            const float inv = __expf(-(float)(lane & 7) * (9.210340371976184f / 8.0f));
            const float ang = (float)((lane < 8) ? (t >> 6) : (t & 63)) * inv;
            float s1, c1; sincosf(ang, &s1, &c1);
            const bf16_t o1 = f2bf(x1 * c1 - x2 * s1), o2 = f2bf(x1 * s1 + x2 * c1);
#pragma unroll
            for (int hh = 0; hh < 4; ++hh) { bf16_t* dst = Km + ((size_t)(b * 4 + hh) * L_ + t) * 96 + 64; dst[lane] = o1; dst[16 + lane] = o2; }
        }
    }
}

template <int DQK> DI int kswz(int row, int chunk) {
    if (DQK == 64) return row * 128 + ((chunk ^ ((row >> 1) & 7)) << 4);
    else return row * 192 + ((chunk ^ ((row >> 2) & 3)) << 4);
}
template <int DQK>
DI void attn_unit(unsigned char* lds, const bf16_t* __restrict__ Qp, const bf16_t* __restrict__ Kp, const bf16_t* __restrict__ VTp, bf16_t* __restrict__ Yp  ) {
    constexpr int NS = DQK / 16, NC = DQK / 8, KB = 64 * DQK * 2, KVB = KB + 8192;
    const int tid = tid_fresh(), lane = tid & 63, w = tid >> 6, r = lane & 31, h = lane >> 5;
    bf16x8 qf[NS];
#pragma unroll
    for (int s = 0; s < NS; ++s) qf[s] = *(const bf16x8*)(Qp + (size_t)(32 * w + r) * DQK + 16 * s + 8 * h);
    f32x16 o0, o1;
#pragma unroll
    for (int i = 0; i < 16; ++i) { o0[i] = 0.f; o1[i] = 0.f; }
    float m = 0.f, lsum = 0.f;
    const int k_row0 = tid / NC, k_c0 = tid % NC;
    const int k_row1 = (tid + 512) / NC, k_c1 = (tid + 512) % NC;
    const bool k_two = (DQK == 96) && (tid < 256);
    const int v_row = tid >> 3, v_c = tid & 7;
    u32x4 rkA0, rkA1, rvA, rkB0, rkB1, rvB;
    rkA1 = (u32x4){0u, 0u, 0u, 0u}; rkB1 = rkA1;
#define A_LOAD(kt, R0, R1, RV) do { R0 = *(const u32x4*)(Kp + (size_t)((kt) * 64 + k_row0) * DQK + k_c0 * 8); \
                        if (k_two) R1 = *(const u32x4*)(Kp + (size_t)((kt) * 64 + k_row1) * DQK + k_c1 * 8); \
                        RV = *(const u32x4*)(VTp + (size_t)v_row * L_ + (kt) * 64 + v_c * 8); } while (0)
#define A_STORE(buf, R0, R1, RV) do { *(u32x4*)(lds + (buf) * KVB + kswz<DQK>(k_row0, k_c0)) = R0; \
                          if (k_two) *(u32x4*)(lds + (buf) * KVB + kswz<DQK>(k_row1, k_c1)) = R1; \
                          *(u32x4*)(lds + (buf) * KVB + KB + swz128(v_row, v_c)) = RV; } while (0)
    A_LOAD(0, rkA0, rkA1, rvA);
    A_LOAD(1, rkB0, rkB1, rvB);
    A_STORE(0, rkA0, rkA1, rvA);
    __syncthreads();
    constexpr int NKT = L_ / 64;
#pragma unroll 1
    for (int kt2 = 0; kt2 < NKT; kt2 += 2) {
#pragma unroll
      for (int cur = 0; cur < 2; ++cur) {
        const int kt = kt2 + cur;
        if (kt + 2 < NKT) { if (cur == 0) A_LOAD(kt + 2, rkA0, rkA1, rvA); else A_LOAD(kt + 2, rkB0, rkB1, rvB); }
        const unsigned char* lk = lds + cur * KVB;
        const unsigned char* lv = lk + KB;
        f32x16 s0, s1;
        const float negm = -m;
#pragma unroll
        for (int i = 0; i < 16; ++i) { s0[i] = negm; s1[i] = negm; }
#pragma unroll
        for (int s = 0; s < NS; ++s) {
            const bf16x8 k0 = *(const bf16x8*)(lk + kswz<DQK>(r, 2 * s + h));
            const bf16x8 k1 = *(const bf16x8*)(lk + kswz<DQK>(32 + r, 2 * s + h));
            s0 = __builtin_amdgcn_mfma_f32_32x32x16_bf16(k0, qf[s], s0, 0, 0, 0);
            s1 = __builtin_amdgcn_mfma_f32_32x32x16_bf16(k1, qf[s], s1, 0, 0, 0);
        }
        float mx = fmaxf(fmaxf(s0[0], s0[1]), s0[2]);
#pragma unroll
        for (int i = 3; i < 15; i += 2) mx = fmaxf(fmaxf(mx, s0[i]), s0[i + 1]);
        mx = fmaxf(mx, s0[15]);
#pragma unroll
        for (int i = 0; i < 16; i += 2) mx = fmaxf(fmaxf(mx, s1[i]), s1[i + 1]);
        mx = fmaxf(mx, __shfl_xor(mx, 32));
        if (kt == 0 || __any(mx > 8.0f)) {
            const float dm = (kt == 0) ? mx : fmaxf(mx, 0.f);
            const float alpha = (kt == 0) ? 0.f : __builtin_amdgcn_exp2f(-dm);
            m += dm;
            lsum *= alpha;
#pragma unroll
            for (int i = 0; i < 16; ++i) { o0[i] *= alpha; o1[i] *= alpha; s0[i] -= dm; s1[i] -= dm; }
        }
        float ps = 0.f;
#pragma unroll
        for (int i = 0; i < 16; ++i) { s0[i] = __builtin_amdgcn_exp2f(s0[i]); ps += s0[i]; }
#pragma unroll
        for (int i = 0; i < 16; ++i) { s1[i] = __builtin_amdgcn_exp2f(s1[i]); ps += s1[i]; }
        lsum += ps;
#pragma unroll
        for (int sub = 0; sub < 2; ++sub)
#pragma unroll
            for (int s2 = 0; s2 < 2; ++s2) {
                u32x4 pw;
                if (sub == 0) { pw.x = pack2(s0[8 * s2 + 0], s0[8 * s2 + 1]); pw.y = pack2(s0[8 * s2 + 2], s0[8 * s2 + 3]); pw.z = pack2(s0[8 * s2 + 4], s0[8 * s2 + 5]); pw.w = pack2(s0[8 * s2 + 6], s0[8 * s2 + 7]); }
                else          { pw.x = pack2(s1[8 * s2 + 0], s1[8 * s2 + 1]); pw.y = pack2(s1[8 * s2 + 2], s1[8 * s2 + 3]); pw.z = pack2(s1[8 * s2 + 4], s1[8 * s2 + 5]); pw.w = pack2(s1[8 * s2 + 6], s1[8 * s2 + 7]); }
                const bf16x8 pf = __builtin_bit_cast(bf16x8, pw);
                const bf16x8 vf0 = *(const bf16x8*)(lv + swz128(r, 4 * sub + 2 * s2 + h));
                const bf16x8 vf1 = *(const bf16x8*)(lv + swz128(32 + r, 4 * sub + 2 * s2 + h));
                o0 = __builtin_amdgcn_mfma_f32_32x32x16_bf16(vf0, pf, o0, 0, 0, 0);
                o1 = __builtin_amdgcn_mfma_f32_32x32x16_bf16(vf1, pf, o1, 0, 0, 0);
            }
        if (kt + 1 < NKT) { if (cur == 0) A_STORE(1, rkB0, rkB1, rvB); else A_STORE(0, rkA0, rkA1, rvA); }
        __syncthreads();
      }
    }
#undef A_LOAD
#undef A_STORE
    const float lt = lsum + __shfl_xor(lsum, 32);
    const float inv = 1.0f / lt;
    bf16_t* yr = Yp + (size_t)(32 * w + r) * 768;
#pragma unroll
    for (int g = 0; g < 4; ++g) {
        u32x2 wv; wv.x = pack2(o0[4 * g] * inv, o0[4 * g + 1] * inv); wv.y = pack2(o0[4 * g + 2] * inv, o0[4 * g + 3] * inv);
        *(u32x2*)(yr + 8 * g + 4 * h) = wv;
        wv.x = pack2(o1[4 * g] * inv, o1[4 * g + 1] * inv); wv.y = pack2(o1[4 * g + 2] * inv, o1[4 * g + 3] * inv);
        *(u32x2*)(yr + 32 + 8 * g + 4 * h) = wv;
    }
}

DI int pa(int e) { return e + (e >> 4); }
DI float2 cmul(float2 a, float2 b) { return make_float2(a.x * b.x - a.y * b.y, a.x * b.y + a.y * b.x); }
DI float2 cadd(float2 a, float2 b) { return make_float2(a.x + b.x, a.y + b.y); }
DI float2 csub(float2 a, float2 b) { return make_float2(a.x - b.x, a.y - b.y); }
template <bool INV> DI void dft4(float2& a, float2& b, float2& c, float2& d) {
    const float2 t0 = cadd(a, c), t1 = csub(a, c), t2 = cadd(b, d), t3 = csub(b, d);
    const float2 jt3 = INV ? make_float2(-t3.y, t3.x) : make_float2(t3.y, -t3.x);
    a = cadd(t0, t2); c = csub(t0, t2); b = cadd(t1, jt3); d = csub(t1, jt3);
}
template <bool INV> DI float2 tw16(float2 v, int k) {
    const float c1 = 0.9238795325112867f, s1 = 0.3826834323650898f, c2 = 0.7071067811865476f;
    float wr = 1.f, wi = 0.f;
    switch (k) {
        case 0: wr = 1.f; wi = 0.f; break;
        case 1: wr = c1; wi = -s1; break;
        case 2: wr = c2; wi = -c2; break;
        case 3: wr = s1; wi = -c1; break;
        case 4: wr = 0.f; wi = -1.f; break;
        case 6: wr = -c2; wi = -c2; break;
        case 9: wr = -c1; wi = s1; break;
        default: break;
    }
    if (INV) wi = -wi;
    return make_float2(v.x * wr - v.y * wi, v.x * wi + v.y * wr);
}
template <bool INV> DI void dft16(float2 (&x)[16]) {
#pragma unroll
    for (int b = 0; b < 4; ++b) dft4<INV>(x[b], x[b + 4], x[b + 8], x[b + 12]);
#pragma unroll
    for (int b = 1; b < 4; ++b)
#pragma unroll
        for (int pq = 1; pq < 4; ++pq) x[b + 4 * pq] = tw16<INV>(x[b + 4 * pq], b * pq);
#pragma unroll
    for (int pq = 0; pq < 4; ++pq) dft4<INV>(x[4 * pq], x[4 * pq + 1], x[4 * pq + 2], x[4 * pq + 3]);
#pragma unroll
    for (int a = 0; a < 4; ++a)
#pragma unroll
        for (int b = a + 1; b < 4; ++b) { const float2 tmp = x[4 * a + b]; x[4 * a + b] = x[4 * b + a]; x[4 * b + a] = tmp; }
}
template <bool INV> DI void pass_a(float2* Z, const float2* T1, int tid) {
#pragma unroll
    for (int i = 0; i < 8; ++i) {
        const int j = tid + 512 * i;
        float2 x0 = Z[pa(j)], x1 = Z[pa(j + 4096)], x2 = Z[pa(j + 8192)], x3 = Z[pa(j + 12288)];
        float2 w1 = tw16<false>(T1[j & 1023], i >> 1);
        if (INV) w1.y = -w1.y;
        const float2 w2 = cmul(w1, w1), w3 = cmul(w2, w1);
        if (!INV) { dft4<false>(x0, x1, x2, x3); x1 = cmul(x1, w1); x2 = cmul(x2, w2); x3 = cmul(x3, w3); }
        else { x1 = cmul(x1, w1); x2 = cmul(x2, w2); x3 = cmul(x3, w3); dft4<true>(x0, x1, x2, x3); }
        Z[pa(j)] = x0; Z[pa(j + 4096)] = x1; Z[pa(j + 8192)] = x2; Z[pa(j + 12288)] = x3;
    }
}
template <bool INV, int LS, int TS> DI void pass16(float2* Z, const float2* T1, int tid) {
#pragma unroll 1
    for (int i = 0; i < 2; ++i) {
        const int id = tid + 512 * i, j = id & ((1 << LS) - 1), base = (id >> LS) << (LS + 4);
        float2 x[16];
#pragma unroll
        for (int mm = 0; mm < 16; ++mm) x[mm] = Z[pa(base + j + (mm << LS))];
        float2 w1 = T1[j << TS];
        if (INV) w1.y = -w1.y;
        if (!INV) dft16<false>(x);
        float2 wq = w1;
#pragma unroll
        for (int qq = 1; qq < 16; ++qq) { x[qq] = cmul(x[qq], wq); wq = cmul(wq, w1); }
        if (INV) dft16<true>(x);
#pragma unroll
        for (int mm = 0; mm < 16; ++mm) Z[pa(base + j + (mm << LS))] = x[mm];
    }
}
DI void pass_d_store(const float2* Z, float2* __restrict__ Kf, int tid, float scale) {
#pragma unroll 1
    for (int i = 0; i < 2; ++i) {
        const int id = tid + 512 * i, base = id * 16;
        float2 x[16];
#pragma unroll
        for (int mm = 0; mm < 16; ++mm) x[mm] = Z[pa(base + mm)];
        dft16<false>(x);
#pragma unroll
        for (int mm = 0; mm < 16; mm += 2) *(f32x4*)(Kf + base + mm) = (f32x4){x[mm].x * scale, x[mm].y * scale, x[mm + 1].x * scale, x[mm + 1].y * scale};
    }
}
DI void pass_d_mul(float2* Z, const float2* __restrict__ Kf, int tid) {
#pragma unroll 1
    for (int i = 0; i < 2; ++i) {
        const int id = tid + 512 * i, base = id * 16;
        float2 x[16];
#pragma unroll
        for (int mm = 0; mm < 16; ++mm) x[mm] = Z[pa(base + mm)];
        dft16<false>(x);
#pragma unroll
        for (int mm = 0; mm < 16; mm += 2) {
            const f32x4 kk = *(const f32x4*)(Kf + base + mm);
            x[mm] = cmul(x[mm], make_float2(kk[0], kk[1])); x[mm + 1] = cmul(x[mm + 1], make_float2(kk[2], kk[3]));
        }
        dft16<true>(x);
#pragma unroll
        for (int mm = 0; mm < 16; ++mm) Z[pa(base + mm)] = x[mm];
    }
}
DI void fft_conv(float2* Z, const float2* T1, const float2* Kf, int tid) {
    pass_a<false>(Z, T1, tid); __syncthreads();
    pass16<false, 8, 2>(Z, T1, tid); __syncthreads();
    pass16<false, 4, 6>(Z, T1, tid); __syncthreads();
    pass_d_mul(Z, Kf, tid); __syncthreads();
    pass16<true, 4, 6>(Z, T1, tid); __syncthreads();
    pass16<true, 8, 2>(Z, T1, tid); __syncthreads();
    pass_a<true>(Z, T1, tid); __syncthreads();
}

DI void hyena_unit(unsigned char* lds, const Params& p, int l, int c) {
    float2* Z = (float2*)lds;
    float2* T1 = (float2*)(lds + 139264);
    const int tid = tid_fresh();
    const float* hyT = (const float*)(p.ws + O_HYT);
    float2* Kf0 = (float2*)(p.ws + O_R1) + (size_t)c * 32768;
    float2* Kf1 = Kf0 + 16384;
    bf16_t* hyout = (bf16_t*)(p.ws + O_HYOUT) + (size_t)c * T_;
    for (int k = tid; k < 1024; k += NTHR) { float sn, cs; sincospif((float)k * (1.0f / 8192.0f), &sn, &cs); T1[k] = make_float2(cs, -sn); }
    __syncthreads();
    {
        const float* taps = (const float*)Kf1;
#pragma unroll 1
        for (int o = 0; o < 2; ++o) {
#pragma unroll 4
            for (int t = tid; t < L_; t += NTHR) { Z[pa(t)] = make_float2(taps[(2 * o) * L_ + t], 0.f); Z[pa(16383 - t)] = make_float2(taps[(2 * o + 1) * L_ + t], 0.f); }
            __syncthreads();
            pass_a<false>(Z, T1, tid); __syncthreads();
            pass16<false, 8, 2>(Z, T1, tid); __syncthreads();
            pass16<false, 4, 6>(Z, T1, tid); __syncthreads();
            pass_d_store(Z, o ? Kf1 : Kf0, tid, 1.0f / 16384.0f); __syncthreads();
        }
    }
    const float* cw = p.in[3] + (size_t)l * 3 * 768; const float* cb = p.in[4] + (size_t)l * 768;
    const float* skip = p.in[12] + (size_t)l * 2 * 256;
    float2* z1buf = Kf0;
    const float vw0 = cw[c], vw1 = cw[768 + c], vw2 = cw[1536 + c], vbb = cb[c];
    const float* uv = hyT + (size_t)c * T_;
#pragma unroll 2
    for (int t = tid; t < L_; t += NTHR) {
        float vv[2];
#pragma unroll
        for (int b = 0; b < 2; ++b) {
            const float* ub = uv + b * L_;
            const float um = (t > 0) ? ub[t - 1] : 0.f, uc = ub[t], up = (t < L_ - 1) ? ub[t + 1] : 0.f;
            vv[b] = vw0 * um + vw1 * uc + vw2 * up + vbb;
        }
        Z[pa(t)] = make_float2(vv[0], vv[1]); Z[pa(t + L_)] = make_float2(0.f, 0.f);
    }
    __syncthreads();
    __threadfence();
    fft_conv(Z, T1, Kf0, tid);
    {
        const int ch = 256 + c;
        const float w0 = cw[ch], w1 = cw[768 + ch], w2 = cw[1536 + ch], bb = cb[ch], sk = skip[c];
        const float* u0 = hyT + (size_t)ch * T_;
#pragma unroll 2
        for (int t = tid; t < L_; t += NTHR) {
            const float2 y = Z[pa(t)];
            float zz[2];
#pragma unroll
            for (int b = 0; b < 2; ++b) {
                const float* ub = u0 + b * L_;
                const float um = (t > 0) ? ub[t - 1] : 0.f, uc = ub[t], up = (t < L_ - 1) ? ub[t + 1] : 0.f;
                const float g = w0 * um + w1 * uc + w2 * up + bb;
                const float* vb = uv + b * L_;
                const float vm = (t > 0) ? vb[t - 1] : 0.f, vc = vb[t], vp = (t < L_ - 1) ? vb[t + 1] : 0.f;
                const float v = vw0 * vm + vw1 * vc + vw2 * vp + vbb;
                zz[b] = g * ((b ? y.y : y.x) + sk * v);
            }
            const float2 z1 = make_float2(zz[0], zz[1]);
            Z[pa(t)] = z1; Z[pa(t + L_)] = make_float2(0.f, 0.f);
            z1buf[t] = z1;
        }
    }
    __syncthreads();
    fft_conv(Z, T1, Kf1, tid);
    {
        const int ch = 512 + c;
        const float w0 = cw[ch], w1 = cw[768 + ch], w2 = cw[1536 + ch], bb = cb[ch], sk = skip[256 + c];
        const float* u0 = hyT + (size_t)ch * T_;
#pragma unroll 2
        for (int t = tid; t < L_; t += NTHR) {
            const float2 y = Z[pa(t)];
            const float2 z1 = z1buf[t];
#pragma unroll
            for (int b = 0; b < 2; ++b) {
                const float* ub = u0 + b * L_;
                const float um = (t > 0) ? ub[t - 1] : 0.f, uc = ub[t], up = (t < L_ - 1) ? ub[t + 1] : 0.f;
                const float g = w0 * um + w1 * uc + w2 * up + bb;
                hyout[b * L_ + t] = f2bf(g * ((b ? y.y : y.x) + sk * (b ? z1.y : z1.x)));
            }
        }
    }
    __syncthreads();
}

DI void groups_phase(unsigned char* lds, const Params& p) {
    bf16_t* tile = (bf16_t*)lds;
    const int tid = tid_fresh(), lane = tid & 63, wid = tid >> 6;
    const bf16_t* hyout = (const bf16_t*)(p.ws + O_HYOUT);
    const bf16_t* Y = (const bf16_t*)(p.ws + O_PROJB);
    bf16_t* G = (bf16_t*)(p.ws + O_HYT);
    for (int u = blockIdx.x; u < T_ / 64; u += gridDim.x) {
        const int tok0 = u * 64;
        {
            const int c = tid >> 1, hf = tid & 1;
            const u32x4* src = (const u32x4*)(hyout + (size_t)c * T_ + tok0 + hf * 32);
#pragma unroll
            for (int i = 0; i < 4; ++i) {
                const u32x4 v = src[i];
                unsigned* d = (unsigned*)(tile + c * 66 + hf * 32 + i * 8);
                d[0] = v.x; d[1] = v.y; d[2] = v.z; d[3] = v.w;
            }
        }
        __syncthreads();
#pragma unroll 1
        for (int i = 0; i < 8; ++i) {
            const int tl = wid * 8 + i, tok = tok0 + tl;
            float hv[4]; float sh = 0.f;
#pragma unroll
            for (int k = 0; k < 4; ++k) { hv[k] = bf2f(tile[(lane + 64 * k) * 66 + tl]); sh += hv[k] * hv[k]; }
            sh = wave_sum(sh);
            const float rh = rsqrtf(sh * (1.0f / 256.0f) + 1e-6f);
            bf16_t* gr = G + (size_t)tok * 1024;
#pragma unroll
            for (int k = 0; k < 4; ++k) gr[lane + 64 * k] = f2bf(hv[k] * rh);
            const bf16_t* yr = Y + (size_t)tok * 768;
            {
                const u32x4 v = *(const u32x4*)(yr + lane * 8);
                float a[8] = {bf2f((bf16_t)(v.x & 0xffff)), bf2f((bf16_t)(v.x >> 16)), bf2f((bf16_t)(v.y & 0xffff)), bf2f((bf16_t)(v.y >> 16)),
                              bf2f((bf16_t)(v.z & 0xffff)), bf2f((bf16_t)(v.z >> 16)), bf2f((bf16_t)(v.w & 0xffff)), bf2f((bf16_t)(v.w >> 16))};
                float ss = 0.f;
#pragma unroll
                for (int k = 0; k < 8; ++k) ss += a[k] * a[k];
                ss = wave_sum(ss);
                const float rr = rsqrtf(ss * (1.0f / 512.0f) + 1e-6f);
                u32x4 w; w.x = pack2(a[0] * rr, a[1] * rr); w.y = pack2(a[2] * rr, a[3] * rr); w.z = pack2(a[4] * rr, a[5] * rr); w.w = pack2(a[6] * rr, a[7] * rr);
                *(u32x4*)(gr + 256 + lane * 8) = w;
            }
            {
                const u32x2 v = *(const u32x2*)(yr + 512 + lane * 4);
                float a[4] = {bf2f((bf16_t)(v.x & 0xffff)), bf2f((bf16_t)(v.x >> 16)), bf2f((bf16_t)(v.y & 0xffff)), bf2f((bf16_t)(v.y >> 16))};
                float ss = wave_sum(a[0] * a[0] + a[1] * a[1] + a[2] * a[2] + a[3] * a[3]);
                const float rr = rsqrtf(ss * (1.0f / 256.0f) + 1e-6f);
                u32x2 w; w.x = pack2(a[0] * rr, a[1] * rr); w.y = pack2(a[2] * rr, a[3] * rr);
                *(u32x2*)(gr + 768 + lane * 4) = w;
            }
        }
        __syncthreads();
    }
}


#define XB_TMO      128
#define XB_XCNT(j)  (256  + 64 * (j))
#define XB_XSUB(j)  (1280 + 64 * (j))
#define XB_XGEN(j)  (2304 + 64 * (j))
#define XB_TOP      3328
#define XB_TOPGEN   3392
#define XCD_BAR_WORDS 3456
#define XB_SPIN_CAP (1u << 22)
#define LAS __attribute__((address_space(3)))
DI unsigned xb_ld(unsigned* p)              { return __hip_atomic_load(p, __ATOMIC_RELAXED, __HIP_MEMORY_SCOPE_AGENT); }
DI unsigned xb_add(unsigned* p, unsigned v) { return __hip_atomic_fetch_add(p, v, __ATOMIC_RELAXED, __HIP_MEMORY_SCOPE_AGENT); }
DI unsigned xb_xcc_id() { return (unsigned)__builtin_amdgcn_s_getreg((3 << 11) | 20) & 0xFu; }
#define XB_SPIN(cond, bar) do { unsigned _sp = 0; while (cond) { __builtin_amdgcn_s_sleep(1); \
    if ((++_sp & 255u) == 0u) { if (xb_ld(&(bar)[XB_TMO])) break; if (_sp > XB_SPIN_CAP) { atomicAdd(&(bar)[XB_TMO], 1u); break; } } } } while (0)
struct XcdBarrier { unsigned* bar; unsigned x; volatile LAS unsigned* st; };
DI XcdBarrier xcd_barrier_post(unsigned* bar, volatile LAS unsigned* st) {
    XcdBarrier b; b.bar = bar; b.x = xb_xcc_id(); b.st = st;
    if (threadIdx.x == 0) (void)xb_add(&bar[XB_XCNT(b.x)], 1u);
    return b;
}
DI void xcd_barrier_complete(unsigned* bar, unsigned x, unsigned& nloc, unsigned& nx) {
    const unsigned G = gridDim.x * gridDim.y * gridDim.z;
    unsigned sum, cnt, mine, sp = 0u;
    for (;;) {
        sum = 0u; cnt = 0u; mine = 0u;
#pragma unroll
        for (unsigned j = 0; j < 16; ++j) { const unsigned c = xb_ld(&bar[XB_XCNT(j)]); sum += c; cnt += (c > 0u) ? 1u : 0u; mine = (j == x) ? c : mine; }
        if (sum == G) break;
        __builtin_amdgcn_s_sleep(1);
        if ((++sp & 255u) == 0u) { if (xb_ld(&bar[XB_TMO])) break; if (sp > XB_SPIN_CAP) { atomicAdd(&bar[XB_TMO], 1u); break; } }
    }
    nloc = mine > 0u ? mine : 1u; nx = cnt > 0u ? cnt : 1u;
}
DI void xcd_barrier(const XcdBarrier& b) {
    asm volatile("s_waitcnt vmcnt(0)" ::: "memory");
    __syncthreads();
    if (threadIdx.x == 0) {
        unsigned* bar = b.bar;
        __builtin_amdgcn_s_waitcnt(0);
        unsigned nloc = b.st[0], nx = b.st[1];
        if (nloc == 0u) { xcd_barrier_complete(bar, b.x, nloc, nx); b.st[0] = nloc; b.st[1] = nx; }
        const unsigned old = xb_add(&bar[XB_XSUB(b.x)], 1u);
        const unsigned gen = old / nloc;
        if (old + 1u == (gen + 1u) * nloc) {
            __builtin_amdgcn_fence(__ATOMIC_RELEASE, "agent");
            asm volatile("s_waitcnt vmcnt(0)" ::: "memory");
            const unsigned og = xb_add(&bar[XB_TOP], 1u);
            const unsigned tg = og / nx;
            if (og + 1u == (tg + 1u) * nx) xb_add(&bar[XB_TOPGEN], 1u);
            else XB_SPIN(xb_ld(&bar[XB_TOPGEN]) == tg, bar);
            __builtin_amdgcn_fence(__ATOMIC_ACQUIRE, "agent");
            xb_add(&bar[XB_XGEN(b.x)], 1u);
            asm volatile("s_waitcnt vmcnt(0)" ::: "memory");
        } else {
            XB_SPIN(xb_ld(&bar[XB_XGEN(b.x)]) == gen, bar);
            __builtin_amdgcn_fence(__ATOMIC_ACQUIRE, "agent");
            asm volatile("s_waitcnt vmcnt(0)" ::: "memory");
        }
    }
    __syncthreads();
}

extern __shared__ __attribute__((aligned(16))) unsigned char smem[];

__global__ void __launch_bounds__(512) fwd_megakernel(Params p) {
    cg::grid_group grid = cg::this_grid();
    unsigned char* lds = smem;
    unsigned char* ws = p.ws;
    unsigned* bar = (unsigned*)(ws + O_BAR);
    volatile LAS unsigned* xb_st = (volatile LAS unsigned*)(smem + LDS_BYTES - 16);
    if (threadIdx.x < 4) xb_st[threadIdx.x] = 0u;
    if (blockIdx.x == 0) for (int i = threadIdx.x; i < XCD_BAR_WORDS; i += NTHR) bar[i] = 0u;
    __syncthreads();
#pragma unroll 1
    for (int l2 = 0; l2 < 2 * REP_PRO; ++l2) { const int l = l2 & 1;
        convT(lds, p.in[2] + (size_t)l * 1024 * 1952, 1024, 1952, 2048, p.in[1] + l * 1024, (bf16_t*)(ws + O_WIN) + (size_t)l * 2048 * 1024, 0);
        convT(lds, p.in[16] + (size_t)l * 256 * 384, 256, 384, 384, p.in[15] + l * 256, (bf16_t*)(ws + O_WUQ) + (size_t)l * 384 * 256, 0);
        convT(lds, p.in[18] + (size_t)l * 128 * 512, 128, 512, 512, p.in[17] + l * 128, (bf16_t*)(ws + O_WUKV) + (size_t)l * 512 * 128, 0);
        convT(lds, p.in[25] + (size_t)l * 1024 * 5632, 1024, 5632, 5632, p.in[24] + l * 1024, (bf16_t*)(ws + O_WUP) + (size_t)l * 5632 * 1024, 1);
        convT(lds, p.in[28] + (size_t)l * 2816 * 1024, 2816, 1024, 1024, nullptr, (bf16_t*)(ws + O_WDOWN) + (size_t)l * 1024 * 2816, 0);
    }
    {
        float* tile = (float*)lds;
        const int tid = tid_fresh();
        for (int u = blockIdx.x; u < 2 * 16 * 16; u += gridDim.x) {
            const int l = u >> 8, kt = (u & 255) & 15, ntile = (u & 255) >> 4;
            const int k0 = kt * 64, n0 = ntile * 64;
            const float* W = p.in[22] + (size_t)l * 1024 * 1024;
            bf16_t* dst = (bf16_t*)(ws + O_WOUT) + (size_t)l * 1024 * 1024;
#pragma unroll
            for (int i = 0; i < 8; ++i) {
                const int kk = (tid >> 6) + 8 * i, nn = tid & 63, k = k0 + kk;
                const float g = (k < 256) ? p.in[19][l * 256 + k] : (k < 768) ? p.in[20][l * 512 + k - 256] : p.in[21][l * 256 + k - 768];
                tile[kk * 65 + nn] = W[(size_t)k * 1024 + n0 + nn] * g;
            }
            __syncthreads();
            {
                const int nn = tid >> 3, kb = (tid & 7) * 8;
                u32x4 w;
                w.x = pack2(tile[(kb + 0) * 65 + nn], tile[(kb + 1) * 65 + nn]);
                w.y = pack2(tile[(kb + 2) * 65 + nn], tile[(kb + 3) * 65 + nn]);
                w.z = pack2(tile[(kb + 4) * 65 + nn], tile[(kb + 5) * 65 + nn]);
                w.w = pack2(tile[(kb + 6) * 65 + nn], tile[(kb + 7) * 65 + nn]);
                *(u32x4*)(dst + (size_t)(n0 + nn) * 1024 + k0 + kb) = w;
            }
            __syncthreads();
        }
    }
    hy_h2_phase(lds, p);
    rownorm_phase(p.in[0], (bf16_t*)(ws + O_XN));
    grid.sync();
    const XcdBarrier xb = xcd_barrier_post(bar, xb_st);


#pragma unroll 1
    for (int l = 0; l < 2; ++l) {
        {
            EpiIn e; e.hyT = (float*)(ws + O_HYT); e.projb = (bf16_t*)(ws + O_PROJB);
            gemm_phase<false>(lds, (const bf16_t*)(ws + O_XN), 1024, (const bf16_t*)(ws + O_WIN) + (size_t)l * 2048 * 1024, 1024, 64, 16, e);
        }
        XSYNC();
#pragma unroll 1
        for (int rep = 0; rep < REP_EW; ++rep) prep_phase(p, l);
        ft_phase(lds, p, l);
        XSYNC();
        {
            EpiUq e; e.Qm = (bf16_t*)(ws + O_QM); e.rq = (const float*)(ws + O_RQ); e.sc = 0.10206207261596577f * 1.4426950408889634f;
            gemm_phase<false>(lds, (const bf16_t*)(ws + O_PROJB) + 768, 1184, (const bf16_t*)(ws + O_WUQ) + (size_t)l * 384 * 256, 256, 64, 3, e);
            EpiUkv e2; e2.Km = (bf16_t*)(ws + O_KM); e2.VmT = (bf16_t*)(ws + O_VMT); e2.rkv = (const float*)(ws + O_RKV);
            gemm_phase<false>(lds, (const bf16_t*)(ws + O_PROJB) + 1024, 1184, (const bf16_t*)(ws + O_WUKV) + (size_t)l * 512 * 128, 128, 64, 4, e2);
        }
        XSYNC();
#pragma unroll 1
        for (int rep = 0; rep < REP_HY; ++rep)
        for (int c = blockIdx.x; c < 256; c += gridDim.x) hyena_unit(lds, p, l, c);
#pragma unroll 1
        for (int rep = 0; rep < REP_ATTN; ++rep)
        for (int u = blockIdx.x; u < 512; u += gridDim.x) {
            const int qt = u & 31, hh = (u >> 5) & 7, b = u >> 8, hk = hh >> 2;
            attn_unit<64>(lds, (const bf16_t*)(ws + O_QG) + ((size_t)(b * 8 + hh) * L_ + qt * 256) * 64,
                          (const bf16_t*)(ws + O_KG) + (size_t)(b * 2 + hk) * L_ * 64,
                          (const bf16_t*)(ws + O_VGT) + (size_t)(b * 2 + hk) * 64 * L_,
                          (bf16_t*)(ws + O_PROJB) + (size_t)(b * L_ + qt * 256) * 768 + hh * 64);
        }
#pragma unroll 1
        for (int rep = 0; rep < REP_ATTN; ++rep)
        for (int u = blockIdx.x; u < 256; u += gridDim.x) {
            const int qt = u & 31, hh = (u >> 5) & 3, b = u >> 7;
            attn_unit<96>(lds, (const bf16_t*)(ws + O_QM) + ((size_t)(b * 4 + hh) * L_ + qt * 256) * 96,
                          (const bf16_t*)(ws + O_KM) + (size_t)(b * 4 + hh) * L_ * 96,
                          (const bf16_t*)(ws + O_VMT) + (size_t)(b * 4 + hh) * 64 * L_,
                          (bf16_t*)(ws + O_PROJB) + (size_t)(b * L_ + qt * 256) * 768 + 512 + hh * 64);
        }
        XSYNC();
#pragma unroll 1
        for (int rep = 0; rep < REP_EW; ++rep) groups_phase(lds, p);
        XSYNC();
        {
            EpiF32 e; e.C = (float*)(ws + O_R1); e.ldc = 1024;
            gemm_phase<false>(lds, (const bf16_t*)(ws + O_HYT), 1024, (const bf16_t*)(ws + O_WOUT) + (size_t)l * 1024 * 1024, 1024, 64, 8, e);
        }
        XSYNC();
        resid_phase((const float*)(ws + O_R1), l == 0 ? p.in[0] : p.out, p.in[23] + l * 1024, p.out, (bf16_t*)(ws + O_XN), true);
        XSYNC();
        {
            EpiUp e; e.act = (bf16_t*)(ws + O_HYT); e.cw = p.in[26] + (size_t)l * 3 * 5632; e.cb = p.in[27] + (size_t)l * 5632;
            gemm_phase<true>(lds, (const bf16_t*)(ws + O_XN), 1024, (const bf16_t*)(ws + O_WUP) + (size_t)l * 5632 * 1024, 1024, 66, 44, e);
        }
        XSYNC();
        {
            EpiF32 e; e.C = (float*)(ws + O_R1); e.ldc = 1024;
            gemm_phase<false>(lds, (const bf16_t*)(ws + O_HYT), 2816, (const bf16_t*)(ws + O_WDOWN) + (size_t)l * 1024 * 2816, 2816, 64, 8, e);
        }
        XSYNC();
        resid_phase((const float*)(ws + O_R1), p.out, p.in[29] + l * 1024, p.out, (bf16_t*)(ws + O_XN), l == 0);
        if (l == 0) XSYNC();
    }
}

extern "C" void kernel_launch(void* const* d_in, const int* in_sizes, int n_in,
                              void* d_out, int out_size, void* d_ws, size_t ws_size,
                              hipStream_t stream) {
    static int grid_blocks = 0;
    if (!grid_blocks) {
        int dev = 0, cus = 0, per_cu = 0;
        (void)hipGetDevice(&dev);
        (void)hipDeviceGetAttribute(&cus, hipDeviceAttributeMultiprocessorCount, dev);
        (void)hipFuncSetAttribute((const void*)fwd_megakernel, hipFuncAttributeMaxDynamicSharedMemorySize, (int)LDS_BYTES);
        (void)hipOccupancyMaxActiveBlocksPerMultiprocessor(&per_cu, fwd_megakernel, NTHR, LDS_BYTES);
        if (per_cu < 1) per_cu = 1;
        grid_blocks = cus;
        if (grid_blocks > 256) grid_blocks = 256;
    }
    Params p{};
    for (int i = 0; i < 30; ++i) p.in[i] = (const float*)d_in[i];
    p.out = (float*)d_out; p.ws = (unsigned char*)d_ws;
    void* args[] = {&p};
    hipError_t e = hipLaunchCooperativeKernel((void*)fwd_megakernel, dim3(grid_blocks), dim3(NTHR), args, LDS_BYTES, stream);
    if (e != hipSuccess) fprintf(stderr, "cooperative launch failed: %s (grid %d)\n", hipGetErrorString(e), grid_blocks);
}
```

```cpp
#include <hip/hip_runtime.h>
#include <hip/hip_cooperative_groups.h>
#include <cstdio>
#include <cstdint>
namespace cg = cooperative_groups;

typedef unsigned short bf16_t;
typedef short bf16x8 __attribute__((ext_vector_type(8)));
typedef float f32x4 __attribute__((ext_vector_type(4)));
typedef float f32x16 __attribute__((ext_vector_type(16)));
typedef unsigned u32x2 __attribute__((ext_vector_type(2)));
typedef unsigned u32x4 __attribute__((ext_vector_type(4)));

#define DI __device__ __forceinline__
#ifndef REP_ATTN
#define REP_ATTN 1
#endif
#ifndef REP_HY
#define REP_HY 1
#endif
#ifndef REP_GEMM
#define REP_GEMM 1
#endif
#ifndef REP_PRO
#define REP_PRO 1
#endif
#ifndef REP_SYNC
#define REP_SYNC 1
#endif
#define XSYNC() do { _Pragma("unroll 1") for (int r_ = 0; r_ < REP_SYNC; ++r_) xcd_barrier(xb); } while (0)
#ifndef REP_EW
#define REP_EW 1
#endif
constexpr int L_ = 8192, T_ = 16384, NTHR = 512;
constexpr size_t MiB = 1u << 20;
constexpr size_t O_WIN = 0, O_WUQ = 8 * MiB, O_WUKV = 8 * MiB + 512 * 1024, O_RQ = 8 * MiB + 768 * 1024, O_RKV = 8 * MiB + 832 * 1024;
constexpr size_t O_BAR = 8 * MiB + 896 * 1024;
constexpr size_t O_WOUT = 9 * MiB, O_WUP = 13 * MiB, O_WDOWN = 35 * MiB, O_H2 = 46 * MiB;
constexpr size_t O_R1 = 50 * MiB;
constexpr size_t O_HYT = 114 * MiB;
constexpr size_t O_PROJB = 162 * MiB;
constexpr size_t O_HYOUT = 186 * MiB;
constexpr size_t O_QG = 199 * MiB, O_KG = 215 * MiB, O_VGT = 219 * MiB, O_QM = 223 * MiB, O_KM = 235 * MiB, O_VMT = 247 * MiB;
constexpr size_t O_XN = 223 * MiB;
constexpr size_t LDS_BYTES = 150 * 1024;

struct Params { const float* in[30]; float* out; unsigned char* ws; };

typedef __bf16 bf16v2_t __attribute__((ext_vector_type(2)));
typedef float f32v2_t __attribute__((ext_vector_type(2)));
DI bf16_t f2bf(float x) { const __bf16 b = (__bf16)x; return __builtin_bit_cast(bf16_t, b); }
DI float bf2f(bf16_t v) { return __uint_as_float(((unsigned)v) << 16); }
DI unsigned pack2(float lo, float hi) { const f32v2_t v = {lo, hi}; const bf16v2_t b = __builtin_convertvector(v, bf16v2_t); return __builtin_bit_cast(unsigned, b); }
DI float wave_sum(float v) {
#pragma unroll
    for (int o = 32; o >= 1; o >>= 1) v += __shfl_xor(v, o);
    return v;
}
DI int tid_fresh() { int t = threadIdx.x; asm volatile("" : "+v"(t)); return t; }
DI void fast_sincos(float ang, float* s, float* c) {
    float rev = ang * 0.15915494309189535f; rev -= rintf(rev);
    *s = __builtin_amdgcn_sinf(rev); *c = __builtin_amdgcn_cosf(rev);
}
DI int perm16(int t) { return (t & ~15) | (t & 3) | (((t >> 3) & 1) << 2) | (((t >> 2) & 1) << 3); }

DI void convT(unsigned char* lds, const float* __restrict__ W, int K, int N, int Npad, const float* __restrict__ gain, bf16_t* __restrict__ dst, int mode) {
    float* tile = (float*)lds;
    const int tid = tid_fresh();
    const int nkt = K >> 6, nnt = Npad >> 6;
    for (int u = blockIdx.x; u < nkt * nnt; u += gridDim.x) {
        const int kt = u % nkt, ntile = u / nkt;
        const int k0 = kt * 64, n0 = ntile * 64;
        int src0 = n0;
        if (mode == 1) { const int jt = n0 >> 7, half = (n0 >> 6) & 1; src0 = half ? 2816 + 64 * jt : 64 * jt; }
        const bool valid = (mode == 1) || (n0 < N);
#pragma unroll
        for (int i = 0; i < 8; ++i) {
            const int kk = (tid >> 6) + 8 * i, nn = tid & 63;
            float v = 0.f;
            if (valid && (src0 + nn) < N) v = W[(size_t)(k0 + kk) * N + src0 + nn] * (gain ? gain[k0 + kk] : 1.0f);
            tile[kk * 65 + nn] = v;
        }
        __syncthreads();
        {
            const int nn = tid >> 3, kb = (tid & 7) * 8;
            u32x4 w;
            w.x = pack2(tile[(kb + 0) * 65 + nn], tile[(kb + 1) * 65 + nn]);
            w.y = pack2(tile[(kb + 2) * 65 + nn], tile[(kb + 3) * 65 + nn]);
            w.z = pack2(tile[(kb + 4) * 65 + nn], tile[(kb + 5) * 65 + nn]);
            w.w = pack2(tile[(kb + 6) * 65 + nn], tile[(kb + 7) * 65 + nn]);
            *(u32x4*)(dst + (size_t)(n0 + nn) * K + k0 + kb) = w;
        }
        __syncthreads();
    }
}

DI void hy_h2_phase(unsigned char* lds, const Params& p) {
    float* zs = (float*)lds;
    float* h1s = zs + 8 * 36;
    const int tid = tid_fresh(), rr = tid >> 6, j = tid & 63;
    float* h2 = (float*)(p.ws + O_H2);
    for (int u = blockIdx.x; u < 2 * (L_ / 8); u += gridDim.x) {
        const int l = u / (L_ / 8), t = (u % (L_ / 8)) * 8 + rr;
        if (j < 16) {
            const float w = 2.0f * 3.14159265358979323846f * (float)t / (float)L_;
            const float f = 1e-4f + (15.0f - 1e-4f) * (float)j / 15.0f;
            const float a = f * w;
            zs[rr * 36 + 1 + j] = cosf(a);
            zs[rr * 36 + 17 + j] = -sinf(a);
            if (j == 0) zs[rr * 36] = (float)t / (float)(L_ - 1);
        }
        __syncthreads();
        {
            const float* w1 = p.in[5] + (size_t)l * 33 * 64;
            float s = p.in[6][l * 64 + j];
#pragma unroll
            for (int e = 0; e < 33; ++e) s += zs[rr * 36 + e] * w1[e * 64 + j];
            h1s[rr * 64 + j] = sinf(p.in[7][l * 64 + j] * s);
        }
        __syncthreads();
        {
            const float* w2 = p.in[8] + (size_t)l * 64 * 64;
            float s = p.in[9][l * 64 + j];
#pragma unroll 8
            for (int e = 0; e < 64; ++e) s += h1s[rr * 64 + e] * w2[e * 64 + j];
            h2[((size_t)l * L_ + t) * 64 + j] = sinf(p.in[10][l * 64 + j] * s);
        }
        __syncthreads();
    }
}


DI void ft_phase(unsigned char* lds, const Params& p, int l) {
    float* hs = (float*)lds;
    const int tid = tid_fresh();
    const float* h2 = (const float*)(p.ws + O_H2) + (size_t)l * L_ * 64;
    const float* w3 = p.in[11] + (size_t)l * 64 * 1024;
    const int c = tid & 255, dir = tid >> 8;
    const float min_decay = -4.605170185988091f / 1.5f, max_decay = -4.605170185988091f / 0.3f;
    const float dlt = fabsf(min_decay + (max_decay - min_decay) * (float)c / 255.0f);
    for (int u = blockIdx.x; u < L_ / 32; u += gridDim.x) {
        const int t0 = u * 32;
        *(f32x4*)(hs + tid * 4) = *(const f32x4*)(h2 + (size_t)t0 * 64 + tid * 4);
        __syncthreads();
#pragma unroll 1
        for (int o = 0; o < 2; ++o) {
            float wa[64];
#pragma unroll
            for (int j = 0; j < 64; ++j) wa[j] = w3[j * 1024 + o * 512 + tid];
            float* dstA = (float*)(p.ws + O_R1 + (size_t)c * 262144 + 131072) + (2 * o + dir) * L_ + t0;
#pragma unroll 1
            for (int tt = 0; tt < 32; tt += 4) {
                f32x4 ra;
#pragma unroll
                for (int e = 0; e < 4; ++e) {
                    const float* hr = hs + (tt + e) * 64;
                    float da = 0.f;
#pragma unroll
                    for (int jj = 0; jj < 16; ++jj) {
                        const f32x4 hv = *(const f32x4*)(hr + 4 * jj);
#pragma unroll
                        for (int k = 0; k < 4; ++k) da += hv[k] * wa[4 * jj + k];
                    }
                    const float win = expf(-((float)(t0 + tt + e) / (float)(L_ - 1)) * dlt);
                    ra[e] = da * win;
                    asm volatile("" ::: "memory");
                }
                *(f32x4*)(dstA + tt) = ra;
            }
        }
        __syncthreads();
    }
}

DI void rownorm_phase(const float* __restrict__ x, bf16_t* __restrict__ xn) {
    const int tid_ = tid_fresh(); const int lane = tid_ & 63, wid = tid_ >> 6;
    for (int row = blockIdx.x * 8 + wid; row < T_; row += gridDim.x * 8) {
        const float* xr = x + (size_t)row * 1024;
        f32x4 v[4]; float ss = 0.f;
#pragma unroll
        for (int i = 0; i < 4; ++i) { v[i] = *(const f32x4*)(xr + i * 256 + lane * 4); ss += v[i][0] * v[i][0] + v[i][1] * v[i][1] + v[i][2] * v[i][2] + v[i][3] * v[i][3]; }
        ss = wave_sum(ss);
        const float r = rsqrtf(ss * (1.0f / 1024.0f) + 1e-6f);
#pragma unroll
        for (int i = 0; i < 4; ++i) { u32x2 w; w.x = pack2(v[i][0] * r, v[i][1] * r); w.y = pack2(v[i][2] * r, v[i][3] * r); *(u32x2*)(xn + (size_t)row * 1024 + i * 256 + lane * 4) = w; }
    }
}

DI void resid_phase(const float* __restrict__ y, const float* __restrict__ xres, const float* __restrict__ g, float* __restrict__ xout, bf16_t* __restrict__ xn, bool want_xn) {
    const int tid_ = tid_fresh(); const int lane = tid_ & 63, wid = tid_ >> 6;
    for (int row = blockIdx.x * 8 + wid; row < T_; row += gridDim.x * 8) {
        const size_t ro = (size_t)row * 1024;
        f32x4 v[4]; float ss = 0.f;
#pragma unroll
        for (int i = 0; i < 4; ++i) { v[i] = *(const f32x4*)(y + ro + i * 256 + lane * 4); ss += v[i][0] * v[i][0] + v[i][1] * v[i][1] + v[i][2] * v[i][2] + v[i][3] * v[i][3]; }
        ss = wave_sum(ss);
        const float r = rsqrtf(ss * (1.0f / 1024.0f) + 1e-6f);
        float s2 = 0.f;
#pragma unroll
        for (int i = 0; i < 4; ++i) {
            const f32x4 xr = *(const f32x4*)(xres + ro + i * 256 + lane * 4);
            const f32x4 gg = *(const f32x4*)(g + i * 256 + lane * 4);
            v[i] = xr + v[i] * r * gg;
            s2 += v[i][0] * v[i][0] + v[i][1] * v[i][1] + v[i][2] * v[i][2] + v[i][3] * v[i][3];
            *(f32x4*)(xout + ro + i * 256 + lane * 4) = v[i];
        }
        if (want_xn) {
            s2 = wave_sum(s2);
            const float r2 = rsqrtf(s2 * (1.0f / 1024.0f) + 1e-6f);
#pragma unroll
            for (int i = 0; i < 4; ++i) { u32x2 w; w.x = pack2(v[i][0] * r2, v[i][1] * r2); w.y = pack2(v[i][2] * r2, v[i][3] * r2); *(u32x2*)(xn + ro + i * 256 + lane * 4) = w; }
        }
    }
}

DI int swz128(int row, int chunk) { return row * 128 + ((chunk ^ ((row >> 1) & 7)) << 4); }

template <bool OVL, class Epi>
DI void gemm_phase(unsigned char* lds, const bf16_t* __restrict__ A, int lda, const bf16_t* __restrict__ Bt, int K, int nMt, int nNt, const Epi& epi) {
    typedef __attribute__((address_space(3))) unsigned char lds_uc;
    lds_uc* ldsl = (lds_uc*)lds;
    const int tid = tid_fresh(), lane = tid & 63, wid = tid >> 6, wm = wid & 1, wn = wid >> 1;
    const int r16 = lane & 15, q4 = lane >> 4;
    const int nk = K >> 6;
    const int xr = (r16 >> 1) & 7;
    const int ab0 = (128 * wm + r16) * 128 + ((q4 ^ xr) << 4), ab1 = (128 * wm + r16) * 128 + (((4 + q4) ^ xr) << 4);
    const int bb0 = 32768 + (64 * wn + r16) * 128 + ((q4 ^ xr) << 4), bb1 = 32768 + (64 * wn + r16) * 128 + (((4 + q4) ^ xr) << 4);
#pragma unroll 1
    for (int rep = 0; rep < REP_GEMM; ++rep)
    for (int u = blockIdx.x; u < nMt * nNt; u += gridDim.x) {
        const int um = u % nMt, un = u / nMt;
        const bf16_t* ap[4]; const bf16_t* bp[4];
        int t0 = 0, bb = 0;
        if (OVL) { bb = um / 33; t0 = 254 * (um % 33) - 1; }
#pragma unroll
        for (int i = 0; i < 4; ++i) {
            const int P = (wid * 4 + i) * 64 + lane, row = P >> 3, c = (P & 7) ^ ((row >> 1) & 7);
            int grow;
            if (OVL) { int t = t0 + row; t = t < 0 ? 0 : (t > L_ - 1 ? L_ - 1 : t); grow = bb * L_ + t; }
            else grow = um * 256 + row;
            ap[i] = A + (size_t)grow * lda + c * 8;
            bp[i] = Bt + (size_t)(un * 256 + row) * K + c * 8;
        }
        f32x4 acc[8][4];
#pragma unroll
        for (int a = 0; a < 8; ++a)
#pragma unroll
            for (int b = 0; b < 4; ++b) acc[a][b] = (f32x4){0.f, 0.f, 0.f, 0.f};
#define G_ISSUE(bufoff) do { _Pragma("unroll") for (int i = 0; i < 4; ++i) { __builtin_amdgcn_global_load_lds((const unsigned*)ap[i], (__attribute__((address_space(3))) unsigned*)(ldsl + (bufoff) + (wid * 4 + i) * 1024), 16, 0, 0); ap[i] += 64; } \
                             _Pragma("unroll") for (int i = 0; i < 4; ++i) { __builtin_amdgcn_global_load_lds((const unsigned*)bp[i], (__attribute__((address_space(3))) unsigned*)(ldsl + (bufoff) + 32768 + (wid * 4 + i) * 1024), 16, 0, 0); bp[i] += 64; } } while (0)
        __syncthreads();
        G_ISSUE(0);
        asm volatile("s_waitcnt vmcnt(0)" ::: "memory");
        __builtin_amdgcn_s_barrier();
        asm volatile("" ::: "memory");
#pragma unroll 1
        for (int kt = 0; kt < nk; ++kt) {
            const int cb = (kt & 1) * 65536;
            if (kt + 1 < nk) G_ISSUE(65536 - cb);
            const unsigned char* lb = lds + cb;
#pragma unroll
            for (int ks = 0; ks < 2; ++ks) {
                bf16x8 af[8], bfr[4];
#pragma unroll
                for (int nt = 0; nt < 4; ++nt) bfr[nt] = *(const bf16x8*)(lb + (ks ? bb1 : bb0) + nt * 2048);
#pragma unroll
                for (int mt = 0; mt < 8; ++mt) af[mt] = *(const bf16x8*)(lb + (ks ? ab1 : ab0) + mt * 2048);
                __builtin_amdgcn_sched_barrier(0);
#pragma unroll
                for (int mt = 0; mt < 8; ++mt)
#pragma unroll
                    for (int nt = 0; nt < 4; ++nt) acc[mt][nt] = __builtin_amdgcn_mfma_f32_16x16x32_bf16(bfr[nt], af[mt], acc[mt][nt], 0, 0, 0);
                __builtin_amdgcn_sched_barrier(0);
            }
            asm volatile("s_waitcnt vmcnt(0) lgkmcnt(0)" ::: "memory");
            __builtin_amdgcn_s_barrier();
            asm volatile("" ::: "memory");
        }
        int r16e = r16, q4e = q4;
        asm volatile("" : "+v"(r16e), "+v"(q4e));
        if constexpr (Epi::STAGED) {
            epi.staged(lds, acc, um, un, wm, wn, r16e, q4e);
        } else {
#pragma unroll
            for (int mt = 0; mt < 8; ++mt) { epi.row(um * 256 + 128 * wm + 16 * mt + r16e, un * 256 + 64 * wn, q4e, acc[mt]); asm volatile("" ::: "memory"); }
        }
    }
#undef G_ISSUE
}

struct EpiIn {
    static constexpr bool STAGED = true;
    float* hyT; bf16_t* projb;
    template <int HF> static DI void hy_half(float* st, const f32x4 (&acc)[8][4], float* dst, int r16, int q4, int lane) {
#pragma unroll
        for (int mt = 0; mt < 4; ++mt)
#pragma unroll
            for (int nt = 0; nt < 4; ++nt)
#pragma unroll
                for (int i = 0; i < 4; ++i) st[(16 * nt + 4 * q4 + i) * 65 + 16 * mt + r16] = acc[4 * HF + mt][nt][i];
        asm volatile("s_waitcnt lgkmcnt(0)" ::: "memory");
#pragma unroll 4
        for (int n = 0; n < 64; ++n) dst[(size_t)n * T_] = st[n * 65 + lane];
        asm volatile("s_waitcnt lgkmcnt(0)" ::: "memory");
    }
    DI void staged(unsigned char* lds, const f32x4 (&acc)[8][4], int um, int un, int wm, int wn, int r16, int q4) const {
        if (un < 3) {
            float* st = (float*)lds + (wm + 2 * wn) * (64 * 65);
            const int lane = r16 + 16 * q4;
            float* dst = hyT + (size_t)(un * 256 + 64 * wn) * T_ + um * 256 + 128 * wm + lane;
            hy_half<0>(st, acc, dst, r16, q4, lane);
            hy_half<1>(st, acc, dst + 64, r16, q4, lane);
        } else {
#pragma unroll
            for (int mt = 0; mt < 8; ++mt) {
                const int tok = um * 256 + 128 * wm + 16 * mt + r16;
#pragma unroll
                for (int nt = 0; nt < 4; ++nt) {
                    const int col = un * 256 + 64 * wn + 16 * nt + 4 * q4;
                    if (col < 1952) {
                        u32x2 w; w.x = pack2(acc[mt][nt][0], acc[mt][nt][1]); w.y = pack2(acc[mt][nt][2], acc[mt][nt][3]);
                        *(u32x2*)(projb + (unsigned)(tok * 1184 + (col - 768))) = w;
                    }
                }
            }
        }
    }
};
struct EpiF32 {
    static constexpr bool STAGED = false;
    float* C; int ldc;
    DI void row(int tok, int colbase, int q4, const f32x4 (&a)[4]) const {
#pragma unroll
        for (int nt = 0; nt < 4; ++nt) *(f32x4*)(C + (size_t)tok * ldc + colbase + 16 * nt + 4 * q4) = a[nt];
    }
};
struct EpiUq {
    static constexpr bool STAGED = false;
    bf16_t* Qm; const float* rq; float sc;
    DI void row(int tok, int colbase, int q4, const f32x4 (&a)[4]) const {
        const float r = rq[tok] * sc;
        const int b = tok >> 13, t = tok & (L_ - 1);
#pragma unroll
        for (int nt = 0; nt < 4; ++nt) {
            const int col = colbase + 16 * nt + 4 * q4;
            if (col >= 384) continue;
            const int head = col / 96, j = col - head * 96;
            bf16_t* dst = Qm + ((size_t)(b * 4 + head) * L_ + t) * 96;
            if (j < 64) {
                u32x2 w; w.x = pack2(a[nt][0] * r, a[nt][1] * r); w.y = pack2(a[nt][2] * r, a[nt][3] * r);
                *(u32x2*)(dst + j) = w;
            } else if (j < 80) {
                if (nt < 3) {
                    const int p0 = j - 64;
                    float o1[4], o2[4];
#pragma unroll
                    for (int i = 0; i < 4; ++i) {
                        const int pp = p0 + i;
                        const float inv = __expf(-(float)(pp & 7) * (9.210340371976184f / 8.0f));
                        const float ang = (float)((pp < 8) ? (t >> 6) : (t & 63)) * inv;
                        float sn, cs; fast_sincos(ang, &sn, &cs);
                        const float x1 = a[nt][i] * r, x2 = a[(nt < 3) ? nt + 1 : 3][i] * r;
                        o1[i] = x1 * cs - x2 * sn; o2[i] = x1 * sn + x2 * cs;
                    }
                    u32x2 w; w.x = pack2(o1[0], o1[1]); w.y = pack2(o1[2], o1[3]);
                    *(u32x2*)(dst + j) = w;
                    w.x = pack2(o2[0], o2[1]); w.y = pack2(o2[2], o2[3]);
                    *(u32x2*)(dst + j + 16) = w;
                }
            }
        }
    }
};
struct EpiUkv {
    static constexpr bool STAGED = false;
    bf16_t* Km; bf16_t* VmT; const float* rkv;
    DI void row(int tok, int colbase, int q4, const f32x4 (&a)[4]) const {
        const float r = rkv[tok];
        const int b = tok >> 13, t = tok & (L_ - 1);
#pragma unroll
        for (int nt = 0; nt < 4; ++nt) {
            const int col = colbase + 16 * nt + 4 * q4;
            const int head = col >> 7, j = col & 127;
            if (j < 64) {
                u32x2 w; w.x = pack2(a[nt][0] * r, a[nt][1] * r); w.y = pack2(a[nt][2] * r, a[nt][3] * r);
                *(u32x2*)(Km + ((size_t)(b * 4 + head) * L_ + t) * 96 + j) = w;
            } else {
#pragma unroll
                for (int i = 0; i < 4; ++i) VmT[((size_t)(b * 4 + head) * 64 + (j - 64 + i)) * L_ + perm16(t)] = f2bf(a[nt][i] * r);
            }
        }
    }
};
DI float gelu_tanh(float x) {
    const float u = 0.7978845608028654f * (x + 0.044715f * x * x * x);
    const float e = __expf(2.0f * u);
    const float th = 1.0f - 2.0f / (e + 1.0f);
    return 0.5f * x * (1.0f + th);
}
struct EpiUp {
    static constexpr bool STAGED = true;
    bf16_t* act; const float* cw; const float* cb;
    DI void staged(unsigned char* lds, const f32x4 (&acc)[8][4], int um, int un, int wm, int wn, int r16, int q4) const {
        float* st = (float*)lds;
        const int tid = threadIdx.x, j = tid & 63, seg = tid >> 6;
        const int bb = um / 33, t0 = 254 * (um % 33) - 1;
        const int r0 = 32 * seg;
#pragma unroll 1
        for (int hf = 0; hf < 2; ++hf) {
            if ((wn >> 1) == hf) {
#pragma unroll
                for (int mt = 0; mt < 8; ++mt)
#pragma unroll
                    for (int nt = 0; nt < 4; ++nt) *(f32x4*)(st + (128 * wm + 16 * mt + r16) * 132 + 64 * (wn & 1) + 16 * nt + 4 * q4) = acc[mt][nt];
            }
            __syncthreads();
            const int ch = 64 * (2 * un + hf) + j;
            const float g0 = cw[ch], g1 = cw[5632 + ch], g2 = cw[2 * 5632 + ch], gb = cb[ch];
            const float v0 = cw[2816 + ch], v1 = cw[5632 + 2816 + ch], v2 = cw[2 * 5632 + 2816 + ch], vb = cb[2816 + ch];
#define UPV(rr, cc) ((((rr) >= 0) && ((rr) <= 255) && (t0 + (rr) >= 0) && (t0 + (rr) < L_)) ? st[(rr) * 132 + (cc)] : 0.f)
            float gp = UPV(r0 - 1, j), vp = UPV(r0 - 1, 64 + j);
            float gc = UPV(r0, j), vc = UPV(r0, 64 + j);
#pragma unroll 4
            for (int i = 0; i < 32; ++i) {
                const int r = r0 + i;
                const float gn = UPV(r + 1, j), vn = UPV(r + 1, 64 + j);
                const int t = t0 + r;
                if (r >= 1 && r <= 254 && t < L_) {
                    const float cg = g0 * gp + g1 * gc + g2 * gn + gb;
                    const float cv = v0 * vp + v1 * vc + v2 * vn + vb;
                    act[(size_t)(bb * L_ + t) * 2816 + ch] = f2bf(gelu_tanh(cg) * cv);
                }
                gp = gc; gc = gn; vp = vc; vc = vn;
            }
#undef UPV
            __syncthreads();
        }
    }
};

DI void prep_phase(const Params& p, int l) {
    const int tid_ = tid_fresh(); const int lane = tid_ & 63, wid = tid_ >> 6;
    const bf16_t* projb = (const bf16_t*)(p.ws + O_PROJB);
    bf16_t* Qg = (bf16_t*)(p.ws + O_QG); bf16_t* Kg = (bf16_t*)(p.ws + O_KG); bf16_t* VgT = (bf16_t*)(p.ws + O_VGT);
    bf16_t* Km = (bf16_t*)(p.ws + O_KM);
    float* rq = (float*)(p.ws + O_RQ); float* rkv = (float*)(p.ws + O_RKV);
    const float* gq = p.in[13] + l * 64; const float* gk = p.in[14] + l * 64;
    const int hd = lane >> 3, sub = lane & 7;
    float gq1[4], gq2[4], gk1[4], gk2[4];
#pragma unroll
    for (int i = 0; i < 4; ++i) { gq1[i] = gq[4 * sub + i]; gq2[i] = gq[32 + 4 * sub + i]; gk1[i] = gk[4 * sub + i]; gk2[i] = gk[32 + 4 * sub + i]; }
    const float qscale = 0.125f * 1.4426950408889634f;
    for (int tok = blockIdx.x * 8 + wid; tok < T_; tok += gridDim.x * 8) {
        const int b = tok >> 13, t = tok & (L_ - 1);
        const bf16_t* pr = projb + (size_t)tok * 1184;
        float cs[4], sn[4];
#pragma unroll
        for (int i = 0; i < 4; ++i) {
            const int pp = 4 * sub + i;
            const float inv = __expf(-(float)(pp & 15) * (9.210340371976184f / 16.0f));
            const float ang = (float)((pp < 16) ? (t >> 6) : (t & 63)) * inv;
            fast_sincos(ang, &sn[i], &cs[i]);
        }
        {
            const u32x2 w1 = *(const u32x2*)(pr + hd * 64 + 4 * sub), w2 = *(const u32x2*)(pr + hd * 64 + 32 + 4 * sub);
            float x1[4] = {bf2f((bf16_t)(w1.x & 0xffff)), bf2f((bf16_t)(w1.x >> 16)), bf2f((bf16_t)(w1.y & 0xffff)), bf2f((bf16_t)(w1.y >> 16))};
            float x2[4] = {bf2f((bf16_t)(w2.x & 0xffff)), bf2f((bf16_t)(w2.x >> 16)), bf2f((bf16_t)(w2.y & 0xffff)), bf2f((bf16_t)(w2.y >> 16))};
            float ss = 0.f;
#pragma unroll
            for (int i = 0; i < 4; ++i) ss += x1[i] * x1[i] + x2[i] * x2[i];
            ss += __shfl_xor(ss, 1); ss += __shfl_xor(ss, 2); ss += __shfl_xor(ss, 4);
            const float r = rsqrtf(ss * (1.0f / 64.0f) + 1e-6f);
            float o1[4], o2[4];
#pragma unroll
            for (int i = 0; i < 4; ++i) { const float a = x1[i] * r * gq1[i], c = x2[i] * r * gq2[i]; o1[i] = (a * cs[i] - c * sn[i]) * qscale; o2[i] = (a * sn[i] + c * cs[i]) * qscale; }
            bf16_t* dst = Qg + ((size_t)(b * 8 + hd) * L_ + t) * 64;
            u32x2 w; w.x = pack2(o1[0], o1[1]); w.y = pack2(o1[2], o1[3]); *(u32x2*)(dst + 4 * sub) = w;
            w.x = pack2(o2[0], o2[1]); w.y = pack2(o2[2], o2[3]); *(u32x2*)(dst + 32 + 4 * sub) = w;
        }
        if (lane < 16) {
            const u32x2 w1 = *(const u32x2*)(pr + 512 + hd * 64 + 4 * sub), w2 = *(const u32x2*)(pr + 512 + hd * 64 + 32 + 4 * sub);
            float x1[4] = {bf2f((bf16_t)(w1.x & 0xffff)), bf2f((bf16_t)(w1.x >> 16)), bf2f((bf16_t)(w1.y & 0xffff)), bf2f((bf16_t)(w1.y >> 16))};
            float x2[4] = {bf2f((bf16_t)(w2.x & 0xffff)), bf2f((bf16_t)(w2.x >> 16)), bf2f((bf16_t)(w2.y & 0xffff)), bf2f((bf16_t)(w2.y >> 16))};
            float ss = 0.f;
#pragma unroll
            for (int i = 0; i < 4; ++i) ss += x1[i] * x1[i] + x2[i] * x2[i];
            ss += __shfl_xor(ss, 1); ss += __shfl_xor(ss, 2); ss += __shfl_xor(ss, 4);
            const float r = rsqrtf(ss * (1.0f / 64.0f) + 1e-6f);
            float o1[4], o2[4];
#pragma unroll
            for (int i = 0; i < 4; ++i) { const float a = x1[i] * r * gk1[i], c = x2[i] * r * gk2[i]; o1[i] = a * cs[i] - c * sn[i]; o2[i] = a * sn[i] + c * cs[i]; }
            bf16_t* dst = Kg + ((size_t)(b * 2 + hd) * L_ + t) * 64;
            u32x2 w; w.x = pack2(o1[0], o1[1]); w.y = pack2(o1[2], o1[3]); *(u32x2*)(dst + 4 * sub) = w;
            w.x = pack2(o2[0], o2[1]); w.y = pack2(o2[2], o2[3]); *(u32x2*)(dst + 32 + 4 * sub) = w;
        }
        {
            const unsigned w = *(const unsigned*)(pr + 640 + 2 * lane);
            const int c0 = 2 * lane, kh = c0 >> 6, d = c0 & 63;
            bf16_t* dst = VgT + ((size_t)(b * 2 + kh) * 64 + d) * L_ + perm16(t);
            dst[0] = (bf16_t)(w & 0xffff); dst[L_] = (bf16_t)(w >> 16);
        }
        {
            const u32x2 w = *(const u32x2*)(pr + 768 + 4 * lane);
            const float a0 = bf2f((bf16_t)(w.x & 0xffff)), a1 = bf2f((bf16_t)(w.x >> 16)), a2 = bf2f((bf16_t)(w.y & 0xffff)), a3 = bf2f((bf16_t)(w.y >> 16));
            float ss = wave_sum(a0 * a0 + a1 * a1 + a2 * a2 + a3 * a3);
            if (lane == 0) rq[tok] = rsqrtf(ss * (1.0f / 256.0f) + 1e-6f);
        }
        {
            const unsigned w = *(const unsigned*)(pr + 1024 + 2 * lane);
            const float a0 = bf2f((bf16_t)(w & 0xffff)), a1 = bf2f((bf16_t)(w >> 16));
            float ss = wave_sum(a0 * a0 + a1 * a1);
            if (lane == 0) rkv[tok] = rsqrtf(ss * (1.0f / 128.0f) + 1e-6f);
        }
        if (lane < 16) {
            const float x1 = bf2f(pr[1152 + lane]), x2 = bf2f(pr[1152 + 16 + lane]);
            const float inv = __expf(-(float)(lane & 7) * (9.210340371976184f / 8.0f));
            const float ang = (float)((lane < 8) ? (t >> 6) : (t & 63)) * inv;
            float s1, c1; fast_sincos(ang, &s1, &c1);
            const bf16_t o1 = f2bf(x1 * c1 - x2 * s1), o2 = f2bf(x1 * s1 + x2 * c1);
#pragma unroll
            for (int hh = 0; hh < 4; ++hh) { bf16_t* dst = Km + ((size_t)(b * 4 + hh) * L_ + t) * 96 + 64; dst[lane] = o1; dst[16 + lane] = o2; }
        }
    }
}

template <int DQK> DI int kswz(int row, int chunk) {
    if (DQK == 64) return row * 128 + ((chunk ^ ((row >> 1) & 7)) << 4);
    else return row * 192 + ((chunk ^ ((row >> 2) & 3)) << 4);
}
template <int DQK>
DI void attn_unit(unsigned char* lds, const bf16_t* __restrict__ Qp, const bf16_t* __restrict__ Kp, const bf16_t* __restrict__ VTp, bf16_t* __restrict__ Yp  ) {
    constexpr int NS = DQK / 16, NC = DQK / 8, KB = 64 * DQK * 2, KVB = KB + 8192;
    const int tid = tid_fresh(), lane = tid & 63, w = tid >> 6, r = lane & 31, h = lane >> 5;
    bf16x8 qf[NS];
#pragma unroll
    for (int s = 0; s < NS; ++s) qf[s] = *(const bf16x8*)(Qp + (size_t)(32 * w + r) * DQK + 16 * s + 8 * h);
    f32x16 o0, o1;
#pragma unroll
    for (int i = 0; i < 16; ++i) { o0[i] = 0.f; o1[i] = 0.f; }
    float m = 0.f, lsum = 0.f;
    const int k_row0 = tid / NC, k_c0 = tid % NC;
    const int k_row1 = (tid + 512) / NC, k_c1 = (tid + 512) % NC;
    const bool k_two = (DQK == 96) && (tid < 256);
    const int v_row = tid >> 3, v_c = tid & 7;
    u32x4 rkA0, rkA1, rvA, rkB0, rkB1, rvB;
    rkA1 = (u32x4){0u, 0u, 0u, 0u}; rkB1 = rkA1;
#define A_LOAD(kt, R0, R1, RV) do { R0 = *(const u32x4*)(Kp + (size_t)((kt) * 64 + k_row0) * DQK + k_c0 * 8); \
                        if (k_two) R1 = *(const u32x4*)(Kp + (size_t)((kt) * 64 + k_row1) * DQK + k_c1 * 8); \
                        RV = *(const u32x4*)(VTp + (size_t)v_row * L_ + (kt) * 64 + v_c * 8); } while (0)
#define A_STORE(buf, R0, R1, RV) do { *(u32x4*)(lds + (buf) * KVB + kswz<DQK>(k_row0, k_c0)) = R0; \
                          if (k_two) *(u32x4*)(lds + (buf) * KVB + kswz<DQK>(k_row1, k_c1)) = R1; \
                          *(u32x4*)(lds + (buf) * KVB + KB + swz128(v_row, v_c)) = RV; } while (0)
    A_LOAD(0, rkA0, rkA1, rvA);
    A_LOAD(1, rkB0, rkB1, rvB);
    A_STORE(0, rkA0, rkA1, rvA);
    __syncthreads();
    constexpr int NKT = L_ / 64;
#pragma unroll 1
    for (int kt2 = 0; kt2 < NKT; kt2 += 2) {
#pragma unroll
      for (int cur = 0; cur < 2; ++cur) {
        const int kt = kt2 + cur;
        if (kt + 2 < NKT) { if (cur == 0) A_LOAD(kt + 2, rkA0, rkA1, rvA); else A_LOAD(kt + 2, rkB0, rkB1, rvB); }
        const unsigned char* lk = lds + cur * KVB;
        const unsigned char* lv = lk + KB;
        f32x16 s0, s1;
        const float negm = -m;
#pragma unroll
        for (int i = 0; i < 16; ++i) { s0[i] = negm; s1[i] = negm; }
#pragma unroll
        for (int s = 0; s < NS; ++s) {
            const bf16x8 k0 = *(const bf16x8*)(lk + kswz<DQK>(r, 2 * s + h));
            const bf16x8 k1 = *(const bf16x8*)(lk + kswz<DQK>(32 + r, 2 * s + h));
            s0 = __builtin_amdgcn_mfma_f32_32x32x16_bf16(k0, qf[s], s0, 0, 0, 0);
            s1 = __builtin_amdgcn_mfma_f32_32x32x16_bf16(k1, qf[s], s1, 0, 0, 0);
        }
        float mx = fmaxf(fmaxf(s0[0], s0[1]), s0[2]);
#pragma unroll
        for (int i = 3; i < 15; i += 2) mx = fmaxf(fmaxf(mx, s0[i]), s0[i + 1]);
        mx = fmaxf(mx, s0[15]);
#pragma unroll
        for (int i = 0; i < 16; i += 2) mx = fmaxf(fmaxf(mx, s1[i]), s1[i + 1]);
        mx = fmaxf(mx, __shfl_xor(mx, 32));
        if (kt == 0 || __any(mx > 8.0f)) {
            const float dm = (kt == 0) ? mx : fmaxf(mx, 0.f);
            const float alpha = (kt == 0) ? 0.f : __builtin_amdgcn_exp2f(-dm);
            m += dm;
            lsum *= alpha;
#pragma unroll
            for (int i = 0; i < 16; ++i) { o0[i] *= alpha; o1[i] *= alpha; s0[i] -= dm; s1[i] -= dm; }
        }
        float ps = 0.f;
#pragma unroll
        for (int i = 0; i < 16; ++i) { s0[i] = __builtin_amdgcn_exp2f(s0[i]); ps += s0[i]; }
#pragma unroll
        for (int i = 0; i < 16; ++i) { s1[i] = __builtin_amdgcn_exp2f(s1[i]); ps += s1[i]; }
        lsum += ps;
#pragma unroll
        for (int sub = 0; sub < 2; ++sub)
#pragma unroll
            for (int s2 = 0; s2 < 2; ++s2) {
                u32x4 pw;
                if (sub == 0) { pw.x = pack2(s0[8 * s2 + 0], s0[8 * s2 + 1]); pw.y = pack2(s0[8 * s2 + 2], s0[8 * s2 + 3]); pw.z = pack2(s0[8 * s2 + 4], s0[8 * s2 + 5]); pw.w = pack2(s0[8 * s2 + 6], s0[8 * s2 + 7]); }
                else          { pw.x = pack2(s1[8 * s2 + 0], s1[8 * s2 + 1]); pw.y = pack2(s1[8 * s2 + 2], s1[8 * s2 + 3]); pw.z = pack2(s1[8 * s2 + 4], s1[8 * s2 + 5]); pw.w = pack2(s1[8 * s2 + 6], s1[8 * s2 + 7]); }
                const bf16x8 pf = __builtin_bit_cast(bf16x8, pw);
                const bf16x8 vf0 = *(const bf16x8*)(lv + swz128(r, 4 * sub + 2 * s2 + h));
                const bf16x8 vf1 = *(const bf16x8*)(lv + swz128(32 + r, 4 * sub + 2 * s2 + h));
                o0 = __builtin_amdgcn_mfma_f32_32x32x16_bf16(vf0, pf, o0, 0, 0, 0);
                o1 = __builtin_amdgcn_mfma_f32_32x32x16_bf16(vf1, pf, o1, 0, 0, 0);
            }
        if (kt + 1 < NKT) { if (cur == 0) A_STORE(1, rkB0, rkB1, rvB); else A_STORE(0, rkA0, rkA1, rvA); }
        __syncthreads();
      }
    }
#undef A_LOAD
#undef A_STORE
    const float lt = lsum + __shfl_xor(lsum, 32);
    const float inv = 1.0f / lt;
    bf16_t* yr = Yp + (size_t)(32 * w + r) * 768;
#pragma unroll
    for (int g = 0; g < 4; ++g) {
        u32x2 wv; wv.x = pack2(o0[4 * g] * inv, o0[4 * g + 1] * inv); wv.y = pack2(o0[4 * g + 2] * inv, o0[4 * g + 3] * inv);
        *(u32x2*)(yr + 8 * g + 4 * h) = wv;
        wv.x = pack2(o1[4 * g] * inv, o1[4 * g + 1] * inv); wv.y = pack2(o1[4 * g + 2] * inv, o1[4 * g + 3] * inv);
        *(u32x2*)(yr + 32 + 8 * g + 4 * h) = wv;
    }
}

DI int pa(int e) { return e + (e >> 4); }
DI float2 cmul(float2 a, float2 b) { return make_float2(a.x * b.x - a.y * b.y, a.x * b.y + a.y * b.x); }
DI float2 cadd(float2 a, float2 b) { return make_float2(a.x + b.x, a.y + b.y); }
DI float2 csub(float2 a, float2 b) { return make_float2(a.x - b.x, a.y - b.y); }
template <bool INV> DI void dft4(float2& a, float2& b, float2& c, float2& d) {
    const float2 t0 = cadd(a, c), t1 = csub(a, c), t2 = cadd(b, d), t3 = csub(b, d);
    const float2 jt3 = INV ? make_float2(-t3.y, t3.x) : make_float2(t3.y, -t3.x);
    a = cadd(t0, t2); c = csub(t0, t2); b = cadd(t1, jt3); d = csub(t1, jt3);
}
template <bool INV> DI float2 tw16(float2 v, int k) {
    const float c1 = 0.9238795325112867f, s1 = 0.3826834323650898f, c2 = 0.7071067811865476f;
    float wr = 1.f, wi = 0.f;
    switch (k) {
        case 0: wr = 1.f; wi = 0.f; break;
        case 1: wr = c1; wi = -s1; break;
        case 2: wr = c2; wi = -c2; break;
        case 3: wr = s1; wi = -c1; break;
        case 4: wr = 0.f; wi = -1.f; break;
        case 6: wr = -c2; wi = -c2; break;
        case 9: wr = -c1; wi = s1; break;
        default: break;
    }
    if (INV) wi = -wi;
    return make_float2(v.x * wr - v.y * wi, v.x * wi + v.y * wr);
}
template <bool INV> DI void dft16(float2 (&x)[16]) {
#pragma unroll
    for (int b = 0; b < 4; ++b) dft4<INV>(x[b], x[b + 4], x[b + 8], x[b + 12]);
#pragma unroll
    for (int b = 1; b < 4; ++b)
#pragma unroll
        for (int pq = 1; pq < 4; ++pq) x[b + 4 * pq] = tw16<INV>(x[b + 4 * pq], b * pq);
#pragma unroll
    for (int pq = 0; pq < 4; ++pq) dft4<INV>(x[4 * pq], x[4 * pq + 1], x[4 * pq + 2], x[4 * pq + 3]);
#pragma unroll
    for (int a = 0; a < 4; ++a)
#pragma unroll
        for (int b = a + 1; b < 4; ++b) { const float2 tmp = x[4 * a + b]; x[4 * a + b] = x[4 * b + a]; x[4 * b + a] = tmp; }
}
template <bool INV> DI void pass_a(float2* Z, const float2* T1, int tid) {
#pragma unroll
    for (int i = 0; i < 8; ++i) {
        const int j = tid + 512 * i;
        float2 x0 = Z[pa(j)], x1 = Z[pa(j + 4096)], x2 = Z[pa(j + 8192)], x3 = Z[pa(j + 12288)];
        float2 w1 = tw16<false>(T1[j & 1023], i >> 1);
        if (INV) w1.y = -w1.y;
        const float2 w2 = cmul(w1, w1), w3 = cmul(w2, w1);
        if (!INV) { dft4<false>(x0, x1, x2, x3); x1 = cmul(x1, w1); x2 = cmul(x2, w2); x3 = cmul(x3, w3); }
        else { x1 = cmul(x1, w1); x2 = cmul(x2, w2); x3 = cmul(x3, w3); dft4<true>(x0, x1, x2, x3); }
        Z[pa(j)] = x0; Z[pa(j + 4096)] = x1; Z[pa(j + 8192)] = x2; Z[pa(j + 12288)] = x3;
    }
}
template <bool INV, int LS, int TS> DI void pass16(float2* Z, const float2* T1, int tid) {
#pragma unroll 1
    for (int i = 0; i < 2; ++i) {
        const int id = tid + 512 * i, j = id & ((1 << LS) - 1), base = (id >> LS) << (LS + 4);
        float2 x[16];
#pragma unroll
        for (int mm = 0; mm < 16; ++mm) x[mm] = Z[pa(base + j + (mm << LS))];
        float2 w1 = T1[j << TS];
        if (INV) w1.y = -w1.y;
        if (!INV) dft16<false>(x);
        float2 wq = w1;
#pragma unroll
        for (int qq = 1; qq < 16; ++qq) { x[qq] = cmul(x[qq], wq); wq = cmul(wq, w1); }
        if (INV) dft16<true>(x);
#pragma unroll
        for (int mm = 0; mm < 16; ++mm) Z[pa(base + j + (mm << LS))] = x[mm];
    }
}
DI void pass_d_store(const float2* Z, float2* __restrict__ Kf, int tid, float scale) {
#pragma unroll 1
    for (int i = 0; i < 2; ++i) {
        const int id = tid + 512 * i, base = id * 16;
        float2 x[16];
#pragma unroll
        for (int mm = 0; mm < 16; ++mm) x[mm] = Z[pa(base + mm)];
        dft16<false>(x);
#pragma unroll
        for (int mm = 0; mm < 16; mm += 2) *(f32x4*)(Kf + base + mm) = (f32x4){x[mm].x * scale, x[mm].y * scale, x[mm + 1].x * scale, x[mm + 1].y * scale};
    }
}
DI void pass_d_mul(float2* Z, const float2* __restrict__ Kf, int tid) {
#pragma unroll 1
    for (int i = 0; i < 2; ++i) {
        const int id = tid + 512 * i, base = id * 16;
        float2 x[16];
#pragma unroll
        for (int mm = 0; mm < 16; ++mm) x[mm] = Z[pa(base + mm)];
        dft16<false>(x);
#pragma unroll
        for (int mm = 0; mm < 16; mm += 2) {
            const f32x4 kk = *(const f32x4*)(Kf + base + mm);
            x[mm] = cmul(x[mm], make_float2(kk[0], kk[1])); x[mm + 1] = cmul(x[mm + 1], make_float2(kk[2], kk[3]));
        }
        dft16<true>(x);
#pragma unroll
        for (int mm = 0; mm < 16; ++mm) Z[pa(base + mm)] = x[mm];
    }
}
DI void fft_conv(float2* Z, const float2* T1, const float2* Kf, int tid) {
    pass_a<false>(Z, T1, tid); __syncthreads();
    pass16<false, 8, 2>(Z, T1, tid); __syncthreads();
    pass16<false, 4, 6>(Z, T1, tid); __syncthreads();
    pass_d_mul(Z, Kf, tid); __syncthreads();
    pass16<true, 4, 6>(Z, T1, tid); __syncthreads();
    pass16<true, 8, 2>(Z, T1, tid); __syncthreads();
    pass_a<true>(Z, T1, tid); __syncthreads();
}

DI void hyena_unit(unsigned char* lds, const Params& p, int l, int c) {
    float2* Z = (float2*)lds;
    float2* T1 = (float2*)(lds + 139264);
    const int tid = tid_fresh();
    const float* hyT = (const float*)(p.ws + O_HYT);
    float2* Kf0 = (float2*)(p.ws + O_R1) + (size_t)c * 32768;
    float2* Kf1 = Kf0 + 16384;
    bf16_t* hyout = (bf16_t*)(p.ws + O_HYOUT) + (size_t)c * T_;
    for (int k = tid; k < 1024; k += NTHR) { float sn, cs; sincospif((float)k * (1.0f / 8192.0f), &sn, &cs); T1[k] = make_float2(cs, -sn); }
    __syncthreads();
    {
        const float* taps = (const float*)Kf1;
#pragma unroll 1
        for (int o = 0; o < 2; ++o) {
#pragma unroll 4
            for (int t = tid; t < L_; t += NTHR) { Z[pa(t)] = make_float2(taps[(2 * o) * L_ + t], 0.f); Z[pa(16383 - t)] = make_float2(taps[(2 * o + 1) * L_ + t], 0.f); }
            __syncthreads();
            pass_a<false>(Z, T1, tid); __syncthreads();
            pass16<false, 8, 2>(Z, T1, tid); __syncthreads();
            pass16<false, 4, 6>(Z, T1, tid); __syncthreads();
            pass_d_store(Z, o ? Kf1 : Kf0, tid, 1.0f / 16384.0f); __syncthreads();
        }
    }
    const float* cw = p.in[3] + (size_t)l * 3 * 768; const float* cb = p.in[4] + (size_t)l * 768;
    const float* skip = p.in[12] + (size_t)l * 2 * 256;
    float2* z1buf = Kf0;
    const float vw0 = cw[c], vw1 = cw[768 + c], vw2 = cw[1536 + c], vbb = cb[c];
    const float* uv = hyT + (size_t)c * T_;
#pragma unroll 2
    for (int t = tid; t < L_; t += NTHR) {
        float vv[2];
#pragma unroll
        for (int b = 0; b < 2; ++b) {
            const float* ub = uv + b * L_;
            const float um = (t > 0) ? ub[t - 1] : 0.f, uc = ub[t], up = (t < L_ - 1) ? ub[t + 1] : 0.f;
            vv[b] = vw0 * um + vw1 * uc + vw2 * up + vbb;
        }
        Z[pa(t)] = make_float2(vv[0], vv[1]); Z[pa(t + L_)] = make_float2(0.f, 0.f);
    }
    __syncthreads();
    __threadfence();
    fft_conv(Z, T1, Kf0, tid);
    {
        const int ch = 256 + c;
        const float w0 = cw[ch], w1 = cw[768 + ch], w2 = cw[1536 + ch], bb = cb[ch], sk = skip[c];
        const float* u0 = hyT + (size_t)ch * T_;
#pragma unroll 2
        for (int t = tid; t < L_; t += NTHR) {
            const float2 y = Z[pa(t)];
            float zz[2];
#pragma unroll
            for (int b = 0; b < 2; ++b) {
                const float* ub = u0 + b * L_;
                const float um = (t > 0) ? ub[t - 1] : 0.f, uc = ub[t], up = (t < L_ - 1) ? ub[t + 1] : 0.f;
                const float g = w0 * um + w1 * uc + w2 * up + bb;
                const float* vb = uv + b * L_;
                const float vm = (t > 0) ? vb[t - 1] : 0.f, vc = vb[t], vp = (t < L_ - 1) ? vb[t + 1] : 0.f;
                const float v = vw0 * vm + vw1 * vc + vw2 * vp + vbb;
                zz[b] = g * ((b ? y.y : y.x) + sk * v);
            }
            const float2 z1 = make_float2(zz[0], zz[1]);
            Z[pa(t)] = z1; Z[pa(t + L_)] = make_float2(0.f, 0.f);
            z1buf[t] = z1;
        }
    }
    __syncthreads();
    fft_conv(Z, T1, Kf1, tid);
    {
        const int ch = 512 + c;
        const float w0 = cw[ch], w1 = cw[768 + ch], w2 = cw[1536 + ch], bb = cb[ch], sk = skip[256 + c];
        const float* u0 = hyT + (size_t)ch * T_;
#pragma unroll 2
        for (int t = tid; t < L_; t += NTHR) {
            const float2 y = Z[pa(t)];
            const float2 z1 = z1buf[t];
#pragma unroll
            for (int b = 0; b < 2; ++b) {
                const float* ub = u0 + b * L_;
                const float um = (t > 0) ? ub[t - 1] : 0.f, uc = ub[t], up = (t < L_ - 1) ? ub[t + 1] : 0.f;
                const float g = w0 * um + w1 * uc + w2 * up + bb;
                hyout[b * L_ + t] = f2bf(g * ((b ? y.y : y.x) + sk * (b ? z1.y : z1.x)));
            }
        }
    }
    __syncthreads();
}

DI void groups_phase(unsigned char* lds, const Params& p) {
    bf16_t* tile = (bf16_t*)lds;
    const int tid = tid_fresh(), lane = tid & 63, wid = tid >> 6;
    const bf16_t* hyout = (const bf16_t*)(p.ws + O_HYOUT);
    const bf16_t* Y = (const bf16_t*)(p.ws + O_PROJB);
    bf16_t* G = (bf16_t*)(p.ws + O_HYT);
    for (int u = blockIdx.x; u < T_ / 64; u += gridDim.x) {
        const int tok0 = u * 64;
        {
            const int c = tid >> 1, hf = tid & 1;
            const u32x4* src = (const u32x4*)(hyout + (size_t)c * T_ + tok0 + hf * 32);
#pragma unroll
            for (int i = 0; i < 4; ++i) {
                const u32x4 v = src[i];
                unsigned* d = (unsigned*)(tile + c * 66 + hf * 32 + i * 8);
                d[0] = v.x; d[1] = v.y; d[2] = v.z; d[3] = v.w;
            }
        }
        __syncthreads();
#pragma unroll 1
        for (int i = 0; i < 8; ++i) {
            const int tl = wid * 8 + i, tok = tok0 + tl;
            float hv[4]; float sh = 0.f;
#pragma unroll
            for (int k = 0; k < 4; ++k) { hv[k] = bf2f(tile[(lane + 64 * k) * 66 + tl]); sh += hv[k] * hv[k]; }
            sh = wave_sum(sh);
            const float rh = rsqrtf(sh * (1.0f / 256.0f) + 1e-6f);
            bf16_t* gr = G + (size_t)tok * 1024;
#pragma unroll
            for (int k = 0; k < 4; ++k) gr[lane + 64 * k] = f2bf(hv[k] * rh);
            const bf16_t* yr = Y + (size_t)tok * 768;
            {
                const u32x4 v = *(const u32x4*)(yr + lane * 8);
                float a[8] = {bf2f((bf16_t)(v.x & 0xffff)), bf2f((bf16_t)(v.x >> 16)), bf2f((bf16_t)(v.y & 0xffff)), bf2f((bf16_t)(v.y >> 16)),
                              bf2f((bf16_t)(v.z & 0xffff)), bf2f((bf16_t)(v.z >> 16)), bf2f((bf16_t)(v.w & 0xffff)), bf2f((bf16_t)(v.w >> 16))};
                float ss = 0.f;
#pragma unroll
                for (int k = 0; k < 8; ++k) ss += a[k] * a[k];
                ss = wave_sum(ss);
                const float rr = rsqrtf(ss * (1.0f / 512.0f) + 1e-6f);
                u32x4 w; w.x = pack2(a[0] * rr, a[1] * rr); w.y = pack2(a[2] * rr, a[3] * rr); w.z = pack2(a[4] * rr, a[5] * rr); w.w = pack2(a[6] * rr, a[7] * rr);
                *(u32x4*)(gr + 256 + lane * 8) = w;
            }
            {
                const u32x2 v = *(const u32x2*)(yr + 512 + lane * 4);
                float a[4] = {bf2f((bf16_t)(v.x & 0xffff)), bf2f((bf16_t)(v.x >> 16)), bf2f((bf16_t)(v.y & 0xffff)), bf2f((bf16_t)(v.y >> 16))};
                float ss = wave_sum(a[0] * a[0] + a[1] * a[1] + a[2] * a[2] + a[3] * a[3]);
                const float rr = rsqrtf(ss * (1.0f / 256.0f) + 1e-6f);
                u32x2 w; w.x = pack2(a[0] * rr, a[1] * rr); w.y = pack2(a[2] * rr, a[3] * rr);
                *(u32x2*)(gr + 768 + lane * 4) = w;
            }
        }
        __syncthreads();
    }
}


#define XB_TMO      128
#define XB_XCNT(j)  (256  + 64 * (j))
#define XB_XSUB(j)  (1280 + 64 * (j))
#define XB_XGEN(j)  (2304 + 64 * (j))
#define XB_TOP      3328
#define XB_TOPGEN   3392
#define XCD_BAR_WORDS 3456
#define XB_SPIN_CAP (1u << 22)
#define LAS __attribute__((address_space(3)))
DI unsigned xb_ld(unsigned* p)              { return __hip_atomic_load(p, __ATOMIC_RELAXED, __HIP_MEMORY_SCOPE_AGENT); }
DI unsigned xb_add(unsigned* p, unsigned v) { return __hip_atomic_fetch_add(p, v, __ATOMIC_RELAXED, __HIP_MEMORY_SCOPE_AGENT); }
DI unsigned xb_xcc_id() { return (unsigned)__builtin_amdgcn_s_getreg((3 << 11) | 20) & 0xFu; }
#define XB_SPIN(cond, bar) do { unsigned _sp = 0; while (cond) { __builtin_amdgcn_s_sleep(1); \
    if ((++_sp & 255u) == 0u) { if (xb_ld(&(bar)[XB_TMO])) break; if (_sp > XB_SPIN_CAP) { atomicAdd(&(bar)[XB_TMO], 1u); break; } } } } while (0)
struct XcdBarrier { unsigned* bar; unsigned x; volatile LAS unsigned* st; };
DI XcdBarrier xcd_barrier_post(unsigned* bar, volatile LAS unsigned* st) {
    XcdBarrier b; b.bar = bar; b.x = xb_xcc_id(); b.st = st;
    if (threadIdx.x == 0) (void)xb_add(&bar[XB_XCNT(b.x)], 1u);
    return b;
}
DI void xcd_barrier_complete(unsigned* bar, unsigned x, unsigned& nloc, unsigned& nx) {
    const unsigned G = gridDim.x * gridDim.y * gridDim.z;
    unsigned sum, cnt, mine, sp = 0u;
    for (;;) {
        sum = 0u; cnt = 0u; mine = 0u;
#pragma unroll
        for (unsigned j = 0; j < 16; ++j) { const unsigned c = xb_ld(&bar[XB_XCNT(j)]); sum += c; cnt += (c > 0u) ? 1u : 0u; mine = (j == x) ? c : mine; }
        if (sum == G) break;
        __builtin_amdgcn_s_sleep(1);
        if ((++sp & 255u) == 0u) { if (xb_ld(&bar[XB_TMO])) break; if (sp > XB_SPIN_CAP) { atomicAdd(&bar[XB_TMO], 1u); break; } }
    }
    nloc = mine > 0u ? mine : 1u; nx = cnt > 0u ? cnt : 1u;
}
DI void xcd_barrier(const XcdBarrier& b) {
    asm volatile("s_waitcnt vmcnt(0)" ::: "memory");
    __syncthreads();
    if (threadIdx.x == 0) {
        unsigned* bar = b.bar;
        __builtin_amdgcn_s_waitcnt(0);
        unsigned nloc = b.st[0], nx = b.st[1];
        if (nloc == 0u) { xcd_barrier_complete(bar, b.x, nloc, nx); b.st[0] = nloc; b.st[1] = nx; }
        const unsigned old = xb_add(&bar[XB_XSUB(b.x)], 1u);
        const unsigned gen = old / nloc;
        if (old + 1u == (gen + 1u) * nloc) {
            __builtin_amdgcn_fence(__ATOMIC_RELEASE, "agent");
            asm volatile("s_waitcnt vmcnt(0)" ::: "memory");
            const unsigned og = xb_add(&bar[XB_TOP], 1u);
            const unsigned tg = og / nx;
            if (og + 1u == (tg + 1u) * nx) xb_add(&bar[XB_TOPGEN], 1u);
            else XB_SPIN(xb_ld(&bar[XB_TOPGEN]) == tg, bar);
            __builtin_amdgcn_fence(__ATOMIC_ACQUIRE, "agent");
            xb_add(&bar[XB_XGEN(b.x)], 1u);
            asm volatile("s_waitcnt vmcnt(0)" ::: "memory");
        } else {
            XB_SPIN(xb_ld(&bar[XB_XGEN(b.x)]) == gen, bar);
            __builtin_amdgcn_fence(__ATOMIC_ACQUIRE, "agent");
            asm volatile("s_waitcnt vmcnt(0)" ::: "memory");
        }
    }
    __syncthreads();
}

extern __shared__ __attribute__((aligned(16))) unsigned char smem[];

__global__ void __launch_bounds__(512) fwd_megakernel(Params p) {
    cg::grid_group grid = cg::this_grid();
    unsigned char* lds = smem;
    unsigned char* ws = p.ws;
    unsigned* bar = (unsigned*)(ws + O_BAR);
    volatile LAS unsigned* xb_st = (volatile LAS unsigned*)(smem + LDS_BYTES - 16);
    if (threadIdx.x < 4) xb_st[threadIdx.x] = 0u;
    if (blockIdx.x == 0) for (int i = threadIdx.x; i < XCD_BAR_WORDS; i += NTHR) bar[i] = 0u;
    __syncthreads();
#pragma unroll 1
    for (int l2 = 0; l2 < 2 * REP_PRO; ++l2) { const int l = l2 & 1;
        convT(lds, p.in[2] + (size_t)l * 1024 * 1952, 1024, 1952, 2048, p.in[1] + l * 1024, (bf16_t*)(ws + O_WIN) + (size_t)l * 2048 * 1024, 0);
        convT(lds, p.in[16] + (size_t)l * 256 * 384, 256, 384, 512, p.in[15] + l * 256, (bf16_t*)(ws + O_WUQ) + (size_t)l * 512 * 256, 0);
        convT(lds, p.in[18] + (size_t)l * 128 * 512, 128, 512, 512, p.in[17] + l * 128, (bf16_t*)(ws + O_WUKV) + (size_t)l * 512 * 128, 0);
        convT(lds, p.in[25] + (size_t)l * 1024 * 5632, 1024, 5632, 5632, p.in[24] + l * 1024, (bf16_t*)(ws + O_WUP) + (size_t)l * 5632 * 1024, 1);
        convT(lds, p.in[28] + (size_t)l * 2816 * 1024, 2816, 1024, 1024, nullptr, (bf16_t*)(ws + O_WDOWN) + (size_t)l * 1024 * 2816, 0);
    }
    {
        float* tile = (float*)lds;
        const int tid = tid_fresh();
        for (int u = blockIdx.x; u < 2 * 16 * 16; u += gridDim.x) {
            const int l = u >> 8, kt = (u & 255) & 15, ntile = (u & 255) >> 4;
            const int k0 = kt * 64, n0 = ntile * 64;
            const float* W = p.in[22] + (size_t)l * 1024 * 1024;
            bf16_t* dst = (bf16_t*)(ws + O_WOUT) + (size_t)l * 1024 * 1024;
#pragma unroll
            for (int i = 0; i < 8; ++i) {
                const int kk = (tid >> 6) + 8 * i, nn = tid & 63, k = k0 + kk;
                const float g = (k < 256) ? p.in[19][l * 256 + k] : (k < 768) ? p.in[20][l * 512 + k - 256] : p.in[21][l * 256 + k - 768];
                tile[kk * 65 + nn] = W[(size_t)k * 1024 + n0 + nn] * g;
            }
            __syncthreads();
            {
                const int nn = tid >> 3, kb = (tid & 7) * 8;
                u32x4 w;
                w.x = pack2(tile[(kb + 0) * 65 + nn], tile[(kb + 1) * 65 + nn]);
                w.y = pack2(tile[(kb + 2) * 65 + nn], tile[(kb + 3) * 65 + nn]);
                w.z = pack2(tile[(kb + 4) * 65 + nn], tile[(kb + 5) * 65 + nn]);
                w.w = pack2(tile[(kb + 6) * 65 + nn], tile[(kb + 7) * 65 + nn]);
                *(u32x4*)(dst + (size_t)(n0 + nn) * 1024 + k0 + kb) = w;
            }
            __syncthreads();
        }
    }
    hy_h2_phase(lds, p);
    rownorm_phase(p.in[0], (bf16_t*)(ws + O_XN));
    grid.sync();
    const XcdBarrier xb = xcd_barrier_post(bar, xb_st);


#pragma unroll 1
    for (int l = 0; l < 2; ++l) {
        {
            EpiIn e; e.hyT = (float*)(ws + O_HYT); e.projb = (bf16_t*)(ws + O_PROJB);
            gemm_phase<false>(lds, (const bf16_t*)(ws + O_XN), 1024, (const bf16_t*)(ws + O_WIN) + (size_t)l * 2048 * 1024, 1024, 64, 8, e);
        }
        XSYNC();
#pragma unroll 1
        for (int rep = 0; rep < REP_EW; ++rep) prep_phase(p, l);
        ft_phase(lds, p, l);
        XSYNC();
        {
            EpiUq e; e.Qm = (bf16_t*)(ws + O_QM); e.rq = (const float*)(ws + O_RQ); e.sc = 0.10206207261596577f * 1.4426950408889634f;
            gemm_phase<false>(lds, (const bf16_t*)(ws + O_PROJB) + 768, 1184, (const bf16_t*)(ws + O_WUQ) + (size_t)l * 512 * 256, 256, 64, 2, e);
            EpiUkv e2; e2.Km = (bf16_t*)(ws + O_KM); e2.VmT = (bf16_t*)(ws + O_VMT); e2.rkv = (const float*)(ws + O_RKV);
            gemm_phase<false>(lds, (const bf16_t*)(ws + O_PROJB) + 1024, 1184, (const bf16_t*)(ws + O_WUKV) + (size_t)l * 512 * 128, 128, 64, 2, e2);
        }
        XSYNC();
#pragma unroll 1
        for (int rep = 0; rep < REP_HY; ++rep)
        for (int c = blockIdx.x; c < 256; c += gridDim.x) hyena_unit(lds, p, l, c);
#pragma unroll 1
        for (int rep = 0; rep < REP_ATTN; ++rep)
        for (int u = blockIdx.x; u < 512; u += gridDim.x) {
            const int qt = u & 31, hh = (u >> 5) & 7, b = u >> 8, hk = hh >> 2;
            attn_unit<64>(lds, (const bf16_t*)(ws + O_QG) + ((size_t)(b * 8 + hh) * L_ + qt * 256) * 64,
                          (const bf16_t*)(ws + O_KG) + (size_t)(b * 2 + hk) * L_ * 64,
                          (const bf16_t*)(ws + O_VGT) + (size_t)(b * 2 + hk) * 64 * L_,
                          (bf16_t*)(ws + O_PROJB) + (size_t)(b * L_ + qt * 256) * 768 + hh * 64);
        }
#pragma unroll 1
        for (int rep = 0; rep < REP_ATTN; ++rep)
        for (int u = blockIdx.x; u < 256; u += gridDim.x) {
            const int qt = u & 31, hh = (u >> 5) & 3, b = u >> 7;
            attn_unit<96>(lds, (const bf16_t*)(ws + O_QM) + ((size_t)(b * 4 + hh) * L_ + qt * 256) * 96,
                          (const bf16_t*)(ws + O_KM) + (size_t)(b * 4 + hh) * L_ * 96,
                          (const bf16_t*)(ws + O_VMT) + (size_t)(b * 4 + hh) * 64 * L_,
                          (bf16_t*)(ws + O_PROJB) + (size_t)(b * L_ + qt * 256) * 768 + 512 + hh * 64);
        }
        XSYNC();
#pragma unroll 1
        for (int rep = 0; rep < REP_EW; ++rep) groups_phase(lds, p);
        XSYNC();
        {
            EpiF32 e; e.C = (float*)(ws + O_R1); e.ldc = 1024;
            gemm_phase<false>(lds, (const bf16_t*)(ws + O_HYT), 1024, (const bf16_t*)(ws + O_WOUT) + (size_t)l * 1024 * 1024, 1024, 64, 4, e);
        }
        XSYNC();
        resid_phase((const float*)(ws + O_R1), l == 0 ? p.in[0] : p.out, p.in[23] + l * 1024, p.out, (bf16_t*)(ws + O_XN), true);
        XSYNC();
        {
            EpiUp e; e.act = (bf16_t*)(ws + O_HYT); e.cw = p.in[26] + (size_t)l * 3 * 5632; e.cb = p.in[27] + (size_t)l * 5632;
            gemm_phase<true>(lds, (const bf16_t*)(ws + O_XN), 1024, (const bf16_t*)(ws + O_WUP) + (size_t)l * 5632 * 1024, 1024, 66, 22, e);
        }
        XSYNC();
        {
            EpiF32 e; e.C = (float*)(ws + O_R1); e.ldc = 1024;
            gemm_phase<false>(lds, (const bf16_t*)(ws + O_HYT), 2816, (const bf16_t*)(ws + O_WDOWN) + (size_t)l * 1024 * 2816, 2816, 64, 4, e);
        }
        XSYNC();
        resid_phase((const float*)(ws + O_R1), p.out, p.in[29] + l * 1024, p.out, (bf16_t*)(ws + O_XN), l == 0);
        if (l == 0) XSYNC();
    }
}

extern "C" void kernel_launch(void* const* d_in, const int* in_sizes, int n_in,
                              void* d_out, int out_size, void* d_ws, size_t ws_size,
                              hipStream_t stream) {
    static int grid_blocks = 0;
    if (!grid_blocks) {
        int dev = 0, cus = 0, per_cu = 0;
        (void)hipGetDevice(&dev);
        (void)hipDeviceGetAttribute(&cus, hipDeviceAttributeMultiprocessorCount, dev);
        (void)hipFuncSetAttribute((const void*)fwd_megakernel, hipFuncAttributeMaxDynamicSharedMemorySize, (int)LDS_BYTES);
        (void)hipOccupancyMaxActiveBlocksPerMultiprocessor(&per_cu, fwd_megakernel, NTHR, LDS_BYTES);
        if (per_cu < 1) per_cu = 1;
        grid_blocks = cus;
        if (grid_blocks > 256) grid_blocks = 256;
    }
    Params p{};
    for (int i = 0; i < 30; ++i) p.in[i] = (const float*)d_in[i];
    p.out = (float*)d_out; p.ws = (unsigned char*)d_ws;
    void* args[] = {&p};
    hipError_t e = hipLaunchCooperativeKernel((void*)fwd_megakernel, dim3(grid_blocks), dim3(NTHR), args, LDS_BYTES, stream);
    if (e != hipSuccess) fprintf(stderr, "cooperative launch failed: %s (grid %d)\n", hipGetErrorString(e), grid_blocks);
}
```

```cpp
#include <hip/hip_runtime.h>
#include <hip/hip_cooperative_groups.h>
#include <cstdio>
#include <cstdint>
namespace cg = cooperative_groups;

typedef unsigned short bf16_t;
typedef short bf16x8 __attribute__((ext_vector_type(8)));
typedef float f32x4 __attribute__((ext_vector_type(4)));
typedef float f32x16 __attribute__((ext_vector_type(16)));
typedef unsigned u32x2 __attribute__((ext_vector_type(2)));
typedef unsigned u32x4 __attribute__((ext_vector_type(4)));

#define DI __device__ __forceinline__
#ifndef REP_ATTN
#define REP_ATTN 1
#endif
#ifndef REP_HY
#define REP_HY 1
#endif
#ifndef REP_GEMM
#define REP_GEMM 1
#endif
#ifndef REP_PRO
#define REP_PRO 1
#endif
#ifndef REP_SYNC
#define REP_SYNC 1
#endif
#define XSYNC() do { _Pragma("unroll 1") for (int r_ = 0; r_ < REP_SYNC; ++r_) xcd_barrier(xb); } while (0)
#ifndef REP_EW
#define REP_EW 1
#endif
constexpr int L_ = 8192, T_ = 16384, NTHR = 512;
constexpr size_t MiB = 1u << 20;
constexpr size_t O_WIN = 0, O_WUQ = 8 * MiB, O_WUKV = 8 * MiB + 512 * 1024, O_RQ = 8 * MiB + 768 * 1024, O_RKV = 8 * MiB + 832 * 1024;
constexpr size_t O_BAR = 8 * MiB + 896 * 1024;
constexpr size_t O_WOUT = 9 * MiB, O_WUP = 13 * MiB, O_WDOWN = 35 * MiB, O_H2 = 46 * MiB;
constexpr size_t O_R1 = 50 * MiB;
constexpr size_t O_HYT = 114 * MiB;
constexpr size_t O_PROJB = 162 * MiB;
constexpr size_t O_HYOUT = 186 * MiB;
constexpr size_t O_QG = 199 * MiB, O_KG = 215 * MiB, O_VGT = 219 * MiB, O_QM = 223 * MiB, O_KM = 235 * MiB, O_VMT = 247 * MiB;
constexpr size_t O_XN = 223 * MiB;
constexpr size_t O_SLOTS = 255 * MiB;
constexpr size_t LDS_BYTES = 150 * 1024;

struct Params { const float* in[30]; float* out; unsigned char* ws; };

typedef __bf16 bf16v2_t __attribute__((ext_vector_type(2)));
typedef float f32v2_t __attribute__((ext_vector_type(2)));
DI bf16_t f2bf(float x) { const __bf16 b = (__bf16)x; return __builtin_bit_cast(bf16_t, b); }
DI float bf2f(bf16_t v) { return __uint_as_float(((unsigned)v) << 16); }
DI unsigned pack2(float lo, float hi) { const f32v2_t v = {lo, hi}; const bf16v2_t b = __builtin_convertvector(v, bf16v2_t); return __builtin_bit_cast(unsigned, b); }
DI float wave_sum(float v) {
#pragma unroll
    for (int o = 32; o >= 1; o >>= 1) v += __shfl_xor(v, o);
    return v;
}
DI int tid_fresh() { int t = threadIdx.x; asm volatile("" : "+v"(t)); return t; }
DI void fast_sincos(float ang, float* s, float* c) {
    float rev = ang * 0.15915494309189535f; rev -= rintf(rev);
    *s = __builtin_amdgcn_sinf(rev); *c = __builtin_amdgcn_cosf(rev);
}
DI int perm16(int t) { return (t & ~15) | (t & 3) | (((t >> 3) & 1) << 2) | (((t >> 2) & 1) << 3); }

DI void convT(unsigned char* lds, const float* __restrict__ W, int K, int N, int Npad, const float* __restrict__ gain, bf16_t* __restrict__ dst, int mode) {
    float* tile = (float*)lds;
    const int tid = tid_fresh();
    const int nkt = K >> 6, nnt = Npad >> 6;
    for (int u = blockIdx.x; u < nkt * nnt; u += gridDim.x) {
        const int kt = u % nkt, ntile = u / nkt;
        const int k0 = kt * 64, n0 = ntile * 64;
        int src0 = n0;
        if (mode == 1) { const int jt = n0 >> 7, half = (n0 >> 6) & 1; src0 = half ? 2816 + 64 * jt : 64 * jt; }
        const bool valid = (mode == 1) || (n0 < N);
#pragma unroll
        for (int i = 0; i < 8; ++i) {
            const int kk = (tid >> 6) + 8 * i, nn = tid & 63;
            float v = 0.f;
            if (valid && (src0 + nn) < N) v = W[(size_t)(k0 + kk) * N + src0 + nn] * (gain ? gain[k0 + kk] : 1.0f);
            tile[kk * 65 + nn] = v;
        }
        __syncthreads();
        {
            const int nn = tid >> 3, kb = (tid & 7) * 8;
            u32x4 w;
            w.x = pack2(tile[(kb + 0) * 65 + nn], tile[(kb + 1) * 65 + nn]);
            w.y = pack2(tile[(kb + 2) * 65 + nn], tile[(kb + 3) * 65 + nn]);
            w.z = pack2(tile[(kb + 4) * 65 + nn], tile[(kb + 5) * 65 + nn]);
            w.w = pack2(tile[(kb + 6) * 65 + nn], tile[(kb + 7) * 65 + nn]);
            *(u32x4*)(dst + (size_t)(n0 + nn) * K + k0 + kb) = w;
        }
        __syncthreads();
    }
}

DI void hy_h2_phase(unsigned char* lds, const Params& p) {
    float* zs = (float*)lds;
    float* h1s = zs + 8 * 36;
    const int tid = tid_fresh(), rr = tid >> 6, j = tid & 63;
    float* h2 = (float*)(p.ws + O_H2);
    for (int u = blockIdx.x; u < 2 * (L_ / 8); u += gridDim.x) {
        const int l = u / (L_ / 8), t = (u % (L_ / 8)) * 8 + rr;
        if (j < 16) {
            const float w = 2.0f * 3.14159265358979323846f * (float)t / (float)L_;
            const float f = 1e-4f + (15.0f - 1e-4f) * (float)j / 15.0f;
            const float a = f * w;
            zs[rr * 36 + 1 + j] = cosf(a);
            zs[rr * 36 + 17 + j] = -sinf(a);
            if (j == 0) zs[rr * 36] = (float)t / (float)(L_ - 1);
        }
        __syncthreads();
        {
            const float* w1 = p.in[5] + (size_t)l * 33 * 64;
            float s = p.in[6][l * 64 + j];
#pragma unroll
            for (int e = 0; e < 33; ++e) s += zs[rr * 36 + e] * w1[e * 64 + j];
            h1s[rr * 64 + j] = sinf(p.in[7][l * 64 + j] * s);
        }
        __syncthreads();
        {
            const float* w2 = p.in[8] + (size_t)l * 64 * 64;
            float s = p.in[9][l * 64 + j];
#pragma unroll 8
            for (int e = 0; e < 64; ++e) s += h1s[rr * 64 + e] * w2[e * 64 + j];
            h2[((size_t)l * L_ + t) * 64 + j] = sinf(p.in[10][l * 64 + j] * s);
        }
        __syncthreads();
    }
}


DI void ft_phase(unsigned char* lds, const Params& p, int l) {
    const int tid = tid_fresh(), lane = tid & 63, w = tid >> 6, r16 = lane & 15, q4 = lane >> 4;
    const float* h2 = (const float*)(p.ws + O_H2) + (size_t)l * L_ * 64;
    const float* w3 = p.in[11] + (size_t)l * 64 * 1024;
    const float min_decay = -4.605170185988091f / 1.5f, max_decay = -4.605170185988091f / 0.3f;
    for (int u = blockIdx.x; u < L_ / 32; u += gridDim.x) {
        const int t0 = u * 32;
        bf16x8 hb[2][2];
#pragma unroll
        for (int tt = 0; tt < 2; ++tt)
#pragma unroll
            for (int ks = 0; ks < 2; ++ks) {
                const float* hp = h2 + (size_t)(t0 + 16 * tt + r16) * 64 + 32 * ks + 8 * q4;
                const f32x4 a = *(const f32x4*)hp, b = *(const f32x4*)(hp + 4);
                u32x4 pw; pw.x = pack2(a[0], a[1]); pw.y = pack2(a[2], a[3]); pw.z = pack2(b[0], b[1]); pw.w = pack2(b[2], b[3]);
                hb[tt][ks] = __builtin_bit_cast(bf16x8, pw);
            }
#pragma unroll 1
        for (int nt = 0; nt < 8; ++nt) {
            const int n0 = 128 * w + 16 * nt;
            f32x4 acc0 = {0.f, 0.f, 0.f, 0.f}, acc1 = {0.f, 0.f, 0.f, 0.f};
#pragma unroll
            for (int ks = 0; ks < 2; ++ks) {
                const float* wp = w3 + (size_t)(32 * ks + 8 * q4) * 1024 + n0 + r16;
                u32x4 pw;
                pw.x = pack2(wp[0], wp[1024]); pw.y = pack2(wp[2048], wp[3072]); pw.z = pack2(wp[4096], wp[5120]); pw.w = pack2(wp[6144], wp[7168]);
                const bf16x8 wf = __builtin_bit_cast(bf16x8, pw);
                acc0 = __builtin_amdgcn_mfma_f32_16x16x32_bf16(wf, hb[0][ks], acc0, 0, 0, 0);
                acc1 = __builtin_amdgcn_mfma_f32_16x16x32_bf16(wf, hb[1][ks], acc1, 0, 0, 0);
            }
#pragma unroll
            for (int i = 0; i < 4; ++i) {
                const int col = n0 + 4 * q4 + i, c = col & 255, od = col >> 8;
                const float dlt = fabsf(min_decay + (max_decay - min_decay) * (float)c / 255.0f);
                float* dst = (float*)(p.ws + O_R1 + (size_t)c * 262144 + 131072) + od * L_ + t0 + r16;
                dst[0] = acc0[i] * expf(-((float)(t0 + r16) / (float)(L_ - 1)) * dlt);
                dst[16] = acc1[i] * expf(-((float)(t0 + 16 + r16) / (float)(L_ - 1)) * dlt);
            }
        }
    }
}

DI void rownorm_phase(const float* __restrict__ x, bf16_t* __restrict__ xn) {
    const int tid_ = tid_fresh(); const int lane = tid_ & 63, wid = tid_ >> 6;
    for (int row = blockIdx.x * 8 + wid; row < T_; row += gridDim.x * 8) {
        const float* xr = x + (size_t)row * 1024;
        f32x4 v[4]; float ss = 0.f;
#pragma unroll
        for (int i = 0; i < 4; ++i) { v[i] = *(const f32x4*)(xr + i * 256 + lane * 4); ss += v[i][0] * v[i][0] + v[i][1] * v[i][1] + v[i][2] * v[i][2] + v[i][3] * v[i][3]; }
        ss = wave_sum(ss);
        const float r = rsqrtf(ss * (1.0f / 1024.0f) + 1e-6f);
#pragma unroll
        for (int i = 0; i < 4; ++i) { u32x2 w; w.x = pack2(v[i][0] * r, v[i][1] * r); w.y = pack2(v[i][2] * r, v[i][3] * r); *(u32x2*)(xn + (size_t)row * 1024 + i * 256 + lane * 4) = w; }
    }
}

DI void resid_phase(const float* __restrict__ y, const float* __restrict__ xres, const float* __restrict__ g, float* __restrict__ xout, bf16_t* __restrict__ xn, bool want_xn) {
    const int tid_ = tid_fresh(); const int lane = tid_ & 63, wid = tid_ >> 6;
    for (int row = blockIdx.x * 8 + wid; row < T_; row += gridDim.x * 8) {
        const size_t ro = (size_t)row * 1024;
        f32x4 v[4]; float ss = 0.f;
#pragma unroll
        for (int i = 0; i < 4; ++i) { v[i] = *(const f32x4*)(y + ro + i * 256 + lane * 4); ss += v[i][0] * v[i][0] + v[i][1] * v[i][1] + v[i][2] * v[i][2] + v[i][3] * v[i][3]; }
        ss = wave_sum(ss);
        const float r = rsqrtf(ss * (1.0f / 1024.0f) + 1e-6f);
        float s2 = 0.f;
#pragma unroll
        for (int i = 0; i < 4; ++i) {
            const f32x4 xr = *(const f32x4*)(xres + ro + i * 256 + lane * 4);
            const f32x4 gg = *(const f32x4*)(g + i * 256 + lane * 4);
            v[i] = xr + v[i] * r * gg;
            s2 += v[i][0] * v[i][0] + v[i][1] * v[i][1] + v[i][2] * v[i][2] + v[i][3] * v[i][3];
            *(f32x4*)(xout + ro + i * 256 + lane * 4) = v[i];
        }
        if (want_xn) {
            s2 = wave_sum(s2);
            const float r2 = rsqrtf(s2 * (1.0f / 1024.0f) + 1e-6f);
#pragma unroll
            for (int i = 0; i < 4; ++i) { u32x2 w; w.x = pack2(v[i][0] * r2, v[i][1] * r2); w.y = pack2(v[i][2] * r2, v[i][3] * r2); *(u32x2*)(xn + ro + i * 256 + lane * 4) = w; }
        }
    }
}

#define XB_TMO      128
#define XB_XCNT(j)  (256  + 64 * (j))
#define XB_XSUB(j)  (1280 + 64 * (j))
#define XB_XGEN(j)  (2304 + 64 * (j))
#define XB_TOP      3328
#define XB_TOPGEN   3392
#define XCD_BAR_WORDS 3456
#define XB_SPIN_CAP (1u << 22)
#define LAS __attribute__((address_space(3)))
DI unsigned xb_ld(unsigned* p)              { return __hip_atomic_load(p, __ATOMIC_RELAXED, __HIP_MEMORY_SCOPE_AGENT); }
DI unsigned xb_add(unsigned* p, unsigned v) { return __hip_atomic_fetch_add(p, v, __ATOMIC_RELAXED, __HIP_MEMORY_SCOPE_AGENT); }
DI unsigned xb_xcc_id() { return (unsigned)__builtin_amdgcn_s_getreg((3 << 11) | 20) & 0xFu; }
#define XB_SPIN(cond, bar) do { unsigned _sp = 0; while (cond) { __builtin_amdgcn_s_sleep(1); \
    if ((++_sp & 255u) == 0u) { if (xb_ld(&(bar)[XB_TMO])) break; if (_sp > XB_SPIN_CAP) { atomicAdd(&(bar)[XB_TMO], 1u); break; } } } } while (0)
struct XcdBarrier { unsigned* bar; unsigned x; volatile LAS unsigned* st; };
DI XcdBarrier xcd_barrier_post(unsigned* bar, volatile LAS unsigned* st) {
    XcdBarrier b; b.bar = bar; b.x = xb_xcc_id(); b.st = st;
    if (threadIdx.x == 0) (void)xb_add(&bar[XB_XCNT(b.x)], 1u);
    return b;
}
DI void xcd_barrier_complete(unsigned* bar, unsigned x, unsigned& nloc, unsigned& nx) {
    const unsigned G = gridDim.x * gridDim.y * gridDim.z;
    unsigned sum, cnt, mine, sp = 0u;
    for (;;) {
        sum = 0u; cnt = 0u; mine = 0u;
#pragma unroll
        for (unsigned j = 0; j < 16; ++j) { const unsigned c = xb_ld(&bar[XB_XCNT(j)]); sum += c; cnt += (c > 0u) ? 1u : 0u; mine = (j == x) ? c : mine; }
        if (sum == G) break;
        __builtin_amdgcn_s_sleep(1);
        if ((++sp & 255u) == 0u) { if (xb_ld(&bar[XB_TMO])) break; if (sp > XB_SPIN_CAP) { atomicAdd(&bar[XB_TMO], 1u); break; } }
    }
    nloc = mine > 0u ? mine : 1u; nx = cnt > 0u ? cnt : 1u;
}
DI void xcd_barrier(const XcdBarrier& b) {
    asm volatile("s_waitcnt vmcnt(0)" ::: "memory");
    __syncthreads();
    if (threadIdx.x == 0) {
        unsigned* bar = b.bar;
        __builtin_amdgcn_s_waitcnt(0);
        unsigned nloc = b.st[0], nx = b.st[1];
        if (nloc == 0u) { xcd_barrier_complete(bar, b.x, nloc, nx); b.st[0] = nloc; b.st[1] = nx; }
        const unsigned old = xb_add(&bar[XB_XSUB(b.x)], 1u);
        const unsigned gen = old / nloc;
        if (old + 1u == (gen + 1u) * nloc) {
            __builtin_amdgcn_fence(__ATOMIC_RELEASE, "agent");
            asm volatile("s_waitcnt vmcnt(0)" ::: "memory");
            const unsigned og = xb_add(&bar[XB_TOP], 1u);
            const unsigned tg = og / nx;
            if (og + 1u == (tg + 1u) * nx) xb_add(&bar[XB_TOPGEN], 1u);
            else XB_SPIN(xb_ld(&bar[XB_TOPGEN]) == tg, bar);
            __builtin_amdgcn_fence(__ATOMIC_ACQUIRE, "agent");
            xb_add(&bar[XB_XGEN(b.x)], 1u);
            asm volatile("s_waitcnt vmcnt(0)" ::: "memory");
        } else {
            XB_SPIN(xb_ld(&bar[XB_XGEN(b.x)]) == gen, bar);
            __builtin_amdgcn_fence(__ATOMIC_ACQUIRE, "agent");
            asm volatile("s_waitcnt vmcnt(0)" ::: "memory");
        }
    }
    __syncthreads();
}

DI int swz128(int row, int chunk) { return row * 128 + ((chunk ^ ((row >> 1) & 7)) << 4); }

template <bool OVL, class Epi>
DI void gemm_phase(unsigned char* lds, const bf16_t* __restrict__ A, int lda, const bf16_t* __restrict__ Bt, int K, int nMt, int nNt, const Epi& epi) {
    typedef __attribute__((address_space(3))) unsigned char lds_uc;
    lds_uc* ldsl = (lds_uc*)lds;
    const int tid = tid_fresh(), lane = tid & 63, wid = tid >> 6, wm = wid & 1, wn = wid >> 1;
    const int r16 = lane & 15, q4 = lane >> 4;
    const int nk = K >> 6;
    const int xr = (r16 >> 1) & 7;
    const int ab0 = (128 * wm + r16) * 128 + ((q4 ^ xr) << 4), ab1 = (128 * wm + r16) * 128 + (((4 + q4) ^ xr) << 4);
    const int bb0 = 32768 + (64 * wn + r16) * 128 + ((q4 ^ xr) << 4), bb1 = 32768 + (64 * wn + r16) * 128 + (((4 + q4) ^ xr) << 4);
#pragma unroll 1
    for (int rep = 0; rep < REP_GEMM; ++rep)
    for (int u = blockIdx.x; u < nMt * nNt; u += gridDim.x) {
        const int um = u % nMt, un = u / nMt;
        const bf16_t* ap[4]; const bf16_t* bp[4];
        int t0 = 0, bb = 0;
        if (OVL) { bb = um / 33; t0 = 254 * (um % 33) - 1; }
#pragma unroll
        for (int i = 0; i < 4; ++i) {
            const int P = (wid * 4 + i) * 64 + lane, row = P >> 3, c = (P & 7) ^ ((row >> 1) & 7);
            int grow;
            if (OVL) { int t = t0 + row; t = t < 0 ? 0 : (t > L_ - 1 ? L_ - 1 : t); grow = bb * L_ + t; }
            else grow = um * 256 + row;
            ap[i] = A + (size_t)grow * lda + c * 8;
            bp[i] = Bt + (size_t)(un * 256 + row) * K + c * 8;
        }
        f32x4 acc[8][4];
#pragma unroll
        for (int a = 0; a < 8; ++a)
#pragma unroll
            for (int b = 0; b < 4; ++b) acc[a][b] = (f32x4){0.f, 0.f, 0.f, 0.f};
#define G_ISSUE(bufoff) do { _Pragma("unroll") for (int i = 0; i < 4; ++i) { __builtin_amdgcn_global_load_lds((const unsigned*)ap[i], (__attribute__((address_space(3))) unsigned*)(ldsl + (bufoff) + (wid * 4 + i) * 1024), 16, 0, 0); ap[i] += 64; } \
                             _Pragma("unroll") for (int i = 0; i < 4; ++i) { __builtin_amdgcn_global_load_lds((const unsigned*)bp[i], (__attribute__((address_space(3))) unsigned*)(ldsl + (bufoff) + 32768 + (wid * 4 + i) * 1024), 16, 0, 0); bp[i] += 64; } } while (0)
        __syncthreads();
        G_ISSUE(0);
        asm volatile("s_waitcnt vmcnt(0)" ::: "memory");
        __builtin_amdgcn_s_barrier();
        asm volatile("" ::: "memory");
#pragma unroll 1
        for (int kt = 0; kt < nk; ++kt) {
            const int cb = (kt & 1) * 65536;
            if (kt + 1 < nk) G_ISSUE(65536 - cb);
            const unsigned char* lb = lds + cb;
#pragma unroll
            for (int ks = 0; ks < 2; ++ks) {
                bf16x8 af[4], bfr[4];
#pragma unroll
                for (int nt = 0; nt < 4; ++nt) bfr[nt] = *(const bf16x8*)(lb + (ks ? bb1 : bb0) + nt * 2048);
#pragma unroll
                for (int mh = 0; mh < 2; ++mh) {
#pragma unroll
                    for (int mt = 0; mt < 4; ++mt) af[mt] = *(const bf16x8*)(lb + (ks ? ab1 : ab0) + (4 * mh + mt) * 2048);
                    __builtin_amdgcn_sched_barrier(0);
#pragma unroll
                    for (int mt = 0; mt < 4; ++mt)
#pragma unroll
                        for (int nt = 0; nt < 4; ++nt) acc[4 * mh + mt][nt] = __builtin_amdgcn_mfma_f32_16x16x32_bf16(bfr[nt], af[mt], acc[4 * mh + mt][nt], 0, 0, 0);
                    __builtin_amdgcn_sched_barrier(0);
                }
            }
            asm volatile("s_waitcnt vmcnt(0) lgkmcnt(0)" ::: "memory");
            __builtin_amdgcn_s_barrier();
            asm volatile("" ::: "memory");
        }
        int r16e = r16, q4e = q4;
        asm volatile("" : "+v"(r16e), "+v"(q4e));
        if constexpr (Epi::STAGED) {
            epi.staged(lds, acc, um, un, wm, wn, r16e, q4e);
        } else {
#pragma unroll
            for (int mt = 0; mt < 8; ++mt) { epi.row(um * 256 + 128 * wm + 16 * mt + r16e, un * 256 + 64 * wn, q4e, acc[mt]); asm volatile("" ::: "memory"); }
        }
    }
#undef G_ISSUE
}

struct EpiIn {
    static constexpr bool STAGED = true;
    float* hyT; bf16_t* projb;
    template <int HF> static DI void hy_half(float* st, const f32x4 (&acc)[8][4], float* dst, int r16, int q4, int lane) {
#pragma unroll
        for (int mt = 0; mt < 4; ++mt)
#pragma unroll
            for (int nt = 0; nt < 4; ++nt)
#pragma unroll
                for (int i = 0; i < 4; ++i) st[(16 * nt + 4 * q4 + i) * 65 + 16 * mt + r16] = acc[4 * HF + mt][nt][i];
        asm volatile("s_waitcnt lgkmcnt(0)" ::: "memory");
#pragma unroll 4
        for (int n = 0; n < 64; ++n) dst[(size_t)n * T_] = st[n * 65 + lane];
        asm volatile("s_waitcnt lgkmcnt(0)" ::: "memory");
    }
    DI void staged(unsigned char* lds, const f32x4 (&acc)[8][4], int um, int un, int wm, int wn, int r16, int q4) const {
        if (un < 3) {
            float* st = (float*)lds + (wm + 2 * wn) * (64 * 65);
            const int lane = r16 + 16 * q4;
            float* dst = hyT + (size_t)(un * 256 + 64 * wn) * T_ + um * 256 + 128 * wm + lane;
            hy_half<0>(st, acc, dst, r16, q4, lane);
            hy_half<1>(st, acc, dst + 64, r16, q4, lane);
        } else {
#pragma unroll
            for (int mt = 0; mt < 8; ++mt) {
                const int tok = um * 256 + 128 * wm + 16 * mt + r16;
#pragma unroll
                for (int nt = 0; nt < 4; ++nt) {
                    const int col = un * 256 + 64 * wn + 16 * nt + 4 * q4;
                    if (col < 1952) {
                        u32x2 w; w.x = pack2(acc[mt][nt][0], acc[mt][nt][1]); w.y = pack2(acc[mt][nt][2], acc[mt][nt][3]);
                        *(u32x2*)(projb + (unsigned)(tok * 1184 + (col - 768))) = w;
                    }
                }
            }
        }
    }
};
struct EpiF32 {
    static constexpr bool STAGED = false;
    float* C; int ldc;
    DI void row(int tok, int colbase, int q4, const f32x4 (&a)[4]) const {
#pragma unroll
        for (int nt = 0; nt < 4; ++nt) *(f32x4*)(C + (size_t)tok * ldc + colbase + 16 * nt + 4 * q4) = a[nt];
    }
};
struct EpiResid {
    static constexpr bool STAGED = true;
    const float* xold; float* xout; bf16_t* xn; const float* g; float* slots; XcdBarrier xb; bool want_xn;
    DI void staged(unsigned char* lds, f32x4 (&acc)[8][4], int um, int un, int wm, int wn, int r16, int q4) const {
        float* P = (float*)lds;
        const int tid = threadIdx.x;
#pragma unroll
        for (int mt = 0; mt < 8; ++mt) {
            float ss = 0.f;
#pragma unroll
            for (int nt = 0; nt < 4; ++nt) ss += acc[mt][nt][0] * acc[mt][nt][0] + acc[mt][nt][1] * acc[mt][nt][1] + acc[mt][nt][2] * acc[mt][nt][2] + acc[mt][nt][3] * acc[mt][nt][3];
            ss += __shfl_xor(ss, 16); ss += __shfl_xor(ss, 32);
            if (q4 == 0) P[(128 * wm + 16 * mt + r16) * 4 + wn] = ss;
        }
        __syncthreads();
        if (tid < 256) slots[(size_t)(um * 256 + tid) * 4 + un] = (P[tid * 4] + P[tid * 4 + 1]) + (P[tid * 4 + 2] + P[tid * 4 + 3]);
        xcd_barrier(xb);
#pragma unroll
        for (int mt = 0; mt < 8; ++mt) {
            const int tok = um * 256 + 128 * wm + 16 * mt + r16;
            const f32x4 sl = *(const f32x4*)(slots + (size_t)tok * 4);
            const float rr = rsqrtf(((sl[0] + sl[1]) + (sl[2] + sl[3])) * (1.0f / 1024.0f) + 1e-6f);
            float ss = 0.f;
#pragma unroll
            for (int nt = 0; nt < 4; ++nt) {
                const int col = un * 256 + 64 * wn + 16 * nt + 4 * q4;
                const f32x4 xo = *(const f32x4*)(xold + (size_t)tok * 1024 + col);
                const f32x4 gg = *(const f32x4*)(g + col);
                const f32x4 v = xo + acc[mt][nt] * rr * gg;
                acc[mt][nt] = v;
                *(f32x4*)(xout + (size_t)tok * 1024 + col) = v;
                ss += v[0] * v[0] + v[1] * v[1] + v[2] * v[2] + v[3] * v[3];
            }
            ss += __shfl_xor(ss, 16); ss += __shfl_xor(ss, 32);
            if (q4 == 0) P[(128 * wm + 16 * mt + r16) * 4 + wn] = ss;
            asm volatile("" ::: "memory");
        }
        if (want_xn) {
            __syncthreads();
            float* slots2 = slots + (size_t)T_ * 4;
            if (tid < 256) slots2[(size_t)(um * 256 + tid) * 4 + un] = (P[tid * 4] + P[tid * 4 + 1]) + (P[tid * 4 + 2] + P[tid * 4 + 3]);
            xcd_barrier(xb);
#pragma unroll
            for (int mt = 0; mt < 8; ++mt) {
                const int tok = um * 256 + 128 * wm + 16 * mt + r16;
                const f32x4 sl = *(const f32x4*)(slots2 + (size_t)tok * 4);
                const float rr = rsqrtf(((sl[0] + sl[1]) + (sl[2] + sl[3])) * (1.0f / 1024.0f) + 1e-6f);
#pragma unroll
                for (int nt = 0; nt < 4; ++nt) {
                    const int col = un * 256 + 64 * wn + 16 * nt + 4 * q4;
                    u32x2 w; w.x = pack2(acc[mt][nt][0] * rr, acc[mt][nt][1] * rr); w.y = pack2(acc[mt][nt][2] * rr, acc[mt][nt][3] * rr);
                    *(u32x2*)(xn + (size_t)tok * 1024 + col) = w;
                }
            }
        }
        __syncthreads();
    }
};
struct EpiUq {
    static constexpr bool STAGED = false;
    bf16_t* Qm; const float* rq; float sc;
    DI void row(int tok, int colbase, int q4, const f32x4 (&a)[4]) const {
        const float r = rq[tok] * sc;
        const int b = tok >> 13, t = tok & (L_ - 1);
#pragma unroll
        for (int nt = 0; nt < 4; ++nt) {
            const int col = colbase + 16 * nt + 4 * q4;
            if (col >= 384) continue;
            const int head = col / 96, j = col - head * 96;
            bf16_t* dst = Qm + ((size_t)(b * 4 + head) * L_ + t) * 96;
            if (j < 64) {
                u32x2 w; w.x = pack2(a[nt][0] * r, a[nt][1] * r); w.y = pack2(a[nt][2] * r, a[nt][3] * r);
                *(u32x2*)(dst + j) = w;
            } else if (j < 80) {
                if (nt < 3) {
                    const int p0 = j - 64;
                    float o1[4], o2[4];
#pragma unroll
                    for (int i = 0; i < 4; ++i) {
                        const int pp = p0 + i;
                        const float inv = __expf(-(float)(pp & 7) * (9.210340371976184f / 8.0f));
                        const float ang = (float)((pp < 8) ? (t >> 6) : (t & 63)) * inv;
                        float sn, cs; fast_sincos(ang, &sn, &cs);
                        const float x1 = a[nt][i] * r, x2 = a[(nt < 3) ? nt + 1 : 3][i] * r;
                        o1[i] = x1 * cs - x2 * sn; o2[i] = x1 * sn + x2 * cs;
                    }
                    u32x2 w; w.x = pack2(o1[0], o1[1]); w.y = pack2(o1[2], o1[3]);
                    *(u32x2*)(dst + j) = w;
                    w.x = pack2(o2[0], o2[1]); w.y = pack2(o2[2], o2[3]);
                    *(u32x2*)(dst + j + 16) = w;
                }
            }
        }
    }
};
struct EpiUkv {
    static constexpr bool STAGED = false;
    bf16_t* Km; bf16_t* VmT; const float* rkv;
    DI void row(int tok, int colbase, int q4, const f32x4 (&a)[4]) const {
        const float r = rkv[tok];
        const int b = tok >> 13, t = tok & (L_ - 1);
#pragma unroll
        for (int nt = 0; nt < 4; ++nt) {
            const int col = colbase + 16 * nt + 4 * q4;
            const int head = col >> 7, j = col & 127;
            if (j < 64) {
                u32x2 w; w.x = pack2(a[nt][0] * r, a[nt][1] * r); w.y = pack2(a[nt][2] * r, a[nt][3] * r);
                *(u32x2*)(Km + ((size_t)(b * 4 + head) * L_ + t) * 96 + j) = w;
            } else {
#pragma unroll
                for (int i = 0; i < 4; ++i) VmT[((size_t)(b * 4 + head) * 64 + (j - 64 + i)) * L_ + perm16(t)] = f2bf(a[nt][i] * r);
            }
        }
    }
};
DI float gelu_tanh(float x) {
    const float u = 0.7978845608028654f * (x + 0.044715f * x * x * x);
    const float e = __expf(2.0f * u);
    const float th = 1.0f - 2.0f / (e + 1.0f);
    return 0.5f * x * (1.0f + th);
}
struct EpiUp {
    static constexpr bool STAGED = true;
    bf16_t* act; const float* cw; const float* cb;
    DI void staged(unsigned char* lds, const f32x4 (&acc)[8][4], int um, int un, int wm, int wn, int r16, int q4) const {
        float* st = (float*)lds;
        const int tid = threadIdx.x, j = tid & 63, seg = tid >> 6;
        const int bb = um / 33, t0 = 254 * (um % 33) - 1;
        const int r0 = 32 * seg;
#pragma unroll 1
        for (int hf = 0; hf < 2; ++hf) {
            if ((wn >> 1) == hf) {
#pragma unroll
                for (int mt = 0; mt < 8; ++mt)
#pragma unroll
                    for (int nt = 0; nt < 4; ++nt) *(f32x4*)(st + (128 * wm + 16 * mt + r16) * 132 + 64 * (wn & 1) + 16 * nt + 4 * q4) = acc[mt][nt];
            }
            __syncthreads();
            const int ch = 64 * (2 * un + hf) + j;
            const float g0 = cw[ch], g1 = cw[5632 + ch], g2 = cw[2 * 5632 + ch], gb = cb[ch];
            const float v0 = cw[2816 + ch], v1 = cw[5632 + 2816 + ch], v2 = cw[2 * 5632 + 2816 + ch], vb = cb[2816 + ch];
#define UPV(rr, cc) ((((rr) >= 0) && ((rr) <= 255) && (t0 + (rr) >= 0) && (t0 + (rr) < L_)) ? st[(rr) * 132 + (cc)] : 0.f)
            float gp = UPV(r0 - 1, j), vp = UPV(r0 - 1, 64 + j);
            float gc = UPV(r0, j), vc = UPV(r0, 64 + j);
#pragma unroll 4
            for (int i = 0; i < 32; ++i) {
                const int r = r0 + i;
                const float gn = UPV(r + 1, j), vn = UPV(r + 1, 64 + j);
                const int t = t0 + r;
                if (r >= 1 && r <= 254 && t < L_) {
                    const float cg = g0 * gp + g1 * gc + g2 * gn + gb;
                    const float cv = v0 * vp + v1 * vc + v2 * vn + vb;
                    act[(size_t)(bb * L_ + t) * 2816 + ch] = f2bf(gelu_tanh(cg) * cv);
                }
                gp = gc; gc = gn; vp = vc; vc = vn;
            }
#undef UPV
            __syncthreads();
        }
    }
};

DI void prep_phase(const Params& p, int l) {
    const int tid_ = tid_fresh(); const int lane = tid_ & 63, wid = tid_ >> 6;
    const bf16_t* projb = (const bf16_t*)(p.ws + O_PROJB);
    bf16_t* Qg = (bf16_t*)(p.ws + O_QG); bf16_t* Kg = (bf16_t*)(p.ws + O_KG); bf16_t* VgT = (bf16_t*)(p.ws + O_VGT);
    bf16_t* Km = (bf16_t*)(p.ws + O_KM);
    float* rq = (float*)(p.ws + O_RQ); float* rkv = (float*)(p.ws + O_RKV);
    const float* gq = p.in[13] + l * 64; const float* gk = p.in[14] + l * 64;
    const int hd = lane >> 3, sub = lane & 7;
    float gq1[4], gq2[4], gk1[4], gk2[4];
#pragma unroll
    for (int i = 0; i < 4; ++i) { gq1[i] = gq[4 * sub + i]; gq2[i] = gq[32 + 4 * sub + i]; gk1[i] = gk[4 * sub + i]; gk2[i] = gk[32 + 4 * sub + i]; }
    const float qscale = 0.125f * 1.4426950408889634f;
    for (int tok = blockIdx.x * 8 + wid; tok < T_; tok += gridDim.x * 8) {
        const int b = tok >> 13, t = tok & (L_ - 1);
        const bf16_t* pr = projb + (size_t)tok * 1184;
        float cs[4], sn[4];
#pragma unroll
        for (int i = 0; i < 4; ++i) {
            const int pp = 4 * sub + i;
            const float inv = __expf(-(float)(pp & 15) * (9.210340371976184f / 16.0f));
            const float ang = (float)((pp < 16) ? (t >> 6) : (t & 63)) * inv;
            fast_sincos(ang, &sn[i], &cs[i]);
        }
        {
            const u32x2 w1 = *(const u32x2*)(pr + hd * 64 + 4 * sub), w2 = *(const u32x2*)(pr + hd * 64 + 32 + 4 * sub);
            float x1[4] = {bf2f((bf16_t)(w1.x & 0xffff)), bf2f((bf16_t)(w1.x >> 16)), bf2f((bf16_t)(w1.y & 0xffff)), bf2f((bf16_t)(w1.y >> 16))};
            float x2[4] = {bf2f((bf16_t)(w2.x & 0xffff)), bf2f((bf16_t)(w2.x >> 16)), bf2f((bf16_t)(w2.y & 0xffff)), bf2f((bf16_t)(w2.y >> 16))};
            float ss = 0.f;
#pragma unroll
            for (int i = 0; i < 4; ++i) ss += x1[i] * x1[i] + x2[i] * x2[i];
            ss += __shfl_xor(ss, 1); ss += __shfl_xor(ss, 2); ss += __shfl_xor(ss, 4);
            const float r = rsqrtf(ss * (1.0f / 64.0f) + 1e-6f);
            float o1[4], o2[4];
#pragma unroll
            for (int i = 0; i < 4; ++i) { const float a = x1[i] * r * gq1[i], c = x2[i] * r * gq2[i]; o1[i] = (a * cs[i] - c * sn[i]) * qscale; o2[i] = (a * sn[i] + c * cs[i]) * qscale; }
            bf16_t* dst = Qg + ((size_t)(b * 8 + hd) * L_ + t) * 64;
            u32x2 w; w.x = pack2(o1[0], o1[1]); w.y = pack2(o1[2], o1[3]); *(u32x2*)(dst + 4 * sub) = w;
            w.x = pack2(o2[0], o2[1]); w.y = pack2(o2[2], o2[3]); *(u32x2*)(dst + 32 + 4 * sub) = w;
        }
        if (lane < 16) {
            const u32x2 w1 = *(const u32x2*)(pr + 512 + hd * 64 + 4 * sub), w2 = *(const u32x2*)(pr + 512 + hd * 64 + 32 + 4 * sub);
            float x1[4] = {bf2f((bf16_t)(w1.x & 0xffff)), bf2f((bf16_t)(w1.x >> 16)), bf2f((bf16_t)(w1.y & 0xffff)), bf2f((bf16_t)(w1.y >> 16))};
            float x2[4] = {bf2f((bf16_t)(w2.x & 0xffff)), bf2f((bf16_t)(w2.x >> 16)), bf2f((bf16_t)(w2.y & 0xffff)), bf2f((bf16_t)(w2.y >> 16))};
            float ss = 0.f;
#pragma unroll
            for (int i = 0; i < 4; ++i) ss += x1[i] * x1[i] + x2[i] * x2[i];
            ss += __shfl_xor(ss, 1); ss += __shfl_xor(ss, 2); ss += __shfl_xor(ss, 4);
            const float r = rsqrtf(ss * (1.0f / 64.0f) + 1e-6f);
            float o1[4], o2[4];
#pragma unroll
            for (int i = 0; i < 4; ++i) { const float a = x1[i] * r * gk1[i], c = x2[i] * r * gk2[i]; o1[i] = a * cs[i] - c * sn[i]; o2[i] = a * sn[i] + c * cs[i]; }
            bf16_t* dst = Kg + ((size_t)(b * 2 + hd) * L_ + t) * 64;
            u32x2 w; w.x = pack2(o1[0], o1[1]); w.y = pack2(o1[2], o1[3]); *(u32x2*)(dst + 4 * sub) = w;
            w.x = pack2(o2[0], o2[1]); w.y = pack2(o2[2], o2[3]); *(u32x2*)(dst + 32 + 4 * sub) = w;
        }
        {
            const unsigned w = *(const unsigned*)(pr + 640 + 2 * lane);
            const int c0 = 2 * lane, kh = c0 >> 6, d = c0 & 63;
            bf16_t* dst = VgT + ((size_t)(b * 2 + kh) * 64 + d) * L_ + perm16(t);
            dst[0] = (bf16_t)(w & 0xffff); dst[L_] = (bf16_t)(w >> 16);
        }
        {
            const u32x2 w = *(const u32x2*)(pr + 768 + 4 * lane);
            const float a0 = bf2f((bf16_t)(w.x & 0xffff)), a1 = bf2f((bf16_t)(w.x >> 16)), a2 = bf2f((bf16_t)(w.y & 0xffff)), a3 = bf2f((bf16_t)(w.y >> 16));
            float ss = wave_sum(a0 * a0 + a1 * a1 + a2 * a2 + a3 * a3);
            if (lane == 0) rq[tok] = rsqrtf(ss * (1.0f / 256.0f) + 1e-6f);
        }
        {
            const unsigned w = *(const unsigned*)(pr + 1024 + 2 * lane);
            const float a0 = bf2f((bf16_t)(w & 0xffff)), a1 = bf2f((bf16_t)(w >> 16));
            float ss = wave_sum(a0 * a0 + a1 * a1);
            if (lane == 0) rkv[tok] = rsqrtf(ss * (1.0f / 128.0f) + 1e-6f);
        }
        if (lane < 16) {
            const float x1 = bf2f(pr[1152 + lane]), x2 = bf2f(pr[1152 + 16 + lane]);
            const float inv = __expf(-(float)(lane & 7) * (9.210340371976184f / 8.0f));
            const float ang = (float)((lane < 8) ? (t >> 6) : (t & 63)) * inv;
            float s1, c1; fast_sincos(ang, &s1, &c1);
            const bf16_t o1 = f2bf(x1 * c1 - x2 * s1), o2 = f2bf(x1 * s1 + x2 * c1);
#pragma unroll
            for (int hh = 0; hh < 4; ++hh) { bf16_t* dst = Km + ((size_t)(b * 4 + hh) * L_ + t) * 96 + 64; dst[lane] = o1; dst[16 + lane] = o2; }
        }
    }
}

template <int DQK> DI int kswz(int row, int chunk) {
    if (DQK == 64) return row * 128 + ((chunk ^ ((row >> 1) & 7)) << 4);
    else return row * 192 + ((chunk ^ ((row >> 2) & 3)) << 4);
}
template <int DQK>
DI void attn_unit(unsigned char* lds, const bf16_t* __restrict__ Qp, const bf16_t* __restrict__ Kp, const bf16_t* __restrict__ VTp, bf16_t* __restrict__ Yp  ) {
    constexpr int NS = DQK / 16, NC = DQK / 8, KB = 64 * DQK * 2, KVB = KB + 8192;
    const int tid = tid_fresh(), lane = tid & 63, w = tid >> 6, r = lane & 31, h = lane >> 5;
    bf16x8 qf[NS];
#pragma unroll
    for (int s = 0; s < NS; ++s) qf[s] = *(const bf16x8*)(Qp + (size_t)(32 * w + r) * DQK + 16 * s + 8 * h);
    f32x16 o0, o1;
#pragma unroll
    for (int i = 0; i < 16; ++i) { o0[i] = 0.f; o1[i] = 0.f; }
    float m = 0.f, lsum = 0.f;
    const int k_row0 = tid / NC, k_c0 = tid % NC;
    const int k_row1 = (tid + 512) / NC, k_c1 = (tid + 512) % NC;
    const bool k_two = (DQK == 96) && (tid < 256);
    const int v_row = tid >> 3, v_c = tid & 7;
    u32x4 rkA0, rkA1, rvA, rkB0, rkB1, rvB;
    rkA1 = (u32x4){0u, 0u, 0u, 0u}; rkB1 = rkA1;
#define A_LOAD(kt, R0, R1, RV) do { R0 = *(const u32x4*)(Kp + (size_t)((kt) * 64 + k_row0) * DQK + k_c0 * 8); \
                        if (k_two) R1 = *(const u32x4*)(Kp + (size_t)((kt) * 64 + k_row1) * DQK + k_c1 * 8); \
                        RV = *(const u32x4*)(VTp + (size_t)v_row * L_ + (kt) * 64 + v_c * 8); } while (0)
#define A_STORE(buf, R0, R1, RV) do { *(u32x4*)(lds + (buf) * KVB + kswz<DQK>(k_row0, k_c0)) = R0; \
                          if (k_two) *(u32x4*)(lds + (buf) * KVB + kswz<DQK>(k_row1, k_c1)) = R1; \
                          *(u32x4*)(lds + (buf) * KVB + KB + swz128(v_row, v_c)) = RV; } while (0)
    A_LOAD(0, rkA0, rkA1, rvA);
    A_LOAD(1, rkB0, rkB1, rvB);
    A_STORE(0, rkA0, rkA1, rvA);
    __syncthreads();
    constexpr int NKT = L_ / 64;
#pragma unroll 1
    for (int kt2 = 0; kt2 < NKT; kt2 += 2) {
#pragma unroll
      for (int cur = 0; cur < 2; ++cur) {
        const int kt = kt2 + cur;
        if (kt + 2 < NKT) { if (cur == 0) A_LOAD(kt + 2, rkA0, rkA1, rvA); else A_LOAD(kt + 2, rkB0, rkB1, rvB); }
        const unsigned char* lk = lds + cur * KVB;
        const unsigned char* lv = lk + KB;
        f32x16 s0, s1;
        const float negm = -m;
#pragma unroll
        for (int i = 0; i < 16; ++i) { s0[i] = negm; s1[i] = negm; }
#pragma unroll
        for (int s = 0; s < NS; ++s) {
            const bf16x8 k0 = *(const bf16x8*)(lk + kswz<DQK>(r, 2 * s + h));
            const bf16x8 k1 = *(const bf16x8*)(lk + kswz<DQK>(32 + r, 2 * s + h));
            s0 = __builtin_amdgcn_mfma_f32_32x32x16_bf16(k0, qf[s], s0, 0, 0, 0);
            s1 = __builtin_amdgcn_mfma_f32_32x32x16_bf16(k1, qf[s], s1, 0, 0, 0);
        }
        float mx = fmaxf(fmaxf(s0[0], s0[1]), s0[2]);
#pragma unroll
        for (int i = 3; i < 15; i += 2) mx = fmaxf(fmaxf(mx, s0[i]), s0[i + 1]);
        mx = fmaxf(mx, s0[15]);
#pragma unroll
        for (int i = 0; i < 16; i += 2) mx = fmaxf(fmaxf(mx, s1[i]), s1[i + 1]);
        mx = fmaxf(mx, __shfl_xor(mx, 32));
        if (kt == 0 || __any(mx > 8.0f)) {
            const float dm = (kt == 0) ? mx : fmaxf(mx, 0.f);
            const float alpha = (kt == 0) ? 0.f : __builtin_amdgcn_exp2f(-dm);
            m += dm;
            lsum *= alpha;
#pragma unroll
            for (int i = 0; i < 16; ++i) { o0[i] *= alpha; o1[i] *= alpha; s0[i] -= dm; s1[i] -= dm; }
        }
        float ps = 0.f;
#pragma unroll
        for (int i = 0; i < 16; ++i) { s0[i] = __builtin_amdgcn_exp2f(s0[i]); ps += s0[i]; }
#pragma unroll
        for (int i = 0; i < 16; ++i) { s1[i] = __builtin_amdgcn_exp2f(s1[i]); ps += s1[i]; }
        lsum += ps;
#pragma unroll
        for (int sub = 0; sub < 2; ++sub)
#pragma unroll
            for (int s2 = 0; s2 < 2; ++s2) {
                u32x4 pw;
                if (sub == 0) { pw.x = pack2(s0[8 * s2 + 0], s0[8 * s2 + 1]); pw.y = pack2(s0[8 * s2 + 2], s0[8 * s2 + 3]); pw.z = pack2(s0[8 * s2 + 4], s0[8 * s2 + 5]); pw.w = pack2(s0[8 * s2 + 6], s0[8 * s2 + 7]); }
                else          { pw.x = pack2(s1[8 * s2 + 0], s1[8 * s2 + 1]); pw.y = pack2(s1[8 * s2 + 2], s1[8 * s2 + 3]); pw.z = pack2(s1[8 * s2 + 4], s1[8 * s2 + 5]); pw.w = pack2(s1[8 * s2 + 6], s1[8 * s2 + 7]); }
                const bf16x8 pf = __builtin_bit_cast(bf16x8, pw);
                const bf16x8 vf0 = *(const bf16x8*)(lv + swz128(r, 4 * sub + 2 * s2 + h));
                const bf16x8 vf1 = *(const bf16x8*)(lv + swz128(32 + r, 4 * sub + 2 * s2 + h));
                o0 = __builtin_amdgcn_mfma_f32_32x32x16_bf16(vf0, pf, o0, 0, 0, 0);
                o1 = __builtin_amdgcn_mfma_f32_32x32x16_bf16(vf1, pf, o1, 0, 0, 0);
            }
        if (kt + 1 < NKT) { if (cur == 0) A_STORE(1, rkB0, rkB1, rvB); else A_STORE(0, rkA0, rkA1, rvA); }
        __syncthreads();
      }
    }
#undef A_LOAD
#undef A_STORE
    const float lt = lsum + __shfl_xor(lsum, 32);
    const float inv = 1.0f / lt;
    bf16_t* yr = Yp + (size_t)(32 * w + r) * 768;
#pragma unroll
    for (int g = 0; g < 4; ++g) {
        u32x2 wv; wv.x = pack2(o0[4 * g] * inv, o0[4 * g + 1] * inv); wv.y = pack2(o0[4 * g + 2] * inv, o0[4 * g + 3] * inv);
        *(u32x2*)(yr + 8 * g + 4 * h) = wv;
        wv.x = pack2(o1[4 * g] * inv, o1[4 * g + 1] * inv); wv.y = pack2(o1[4 * g + 2] * inv, o1[4 * g + 3] * inv);
        *(u32x2*)(yr + 32 + 8 * g + 4 * h) = wv;
    }
}

DI int pa(int e) { return e + (e >> 4); }
DI float2 cmul(float2 a, float2 b) { return make_float2(a.x * b.x - a.y * b.y, a.x * b.y + a.y * b.x); }
DI float2 cadd(float2 a, float2 b) { return make_float2(a.x + b.x, a.y + b.y); }
DI float2 csub(float2 a, float2 b) { return make_float2(a.x - b.x, a.y - b.y); }
template <bool INV> DI void dft4(float2& a, float2& b, float2& c, float2& d) {
    const float2 t0 = cadd(a, c), t1 = csub(a, c), t2 = cadd(b, d), t3 = csub(b, d);
    const float2 jt3 = INV ? make_float2(-t3.y, t3.x) : make_float2(t3.y, -t3.x);
    a = cadd(t0, t2); c = csub(t0, t2); b = cadd(t1, jt3); d = csub(t1, jt3);
}
template <bool INV> DI float2 tw16(float2 v, int k) {
    const float c1 = 0.9238795325112867f, s1 = 0.3826834323650898f, c2 = 0.7071067811865476f;
    float wr = 1.f, wi = 0.f;
    switch (k) {
        case 0: wr = 1.f; wi = 0.f; break;
        case 1: wr = c1; wi = -s1; break;
        case 2: wr = c2; wi = -c2; break;
        case 3: wr = s1; wi = -c1; break;
        case 4: wr = 0.f; wi = -1.f; break;
        case 6: wr = -c2; wi = -c2; break;
        case 9: wr = -c1; wi = s1; break;
        default: break;
    }
    if (INV) wi = -wi;
    return make_float2(v.x * wr - v.y * wi, v.x * wi + v.y * wr);
}
template <bool INV> DI void dft16(float2 (&x)[16]) {
#pragma unroll
    for (int b = 0; b < 4; ++b) dft4<INV>(x[b], x[b + 4], x[b + 8], x[b + 12]);
#pragma unroll
    for (int b = 1; b < 4; ++b)
#pragma unroll
        for (int pq = 1; pq < 4; ++pq) x[b + 4 * pq] = tw16<INV>(x[b + 4 * pq], b * pq);
#pragma unroll
    for (int pq = 0; pq < 4; ++pq) dft4<INV>(x[4 * pq], x[4 * pq + 1], x[4 * pq + 2], x[4 * pq + 3]);
#pragma unroll
    for (int a = 0; a < 4; ++a)
#pragma unroll
        for (int b = a + 1; b < 4; ++b) { const float2 tmp = x[4 * a + b]; x[4 * a + b] = x[4 * b + a]; x[4 * b + a] = tmp; }
}
template <bool INV> DI void pass_a(float2* Z, const float2* T1, int tid) {
#pragma unroll
    for (int i = 0; i < 8; ++i) {
        const int j = tid + 512 * i;
        float2 x0 = Z[pa(j)], x1 = Z[pa(j + 4096)], x2 = Z[pa(j + 8192)], x3 = Z[pa(j + 12288)];
        float2 w1 = tw16<false>(T1[j & 1023], i >> 1);
        if (INV) w1.y = -w1.y;
        const float2 w2 = cmul(w1, w1), w3 = cmul(w2, w1);
        if (!INV) { dft4<false>(x0, x1, x2, x3); x1 = cmul(x1, w1); x2 = cmul(x2, w2); x3 = cmul(x3, w3); }
        else { x1 = cmul(x1, w1); x2 = cmul(x2, w2); x3 = cmul(x3, w3); dft4<true>(x0, x1, x2, x3); }
        Z[pa(j)] = x0; Z[pa(j + 4096)] = x1; Z[pa(j + 8192)] = x2; Z[pa(j + 12288)] = x3;
    }
}
template <bool INV, int LS, int TS> DI void pass16(float2* Z, const float2* T1, int tid) {
#pragma unroll 1
    for (int i = 0; i < 2; ++i) {
        const int id = tid + 512 * i, j = id & ((1 << LS) - 1), base = (id >> LS) << (LS + 4);
        float2 x[16];
#pragma unroll
        for (int mm = 0; mm < 16; ++mm) x[mm] = Z[pa(base + j + (mm << LS))];
        float2 w1 = T1[j << TS];
        if (INV) w1.y = -w1.y;
        if (!INV) dft16<false>(x);
        float2 wq = w1;
#pragma unroll
        for (int qq = 1; qq < 16; ++qq) { x[qq] = cmul(x[qq], wq); wq = cmul(wq, w1); }
        if (INV) dft16<true>(x);
#pragma unroll
        for (int mm = 0; mm < 16; ++mm) Z[pa(base + j + (mm << LS))] = x[mm];
    }
}
DI void pass_d_store(const float2* Z, float2* __restrict__ Kf, int tid, float scale) {
#pragma unroll 1
    for (int i = 0; i < 2; ++i) {
        const int id = tid + 512 * i, base = id * 16;
        float2 x[16];
#pragma unroll
        for (int mm = 0; mm < 16; ++mm) x[mm] = Z[pa(base + mm)];
        dft16<false>(x);
#pragma unroll
        for (int mm = 0; mm < 16; mm += 2) *(f32x4*)(Kf + base + mm) = (f32x4){x[mm].x * scale, x[mm].y * scale, x[mm + 1].x * scale, x[mm + 1].y * scale};
    }
}
DI void pass_d_lds(float2* Z, int tid) {
#pragma unroll 1
    for (int i = 0; i < 2; ++i) {
        const int id = tid + 512 * i, base = id * 16;
        float2 x[16];
#pragma unroll
        for (int mm = 0; mm < 16; ++mm) x[mm] = Z[pa(base + mm)];
        dft16<false>(x);
#pragma unroll
        for (int mm = 0; mm < 16; ++mm) Z[pa(base + mm)] = x[mm];
    }
}
DI void pass_d_mul(float2* Z, const float2* __restrict__ Kf, int tid) {
#pragma unroll 1
    for (int i = 0; i < 2; ++i) {
        const int id = tid + 512 * i, base = id * 16;
        float2 x[16];
#pragma unroll
        for (int mm = 0; mm < 16; ++mm) x[mm] = Z[pa(base + mm)];
        dft16<false>(x);
#pragma unroll
        for (int mm = 0; mm < 16; mm += 2) {
            const f32x4 kk = *(const f32x4*)(Kf + base + mm);
            x[mm] = cmul(x[mm], make_float2(kk[0], kk[1])); x[mm + 1] = cmul(x[mm + 1], make_float2(kk[2], kk[3]));
        }
        dft16<true>(x);
#pragma unroll
        for (int mm = 0; mm < 16; ++mm) Z[pa(base + mm)] = x[mm];
    }
}
DI void fft_conv(float2* Z, const float2* T1, const float2* Kf, int tid) {
    pass_a<false>(Z, T1, tid); __syncthreads();
    pass16<false, 8, 2>(Z, T1, tid); __syncthreads();
    pass16<false, 4, 6>(Z, T1, tid); __syncthreads();
    pass_d_mul(Z, Kf, tid); __syncthreads();
    pass16<true, 4, 6>(Z, T1, tid); __syncthreads();
    pass16<true, 8, 2>(Z, T1, tid); __syncthreads();
    pass_a<true>(Z, T1, tid); __syncthreads();
}

DI void hyena_unit(unsigned char* lds, const Params& p, int l, int c) {
    float2* Z = (float2*)lds;
    float2* T1 = (float2*)(lds + 139264);
    const int tid = tid_fresh();
    const float* hyT = (const float*)(p.ws + O_HYT);
    float2* Kf0 = (float2*)(p.ws + O_R1) + (size_t)c * 32768;
    float2* Kf1 = Kf0 + 16384;
    bf16_t* hyout = (bf16_t*)(p.ws + O_HYOUT) + (size_t)c * T_;
    for (int k = tid; k < 1024; k += NTHR) { float sn, cs; sincospif((float)k * (1.0f / 8192.0f), &sn, &cs); T1[k] = make_float2(cs, -sn); }
    __syncthreads();
    {
        const float* taps = (const float*)Kf1;
#pragma unroll 4
        for (int t = tid; t < L_; t += NTHR) { Z[pa(t)] = make_float2(taps[t], taps[2 * L_ + t]); Z[pa(16383 - t)] = make_float2(taps[L_ + t], taps[3 * L_ + t]); }
        __syncthreads();
        pass_a<false>(Z, T1, tid); __syncthreads();
        pass16<false, 8, 2>(Z, T1, tid); __syncthreads();
        pass16<false, 4, 6>(Z, T1, tid); __syncthreads();
        pass_d_lds(Z, tid); __syncthreads();
        const float sc = 0.5f / 16384.0f;
#pragma unroll 2
        for (int e = tid; e < 16384; e += NTHR) {
            const int a = e >> 12, b = (e >> 8) & 15, c4 = (e >> 4) & 15, d = e & 15;
            const int k = a + 4 * (b + 16 * (c4 + 16 * d));
            const int k2 = (16384 - k) & 16383;
            const int e2 = ((k2 & 3) << 12) | (((k2 >> 2) & 15) << 8) | (((k2 >> 6) & 15) << 4) | (k2 >> 10);
            const float2 z = Z[pa(e)], z2 = Z[pa(e2)];
            const float sx = z.x + z2.x, sy = z.y - z2.y, dx = z.x - z2.x, dy = z.y + z2.y;
            Kf0[e] = make_float2(sx * sc, sy * sc);
            Kf1[e] = make_float2(dy * sc, -dx * sc);
        }
        __syncthreads();
    }
    const float* cw = p.in[3] + (size_t)l * 3 * 768; const float* cb = p.in[4] + (size_t)l * 768;
    const float* skip = p.in[12] + (size_t)l * 2 * 256;
    float2* z1buf = Kf0;
    const float vw0 = cw[c], vw1 = cw[768 + c], vw2 = cw[1536 + c], vbb = cb[c];
    const float* uv = hyT + (size_t)c * T_;
#pragma unroll 2
    for (int t = tid; t < L_; t += NTHR) {
        float vv[2];
#pragma unroll
        for (int b = 0; b < 2; ++b) {
            const float* ub = uv + b * L_;
            const float um = (t > 0) ? ub[t - 1] : 0.f, uc = ub[t], up = (t < L_ - 1) ? ub[t + 1] : 0.f;
            vv[b] = vw0 * um + vw1 * uc + vw2 * up + vbb;
        }
        Z[pa(t)] = make_float2(vv[0], vv[1]); Z[pa(t + L_)] = make_float2(0.f, 0.f);
    }
    __syncthreads();
    __threadfence();
    fft_conv(Z, T1, Kf0, tid);
    {
        const int ch = 256 + c;
        const float w0 = cw[ch], w1 = cw[768 + ch], w2 = cw[1536 + ch], bb = cb[ch], sk = skip[c];
        const float* u0 = hyT + (size_t)ch * T_;
#pragma unroll 2
        for (int t = tid; t < L_; t += NTHR) {
            const float2 y = Z[pa(t)];
            float zz[2];
#pragma unroll
            for (int b = 0; b < 2; ++b) {
                const float* ub = u0 + b * L_;
                const float um = (t > 0) ? ub[t - 1] : 0.f, uc = ub[t], up = (t < L_ - 1) ? ub[t + 1] : 0.f;
                const float g = w0 * um + w1 * uc + w2 * up + bb;
                const float* vb = uv + b * L_;
                const float vm = (t > 0) ? vb[t - 1] : 0.f, vc = vb[t], vp = (t < L_ - 1) ? vb[t + 1] : 0.f;
                const float v = vw0 * vm + vw1 * vc + vw2 * vp + vbb;
                zz[b] = g * ((b ? y.y : y.x) + sk * v);
            }
            const float2 z1 = make_float2(zz[0], zz[1]);
            Z[pa(t)] = z1; Z[pa(t + L_)] = make_float2(0.f, 0.f);
            z1buf[t] = z1;
        }
    }
    __syncthreads();
    fft_conv(Z, T1, Kf1, tid);
    {
        const int ch = 512 + c;
        const float w0 = cw[ch], w1 = cw[768 + ch], w2 = cw[1536 + ch], bb = cb[ch], sk = skip[256 + c];
        const float* u0 = hyT + (size_t)ch * T_;
#pragma unroll 2
        for (int t = tid; t < L_; t += NTHR) {
            const float2 y = Z[pa(t)];
            const float2 z1 = z1buf[t];
#pragma unroll
            for (int b = 0; b < 2; ++b) {
                const float* ub = u0 + b * L_;
                const float um = (t > 0) ? ub[t - 1] : 0.f, uc = ub[t], up = (t < L_ - 1) ? ub[t + 1] : 0.f;
                const float g = w0 * um + w1 * uc + w2 * up + bb;
                hyout[b * L_ + t] = f2bf(g * ((b ? y.y : y.x) + sk * (b ? z1.y : z1.x)));
            }
        }
    }
    __syncthreads();
}

DI void groups_phase(unsigned char* lds, const Params& p) {
    bf16_t* tile = (bf16_t*)lds;
    const int tid = tid_fresh(), lane = tid & 63, wid = tid >> 6;
    const bf16_t* hyout = (const bf16_t*)(p.ws + O_HYOUT);
    const bf16_t* Y = (const bf16_t*)(p.ws + O_PROJB);
    bf16_t* G = (bf16_t*)(p.ws + O_HYT);
    for (int u = blockIdx.x; u < T_ / 64; u += gridDim.x) {
        const int tok0 = u * 64;
        {
            const int c = tid >> 1, hf = tid & 1;
            const u32x4* src = (const u32x4*)(hyout + (size_t)c * T_ + tok0 + hf * 32);
#pragma unroll
            for (int i = 0; i < 4; ++i) {
                const u32x4 v = src[i];
                unsigned* d = (unsigned*)(tile + c * 66 + hf * 32 + i * 8);
                d[0] = v.x; d[1] = v.y; d[2] = v.z; d[3] = v.w;
            }
        }
        __syncthreads();
#pragma unroll 1
        for (int i = 0; i < 8; ++i) {
            const int tl = wid * 8 + i, tok = tok0 + tl;
            float hv[4]; float sh = 0.f;
#pragma unroll
            for (int k = 0; k < 4; ++k) { hv[k] = bf2f(tile[(lane + 64 * k) * 66 + tl]); sh += hv[k] * hv[k]; }
            sh = wave_sum(sh);
            const float rh = rsqrtf(sh * (1.0f / 256.0f) + 1e-6f);
            bf16_t* gr = G + (size_t)tok * 1024;
#pragma unroll
            for (int k = 0; k < 4; ++k) gr[lane + 64 * k] = f2bf(hv[k] * rh);
            const bf16_t* yr = Y + (size_t)tok * 768;
            {
                const u32x4 v = *(const u32x4*)(yr + lane * 8);
                float a[8] = {bf2f((bf16_t)(v.x & 0xffff)), bf2f((bf16_t)(v.x >> 16)), bf2f((bf16_t)(v.y & 0xffff)), bf2f((bf16_t)(v.y >> 16)),
                              bf2f((bf16_t)(v.z & 0xffff)), bf2f((bf16_t)(v.z >> 16)), bf2f((bf16_t)(v.w & 0xffff)), bf2f((bf16_t)(v.w >> 16))};
                float ss = 0.f;
#pragma unroll
                for (int k = 0; k < 8; ++k) ss += a[k] * a[k];
                ss = wave_sum(ss);
                const float rr = rsqrtf(ss * (1.0f / 512.0f) + 1e-6f);
                u32x4 w; w.x = pack2(a[0] * rr, a[1] * rr); w.y = pack2(a[2] * rr, a[3] * rr); w.z = pack2(a[4] * rr, a[5] * rr); w.w = pack2(a[6] * rr, a[7] * rr);
                *(u32x4*)(gr + 256 + lane * 8) = w;
            }
            {
                const u32x2 v = *(const u32x2*)(yr + 512 + lane * 4);
                float a[4] = {bf2f((bf16_t)(v.x & 0xffff)), bf2f((bf16_t)(v.x >> 16)), bf2f((bf16_t)(v.y & 0xffff)), bf2f((bf16_t)(v.y >> 16))};
                float ss = wave_sum(a[0] * a[0] + a[1] * a[1] + a[2] * a[2] + a[3] * a[3]);
                const float rr = rsqrtf(ss * (1.0f / 256.0f) + 1e-6f);
                u32x2 w; w.x = pack2(a[0] * rr, a[1] * rr); w.y = pack2(a[2] * rr, a[3] * rr);
                *(u32x2*)(gr + 768 + lane * 4) = w;
            }
        }
        __syncthreads();
    }
}


extern __shared__ __attribute__((aligned(16))) unsigned char smem[];

__global__ void __launch_bounds__(512) fwd_megakernel(Params p) {
    cg::grid_group grid = cg::this_grid();
    unsigned char* lds = smem;
    unsigned char* ws = p.ws;
    unsigned* bar = (unsigned*)(ws + O_BAR);
    volatile LAS unsigned* xb_st = (volatile LAS unsigned*)(smem + LDS_BYTES - 16);
    if (threadIdx.x < 4) xb_st[threadIdx.x] = 0u;
    __syncthreads();
    const XcdBarrier xb = xcd_barrier_post(bar, xb_st);
    if (p.ws == nullptr) grid.sync();
#pragma unroll 1
    for (int l2 = 0; l2 < 2 * REP_PRO; ++l2) { const int l = l2 & 1;
        convT(lds, p.in[2] + (size_t)l * 1024 * 1952, 1024, 1952, 2048, p.in[1] + l * 1024, (bf16_t*)(ws + O_WIN) + (size_t)l * 2048 * 1024, 0);
        convT(lds, p.in[16] + (size_t)l * 256 * 384, 256, 384, 512, p.in[15] + l * 256, (bf16_t*)(ws + O_WUQ) + (size_t)l * 512 * 256, 0);
        convT(lds, p.in[18] + (size_t)l * 128 * 512, 128, 512, 512, p.in[17] + l * 128, (bf16_t*)(ws + O_WUKV) + (size_t)l * 512 * 128, 0);
        convT(lds, p.in[25] + (size_t)l * 1024 * 5632, 1024, 5632, 5632, p.in[24] + l * 1024, (bf16_t*)(ws + O_WUP) + (size_t)l * 5632 * 1024, 1);
        convT(lds, p.in[28] + (size_t)l * 2816 * 1024, 2816, 1024, 1024, nullptr, (bf16_t*)(ws + O_WDOWN) + (size_t)l * 1024 * 2816, 0);
    }
    {
        float* tile = (float*)lds;
        const int tid = tid_fresh();
        for (int u = blockIdx.x; u < 2 * 16 * 16; u += gridDim.x) {
            const int l = u >> 8, kt = (u & 255) & 15, ntile = (u & 255) >> 4;
            const int k0 = kt * 64, n0 = ntile * 64;
            const float* W = p.in[22] + (size_t)l * 1024 * 1024;
            bf16_t* dst = (bf16_t*)(ws + O_WOUT) + (size_t)l * 1024 * 1024;
#pragma unroll
            for (int i = 0; i < 8; ++i) {
                const int kk = (tid >> 6) + 8 * i, nn = tid & 63, k = k0 + kk;
                const float g = (k < 256) ? p.in[19][l * 256 + k] : (k < 768) ? p.in[20][l * 512 + k - 256] : p.in[21][l * 256 + k - 768];
                tile[kk * 65 + nn] = W[(size_t)k * 1024 + n0 + nn] * g;
            }
            __syncthreads();
            {
                const int nn = tid >> 3, kb = (tid & 7) * 8;
                u32x4 w;
                w.x = pack2(tile[(kb + 0) * 65 + nn], tile[(kb + 1) * 65 + nn]);
                w.y = pack2(tile[(kb + 2) * 65 + nn], tile[(kb + 3) * 65 + nn]);
                w.z = pack2(tile[(kb + 4) * 65 + nn], tile[(kb + 5) * 65 + nn]);
                w.w = pack2(tile[(kb + 6) * 65 + nn], tile[(kb + 7) * 65 + nn]);
                *(u32x4*)(dst + (size_t)(n0 + nn) * 1024 + k0 + kb) = w;
            }
            __syncthreads();
        }
    }
#ifndef REP_MISC
#define REP_MISC 1
#endif
#pragma unroll 1
    for (int rep = 0; rep < REP_MISC; ++rep) { hy_h2_phase(lds, p);
    rownorm_phase(p.in[0], (bf16_t*)(ws + O_XN)); }
    XSYNC();


#pragma unroll 1
    for (int l = 0; l < 2; ++l) {
        {
            EpiIn e; e.hyT = (float*)(ws + O_HYT); e.projb = (bf16_t*)(ws + O_PROJB);
            gemm_phase<false>(lds, (const bf16_t*)(ws + O_XN), 1024, (const bf16_t*)(ws + O_WIN) + (size_t)l * 2048 * 1024, 1024, 64, 8, e);
        }
        XSYNC();
#pragma unroll 1
        for (int rep = 0; rep < REP_EW; ++rep) prep_phase(p, l);
#pragma unroll 1
        for (int rep = 0; rep < REP_MISC; ++rep) ft_phase(lds, p, l);
        XSYNC();
        {
            EpiUq e; e.Qm = (bf16_t*)(ws + O_QM); e.rq = (const float*)(ws + O_RQ); e.sc = 0.10206207261596577f * 1.4426950408889634f;
            gemm_phase<false>(lds, (const bf16_t*)(ws + O_PROJB) + 768, 1184, (const bf16_t*)(ws + O_WUQ) + (size_t)l * 512 * 256, 256, 64, 2, e);
            EpiUkv e2; e2.Km = (bf16_t*)(ws + O_KM); e2.VmT = (bf16_t*)(ws + O_VMT); e2.rkv = (const float*)(ws + O_RKV);
            gemm_phase<false>(lds, (const bf16_t*)(ws + O_PROJB) + 1024, 1184, (const bf16_t*)(ws + O_WUKV) + (size_t)l * 512 * 128, 128, 64, 2, e2);
        }
        XSYNC();
#pragma unroll 1
        for (int rep = 0; rep < REP_HY; ++rep)
        for (int c = blockIdx.x; c < 256; c += gridDim.x) hyena_unit(lds, p, l, c);
#pragma unroll 1
        for (int rep = 0; rep < REP_ATTN; ++rep)
        for (int u = blockIdx.x; u < 512; u += gridDim.x) {
            const int qt = u & 31, hh = (u >> 5) & 7, b = u >> 8, hk = hh >> 2;
            attn_unit<64>(lds, (const bf16_t*)(ws + O_QG) + ((size_t)(b * 8 + hh) * L_ + qt * 256) * 64,
                          (const bf16_t*)(ws + O_KG) + (size_t)(b * 2 + hk) * L_ * 64,
                          (const bf16_t*)(ws + O_VGT) + (size_t)(b * 2 + hk) * 64 * L_,
                          (bf16_t*)(ws + O_PROJB) + (size_t)(b * L_ + qt * 256) * 768 + hh * 64);
        }
#pragma unroll 1
        for (int rep = 0; rep < REP_ATTN; ++rep)
        for (int u = blockIdx.x; u < 256; u += gridDim.x) {
            const int qt = u & 31, hh = (u >> 5) & 3, b = u >> 7;
            attn_unit<96>(lds, (const bf16_t*)(ws + O_QM) + ((size_t)(b * 4 + hh) * L_ + qt * 256) * 96,
                          (const bf16_t*)(ws + O_KM) + (size_t)(b * 4 + hh) * L_ * 96,
                          (const bf16_t*)(ws + O_VMT) + (size_t)(b * 4 + hh) * 64 * L_,
                          (bf16_t*)(ws + O_PROJB) + (size_t)(b * L_ + qt * 256) * 768 + 512 + hh * 64);
        }
        XSYNC();
#pragma unroll 1
        for (int rep = 0; rep < REP_EW; ++rep) groups_phase(lds, p);
        XSYNC();
        if (gridDim.x == 256) {
            EpiResid e; e.xold = (l == 0) ? p.in[0] : p.out; e.xout = p.out; e.xn = (bf16_t*)(ws + O_XN); e.g = p.in[23] + l * 1024; e.slots = (float*)(ws + O_SLOTS); e.xb = xb; e.want_xn = true;
            gemm_phase<false>(lds, (const bf16_t*)(ws + O_HYT), 1024, (const bf16_t*)(ws + O_WOUT) + (size_t)l * 1024 * 1024, 1024, 64, 4, e);
            XSYNC();
        } else {
            EpiF32 e; e.C = (float*)(ws + O_R1); e.ldc = 1024;
            gemm_phase<false>(lds, (const bf16_t*)(ws + O_HYT), 1024, (const bf16_t*)(ws + O_WOUT) + (size_t)l * 1024 * 1024, 1024, 64, 4, e);
            XSYNC();
            resid_phase((const float*)(ws + O_R1), l == 0 ? p.in[0] : p.out, p.in[23] + l * 1024, p.out, (bf16_t*)(ws + O_XN), true);
            XSYNC();
        }
        {
            EpiUp e; e.act = (bf16_t*)(ws + O_HYT); e.cw = p.in[26] + (size_t)l * 3 * 5632; e.cb = p.in[27] + (size_t)l * 5632;
            gemm_phase<true>(lds, (const bf16_t*)(ws + O_XN), 1024, (const bf16_t*)(ws + O_WUP) + (size_t)l * 5632 * 1024, 1024, 66, 22, e);
        }
        XSYNC();
        if (gridDim.x == 256) {
            EpiResid e; e.xold = p.out; e.xout = p.out; e.xn = (bf16_t*)(ws + O_XN); e.g = p.in[29] + l * 1024; e.slots = (float*)(ws + O_SLOTS); e.xb = xb; e.want_xn = (l == 0);
            gemm_phase<false>(lds, (const bf16_t*)(ws + O_HYT), 2816, (const bf16_t*)(ws + O_WDOWN) + (size_t)l * 1024 * 2816, 2816, 64, 4, e);
            if (l == 0) XSYNC();
        } else {
            EpiF32 e; e.C = (float*)(ws + O_R1); e.ldc = 1024;
            gemm_phase<false>(lds, (const bf16_t*)(ws + O_HYT), 2816, (const bf16_t*)(ws + O_WDOWN) + (size_t)l * 1024 * 2816, 2816, 64, 4, e);
            XSYNC();
            resid_phase((const float*)(ws + O_R1), p.out, p.in[29] + l * 1024, p.out, (bf16_t*)(ws + O_XN), l == 0);
            if (l == 0) XSYNC();
        }
    }
}

extern "C" void kernel_launch(void* const* d_in, const int* in_sizes, int n_in,
                              void* d_out, int out_size, void* d_ws, size_t ws_size,
                              hipStream_t stream) {
    static int grid_blocks = 0;
    if (!grid_blocks) {
        int dev = 0, cus = 0, per_cu = 0;
        (void)hipGetDevice(&dev);
        (void)hipDeviceGetAttribute(&cus, hipDeviceAttributeMultiprocessorCount, dev);
        (void)hipFuncSetAttribute((const void*)fwd_megakernel, hipFuncAttributeMaxDynamicSharedMemorySize, (int)LDS_BYTES);
        (void)hipOccupancyMaxActiveBlocksPerMultiprocessor(&per_cu, fwd_megakernel, NTHR, LDS_BYTES);
        if (per_cu < 1) per_cu = 1;
        grid_blocks = cus;
        if (grid_blocks > 256) grid_blocks = 256;
    }
    Params p{};
    for (int i = 0; i < 30; ++i) p.in[i] = (const float*)d_in[i];
    p.out = (float*)d_out; p.ws = (unsigned char*)d_ws;
    void* args[] = {&p};
    (void)hipMemsetAsync((unsigned char*)d_ws + O_BAR, 0, XCD_BAR_WORDS * sizeof(unsigned), stream);
    hipError_t e = hipLaunchCooperativeKernel((void*)fwd_megakernel, dim3(grid_blocks), dim3(NTHR), args, LDS_BYTES, stream);
    if (e != hipSuccess) fprintf(stderr, "cooperative launch failed: %s (grid %d)\n", hipGetErrorString(e), grid_blocks);
}
```

```cpp
#include <hip/hip_runtime.h>
#include <hip/hip_cooperative_groups.h>
#include <cstdio>
#include <cstdint>
namespace cg = cooperative_groups;

typedef unsigned short bf16_t;
typedef short bf16x8 __attribute__((ext_vector_type(8)));
typedef float f32x4 __attribute__((ext_vector_type(4)));
typedef float f32x16 __attribute__((ext_vector_type(16)));
typedef unsigned u32x2 __attribute__((ext_vector_type(2)));
typedef unsigned u32x4 __attribute__((ext_vector_type(4)));

#define DI __device__ __forceinline__
#ifndef REP_ATTN
#define REP_ATTN 1
#endif
#ifndef REP_HY
#define REP_HY 1
#endif
#ifndef REP_GEMM
#define REP_GEMM 1
#endif
#ifndef REP_PRO
#define REP_PRO 1
#endif
#ifndef REP_SYNC
#define REP_SYNC 1
#endif
#define XSYNC() do { _Pragma("unroll 1") for (int r_ = 0; r_ < REP_SYNC; ++r_) xcd_barrier(xb); } while (0)
#ifndef REP_EW
#define REP_EW 1
#endif
constexpr int L_ = 8192, T_ = 16384, NTHR = 512;
constexpr size_t MiB = 1u << 20;
constexpr size_t O_WIN = 0, O_WUQ = 8 * MiB, O_WUKV = 8 * MiB + 512 * 1024, O_RQ = 8 * MiB + 768 * 1024, O_RKV = 8 * MiB + 832 * 1024;
constexpr size_t O_BAR = 8 * MiB + 896 * 1024;
constexpr size_t O_WOUT = 9 * MiB, O_WUP = 13 * MiB, O_WDOWN = 35 * MiB, O_H2 = 46 * MiB;
constexpr size_t O_R1 = 50 * MiB;
constexpr size_t O_HYT = 114 * MiB;
constexpr size_t O_PROJB = 162 * MiB;
constexpr size_t O_HYOUT = 186 * MiB;
constexpr size_t O_QG = 199 * MiB, O_KG = 215 * MiB, O_VGT = 219 * MiB, O_QM = 223 * MiB, O_KM = 235 * MiB, O_VMT = 247 * MiB;
constexpr size_t O_XN = 223 * MiB;
constexpr size_t O_SLOTS = 255 * MiB;
constexpr size_t LDS_BYTES = 150 * 1024;

struct Params { const float* in[30]; float* out; unsigned char* ws; };

typedef __bf16 bf16v2_t __attribute__((ext_vector_type(2)));
typedef float f32v2_t __attribute__((ext_vector_type(2)));
DI bf16_t f2bf(float x) { const __bf16 b = (__bf16)x; return __builtin_bit_cast(bf16_t, b); }
DI float bf2f(bf16_t v) { return __uint_as_float(((unsigned)v) << 16); }
DI unsigned pack2(float lo, float hi) { const f32v2_t v = {lo, hi}; const bf16v2_t b = __builtin_convertvector(v, bf16v2_t); return __builtin_bit_cast(unsigned, b); }
DI float wave_sum(float v) {
#pragma unroll
    for (int o = 32; o >= 1; o >>= 1) v += __shfl_xor(v, o);
    return v;
}
DI int tid_fresh() { int t = threadIdx.x; asm volatile("" : "+v"(t)); return t; }
DI void fast_sincos(float ang, float* s, float* c) {
    float rev = ang * 0.15915494309189535f; rev -= rintf(rev);
    *s = __builtin_amdgcn_sinf(rev); *c = __builtin_amdgcn_cosf(rev);
}
DI int perm16(int t) { return (t & ~15) | (t & 3) | (((t >> 3) & 1) << 2) | (((t >> 2) & 1) << 3); }

DI void convT(unsigned char* lds, const float* __restrict__ W, int K, int N, int Npad, const float* __restrict__ gain, bf16_t* __restrict__ dst, int mode) {
    float* tile = (float*)lds;
    const int tid = tid_fresh();
    const int nkt = K >> 6, nnt = Npad >> 8;
    for (int u = blockIdx.x; u < nkt * nnt; u += gridDim.x) {
        const int kt = u % nkt, ntile = u / nkt;
        const int k0 = kt * 64, n0 = ntile * 256;
        const int cl = 4 * (tid & 63);
        int src = n0 + cl;
        if (mode == 1) { const int nq = n0 + (cl & ~63), jt = nq >> 7, half = (nq >> 6) & 1; src = (half ? 2816 + 64 * jt : 64 * jt) + (cl & 63); }
        const bool valid = src < N;
        f32x4 v[8];
#pragma unroll
        for (int i = 0; i < 8; ++i) {
            const int kk = (tid >> 6) + 8 * i;
            v[i] = valid ? *(const f32x4*)(W + (size_t)(k0 + kk) * N + src) : (f32x4){0.f, 0.f, 0.f, 0.f};
        }
#pragma unroll
        for (int i = 0; i < 8; ++i) {
            const int kk = (tid >> 6) + 8 * i;
            const float g = gain ? gain[k0 + kk] : 1.0f;
            *(f32x4*)(tile + kk * 260 + cl) = v[i] * g;
        }
        __syncthreads();
        {
            const int nn = tid >> 1, kh = (tid & 1) * 32;
#pragma unroll
            for (int c = 0; c < 4; ++c) {
                const int kb = kh + 8 * c;
                u32x4 w;
                w.x = pack2(tile[(kb + 0) * 260 + nn], tile[(kb + 1) * 260 + nn]);
                w.y = pack2(tile[(kb + 2) * 260 + nn], tile[(kb + 3) * 260 + nn]);
                w.z = pack2(tile[(kb + 4) * 260 + nn], tile[(kb + 5) * 260 + nn]);
                w.w = pack2(tile[(kb + 6) * 260 + nn], tile[(kb + 7) * 260 + nn]);
                *(u32x4*)(dst + (size_t)(n0 + nn) * K + k0 + kb) = w;
            }
        }
        __syncthreads();
    }
}

DI void hy_h2_phase(unsigned char* lds, const Params& p) {
    float* zs = (float*)lds;
    float* h1s = zs + 8 * 36;
    const int tid = tid_fresh(), rr = tid >> 6, j = tid & 63;
    float* h2 = (float*)(p.ws + O_H2);
    for (int u = blockIdx.x; u < 2 * (L_ / 8); u += gridDim.x) {
        const int l = u / (L_ / 8), t = (u % (L_ / 8)) * 8 + rr;
        if (j < 16) {
            const float w = 2.0f * 3.14159265358979323846f * (float)t / (float)L_;
            const float f = 1e-4f + (15.0f - 1e-4f) * (float)j / 15.0f;
            const float a = f * w;
            zs[rr * 36 + 1 + j] = cosf(a);
            zs[rr * 36 + 17 + j] = -sinf(a);
            if (j == 0) zs[rr * 36] = (float)t / (float)(L_ - 1);
        }
        __syncthreads();
        {
            const float* w1 = p.in[5] + (size_t)l * 33 * 64;
            float s = p.in[6][l * 64 + j];
#pragma unroll
            for (int e = 0; e < 33; ++e) s += zs[rr * 36 + e] * w1[e * 64 + j];
            h1s[rr * 64 + j] = sinf(p.in[7][l * 64 + j] * s);
        }
        __syncthreads();
        {
            const float* w2 = p.in[8] + (size_t)l * 64 * 64;
            float s = p.in[9][l * 64 + j];
#pragma unroll 8
            for (int e = 0; e < 64; ++e) s += h1s[rr * 64 + e] * w2[e * 64 + j];
            h2[((size_t)l * L_ + t) * 64 + j] = sinf(p.in[10][l * 64 + j] * s);
        }
        __syncthreads();
    }
}


DI void ft_phase(unsigned char* lds, const Params& p, int l) {
    const int tid = tid_fresh(), lane = tid & 63, w = tid >> 6, r16 = lane & 15, q4 = lane >> 4;
    const float* h2 = (const float*)(p.ws + O_H2) + (size_t)l * L_ * 64;
    const float* w3 = p.in[11] + (size_t)l * 64 * 1024;
    const float min_decay = -4.605170185988091f / 1.5f, max_decay = -4.605170185988091f / 0.3f;
    for (int u = blockIdx.x; u < L_ / 32; u += gridDim.x) {
        const int t0 = u * 32;
        bf16x8 hb[2][2];
#pragma unroll
        for (int tt = 0; tt < 2; ++tt)
#pragma unroll
            for (int ks = 0; ks < 2; ++ks) {
                const float* hp = h2 + (size_t)(t0 + 16 * tt + r16) * 64 + 32 * ks + 8 * q4;
                const f32x4 a = *(const f32x4*)hp, b = *(const f32x4*)(hp + 4);
                u32x4 pw; pw.x = pack2(a[0], a[1]); pw.y = pack2(a[2], a[3]); pw.z = pack2(b[0], b[1]); pw.w = pack2(b[2], b[3]);
                hb[tt][ks] = __builtin_bit_cast(bf16x8, pw);
            }
#pragma unroll 1
        for (int nt = 0; nt < 8; ++nt) {
            const int n0 = 128 * w + 16 * nt;
            f32x4 acc0 = {0.f, 0.f, 0.f, 0.f}, acc1 = {0.f, 0.f, 0.f, 0.f};
#pragma unroll
            for (int ks = 0; ks < 2; ++ks) {
                const float* wp = w3 + (size_t)(32 * ks + 8 * q4) * 1024 + n0 + r16;
                u32x4 pw;
                pw.x = pack2(wp[0], wp[1024]); pw.y = pack2(wp[2048], wp[3072]); pw.z = pack2(wp[4096], wp[5120]); pw.w = pack2(wp[6144], wp[7168]);
                const bf16x8 wf = __builtin_bit_cast(bf16x8, pw);
                acc0 = __builtin_amdgcn_mfma_f32_16x16x32_bf16(wf, hb[0][ks], acc0, 0, 0, 0);
                acc1 = __builtin_amdgcn_mfma_f32_16x16x32_bf16(wf, hb[1][ks], acc1, 0, 0, 0);
            }
#pragma unroll
            for (int i = 0; i < 4; ++i) {
                const int col = n0 + 4 * q4 + i, c = col & 255, od = col >> 8;
                const float dlt = fabsf(min_decay + (max_decay - min_decay) * (float)c / 255.0f);
                float* dst = (float*)(p.ws + O_R1 + (size_t)c * 262144 + 131072) + od * L_ + t0 + r16;
                dst[0] = acc0[i] * expf(-((float)(t0 + r16) / (float)(L_ - 1)) * dlt);
                dst[16] = acc1[i] * expf(-((float)(t0 + 16 + r16) / (float)(L_ - 1)) * dlt);
            }
        }
    }
}

DI void rownorm_phase(const float* __restrict__ x, bf16_t* __restrict__ xn) {
    const int tid_ = tid_fresh(); const int lane = tid_ & 63, wid = tid_ >> 6;
    for (int row = blockIdx.x * 8 + wid; row < T_; row += gridDim.x * 8) {
        const float* xr = x + (size_t)row * 1024;
        f32x4 v[4]; float ss = 0.f;
#pragma unroll
        for (int i = 0; i < 4; ++i) { v[i] = *(const f32x4*)(xr + i * 256 + lane * 4); ss += v[i][0] * v[i][0] + v[i][1] * v[i][1] + v[i][2] * v[i][2] + v[i][3] * v[i][3]; }
        ss = wave_sum(ss);
        const float r = rsqrtf(ss * (1.0f / 1024.0f) + 1e-6f);
#pragma unroll
        for (int i = 0; i < 4; ++i) { u32x2 w; w.x = pack2(v[i][0] * r, v[i][1] * r); w.y = pack2(v[i][2] * r, v[i][3] * r); *(u32x2*)(xn + (size_t)row * 1024 + i * 256 + lane * 4) = w; }
    }
}

DI void resid_phase(const float* __restrict__ y, const float* __restrict__ xres, const float* __restrict__ g, float* __restrict__ xout, bf16_t* __restrict__ xn, bool want_xn) {
    const int tid_ = tid_fresh(); const int lane = tid_ & 63, wid = tid_ >> 6;
    for (int row = blockIdx.x * 8 + wid; row < T_; row += gridDim.x * 8) {
        const size_t ro = (size_t)row * 1024;
        f32x4 v[4]; float ss = 0.f;
#pragma unroll
        for (int i = 0; i < 4; ++i) { v[i] = *(const f32x4*)(y + ro + i * 256 + lane * 4); ss += v[i][0] * v[i][0] + v[i][1] * v[i][1] + v[i][2] * v[i][2] + v[i][3] * v[i][3]; }
        ss = wave_sum(ss);
        const float r = rsqrtf(ss * (1.0f / 1024.0f) + 1e-6f);
        float s2 = 0.f;
#pragma unroll
        for (int i = 0; i < 4; ++i) {
            const f32x4 xr = *(const f32x4*)(xres + ro + i * 256 + lane * 4);
            const f32x4 gg = *(const f32x4*)(g + i * 256 + lane * 4);
            v[i] = xr + v[i] * r * gg;
            s2 += v[i][0] * v[i][0] + v[i][1] * v[i][1] + v[i][2] * v[i][2] + v[i][3] * v[i][3];
            *(f32x4*)(xout + ro + i * 256 + lane * 4) = v[i];
        }
        if (want_xn) {
            s2 = wave_sum(s2);
            const float r2 = rsqrtf(s2 * (1.0f / 1024.0f) + 1e-6f);
#pragma unroll
            for (int i = 0; i < 4; ++i) { u32x2 w; w.x = pack2(v[i][0] * r2, v[i][1] * r2); w.y = pack2(v[i][2] * r2, v[i][3] * r2); *(u32x2*)(xn + ro + i * 256 + lane * 4) = w; }
        }
    }
}

#define XB_TMO      128
#define XB_XCNT(j)  (256  + 64 * (j))
#define XB_XSUB(j)  (1280 + 64 * (j))
#define XB_XGEN(j)  (2304 + 64 * (j))
#define XB_TOP      3328
#define XB_TOPGEN   3392
#define XCD_BAR_WORDS 3456
#define XB_SPIN_CAP (1u << 22)
#define LAS __attribute__((address_space(3)))
DI unsigned xb_ld(unsigned* p)              { return __hip_atomic_load(p, __ATOMIC_RELAXED, __HIP_MEMORY_SCOPE_AGENT); }
DI unsigned xb_add(unsigned* p, unsigned v) { return __hip_atomic_fetch_add(p, v, __ATOMIC_RELAXED, __HIP_MEMORY_SCOPE_AGENT); }
DI unsigned xb_xcc_id() { return (unsigned)__builtin_amdgcn_s_getreg((3 << 11) | 20) & 0xFu; }
#define XB_SPIN(cond, bar) do { unsigned _sp = 0; while (cond) { __builtin_amdgcn_s_sleep(1); \
    if ((++_sp & 255u) == 0u) { if (xb_ld(&(bar)[XB_TMO])) break; if (_sp > XB_SPIN_CAP) { atomicAdd(&(bar)[XB_TMO], 1u); break; } } } } while (0)
struct XcdBarrier { unsigned* bar; unsigned x; volatile LAS unsigned* st; };
DI XcdBarrier xcd_barrier_post(unsigned* bar, volatile LAS unsigned* st) {
    XcdBarrier b; b.bar = bar; b.x = xb_xcc_id(); b.st = st;
    if (threadIdx.x == 0) (void)xb_add(&bar[XB_XCNT(b.x)], 1u);
    return b;
}
DI void xcd_barrier_complete(unsigned* bar, unsigned x, unsigned& nloc, unsigned& nx) {
    const unsigned G = gridDim.x * gridDim.y * gridDim.z;
    unsigned sum, cnt, mine, sp = 0u;
    for (;;) {
        sum = 0u; cnt = 0u; mine = 0u;
#pragma unroll
        for (unsigned j = 0; j < 16; ++j) { const unsigned c = xb_ld(&bar[XB_XCNT(j)]); sum += c; cnt += (c > 0u) ? 1u : 0u; mine = (j == x) ? c : mine; }
        if (sum == G) break;
        __builtin_amdgcn_s_sleep(1);
        if ((++sp & 255u) == 0u) { if (xb_ld(&bar[XB_TMO])) break; if (sp > XB_SPIN_CAP) { atomicAdd(&bar[XB_TMO], 1u); break; } }
    }
    nloc = mine > 0u ? mine : 1u; nx = cnt > 0u ? cnt : 1u;
}
DI void xcd_barrier(const XcdBarrier& b) {
    asm volatile("s_waitcnt vmcnt(0)" ::: "memory");
    __syncthreads();
    if (threadIdx.x == 0) {
        unsigned* bar = b.bar;
        __builtin_amdgcn_s_waitcnt(0);
        unsigned nloc = b.st[0], nx = b.st[1];
        if (nloc == 0u) { xcd_barrier_complete(bar, b.x, nloc, nx); b.st[0] = nloc; b.st[1] = nx; }
        const unsigned old = xb_add(&bar[XB_XSUB(b.x)], 1u);
        const unsigned gen = old / nloc;
        if (old + 1u == (gen + 1u) * nloc) {
            __builtin_amdgcn_fence(__ATOMIC_RELEASE, "agent");
            asm volatile("s_waitcnt vmcnt(0)" ::: "memory");
            const unsigned og = xb_add(&bar[XB_TOP], 1u);
            const unsigned tg = og / nx;
            if (og + 1u == (tg + 1u) * nx) xb_add(&bar[XB_TOPGEN], 1u);
            else XB_SPIN(xb_ld(&bar[XB_TOPGEN]) == tg, bar);
            __builtin_amdgcn_fence(__ATOMIC_ACQUIRE, "agent");
            xb_add(&bar[XB_XGEN(b.x)], 1u);
            asm volatile("s_waitcnt vmcnt(0)" ::: "memory");
        } else {
            XB_SPIN(xb_ld(&bar[XB_XGEN(b.x)]) == gen, bar);
            __builtin_amdgcn_fence(__ATOMIC_ACQUIRE, "agent");
            asm volatile("s_waitcnt vmcnt(0)" ::: "memory");
        }
    }
    __syncthreads();
}

DI int swz128(int row, int chunk) { return row * 128 + ((chunk ^ ((row >> 1) & 7)) << 4); }

template <bool OVL, class Epi>
DI void gemm_phase(unsigned char* lds, const bf16_t* __restrict__ A, int lda, const bf16_t* __restrict__ Bt, int K, int nMt, int nNt, const Epi& epi, int bid = -1, int nb = 0) {
    if (bid < 0) { bid = blockIdx.x; nb = gridDim.x; }
    typedef __attribute__((address_space(3))) unsigned char lds_uc;
    lds_uc* ldsl = (lds_uc*)lds;
    const int tid = tid_fresh(), lane = tid & 63, wid = tid >> 6, wm = wid & 1, wn = wid >> 1;
    const int r16 = lane & 15, q4 = lane >> 4;
    const int nk = K >> 6;
    const int xr = (r16 >> 1) & 7;
    const int ab0 = (128 * wm + r16) * 128 + ((q4 ^ xr) << 4), ab1 = (128 * wm + r16) * 128 + (((4 + q4) ^ xr) << 4);
    const int bb0 = 32768 + (64 * wn + r16) * 128 + ((q4 ^ xr) << 4), bb1 = 32768 + (64 * wn + r16) * 128 + (((4 + q4) ^ xr) << 4);
#pragma unroll 1
    for (int rep = 0; rep < REP_GEMM; ++rep)
    for (int u = bid; u < nMt * nNt; u += nb) {
        const int um = u % nMt, un = u / nMt;
        const bf16_t* ap[4]; const bf16_t* bp[4];
        int t0 = 0, bb = 0;
        if (OVL) { bb = um / 33; t0 = 254 * (um % 33) - 1; }
#pragma unroll
        for (int i = 0; i < 4; ++i) {
            const int P = (wid * 4 + i) * 64 + lane, row = P >> 3, c = (P & 7) ^ ((row >> 1) & 7);
            int grow;
            if (OVL) { int t = t0 + row; t = t < 0 ? 0 : (t > L_ - 1 ? L_ - 1 : t); grow = bb * L_ + t; }
            else grow = um * 256 + row;
            ap[i] = A + (size_t)grow * lda + c * 8;
            bp[i] = Bt + (size_t)(un * 256 + row) * K + c * 8;
        }
        f32x4 acc[8][4];
#pragma unroll
        for (int a = 0; a < 8; ++a)
#pragma unroll
            for (int b = 0; b < 4; ++b) acc[a][b] = (f32x4){0.f, 0.f, 0.f, 0.f};
#define G_ISSUE(bufoff) do { _Pragma("unroll") for (int i = 0; i < 4; ++i) { __builtin_amdgcn_global_load_lds((const unsigned*)ap[i], (__attribute__((address_space(3))) unsigned*)(ldsl + (bufoff) + (wid * 4 + i) * 1024), 16, 0, 0); ap[i] += 64; } \
                             _Pragma("unroll") for (int i = 0; i < 4; ++i) { __builtin_amdgcn_global_load_lds((const unsigned*)bp[i], (__attribute__((address_space(3))) unsigned*)(ldsl + (bufoff) + 32768 + (wid * 4 + i) * 1024), 16, 0, 0); bp[i] += 64; } } while (0)
        __syncthreads();
        G_ISSUE(0);
        asm volatile("s_waitcnt vmcnt(0)" ::: "memory");
        __builtin_amdgcn_s_barrier();
        asm volatile("" ::: "memory");
#pragma unroll 1
        for (int kt = 0; kt < nk; ++kt) {
            const int cb = (kt & 1) * 65536;
            if (kt + 1 < nk) G_ISSUE(65536 - cb);
            const unsigned char* lb = lds + cb;
#pragma unroll
            for (int ks = 0; ks < 2; ++ks) {
                bf16x8 af[4], bfr[4];
#pragma unroll
                for (int nt = 0; nt < 4; ++nt) bfr[nt] = *(const bf16x8*)(lb + (ks ? bb1 : bb0) + nt * 2048);
#pragma unroll
                for (int mh = 0; mh < 2; ++mh) {
#pragma unroll
                    for (int mt = 0; mt < 4; ++mt) af[mt] = *(const bf16x8*)(lb + (ks ? ab1 : ab0) + (4 * mh + mt) * 2048);
                    __builtin_amdgcn_sched_barrier(0);
#pragma unroll
                    for (int mt = 0; mt < 4; ++mt)
#pragma unroll
                        for (int nt = 0; nt < 4; ++nt) acc[4 * mh + mt][nt] = __builtin_amdgcn_mfma_f32_16x16x32_bf16(bfr[nt], af[mt], acc[4 * mh + mt][nt], 0, 0, 0);
                    __builtin_amdgcn_sched_barrier(0);
                }
            }
            asm volatile("s_waitcnt vmcnt(0) lgkmcnt(0)" ::: "memory");
            __builtin_amdgcn_s_barrier();
            asm volatile("" ::: "memory");
        }
        int r16e = r16, q4e = q4;
        asm volatile("" : "+v"(r16e), "+v"(q4e));
        if constexpr (Epi::STAGED) {
            epi.staged(lds, acc, um, un, wm, wn, r16e, q4e);
        } else {
#pragma unroll
            for (int mt = 0; mt < 8; ++mt) { epi.row(um * 256 + 128 * wm + 16 * mt + r16e, un * 256 + 64 * wn, q4e, acc[mt]); asm volatile("" ::: "memory"); }
        }
    }
#undef G_ISSUE
}

struct EpiIn {
    static constexpr bool STAGED = true;
    float* hyT; bf16_t* projb;
    template <int HF> static DI void hy_half(float* st, const f32x4 (&acc)[8][4], float* dst, int r16, int q4, int lane) {
#pragma unroll
        for (int mt = 0; mt < 4; ++mt)
#pragma unroll
            for (int nt = 0; nt < 4; ++nt)
#pragma unroll
                for (int i = 0; i < 4; ++i) st[(16 * nt + 4 * q4 + i) * 65 + 16 * mt + r16] = acc[4 * HF + mt][nt][i];
        asm volatile("s_waitcnt lgkmcnt(0)" ::: "memory");
#pragma unroll 4
        for (int n = 0; n < 64; ++n) dst[(size_t)n * T_] = st[n * 65 + lane];
        asm volatile("s_waitcnt lgkmcnt(0)" ::: "memory");
    }
    DI void staged(unsigned char* lds, const f32x4 (&acc)[8][4], int um, int un, int wm, int wn, int r16, int q4) const {
        if (un < 3) {
            float* st = (float*)lds + (wm + 2 * wn) * (64 * 65);
            const int lane = r16 + 16 * q4;
            float* dst = hyT + (size_t)(un * 256 + 64 * wn) * T_ + um * 256 + 128 * wm + lane;
            hy_half<0>(st, acc, dst, r16, q4, lane);
            hy_half<1>(st, acc, dst + 64, r16, q4, lane);
        } else {
#pragma unroll
            for (int mt = 0; mt < 8; ++mt) {
                const int tok = um * 256 + 128 * wm + 16 * mt + r16;
#pragma unroll
                for (int nt = 0; nt < 4; ++nt) {
                    const int col = un * 256 + 64 * wn + 16 * nt + 4 * q4;
                    if (col < 1952) {
                        u32x2 w; w.x = pack2(acc[mt][nt][0], acc[mt][nt][1]); w.y = pack2(acc[mt][nt][2], acc[mt][nt][3]);
                        *(u32x2*)(projb + (unsigned)(tok * 1184 + (col - 768))) = w;
                    }
                }
            }
        }
    }
};
struct EpiF32 {
    static constexpr bool STAGED = false;
    float* C; int ldc;
    DI void row(int tok, int colbase, int q4, const f32x4 (&a)[4]) const {
#pragma unroll
        for (int nt = 0; nt < 4; ++nt) *(f32x4*)(C + (size_t)tok * ldc + colbase + 16 * nt + 4 * q4) = a[nt];
    }
};
struct EpiResid {
    static constexpr bool STAGED = true;
    const float* xold; float* xout; bf16_t* xn; const float* g; float* slots; XcdBarrier xb; bool want_xn;
    DI void staged(unsigned char* lds, f32x4 (&acc)[8][4], int um, int un, int wm, int wn, int r16, int q4) const {
        float* P = (float*)lds;
        const int tid = threadIdx.x;
#pragma unroll
        for (int mt = 0; mt < 8; ++mt) {
            float ss = 0.f;
#pragma unroll
            for (int nt = 0; nt < 4; ++nt) ss += acc[mt][nt][0] * acc[mt][nt][0] + acc[mt][nt][1] * acc[mt][nt][1] + acc[mt][nt][2] * acc[mt][nt][2] + acc[mt][nt][3] * acc[mt][nt][3];
            ss += __shfl_xor(ss, 16); ss += __shfl_xor(ss, 32);
            if (q4 == 0) P[(128 * wm + 16 * mt + r16) * 4 + wn] = ss;
        }
        __syncthreads();
        if (tid < 256) slots[(size_t)(um * 256 + tid) * 4 + un] = (P[tid * 4] + P[tid * 4 + 1]) + (P[tid * 4 + 2] + P[tid * 4 + 3]);
        xcd_barrier(xb);
#pragma unroll
        for (int mt = 0; mt < 8; ++mt) {
            const int tok = um * 256 + 128 * wm + 16 * mt + r16;
            const f32x4 sl = *(const f32x4*)(slots + (size_t)tok * 4);
            const float rr = rsqrtf(((sl[0] + sl[1]) + (sl[2] + sl[3])) * (1.0f / 1024.0f) + 1e-6f);
            float ss = 0.f;
#pragma unroll
            for (int nt = 0; nt < 4; ++nt) {
                const int col = un * 256 + 64 * wn + 16 * nt + 4 * q4;
                const f32x4 xo = *(const f32x4*)(xold + (size_t)tok * 1024 + col);
                const f32x4 gg = *(const f32x4*)(g + col);
                const f32x4 v = xo + acc[mt][nt] * rr * gg;
                acc[mt][nt] = v;
                *(f32x4*)(xout + (size_t)tok * 1024 + col) = v;
                ss += v[0] * v[0] + v[1] * v[1] + v[2] * v[2] + v[3] * v[3];
            }
            ss += __shfl_xor(ss, 16); ss += __shfl_xor(ss, 32);
            if (q4 == 0) P[(128 * wm + 16 * mt + r16) * 4 + wn] = ss;
            asm volatile("" ::: "memory");
        }
        if (want_xn) {
            __syncthreads();
            float* slots2 = slots + (size_t)T_ * 4;
            if (tid < 256) slots2[(size_t)(um * 256 + tid) * 4 + un] = (P[tid * 4] + P[tid * 4 + 1]) + (P[tid * 4 + 2] + P[tid * 4 + 3]);
            xcd_barrier(xb);
#pragma unroll
            for (int mt = 0; mt < 8; ++mt) {
                const int tok = um * 256 + 128 * wm + 16 * mt + r16;
                const f32x4 sl = *(const f32x4*)(slots2 + (size_t)tok * 4);
                const float rr = rsqrtf(((sl[0] + sl[1]) + (sl[2] + sl[3])) * (1.0f / 1024.0f) + 1e-6f);
#pragma unroll
                for (int nt = 0; nt < 4; ++nt) {
                    const int col = un * 256 + 64 * wn + 16 * nt + 4 * q4;
                    u32x2 w; w.x = pack2(acc[mt][nt][0] * rr, acc[mt][nt][1] * rr); w.y = pack2(acc[mt][nt][2] * rr, acc[mt][nt][3] * rr);
                    *(u32x2*)(xn + (size_t)tok * 1024 + col) = w;
                }
            }
        }
        __syncthreads();
    }
};
struct EpiUq {
    static constexpr bool STAGED = false;
    bf16_t* Qm; const float* rq; float sc;
    DI void row(int tok, int colbase, int q4, const f32x4 (&a)[4]) const {
        const float r = rq[tok] * sc;
        const int b = tok >> 13, t = tok & (L_ - 1);
#pragma unroll
        for (int nt = 0; nt < 4; ++nt) {
            const int col = colbase + 16 * nt + 4 * q4;
            if (col >= 384) continue;
            const int head = col / 96, j = col - head * 96;
            bf16_t* dst = Qm + ((size_t)(b * 4 + head) * L_ + t) * 96;
            if (j < 64) {
                u32x2 w; w.x = pack2(a[nt][0] * r, a[nt][1] * r); w.y = pack2(a[nt][2] * r, a[nt][3] * r);
                *(u32x2*)(dst + j) = w;
            } else if (j < 80) {
                if (nt < 3) {
                    const int p0 = j - 64;
                    float o1[4], o2[4];
#pragma unroll
                    for (int i = 0; i < 4; ++i) {
                        const int pp = p0 + i;
                        const float inv = __expf(-(float)(pp & 7) * (9.210340371976184f / 8.0f));
                        const float ang = (float)((pp < 8) ? (t >> 6) : (t & 63)) * inv;
                        float sn, cs; fast_sincos(ang, &sn, &cs);
                        const float x1 = a[nt][i] * r, x2 = a[(nt < 3) ? nt + 1 : 3][i] * r;
                        o1[i] = x1 * cs - x2 * sn; o2[i] = x1 * sn + x2 * cs;
                    }
                    u32x2 w; w.x = pack2(o1[0], o1[1]); w.y = pack2(o1[2], o1[3]);
                    *(u32x2*)(dst + j) = w;
                    w.x = pack2(o2[0], o2[1]); w.y = pack2(o2[2], o2[3]);
                    *(u32x2*)(dst + j + 16) = w;
                }
            }
        }
    }
};
struct EpiUkv {
    static constexpr bool STAGED = false;
    bf16_t* Km; bf16_t* VmT; const float* rkv;
    DI void row(int tok, int colbase, int q4, const f32x4 (&a)[4]) const {
        const float r = rkv[tok];
        const int b = tok >> 13, t = tok & (L_ - 1);
#pragma unroll
        for (int nt = 0; nt < 4; ++nt) {
            const int col = colbase + 16 * nt + 4 * q4;
            const int head = col >> 7, j = col & 127;
            if (j < 64) {
                u32x2 w; w.x = pack2(a[nt][0] * r, a[nt][1] * r); w.y = pack2(a[nt][2] * r, a[nt][3] * r);
                *(u32x2*)(Km + ((size_t)(b * 4 + head) * L_ + t) * 96 + j) = w;
            } else {
#pragma unroll
                for (int i = 0; i < 4; ++i) VmT[((size_t)(b * 4 + head) * 64 + (j - 64 + i)) * L_ + perm16(t)] = f2bf(a[nt][i] * r);
            }
        }
    }
};
DI float gelu_tanh(float x) {
    const float x2 = x * x;
    const float w = x * (-2.302208198f - 0.1029432397f * x2);
    return x * __builtin_amdgcn_rcpf(1.0f + __builtin_amdgcn_exp2f(w));
}
struct EpiUp {
    static constexpr bool STAGED = true;
    bf16_t* act; const float* cw; const float* cb;
    DI void staged(unsigned char* lds, const f32x4 (&acc)[8][4], int um, int un, int wm, int wn, int r16, int q4) const {
        bf16_t* st = (bf16_t*)lds;
#pragma unroll
        for (int mt = 0; mt < 8; ++mt)
#pragma unroll
            for (int nt = 0; nt < 4; ++nt) {
                u32x2 w; w.x = pack2(acc[mt][nt][0], acc[mt][nt][1]); w.y = pack2(acc[mt][nt][2], acc[mt][nt][3]);
                *(u32x2*)(st + (128 * wm + 16 * mt + r16) * 264 + 64 * wn + 16 * nt + 4 * q4) = w;
            }
        __syncthreads();
        const int tid = threadIdx.x, jp = tid & 31, hf = (tid >> 5) & 1, seg = __builtin_amdgcn_readfirstlane(tid >> 6);
        const int bb = um / 33, t0 = 254 * (um % 33) - 1;
        const int r0 = 32 * seg;
        const int ch = 64 * (2 * un + hf) + 2 * jp;
        float g0[2], g1[2], g2[2], gb[2], v0[2], v1[2], v2[2], vb[2];
#pragma unroll
        for (int e = 0; e < 2; ++e) {
            g0[e] = cw[ch + e]; g1[e] = cw[5632 + ch + e]; g2[e] = cw[2 * 5632 + ch + e]; gb[e] = cb[ch + e];
            v0[e] = cw[2816 + ch + e]; v1[e] = cw[5632 + 2816 + ch + e]; v2[e] = cw[2 * 5632 + 2816 + ch + e]; vb[e] = cb[2816 + ch + e];
        }
        const int rlo = (t0 < 0) ? -t0 : 0, rhi = (L_ - 1 - t0 < 255) ? (L_ - 1 - t0) : 255;
        const bf16_t* sp = st + r0 * 264 + 128 * hf + 2 * jp;
        const bool pv = (r0 - 1 >= rlo) && (r0 - 1 <= rhi), cvd = (r0 >= rlo) && (r0 <= rhi);
        unsigned gpw = pv ? *(const unsigned*)(sp - 264) : 0u, vpw = pv ? *(const unsigned*)(sp - 264 + 64) : 0u;
        unsigned gcw = cvd ? *(const unsigned*)sp : 0u, vcw = cvd ? *(const unsigned*)(sp + 64) : 0u;
        bf16_t* dst = act + (size_t)(bb * L_ + t0 + r0) * 2816 + ch;
#define LO(w) __uint_as_float((w) << 16)
#define HI(w) __uint_as_float((w) & 0xffff0000u)
#pragma unroll 4
        for (int i = 0; i < 32; ++i) {
            const int r = r0 + i;
            const bool nv = (r + 1 >= rlo) && (r + 1 <= rhi);
            const unsigned gnw = nv ? *(const unsigned*)(sp + (i + 1) * 264) : 0u, vnw = nv ? *(const unsigned*)(sp + (i + 1) * 264 + 64) : 0u;
            if (r >= 1 && r <= 254 && r <= rhi) {
                const float cg0 = g0[0] * LO(gpw) + g1[0] * LO(gcw) + g2[0] * LO(gnw) + gb[0];
                const float cv0 = v0[0] * LO(vpw) + v1[0] * LO(vcw) + v2[0] * LO(vnw) + vb[0];
                const float cg1 = g0[1] * HI(gpw) + g1[1] * HI(gcw) + g2[1] * HI(gnw) + gb[1];
                const float cv1 = v0[1] * HI(vpw) + v1[1] * HI(vcw) + v2[1] * HI(vnw) + vb[1];
                *(unsigned*)(dst + (size_t)i * 2816) = pack2(gelu_tanh(cg0) * cv0, gelu_tanh(cg1) * cv1);
            }
            gpw = gcw; gcw = gnw; vpw = vcw; vcw = vnw;
        }
#undef LO
#undef HI
        __syncthreads();
    }
};

DI void prep_phase(const Params& p, int l) {
    const int tid_ = tid_fresh(); const int lane = tid_ & 63, wid = tid_ >> 6;
    const bf16_t* projb = (const bf16_t*)(p.ws + O_PROJB);
    bf16_t* Qg = (bf16_t*)(p.ws + O_QG); bf16_t* Kg = (bf16_t*)(p.ws + O_KG); bf16_t* VgT = (bf16_t*)(p.ws + O_VGT);
    bf16_t* Km = (bf16_t*)(p.ws + O_KM);
    float* rq = (float*)(p.ws + O_RQ); float* rkv = (float*)(p.ws + O_RKV);
    const float* gq = p.in[13] + l * 64; const float* gk = p.in[14] + l * 64;
    const int hd = lane >> 3, sub = lane & 7;
    float gq1[4], gq2[4], gk1[4], gk2[4];
#pragma unroll
    for (int i = 0; i < 4; ++i) { gq1[i] = gq[4 * sub + i]; gq2[i] = gq[32 + 4 * sub + i]; gk1[i] = gk[4 * sub + i]; gk2[i] = gk[32 + 4 * sub + i]; }
    const float qscale = 0.125f * 1.4426950408889634f;
    for (int tok = blockIdx.x * 8 + wid; tok < T_; tok += gridDim.x * 8) {
        const int b = tok >> 13, t = tok & (L_ - 1);
        const bf16_t* pr = projb + (size_t)tok * 1184;
        float cs[4], sn[4];
#pragma unroll
        for (int i = 0; i < 4; ++i) {
            const int pp = 4 * sub + i;
            const float inv = __expf(-(float)(pp & 15) * (9.210340371976184f / 16.0f));
            const float ang = (float)((pp < 16) ? (t >> 6) : (t & 63)) * inv;
            fast_sincos(ang, &sn[i], &cs[i]);
        }
        {
            const u32x2 w1 = *(const u32x2*)(pr + hd * 64 + 4 * sub), w2 = *(const u32x2*)(pr + hd * 64 + 32 + 4 * sub);
            float x1[4] = {bf2f((bf16_t)(w1.x & 0xffff)), bf2f((bf16_t)(w1.x >> 16)), bf2f((bf16_t)(w1.y & 0xffff)), bf2f((bf16_t)(w1.y >> 16))};
            float x2[4] = {bf2f((bf16_t)(w2.x & 0xffff)), bf2f((bf16_t)(w2.x >> 16)), bf2f((bf16_t)(w2.y & 0xffff)), bf2f((bf16_t)(w2.y >> 16))};
            float ss = 0.f;
#pragma unroll
            for (int i = 0; i < 4; ++i) ss += x1[i] * x1[i] + x2[i] * x2[i];
            ss += __shfl_xor(ss, 1); ss += __shfl_xor(ss, 2); ss += __shfl_xor(ss, 4);
            const float r = rsqrtf(ss * (1.0f / 64.0f) + 1e-6f);
            float o1[4], o2[4];
#pragma unroll
            for (int i = 0; i < 4; ++i) { const float a = x1[i] * r * gq1[i], c = x2[i] * r * gq2[i]; o1[i] = (a * cs[i] - c * sn[i]) * qscale; o2[i] = (a * sn[i] + c * cs[i]) * qscale; }
            bf16_t* dst = Qg + ((size_t)(b * 8 + hd) * L_ + t) * 64;
            u32x2 w; w.x = pack2(o1[0], o1[1]); w.y = pack2(o1[2], o1[3]); *(u32x2*)(dst + 4 * sub) = w;
            w.x = pack2(o2[0], o2[1]); w.y = pack2(o2[2], o2[3]); *(u32x2*)(dst + 32 + 4 * sub) = w;
        }
        if (lane < 16) {
            const u32x2 w1 = *(const u32x2*)(pr + 512 + hd * 64 + 4 * sub), w2 = *(const u32x2*)(pr + 512 + hd * 64 + 32 + 4 * sub);
            float x1[4] = {bf2f((bf16_t)(w1.x & 0xffff)), bf2f((bf16_t)(w1.x >> 16)), bf2f((bf16_t)(w1.y & 0xffff)), bf2f((bf16_t)(w1.y >> 16))};
            float x2[4] = {bf2f((bf16_t)(w2.x & 0xffff)), bf2f((bf16_t)(w2.x >> 16)), bf2f((bf16_t)(w2.y & 0xffff)), bf2f((bf16_t)(w2.y >> 16))};
            float ss = 0.f;
#pragma unroll
            for (int i = 0; i < 4; ++i) ss += x1[i] * x1[i] + x2[i] * x2[i];
            ss += __shfl_xor(ss, 1); ss += __shfl_xor(ss, 2); ss += __shfl_xor(ss, 4);
            const float r = rsqrtf(ss * (1.0f / 64.0f) + 1e-6f);
            float o1[4], o2[4];
#pragma unroll
            for (int i = 0; i < 4; ++i) { const float a = x1[i] * r * gk1[i], c = x2[i] * r * gk2[i]; o1[i] = a * cs[i] - c * sn[i]; o2[i] = a * sn[i] + c * cs[i]; }
            bf16_t* dst = Kg + ((size_t)(b * 2 + hd) * L_ + t) * 64;
            u32x2 w; w.x = pack2(o1[0], o1[1]); w.y = pack2(o1[2], o1[3]); *(u32x2*)(dst + 4 * sub) = w;
            w.x = pack2(o2[0], o2[1]); w.y = pack2(o2[2], o2[3]); *(u32x2*)(dst + 32 + 4 * sub) = w;
        }
        {
            const unsigned w = *(const unsigned*)(pr + 640 + 2 * lane);
            const int c0 = 2 * lane, kh = c0 >> 6, d = c0 & 63;
            bf16_t* dst = VgT + ((size_t)(b * 2 + kh) * 64 + d) * L_ + perm16(t);
            dst[0] = (bf16_t)(w & 0xffff); dst[L_] = (bf16_t)(w >> 16);
        }
        {
            const u32x2 w = *(const u32x2*)(pr + 768 + 4 * lane);
            const float a0 = bf2f((bf16_t)(w.x & 0xffff)), a1 = bf2f((bf16_t)(w.x >> 16)), a2 = bf2f((bf16_t)(w.y & 0xffff)), a3 = bf2f((bf16_t)(w.y >> 16));
            float ss = wave_sum(a0 * a0 + a1 * a1 + a2 * a2 + a3 * a3);
            if (lane == 0) rq[tok] = rsqrtf(ss * (1.0f / 256.0f) + 1e-6f);
        }
        {
            const unsigned w = *(const unsigned*)(pr + 1024 + 2 * lane);
            const float a0 = bf2f((bf16_t)(w & 0xffff)), a1 = bf2f((bf16_t)(w >> 16));
            float ss = wave_sum(a0 * a0 + a1 * a1);
            if (lane == 0) rkv[tok] = rsqrtf(ss * (1.0f / 128.0f) + 1e-6f);
        }
        if (lane < 16) {
            const float x1 = bf2f(pr[1152 + lane]), x2 = bf2f(pr[1152 + 16 + lane]);
            const float inv = __expf(-(float)(lane & 7) * (9.210340371976184f / 8.0f));
            const float ang = (float)((lane < 8) ? (t >> 6) : (t & 63)) * inv;
            float s1, c1; fast_sincos(ang, &s1, &c1);
            const bf16_t o1 = f2bf(x1 * c1 - x2 * s1), o2 = f2bf(x1 * s1 + x2 * c1);
#pragma unroll
            for (int hh = 0; hh < 4; ++hh) { bf16_t* dst = Km + ((size_t)(b * 4 + hh) * L_ + t) * 96 + 64; dst[lane] = o1; dst[16 + lane] = o2; }
        }
    }
}

template <int DQK> DI int kswz(int row, int chunk) {
    if (DQK == 64) return row * 128 + ((chunk ^ ((row >> 1) & 7)) << 4);
    else return row * 192 + ((chunk ^ ((row >> 2) & 3)) << 4);
}
template <int DQK>
DI void attn_unit(unsigned char* lds, const bf16_t* __restrict__ Qp, const bf16_t* __restrict__ Kp, const bf16_t* __restrict__ VTp, bf16_t* __restrict__ Yp  ) {
    constexpr int NS = DQK / 16, NC = DQK / 8, KB = 64 * DQK * 2, KVB = KB + 8192;
    const int tid = tid_fresh(), lane = tid & 63, w = tid >> 6, r = lane & 31, h = lane >> 5;
    bf16x8 qf[NS];
#pragma unroll
    for (int s = 0; s < NS; ++s) qf[s] = *(const bf16x8*)(Qp + (size_t)(32 * w + r) * DQK + 16 * s + 8 * h);
    f32x16 o0, o1;
#pragma unroll
    for (int i = 0; i < 16; ++i) { o0[i] = 0.f; o1[i] = 0.f; }
    float m = 0.f, lsum = 0.f;
    const int k_row0 = tid / NC, k_c0 = tid % NC;
    const int k_row1 = (tid + 512) / NC, k_c1 = (tid + 512) % NC;
    const bool k_two = (DQK == 96) && (tid < 256);
    const int v_row = tid >> 3, v_c = tid & 7;
    u32x4 rkA0, rkA1, rvA, rkB0, rkB1, rvB;
    rkA1 = (u32x4){0u, 0u, 0u, 0u}; rkB1 = rkA1;
#define A_LOAD(kt, R0, R1, RV) do { R0 = *(const u32x4*)(Kp + (size_t)((kt) * 64 + k_row0) * DQK + k_c0 * 8); \
                        if (k_two) R1 = *(const u32x4*)(Kp + (size_t)((kt) * 64 + k_row1) * DQK + k_c1 * 8); \
                        RV = *(const u32x4*)(VTp + (size_t)v_row * L_ + (kt) * 64 + v_c * 8); } while (0)
#define A_STORE(buf, R0, R1, RV) do { *(u32x4*)(lds + (buf) * KVB + kswz<DQK>(k_row0, k_c0)) = R0; \
                          if (k_two) *(u32x4*)(lds + (buf) * KVB + kswz<DQK>(k_row1, k_c1)) = R1; \
                          *(u32x4*)(lds + (buf) * KVB + KB + swz128(v_row, v_c)) = RV; } while (0)
    A_LOAD(0, rkA0, rkA1, rvA);
    A_LOAD(1, rkB0, rkB1, rvB);
    A_STORE(0, rkA0, rkA1, rvA);
    __syncthreads();
    constexpr int NKT = L_ / 64;
#pragma unroll 1
    for (int kt2 = 0; kt2 < NKT; kt2 += 2) {
#pragma unroll
      for (int cur = 0; cur < 2; ++cur) {
        const int kt = kt2 + cur;
        if (kt + 2 < NKT) { if (cur == 0) A_LOAD(kt + 2, rkA0, rkA1, rvA); else A_LOAD(kt + 2, rkB0, rkB1, rvB); }
        const unsigned char* lk = lds + cur * KVB;
        const unsigned char* lv = lk + KB;
        f32x16 s0, s1;
        const float negm = -m;
#pragma unroll
        for (int i = 0; i < 16; ++i) { s0[i] = negm; s1[i] = negm; }
#pragma unroll
        for (int s = 0; s < NS; ++s) {
            const bf16x8 k0 = *(const bf16x8*)(lk + kswz<DQK>(r, 2 * s + h));
            const bf16x8 k1 = *(const bf16x8*)(lk + kswz<DQK>(32 + r, 2 * s + h));
            s0 = __builtin_amdgcn_mfma_f32_32x32x16_bf16(k0, qf[s], s0, 0, 0, 0);
            s1 = __builtin_amdgcn_mfma_f32_32x32x16_bf16(k1, qf[s], s1, 0, 0, 0);
        }
        float mx = fmaxf(fmaxf(s0[0], s0[1]), s0[2]);
#pragma unroll
        for (int i = 3; i < 15; i += 2) mx = fmaxf(fmaxf(mx, s0[i]), s0[i + 1]);
        mx = fmaxf(mx, s0[15]);
#pragma unroll
        for (int i = 0; i < 16; i += 2) mx = fmaxf(fmaxf(mx, s1[i]), s1[i + 1]);
        mx = fmaxf(mx, __shfl_xor(mx, 32));
        if (kt == 0 || __any(mx > 8.0f)) {
            const float dm = (kt == 0) ? mx : fmaxf(mx, 0.f);
            const float alpha = (kt == 0) ? 0.f : __builtin_amdgcn_exp2f(-dm);
            m += dm;
            lsum *= alpha;
#pragma unroll
            for (int i = 0; i < 16; ++i) { o0[i] *= alpha; o1[i] *= alpha; s0[i] -= dm; s1[i] -= dm; }
        }
        float ps = 0.f;
#pragma unroll
        for (int i = 0; i < 16; ++i) { s0[i] = __builtin_amdgcn_exp2f(s0[i]); ps += s0[i]; }
#pragma unroll
        for (int i = 0; i < 16; ++i) { s1[i] = __builtin_amdgcn_exp2f(s1[i]); ps += s1[i]; }
        lsum += ps;
#pragma unroll
        for (int sub = 0; sub < 2; ++sub)
#pragma unroll
            for (int s2 = 0; s2 < 2; ++s2) {
                u32x4 pw;
                if (sub == 0) { pw.x = pack2(s0[8 * s2 + 0], s0[8 * s2 + 1]); pw.y = pack2(s0[8 * s2 + 2], s0[8 * s2 + 3]); pw.z = pack2(s0[8 * s2 + 4], s0[8 * s2 + 5]); pw.w = pack2(s0[8 * s2 + 6], s0[8 * s2 + 7]); }
                else          { pw.x = pack2(s1[8 * s2 + 0], s1[8 * s2 + 1]); pw.y = pack2(s1[8 * s2 + 2], s1[8 * s2 + 3]); pw.z = pack2(s1[8 * s2 + 4], s1[8 * s2 + 5]); pw.w = pack2(s1[8 * s2 + 6], s1[8 * s2 + 7]); }
                const bf16x8 pf = __builtin_bit_cast(bf16x8, pw);
                const bf16x8 vf0 = *(const bf16x8*)(lv + swz128(r, 4 * sub + 2 * s2 + h));
                const bf16x8 vf1 = *(const bf16x8*)(lv + swz128(32 + r, 4 * sub + 2 * s2 + h));
                o0 = __builtin_amdgcn_mfma_f32_32x32x16_bf16(vf0, pf, o0, 0, 0, 0);
                o1 = __builtin_amdgcn_mfma_f32_32x32x16_bf16(vf1, pf, o1, 0, 0, 0);
            }
        if (kt + 1 < NKT) { if (cur == 0) A_STORE(1, rkB0, rkB1, rvB); else A_STORE(0, rkA0, rkA1, rvA); }
        __syncthreads();
      }
    }
#undef A_LOAD
#undef A_STORE
    const float lt = lsum + __shfl_xor(lsum, 32);
    const float inv = 1.0f / lt;
    bf16_t* yr = Yp + (size_t)(32 * w + r) * 768;
#pragma unroll
    for (int g = 0; g < 4; ++g) {
        u32x2 wv; wv.x = pack2(o0[4 * g] * inv, o0[4 * g + 1] * inv); wv.y = pack2(o0[4 * g + 2] * inv, o0[4 * g + 3] * inv);
        *(u32x2*)(yr + 8 * g + 4 * h) = wv;
        wv.x = pack2(o1[4 * g] * inv, o1[4 * g + 1] * inv); wv.y = pack2(o1[4 * g + 2] * inv, o1[4 * g + 3] * inv);
        *(u32x2*)(yr + 32 + 8 * g + 4 * h) = wv;
    }
}

DI int pa(int e) { return e + (e >> 4); }
DI float2 cmul(float2 a, float2 b) { return make_float2(a.x * b.x - a.y * b.y, a.x * b.y + a.y * b.x); }
DI float2 cadd(float2 a, float2 b) { return make_float2(a.x + b.x, a.y + b.y); }
DI float2 csub(float2 a, float2 b) { return make_float2(a.x - b.x, a.y - b.y); }
template <bool INV> DI void dft4(float2& a, float2& b, float2& c, float2& d) {
    const float2 t0 = cadd(a, c), t1 = csub(a, c), t2 = cadd(b, d), t3 = csub(b, d);
    const float2 jt3 = INV ? make_float2(-t3.y, t3.x) : make_float2(t3.y, -t3.x);
    a = cadd(t0, t2); c = csub(t0, t2); b = cadd(t1, jt3); d = csub(t1, jt3);
}
template <bool INV> DI float2 tw16(float2 v, int k) {
    const float c1 = 0.9238795325112867f, s1 = 0.3826834323650898f, c2 = 0.7071067811865476f;
    float wr = 1.f, wi = 0.f;
    switch (k) {
        case 0: wr = 1.f; wi = 0.f; break;
        case 1: wr = c1; wi = -s1; break;
        case 2: wr = c2; wi = -c2; break;
        case 3: wr = s1; wi = -c1; break;
        case 4: wr = 0.f; wi = -1.f; break;
        case 6: wr = -c2; wi = -c2; break;
        case 9: wr = -c1; wi = s1; break;
        default: break;
    }
    if (INV) wi = -wi;
    return make_float2(v.x * wr - v.y * wi, v.x * wi + v.y * wr);
}
template <bool INV> DI void dft16(float2 (&x)[16]) {
#pragma unroll
    for (int b = 0; b < 4; ++b) dft4<INV>(x[b], x[b + 4], x[b + 8], x[b + 12]);
#pragma unroll
    for (int b = 1; b < 4; ++b)
#pragma unroll
        for (int pq = 1; pq < 4; ++pq) x[b + 4 * pq] = tw16<INV>(x[b + 4 * pq], b * pq);
#pragma unroll
    for (int pq = 0; pq < 4; ++pq) dft4<INV>(x[4 * pq], x[4 * pq + 1], x[4 * pq + 2], x[4 * pq + 3]);
#pragma unroll
    for (int a = 0; a < 4; ++a)
#pragma unroll
        for (int b = a + 1; b < 4; ++b) { const float2 tmp = x[4 * a + b]; x[4 * a + b] = x[4 * b + a]; x[4 * b + a] = tmp; }
}
template <bool INV> DI void pass_a(float2* Z, const float2* T1, int tid) {
#pragma unroll
    for (int i = 0; i < 8; ++i) {
        const int j = tid + 512 * i;
        float2* zp = Z + pa(j);
        float2 x0 = zp[0], x1 = zp[4352], x2 = zp[8704], x3 = zp[13056];
        float2 w1 = tw16<false>(T1[j & 1023], i >> 1);
        if (INV) w1.y = -w1.y;
        const float2 w2 = cmul(w1, w1), w3 = cmul(w2, w1);
        if (!INV) { dft4<false>(x0, x1, x2, x3); x1 = cmul(x1, w1); x2 = cmul(x2, w2); x3 = cmul(x3, w3); }
        else { x1 = cmul(x1, w1); x2 = cmul(x2, w2); x3 = cmul(x3, w3); dft4<true>(x0, x1, x2, x3); }
        zp[0] = x0; zp[4352] = x1; zp[8704] = x2; zp[13056] = x3;
    }
}
template <bool INV, int LS, int TS> DI void pass16(float2* Z, const float2* T1, int tid) {
#pragma unroll 1
    for (int i = 0; i < 2; ++i) {
        const int id = tid + 512 * i, j = id & ((1 << LS) - 1), base = (id >> LS) << (LS + 4);
        float2* zp = Z + pa(base + j);
        float2 x[16];
#pragma unroll
        for (int mm = 0; mm < 16; ++mm) x[mm] = zp[mm * ((1 << LS) + (1 << (LS - 4)))];
        float2 w1 = T1[j << TS];
        if (INV) w1.y = -w1.y;
        if (!INV) dft16<false>(x);
        float2 wq = w1;
#pragma unroll
        for (int qq = 1; qq < 16; ++qq) { x[qq] = cmul(x[qq], wq); wq = cmul(wq, w1); }
        if (INV) dft16<true>(x);
#pragma unroll
        for (int mm = 0; mm < 16; ++mm) zp[mm * ((1 << LS) + (1 << (LS - 4)))] = x[mm];
    }
}
DI void pass_d_store(const float2* Z, float2* __restrict__ Kf, int tid, float scale) {
#pragma unroll 1
    for (int i = 0; i < 2; ++i) {
        const int id = tid + 512 * i, base = id * 16;
        float2 x[16];
#pragma unroll
        for (int mm = 0; mm < 16; ++mm) x[mm] = Z[17 * id + mm];
        dft16<false>(x);
#pragma unroll
        for (int mm = 0; mm < 16; mm += 2) *(f32x4*)(Kf + base + mm) = (f32x4){x[mm].x * scale, x[mm].y * scale, x[mm + 1].x * scale, x[mm + 1].y * scale};
    }
}
DI void pass_d_lds(float2* Z, int tid) {
#pragma unroll 1
    for (int i = 0; i < 2; ++i) {
        const int id = tid + 512 * i, base = id * 16;
        float2 x[16];
#pragma unroll
        for (int mm = 0; mm < 16; ++mm) x[mm] = Z[17 * id + mm];
        dft16<false>(x);
#pragma unroll
        for (int mm = 0; mm < 16; ++mm) Z[17 * id + mm] = x[mm];
    }
}
DI void pass_d_mul(float2* Z, const float2* __restrict__ Kf, int tid) {
#pragma unroll 1
    for (int i = 0; i < 2; ++i) {
        const int id = tid + 512 * i, base = id * 16;
        float2 x[16];
#pragma unroll
        for (int mm = 0; mm < 16; ++mm) x[mm] = Z[17 * id + mm];
        dft16<false>(x);
#pragma unroll
        for (int mm = 0; mm < 16; mm += 2) {
            const f32x4 kk = *(const f32x4*)(Kf + base + mm);
            x[mm] = cmul(x[mm], make_float2(kk[0], kk[1])); x[mm + 1] = cmul(x[mm + 1], make_float2(kk[2], kk[3]));
        }
        dft16<true>(x);
#pragma unroll
        for (int mm = 0; mm < 16; ++mm) Z[17 * id + mm] = x[mm];
    }
}
DI void fft_conv(float2* Z, const float2* T1, const float2* Kf, int tid) {
    pass_a<false>(Z, T1, tid); __syncthreads();
    pass16<false, 8, 2>(Z, T1, tid); __syncthreads();
    pass16<false, 4, 6>(Z, T1, tid); __syncthreads();
    pass_d_mul(Z, Kf, tid); __syncthreads();
    pass16<true, 4, 6>(Z, T1, tid); __syncthreads();
    pass16<true, 8, 2>(Z, T1, tid); __syncthreads();
    pass_a<true>(Z, T1, tid); __syncthreads();
}

DI void hyena_unit(unsigned char* lds, const Params& p, int l, int c) {
    float2* Z = (float2*)lds;
    float2* T1 = (float2*)(lds + 139264);
    const int tid = tid_fresh();
    const float* hyT = (const float*)(p.ws + O_HYT);
    float2* Kf0 = (float2*)(p.ws + O_R1) + (size_t)c * 32768;
    float2* Kf1 = Kf0 + 16384;
    bf16_t* hyout = (bf16_t*)(p.ws + O_HYOUT) + (size_t)c * T_;
    for (int k = tid; k < 1024; k += NTHR) { float sn, cs; sincospif((float)k * (1.0f / 8192.0f), &sn, &cs); T1[k] = make_float2(cs, -sn); }
    __syncthreads();
    {
        const float* taps = (const float*)Kf1;
#pragma unroll 4
        for (int t = tid; t < L_; t += NTHR) { Z[pa(t)] = make_float2(taps[t], taps[2 * L_ + t]); Z[pa(16383 - t)] = make_float2(taps[L_ + t], taps[3 * L_ + t]); }
        __syncthreads();
        pass_a<false>(Z, T1, tid); __syncthreads();
        pass16<false, 8, 2>(Z, T1, tid); __syncthreads();
        pass16<false, 4, 6>(Z, T1, tid); __syncthreads();
        pass_d_lds(Z, tid); __syncthreads();
        const float sc = 0.5f / 16384.0f;
#pragma unroll 2
        for (int e = tid; e < 16384; e += NTHR) {
            const int a = e >> 12, b = (e >> 8) & 15, c4 = (e >> 4) & 15, d = e & 15;
            const int k = a + 4 * (b + 16 * (c4 + 16 * d));
            const int k2 = (16384 - k) & 16383;
            const int e2 = ((k2 & 3) << 12) | (((k2 >> 2) & 15) << 8) | (((k2 >> 6) & 15) << 4) | (k2 >> 10);
            const float2 z = Z[pa(e)], z2 = Z[pa(e2)];
            const float sx = z.x + z2.x, sy = z.y - z2.y, dx = z.x - z2.x, dy = z.y + z2.y;
            Kf0[e] = make_float2(sx * sc, sy * sc);
            Kf1[e] = make_float2(dy * sc, -dx * sc);
        }
        __syncthreads();
    }
    const float* cw = p.in[3] + (size_t)l * 3 * 768; const float* cb = p.in[4] + (size_t)l * 768;
    const float* skip = p.in[12] + (size_t)l * 2 * 256;
    float2* z1buf = Kf0;
    const float vw0 = cw[c], vw1 = cw[768 + c], vw2 = cw[1536 + c], vbb = cb[c];
    const float* uv = hyT + (size_t)c * T_;
#pragma unroll 2
    for (int t = tid; t < L_; t += NTHR) {
        float vv[2];
#pragma unroll
        for (int b = 0; b < 2; ++b) {
            const float* ub = uv + b * L_;
            const float um = (t > 0) ? ub[t - 1] : 0.f, uc = ub[t], up = (t < L_ - 1) ? ub[t + 1] : 0.f;
            vv[b] = vw0 * um + vw1 * uc + vw2 * up + vbb;
        }
        Z[pa(t)] = make_float2(vv[0], vv[1]); Z[pa(t + L_)] = make_float2(0.f, 0.f);
    }
    __syncthreads();
    __threadfence();
    fft_conv(Z, T1, Kf0, tid);
    {
        const int ch = 256 + c;
        const float w0 = cw[ch], w1 = cw[768 + ch], w2 = cw[1536 + ch], bb = cb[ch], sk = skip[c];
        const float* u0 = hyT + (size_t)ch * T_;
#pragma unroll 2
        for (int t = tid; t < L_; t += NTHR) {
            const float2 y = Z[pa(t)];
            float zz[2];
#pragma unroll
            for (int b = 0; b < 2; ++b) {
                const float* ub = u0 + b * L_;
                const float um = (t > 0) ? ub[t - 1] : 0.f, uc = ub[t], up = (t < L_ - 1) ? ub[t + 1] : 0.f;
                const float g = w0 * um + w1 * uc + w2 * up + bb;
                const float* vb = uv + b * L_;
                const float vm = (t > 0) ? vb[t - 1] : 0.f, vc = vb[t], vp = (t < L_ - 1) ? vb[t + 1] : 0.f;
                const float v = vw0 * vm + vw1 * vc + vw2 * vp + vbb;
                zz[b] = g * ((b ? y.y : y.x) + sk * v);
            }
            const float2 z1 = make_float2(zz[0], zz[1]);
            Z[pa(t)] = z1; Z[pa(t + L_)] = make_float2(0.f, 0.f);
            z1buf[t] = z1;
        }
    }
    __syncthreads();
    fft_conv(Z, T1, Kf1, tid);
    {
        const int ch = 512 + c;
        const float w0 = cw[ch], w1 = cw[768 + ch], w2 = cw[1536 + ch], bb = cb[ch], sk = skip[256 + c];
        const float* u0 = hyT + (size_t)ch * T_;
#pragma unroll 2
        for (int t = tid; t < L_; t += NTHR) {
            const float2 y = Z[pa(t)];
            const float2 z1 = z1buf[t];
#pragma unroll
            for (int b = 0; b < 2; ++b) {
                const float* ub = u0 + b * L_;
                const float um = (t > 0) ? ub[t - 1] : 0.f, uc = ub[t], up = (t < L_ - 1) ? ub[t + 1] : 0.f;
                const float g = w0 * um + w1 * uc + w2 * up + bb;
                hyout[b * L_ + t] = f2bf(g * ((b ? y.y : y.x) + sk * (b ? z1.y : z1.x)));
            }
        }
    }
    __syncthreads();
}

DI void groups_phase(unsigned char* lds, const Params& p) {
    bf16_t* tile = (bf16_t*)lds;
    const int tid = tid_fresh(), lane = tid & 63, wid = tid >> 6;
    const bf16_t* hyout = (const bf16_t*)(p.ws + O_HYOUT);
    const bf16_t* Y = (const bf16_t*)(p.ws + O_PROJB);
    bf16_t* G = (bf16_t*)(p.ws + O_HYT);
    for (int u = blockIdx.x; u < T_ / 64; u += gridDim.x) {
        const int tok0 = u * 64;
        {
            const int c = tid >> 1, hf = tid & 1;
            const u32x4* src = (const u32x4*)(hyout + (size_t)c * T_ + tok0 + hf * 32);
#pragma unroll
            for (int i = 0; i < 4; ++i) {
                const u32x4 v = src[i];
                unsigned* d = (unsigned*)(tile + c * 66 + hf * 32 + i * 8);
                d[0] = v.x; d[1] = v.y; d[2] = v.z; d[3] = v.w;
            }
        }
        __syncthreads();
#pragma unroll 1
        for (int i = 0; i < 8; ++i) {
            const int tl = wid * 8 + i, tok = tok0 + tl;
            float hv[4]; float sh = 0.f;
#pragma unroll
            for (int k = 0; k < 4; ++k) { hv[k] = bf2f(tile[(lane + 64 * k) * 66 + tl]); sh += hv[k] * hv[k]; }
            sh = wave_sum(sh);
            const float rh = rsqrtf(sh * (1.0f / 256.0f) + 1e-6f);
            bf16_t* gr = G + (size_t)tok * 1024;
#pragma unroll
            for (int k = 0; k < 4; ++k) gr[lane + 64 * k] = f2bf(hv[k] * rh);
            const bf16_t* yr = Y + (size_t)tok * 768;
            {
                const u32x4 v = *(const u32x4*)(yr + lane * 8);
                float a[8] = {bf2f((bf16_t)(v.x & 0xffff)), bf2f((bf16_t)(v.x >> 16)), bf2f((bf16_t)(v.y & 0xffff)), bf2f((bf16_t)(v.y >> 16)),
                              bf2f((bf16_t)(v.z & 0xffff)), bf2f((bf16_t)(v.z >> 16)), bf2f((bf16_t)(v.w & 0xffff)), bf2f((bf16_t)(v.w >> 16))};
                float ss = 0.f;
#pragma unroll
                for (int k = 0; k < 8; ++k) ss += a[k] * a[k];
                ss = wave_sum(ss);
                const float rr = rsqrtf(ss * (1.0f / 512.0f) + 1e-6f);
                u32x4 w; w.x = pack2(a[0] * rr, a[1] * rr); w.y = pack2(a[2] * rr, a[3] * rr); w.z = pack2(a[4] * rr, a[5] * rr); w.w = pack2(a[6] * rr, a[7] * rr);
                *(u32x4*)(gr + 256 + lane * 8) = w;
            }
            {
                const u32x2 v = *(const u32x2*)(yr + 512 + lane * 4);
                float a[4] = {bf2f((bf16_t)(v.x & 0xffff)), bf2f((bf16_t)(v.x >> 16)), bf2f((bf16_t)(v.y & 0xffff)), bf2f((bf16_t)(v.y >> 16))};
                float ss = wave_sum(a[0] * a[0] + a[1] * a[1] + a[2] * a[2] + a[3] * a[3]);
                const float rr = rsqrtf(ss * (1.0f / 256.0f) + 1e-6f);
                u32x2 w; w.x = pack2(a[0] * rr, a[1] * rr); w.y = pack2(a[2] * rr, a[3] * rr);
                *(u32x2*)(gr + 768 + lane * 4) = w;
            }
        }
        __syncthreads();
    }
}


extern __shared__ __attribute__((aligned(16))) unsigned char smem[];

__global__ void __launch_bounds__(512) fwd_megakernel(Params p) {
    cg::grid_group grid = cg::this_grid();
    unsigned char* lds = smem;
    unsigned char* ws = p.ws;
    unsigned* bar = (unsigned*)(ws + O_BAR);
    volatile LAS unsigned* xb_st = (volatile LAS unsigned*)(smem + LDS_BYTES - 16);
    if (threadIdx.x < 4) xb_st[threadIdx.x] = 0u;
    __syncthreads();
    const XcdBarrier xb = xcd_barrier_post(bar, xb_st);
    if (p.ws == nullptr) grid.sync();
#pragma unroll 1
    for (int l2 = 0; l2 < 2 * REP_PRO; ++l2) { const int l = l2 & 1;
        convT(lds, p.in[2] + (size_t)l * 1024 * 1952, 1024, 1952, 2048, p.in[1] + l * 1024, (bf16_t*)(ws + O_WIN) + (size_t)l * 2048 * 1024, 0);
        convT(lds, p.in[16] + (size_t)l * 256 * 384, 256, 384, 512, p.in[15] + l * 256, (bf16_t*)(ws + O_WUQ) + (size_t)l * 512 * 256, 0);
        convT(lds, p.in[18] + (size_t)l * 128 * 512, 128, 512, 512, p.in[17] + l * 128, (bf16_t*)(ws + O_WUKV) + (size_t)l * 512 * 128, 0);
        convT(lds, p.in[25] + (size_t)l * 1024 * 5632, 1024, 5632, 5632, p.in[24] + l * 1024, (bf16_t*)(ws + O_WUP) + (size_t)l * 5632 * 1024, 1);
        convT(lds, p.in[28] + (size_t)l * 2816 * 1024, 2816, 1024, 1024, nullptr, (bf16_t*)(ws + O_WDOWN) + (size_t)l * 1024 * 2816, 0);
    }
    {
        float* tile = (float*)lds;
        const int tid = tid_fresh();
        for (int u = blockIdx.x; u < 2 * 16 * 16; u += gridDim.x) {
            const int l = u >> 8, kt = (u & 255) & 15, ntile = (u & 255) >> 4;
            const int k0 = kt * 64, n0 = ntile * 64;
            const float* W = p.in[22] + (size_t)l * 1024 * 1024;
            bf16_t* dst = (bf16_t*)(ws + O_WOUT) + (size_t)l * 1024 * 1024;
#pragma unroll
            for (int i = 0; i < 8; ++i) {
                const int kk = (tid >> 6) + 8 * i, nn = tid & 63, k = k0 + kk;
                const float g = (k < 256) ? p.in[19][l * 256 + k] : (k < 768) ? p.in[20][l * 512 + k - 256] : p.in[21][l * 256 + k - 768];
                tile[kk * 65 + nn] = W[(size_t)k * 1024 + n0 + nn] * g;
            }
            __syncthreads();
            {
                const int nn = tid >> 3, kb = (tid & 7) * 8;
                u32x4 w;
                w.x = pack2(tile[(kb + 0) * 65 + nn], tile[(kb + 1) * 65 + nn]);
                w.y = pack2(tile[(kb + 2) * 65 + nn], tile[(kb + 3) * 65 + nn]);
                w.z = pack2(tile[(kb + 4) * 65 + nn], tile[(kb + 5) * 65 + nn]);
                w.w = pack2(tile[(kb + 6) * 65 + nn], tile[(kb + 7) * 65 + nn]);
                *(u32x4*)(dst + (size_t)(n0 + nn) * 1024 + k0 + kb) = w;
            }
            __syncthreads();
        }
    }
#ifndef REP_MISC
#define REP_MISC 1
#endif
#pragma unroll 1
    for (int rep = 0; rep < REP_MISC; ++rep) { hy_h2_phase(lds, p);
    rownorm_phase(p.in[0], (bf16_t*)(ws + O_XN)); }
    XSYNC();


#pragma unroll 1
    for (int l = 0; l < 2; ++l) {
        {
            EpiIn e; e.hyT = (float*)(ws + O_HYT); e.projb = (bf16_t*)(ws + O_PROJB);
            gemm_phase<false>(lds, (const bf16_t*)(ws + O_XN), 1024, (const bf16_t*)(ws + O_WIN) + (size_t)l * 2048 * 1024, 1024, 64, 8, e);
        }
        XSYNC();
#pragma unroll 1
        for (int rep = 0; rep < REP_EW; ++rep) prep_phase(p, l);
#pragma unroll 1
        for (int rep = 0; rep < REP_MISC; ++rep) ft_phase(lds, p, l);
        XSYNC();
        {
            EpiUq e; e.Qm = (bf16_t*)(ws + O_QM); e.rq = (const float*)(ws + O_RQ); e.sc = 0.10206207261596577f * 1.4426950408889634f;
            const int hb = gridDim.x >> 1;
            if ((int)blockIdx.x < hb) gemm_phase<false>(lds, (const bf16_t*)(ws + O_PROJB) + 768, 1184, (const bf16_t*)(ws + O_WUQ) + (size_t)l * 512 * 256, 256, 64, 2, e, blockIdx.x, hb);
            EpiUkv e2; e2.Km = (bf16_t*)(ws + O_KM); e2.VmT = (bf16_t*)(ws + O_VMT); e2.rkv = (const float*)(ws + O_RKV);
            if ((int)blockIdx.x >= hb) gemm_phase<false>(lds, (const bf16_t*)(ws + O_PROJB) + 1024, 1184, (const bf16_t*)(ws + O_WUKV) + (size_t)l * 512 * 128, 128, 64, 2, e2, blockIdx.x - hb, gridDim.x - hb);
        }
        XSYNC();
#pragma unroll 1
        for (int rep = 0; rep < REP_HY; ++rep)
        for (int c = blockIdx.x; c < 256; c += gridDim.x) hyena_unit(lds, p, l, c);
#pragma unroll 1
        for (int rep = 0; rep < REP_ATTN; ++rep)
        for (int u = blockIdx.x; u < 512; u += gridDim.x) {
            const int qt = u & 31, hh = (u >> 5) & 7, b = u >> 8, hk = hh >> 2;
            attn_unit<64>(lds, (const bf16_t*)(ws + O_QG) + ((size_t)(b * 8 + hh) * L_ + qt * 256) * 64,
                          (const bf16_t*)(ws + O_KG) + (size_t)(b * 2 + hk) * L_ * 64,
                          (const bf16_t*)(ws + O_VGT) + (size_t)(b * 2 + hk) * 64 * L_,
                          (bf16_t*)(ws + O_PROJB) + (size_t)(b * L_ + qt * 256) * 768 + hh * 64);
        }
#pragma unroll 1
        for (int rep = 0; rep < REP_ATTN; ++rep)
        for (int u = blockIdx.x; u < 256; u += gridDim.x) {
            const int qt = u & 31, hh = (u >> 5) & 3, b = u >> 7;
            attn_unit<96>(lds, (const bf16_t*)(ws + O_QM) + ((size_t)(b * 4 + hh) * L_ + qt * 256) * 96,
                          (const bf16_t*)(ws + O_KM) + (size_t)(b * 4 + hh) * L_ * 96,
                          (const bf16_t*)(ws + O_VMT) + (size_t)(b * 4 + hh) * 64 * L_,
                          (bf16_t*)(ws + O_PROJB) + (size_t)(b * L_ + qt * 256) * 768 + 512 + hh * 64);
        }
        XSYNC();
#pragma unroll 1
        for (int rep = 0; rep < REP_EW; ++rep) groups_phase(lds, p);
        XSYNC();
        if (gridDim.x == 256) {
            EpiResid e; e.xold = (l == 0) ? p.in[0] : p.out; e.xout = p.out; e.xn = (bf16_t*)(ws + O_XN); e.g = p.in[23] + l * 1024; e.slots = (float*)(ws + O_SLOTS); e.xb = xb; e.want_xn = true;
            gemm_phase<false>(lds, (const bf16_t*)(ws + O_HYT), 1024, (const bf16_t*)(ws + O_WOUT) + (size_t)l * 1024 * 1024, 1024, 64, 4, e);
            XSYNC();
        } else {
            EpiF32 e; e.C = (float*)(ws + O_R1); e.ldc = 1024;
            gemm_phase<false>(lds, (const bf16_t*)(ws + O_HYT), 1024, (const bf16_t*)(ws + O_WOUT) + (size_t)l * 1024 * 1024, 1024, 64, 4, e);
            XSYNC();
            resid_phase((const float*)(ws + O_R1), l == 0 ? p.in[0] : p.out, p.in[23] + l * 1024, p.out, (bf16_t*)(ws + O_XN), true);
            XSYNC();
        }
        {
            EpiUp e; e.act = (bf16_t*)(ws + O_HYT); e.cw = p.in[26] + (size_t)l * 3 * 5632; e.cb = p.in[27] + (size_t)l * 5632;
            gemm_phase<true>(lds, (const bf16_t*)(ws + O_XN), 1024, (const bf16_t*)(ws + O_WUP) + (size_t)l * 5632 * 1024, 1024, 66, 22, e);
        }
        XSYNC();
        if (gridDim.x == 256) {
            EpiResid e; e.xold = p.out; e.xout = p.out; e.xn = (bf16_t*)(ws + O_XN); e.g = p.in[29] + l * 1024; e.slots = (float*)(ws + O_SLOTS); e.xb = xb; e.want_xn = (l == 0);
            gemm_phase<false>(lds, (const bf16_t*)(ws + O_HYT), 2816, (const bf16_t*)(ws + O_WDOWN) + (size_t)l * 1024 * 2816, 2816, 64, 4, e);
            if (l == 0) XSYNC();
        } else {
            EpiF32 e; e.C = (float*)(ws + O_R1); e.ldc = 1024;
            gemm_phase<false>(lds, (const bf16_t*)(ws + O_HYT), 2816, (const bf16_t*)(ws + O_WDOWN) + (size_t)l * 1024 * 2816, 2816, 64, 4, e);
            XSYNC();
            resid_phase((const float*)(ws + O_R1), p.out, p.in[29] + l * 1024, p.out, (bf16_t*)(ws + O_XN), l == 0);
            if (l == 0) XSYNC();
        }
    }
}

extern "C" void kernel_launch(void* const* d_in, const int* in_sizes, int n_in,
                              void* d_out, int out_size, void* d_ws, size_t ws_size,
                              hipStream_t stream) {
    static int grid_blocks = 0;
    if (!grid_blocks) {
        int dev = 0, cus = 0, per_cu = 0;
        (void)hipGetDevice(&dev);
        (void)hipDeviceGetAttribute(&cus, hipDeviceAttributeMultiprocessorCount, dev);
        (void)hipFuncSetAttribute((const void*)fwd_megakernel, hipFuncAttributeMaxDynamicSharedMemorySize, (int)LDS_BYTES);
        (void)hipOccupancyMaxActiveBlocksPerMultiprocessor(&per_cu, fwd_megakernel, NTHR, LDS_BYTES);
        if (per_cu < 1) per_cu = 1;
        grid_blocks = cus;
        if (grid_blocks > 256) grid_blocks = 256;
    }
    Params p{};
    for (int i = 0; i < 30; ++i) p.in[i] = (const float*)d_in[i];
    p.out = (float*)d_out; p.ws = (unsigned char*)d_ws;
    void* args[] = {&p};
    (void)hipMemsetAsync((unsigned char*)d_ws + O_BAR, 0, XCD_BAR_WORDS * sizeof(unsigned), stream);
    hipError_t e = hipLaunchCooperativeKernel((void*)fwd_megakernel, dim3(grid_blocks), dim3(NTHR), args, LDS_BYTES, stream);
    if (e != hipSuccess) fprintf(stderr, "cooperative launch failed: %s (grid %d)\n", hipGetErrorString(e), grid_blocks);
}
```

```cpp
#include <hip/hip_runtime.h>
#include <hip/hip_cooperative_groups.h>
#include <cstdio>
#include <cstdint>
namespace cg = cooperative_groups;

typedef unsigned short bf16_t;
typedef short bf16x8 __attribute__((ext_vector_type(8)));
typedef float f32x4 __attribute__((ext_vector_type(4)));
typedef float f32x16 __attribute__((ext_vector_type(16)));
typedef unsigned u32x2 __attribute__((ext_vector_type(2)));
typedef unsigned u32x4 __attribute__((ext_vector_type(4)));

#define DI __device__ __forceinline__
#ifndef REP_ATTN
#define REP_ATTN 1
#endif
#ifndef REP_HY
#define REP_HY 1
#endif
#ifndef REP_GEMM
#define REP_GEMM 1
#endif
#ifndef REP_PRO
#define REP_PRO 1
#endif
#ifndef REP_SYNC
#define REP_SYNC 1
#endif
#define XSYNC() do { _Pragma("unroll 1") for (int r_ = 0; r_ < REP_SYNC; ++r_) xcd_barrier(xb); } while (0)
#ifndef REP_EW
#define REP_EW 1
#endif
constexpr int L_ = 8192, T_ = 16384, NTHR = 512;
constexpr size_t MiB = 1u << 20;
constexpr size_t O_WIN = 0, O_WUQ = 8 * MiB, O_WUKV = 8 * MiB + 512 * 1024, O_RQ = 8 * MiB + 768 * 1024, O_RKV = 8 * MiB + 832 * 1024;
constexpr size_t O_BAR = 8 * MiB + 896 * 1024;
constexpr size_t O_WOUT = 9 * MiB, O_WUP = 13 * MiB, O_WDOWN = 35 * MiB, O_H2 = 46 * MiB;
constexpr size_t O_R1 = 50 * MiB;
constexpr size_t O_HYT = 114 * MiB;
constexpr size_t O_PROJB = 162 * MiB;
constexpr size_t O_HYOUT = 186 * MiB;
constexpr size_t O_QG = 199 * MiB, O_KG = 215 * MiB, O_VGT = 219 * MiB, O_QM = 223 * MiB, O_KM = 235 * MiB, O_VMT = 247 * MiB;
constexpr size_t O_XN = 223 * MiB;
constexpr size_t O_SLOTS = 255 * MiB;
constexpr size_t LDS_BYTES = 150 * 1024;

struct Params { const float* in[30]; float* out; unsigned char* ws; };

typedef __bf16 bf16v2_t __attribute__((ext_vector_type(2)));
typedef float f32v2_t __attribute__((ext_vector_type(2)));
DI bf16_t f2bf(float x) { const __bf16 b = (__bf16)x; return __builtin_bit_cast(bf16_t, b); }
DI float bf2f(bf16_t v) { return __uint_as_float(((unsigned)v) << 16); }
DI unsigned pack2(float lo, float hi) { const f32v2_t v = {lo, hi}; const bf16v2_t b = __builtin_convertvector(v, bf16v2_t); return __builtin_bit_cast(unsigned, b); }
DI float wave_sum(float v) {
#pragma unroll
    for (int o = 32; o >= 1; o >>= 1) v += __shfl_xor(v, o);
    return v;
}
DI int tid_fresh() { int t = threadIdx.x; asm volatile("" : "+v"(t)); return t; }
DI void fast_sincos(float ang, float* s, float* c) {
    float rev = ang * 0.15915494309189535f; rev -= rintf(rev);
    *s = __builtin_amdgcn_sinf(rev); *c = __builtin_amdgcn_cosf(rev);
}
DI float fast_sin(float a) { float rev = a * 0.15915494309189535f; rev -= rintf(rev); return __builtin_amdgcn_sinf(rev); }
DI int perm16(int t) { return (t & ~15) | (t & 3) | (((t >> 3) & 1) << 2) | (((t >> 2) & 1) << 3); }

DI void convT(unsigned char* lds, const float* __restrict__ W, int K, int N, int Npad, const float* __restrict__ gain, bf16_t* __restrict__ dst, int mode, const float* __restrict__ gain_b = nullptr, const float* __restrict__ gain_c = nullptr) {
    float* tile = (float*)lds;
    const int tid = tid_fresh();
    const int nkt = K >> 6, nnt = Npad >> 8;
    for (int u = blockIdx.x; u < nkt * nnt; u += gridDim.x) {
        const int kt = u % nkt, ntile = u / nkt;
        const int k0 = kt * 64, n0 = ntile * 256;
        const int cl = 4 * (tid & 63);
        int src = n0 + cl;
        if (mode == 1) { const int nq = n0 + (cl & ~63), jt = nq >> 7, half = (nq >> 6) & 1; src = (half ? 2816 + 64 * jt : 64 * jt) + (cl & 63); }
        const bool valid = src < N;
        f32x4 v[8];
#pragma unroll
        for (int i = 0; i < 8; ++i) {
            const int kk = (tid >> 6) + 8 * i;
            v[i] = valid ? *(const f32x4*)(W + (size_t)(k0 + kk) * N + src) : (f32x4){0.f, 0.f, 0.f, 0.f};
        }
#pragma unroll
        for (int i = 0; i < 8; ++i) {
            const int kk = (tid >> 6) + 8 * i;
            const int kq = k0 + kk;
            const float g = (mode == 2) ? ((kq < 256) ? gain[kq] : (kq < 768) ? gain_b[kq - 256] : gain_c[kq - 768]) : (gain ? gain[kq] : 1.0f);
            *(f32x4*)(tile + kk * 260 + cl) = v[i] * g;
        }
        __syncthreads();
        {
            const int nn = tid >> 1, kh = (tid & 1) * 32;
#pragma unroll
            for (int c = 0; c < 4; ++c) {
                const int kb = kh + 8 * c;
                u32x4 w;
                w.x = pack2(tile[(kb + 0) * 260 + nn], tile[(kb + 1) * 260 + nn]);
                w.y = pack2(tile[(kb + 2) * 260 + nn], tile[(kb + 3) * 260 + nn]);
                w.z = pack2(tile[(kb + 4) * 260 + nn], tile[(kb + 5) * 260 + nn]);
                w.w = pack2(tile[(kb + 6) * 260 + nn], tile[(kb + 7) * 260 + nn]);
                *(u32x4*)(dst + (size_t)(n0 + nn) * K + k0 + kb) = w;
            }
        }
        __syncthreads();
    }
}

DI void hy_h2_phase(unsigned char* lds, const Params& p) {
    float* zs = (float*)lds;
    float* h1s = zs + 64 * 36;
    const int tid = tid_fresh(), rg = tid >> 6, j = tid & 63;
    float* h2 = (float*)(p.ws + O_H2);
    for (int u = blockIdx.x; u < 2 * (L_ / 64); u += gridDim.x) {
        const int l = u / (L_ / 64), t0 = (u % (L_ / 64)) * 64;
#pragma unroll 1
        for (int e = tid; e < 64 * 16; e += NTHR) {
            const int row = e >> 4, bnd = e & 15, t = t0 + row;
            const float w = 2.0f * 3.14159265358979323846f * (float)t / (float)L_;
            const float f = 1e-4f + (15.0f - 1e-4f) * (float)bnd / 15.0f;
            const float a = f * w;
            float sn, cs; fast_sincos(a, &sn, &cs);
            zs[row * 36 + 1 + bnd] = cs;
            zs[row * 36 + 17 + bnd] = -sn;
            if (bnd == 0) zs[row * 36] = (float)t / (float)(L_ - 1);
        }
        __syncthreads();
        {
            const float* w1 = p.in[5] + (size_t)l * 33 * 64;
            float wc[33];
#pragma unroll
            for (int e = 0; e < 33; ++e) wc[e] = w1[e * 64 + j];
            const float b1 = p.in[6][l * 64 + j], f1 = p.in[7][l * 64 + j];
#pragma unroll 2
            for (int i = 0; i < 8; ++i) {
                const int row = 8 * rg + i;
                float s = b1;
#pragma unroll
                for (int e = 0; e < 33; ++e) s += zs[row * 36 + e] * wc[e];
                h1s[row * 64 + j] = fast_sin(f1 * s);
            }
        }
        __syncthreads();
        {
            const float* w2 = p.in[8] + (size_t)l * 64 * 64;
            float wc[64];
#pragma unroll
            for (int e = 0; e < 64; ++e) wc[e] = w2[e * 64 + j];
            const float b2 = p.in[9][l * 64 + j], f2 = p.in[10][l * 64 + j];
#pragma unroll 2
            for (int i = 0; i < 8; ++i) {
                const int row = 8 * rg + i;
                float s = b2;
#pragma unroll
                for (int e = 0; e < 64; e += 4) { const f32x4 hv = *(const f32x4*)(h1s + row * 64 + e); s += hv[0] * wc[e] + hv[1] * wc[e + 1] + hv[2] * wc[e + 2] + hv[3] * wc[e + 3]; }
                h2[((size_t)l * L_ + t0 + row) * 64 + j] = fast_sin(f2 * s);
            }
        }
        __syncthreads();
    }
}

DI void ft_phase(unsigned char* lds, const Params& p, int l) {
    const int tid = tid_fresh(), lane = tid & 63, w = tid >> 6, r16 = lane & 15, q4 = lane >> 4;
    const float* h2 = (const float*)(p.ws + O_H2) + (size_t)l * L_ * 64;
    const float* w3 = p.in[11] + (size_t)l * 64 * 1024;
    const float min_decay = -4.605170185988091f / 1.5f, max_decay = -4.605170185988091f / 0.3f;
    for (int u = blockIdx.x; u < L_ / 32; u += gridDim.x) {
        const int t0 = u * 32;
        bf16x8 hb[2][2];
#pragma unroll
        for (int tt = 0; tt < 2; ++tt)
#pragma unroll
            for (int ks = 0; ks < 2; ++ks) {
                const float* hp = h2 + (size_t)(t0 + 16 * tt + r16) * 64 + 32 * ks + 8 * q4;
                const f32x4 a = *(const f32x4*)hp, b = *(const f32x4*)(hp + 4);
                u32x4 pw; pw.x = pack2(a[0], a[1]); pw.y = pack2(a[2], a[3]); pw.z = pack2(b[0], b[1]); pw.w = pack2(b[2], b[3]);
                hb[tt][ks] = __builtin_bit_cast(bf16x8, pw);
            }
#pragma unroll 1
        for (int nt = 0; nt < 8; ++nt) {
            const int n0 = 128 * w + 16 * nt;
            f32x4 acc0 = {0.f, 0.f, 0.f, 0.f}, acc1 = {0.f, 0.f, 0.f, 0.f};
#pragma unroll
            for (int ks = 0; ks < 2; ++ks) {
                const float* wp = w3 + (size_t)(32 * ks + 8 * q4) * 1024 + n0 + r16;
                u32x4 pw;
                pw.x = pack2(wp[0], wp[1024]); pw.y = pack2(wp[2048], wp[3072]); pw.z = pack2(wp[4096], wp[5120]); pw.w = pack2(wp[6144], wp[7168]);
                const bf16x8 wf = __builtin_bit_cast(bf16x8, pw);
                acc0 = __builtin_amdgcn_mfma_f32_16x16x32_bf16(wf, hb[0][ks], acc0, 0, 0, 0);
                acc1 = __builtin_amdgcn_mfma_f32_16x16x32_bf16(wf, hb[1][ks], acc1, 0, 0, 0);
            }
#pragma unroll
            for (int i = 0; i < 4; ++i) {
                const int col = n0 + 4 * q4 + i, c = col & 255, od = col >> 8;
                const float dlt = fabsf(min_decay + (max_decay - min_decay) * (float)c / 255.0f);
                float* dst = (float*)(p.ws + O_R1 + (size_t)c * 262144 + 131072) + od * L_ + t0 + r16;
                dst[0] = acc0[i] * expf(-((float)(t0 + r16) / (float)(L_ - 1)) * dlt);
                dst[16] = acc1[i] * expf(-((float)(t0 + 16 + r16) / (float)(L_ - 1)) * dlt);
            }
        }
    }
}

DI void rownorm_phase(const float* __restrict__ x, bf16_t* __restrict__ xn) {
    const int tid_ = tid_fresh(); const int lane = tid_ & 63, wid = tid_ >> 6;
    for (int row = blockIdx.x * 8 + wid; row < T_; row += gridDim.x * 8) {
        const float* xr = x + (size_t)row * 1024;
        f32x4 v[4]; float ss = 0.f;
#pragma unroll
        for (int i = 0; i < 4; ++i) { v[i] = *(const f32x4*)(xr + i * 256 + lane * 4); ss += v[i][0] * v[i][0] + v[i][1] * v[i][1] + v[i][2] * v[i][2] + v[i][3] * v[i][3]; }
        ss = wave_sum(ss);
        const float r = rsqrtf(ss * (1.0f / 1024.0f) + 1e-6f);
#pragma unroll
        for (int i = 0; i < 4; ++i) { u32x2 w; w.x = pack2(v[i][0] * r, v[i][1] * r); w.y = pack2(v[i][2] * r, v[i][3] * r); *(u32x2*)(xn + (size_t)row * 1024 + i * 256 + lane * 4) = w; }
    }
}

DI void resid_phase(const float* __restrict__ y, const float* __restrict__ xres, const float* __restrict__ g, float* __restrict__ xout, bf16_t* __restrict__ xn, bool want_xn) {
    const int tid_ = tid_fresh(); const int lane = tid_ & 63, wid = tid_ >> 6;
    for (int row = blockIdx.x * 8 + wid; row < T_; row += gridDim.x * 8) {
        const size_t ro = (size_t)row * 1024;
        f32x4 v[4]; float ss = 0.f;
#pragma unroll
        for (int i = 0; i < 4; ++i) { v[i] = *(const f32x4*)(y + ro + i * 256 + lane * 4); ss += v[i][0] * v[i][0] + v[i][1] * v[i][1] + v[i][2] * v[i][2] + v[i][3] * v[i][3]; }
        ss = wave_sum(ss);
        const float r = rsqrtf(ss * (1.0f / 1024.0f) + 1e-6f);
        float s2 = 0.f;
#pragma unroll
        for (int i = 0; i < 4; ++i) {
            const f32x4 xr = *(const f32x4*)(xres + ro + i * 256 + lane * 4);
            const f32x4 gg = *(const f32x4*)(g + i * 256 + lane * 4);
            v[i] = xr + v[i] * r * gg;
            s2 += v[i][0] * v[i][0] + v[i][1] * v[i][1] + v[i][2] * v[i][2] + v[i][3] * v[i][3];
            *(f32x4*)(xout + ro + i * 256 + lane * 4) = v[i];
        }
        if (want_xn) {
            s2 = wave_sum(s2);
            const float r2 = rsqrtf(s2 * (1.0f / 1024.0f) + 1e-6f);
#pragma unroll
            for (int i = 0; i < 4; ++i) { u32x2 w; w.x = pack2(v[i][0] * r2, v[i][1] * r2); w.y = pack2(v[i][2] * r2, v[i][3] * r2); *(u32x2*)(xn + ro + i * 256 + lane * 4) = w; }
        }
    }
}

#define XB_TMO      128
#define XB_XCNT(j)  (256  + 64 * (j))
#define XB_XSUB(j)  (1280 + 64 * (j))
#define XB_XGEN(j)  (2304 + 64 * (j))
#define XB_TOP      3328
#define XB_TOPGEN   3392
#define XCD_BAR_WORDS 3456
#define XB_SPIN_CAP (1u << 22)
#define LAS __attribute__((address_space(3)))
DI unsigned xb_ld(unsigned* p)              { return __hip_atomic_load(p, __ATOMIC_RELAXED, __HIP_MEMORY_SCOPE_AGENT); }
DI unsigned xb_add(unsigned* p, unsigned v) { return __hip_atomic_fetch_add(p, v, __ATOMIC_RELAXED, __HIP_MEMORY_SCOPE_AGENT); }
DI unsigned xb_xcc_id() { return (unsigned)__builtin_amdgcn_s_getreg((3 << 11) | 20) & 0xFu; }
#define XB_SPIN(cond, bar) do { unsigned _sp = 0; while (cond) { __builtin_amdgcn_s_sleep(1); \
    if ((++_sp & 255u) == 0u) { if (xb_ld(&(bar)[XB_TMO])) break; if (_sp > XB_SPIN_CAP) { atomicAdd(&(bar)[XB_TMO], 1u); break; } } } } while (0)
struct XcdBarrier { unsigned* bar; unsigned x; volatile LAS unsigned* st; };
DI XcdBarrier xcd_barrier_post(unsigned* bar, volatile LAS unsigned* st) {
    XcdBarrier b; b.bar = bar; b.x = xb_xcc_id(); b.st = st;
    if (threadIdx.x == 0) (void)xb_add(&bar[XB_XCNT(b.x)], 1u);
    return b;
}
DI void xcd_barrier_complete(unsigned* bar, unsigned x, unsigned& nloc, unsigned& nx) {
    const unsigned G = gridDim.x * gridDim.y * gridDim.z;
    unsigned sum, cnt, mine, sp = 0u;
    for (;;) {
        sum = 0u; cnt = 0u; mine = 0u;
#pragma unroll
        for (unsigned j = 0; j < 16; ++j) { const unsigned c = xb_ld(&bar[XB_XCNT(j)]); sum += c; cnt += (c > 0u) ? 1u : 0u; mine = (j == x) ? c : mine; }
        if (sum == G) break;
        __builtin_amdgcn_s_sleep(1);
        if ((++sp & 255u) == 0u) { if (xb_ld(&bar[XB_TMO])) break; if (sp > XB_SPIN_CAP) { atomicAdd(&bar[XB_TMO], 1u); break; } }
    }
    nloc = mine > 0u ? mine : 1u; nx = cnt > 0u ? cnt : 1u;
}
DI void xcd_barrier(const XcdBarrier& b) {
    asm volatile("s_waitcnt vmcnt(0)" ::: "memory");
    __syncthreads();
    if (threadIdx.x == 0) {
        unsigned* bar = b.bar;
        __builtin_amdgcn_s_waitcnt(0);
        unsigned nloc = b.st[0], nx = b.st[1];
        if (nloc == 0u) { xcd_barrier_complete(bar, b.x, nloc, nx); b.st[0] = nloc; b.st[1] = nx; }
        const unsigned old = xb_add(&bar[XB_XSUB(b.x)], 1u);
        const unsigned gen = old / nloc;
        if (old + 1u == (gen + 1u) * nloc) {
            __builtin_amdgcn_fence(__ATOMIC_RELEASE, "agent");
            asm volatile("s_waitcnt vmcnt(0)" ::: "memory");
            const unsigned og = xb_add(&bar[XB_TOP], 1u);
            const unsigned tg = og / nx;
            if (og + 1u == (tg + 1u) * nx) xb_add(&bar[XB_TOPGEN], 1u);
            else XB_SPIN(xb_ld(&bar[XB_TOPGEN]) == tg, bar);
            __builtin_amdgcn_fence(__ATOMIC_ACQUIRE, "agent");
            xb_add(&bar[XB_XGEN(b.x)], 1u);
            asm volatile("s_waitcnt vmcnt(0)" ::: "memory");
        } else {
            XB_SPIN(xb_ld(&bar[XB_XGEN(b.x)]) == gen, bar);
            __builtin_amdgcn_fence(__ATOMIC_ACQUIRE, "agent");
            asm volatile("s_waitcnt vmcnt(0)" ::: "memory");
        }
    }
    __syncthreads();
}

DI int swz128(int row, int chunk) { return row * 128 + ((chunk ^ ((row >> 1) & 7)) << 4); }

template <bool OVL, class Epi>
DI void gemm_phase(unsigned char* lds, const bf16_t* __restrict__ A, int lda, const bf16_t* __restrict__ Bt, int K, int nMt, int nNt, const Epi& epi, int bid = -1, int nb = 0) {
    if (bid < 0) { bid = blockIdx.x; nb = gridDim.x; }
    typedef __attribute__((address_space(3))) unsigned char lds_uc;
    lds_uc* ldsl = (lds_uc*)lds;
    const int tid = tid_fresh(), lane = tid & 63, wid = tid >> 6, wm = wid & 1, wn = wid >> 1;
    const int r16 = lane & 15, q4 = lane >> 4;
    const int nk = K >> 6;
    const int xr = (r16 >> 1) & 7;
    const int ab0 = (128 * wm + r16) * 128 + ((q4 ^ xr) << 4), ab1 = (128 * wm + r16) * 128 + (((4 + q4) ^ xr) << 4);
    const int bb0 = 32768 + (64 * wn + r16) * 128 + ((q4 ^ xr) << 4), bb1 = 32768 + (64 * wn + r16) * 128 + (((4 + q4) ^ xr) << 4);
#pragma unroll 1
    for (int rep = 0; rep < REP_GEMM; ++rep)
    for (int u = bid; u < nMt * nNt; u += nb) {
        const int um = u % nMt, un = u / nMt;
        const bf16_t* ap[4]; const bf16_t* bp[4];
        int t0 = 0, bb = 0;
        if (OVL) { bb = um / 33; t0 = 254 * (um % 33) - 1; }
#pragma unroll
        for (int i = 0; i < 4; ++i) {
            const int P = (wid * 4 + i) * 64 + lane, row = P >> 3, c = (P & 7) ^ ((row >> 1) & 7);
            int grow;
            if (OVL) { int t = t0 + row; t = t < 0 ? 0 : (t > L_ - 1 ? L_ - 1 : t); grow = bb * L_ + t; }
            else grow = um * 256 + row;
            ap[i] = A + (size_t)grow * lda + c * 8;
            bp[i] = Bt + (size_t)(un * 256 + row) * K + c * 8;
        }
        f32x4 acc[8][4];
#pragma unroll
        for (int a = 0; a < 8; ++a)
#pragma unroll
            for (int b = 0; b < 4; ++b) acc[a][b] = (f32x4){0.f, 0.f, 0.f, 0.f};
#define G_ISSUE(bufoff) do { _Pragma("unroll") for (int i = 0; i < 4; ++i) { __builtin_amdgcn_global_load_lds((const unsigned*)ap[i], (__attribute__((address_space(3))) unsigned*)(ldsl + (bufoff) + (wid * 4 + i) * 1024), 16, 0, 0); ap[i] += 64; } \
                             _Pragma("unroll") for (int i = 0; i < 4; ++i) { __builtin_amdgcn_global_load_lds((const unsigned*)bp[i], (__attribute__((address_space(3))) unsigned*)(ldsl + (bufoff) + 32768 + (wid * 4 + i) * 1024), 16, 0, 0); bp[i] += 64; } } while (0)
        __syncthreads();
        G_ISSUE(0);
        asm volatile("s_waitcnt vmcnt(0)" ::: "memory");
        __builtin_amdgcn_s_barrier();
        asm volatile("" ::: "memory");
#pragma unroll 1
        for (int kt = 0; kt < nk; ++kt) {
            const int cb = (kt & 1) * 65536;
            if (kt + 1 < nk) G_ISSUE(65536 - cb);
            const unsigned char* lb = lds + cb;
#pragma unroll
            for (int ks = 0; ks < 2; ++ks) {
                bf16x8 af[4], bfr[4];
#pragma unroll
                for (int nt = 0; nt < 4; ++nt) bfr[nt] = *(const bf16x8*)(lb + (ks ? bb1 : bb0) + nt * 2048);
#pragma unroll
                for (int mh = 0; mh < 2; ++mh) {
#pragma unroll
                    for (int mt = 0; mt < 4; ++mt) af[mt] = *(const bf16x8*)(lb + (ks ? ab1 : ab0) + (4 * mh + mt) * 2048);
                    __builtin_amdgcn_sched_barrier(0);
#pragma unroll
                    for (int mt = 0; mt < 4; ++mt)
#pragma unroll
                        for (int nt = 0; nt < 4; ++nt) acc[4 * mh + mt][nt] = __builtin_amdgcn_mfma_f32_16x16x32_bf16(bfr[nt], af[mt], acc[4 * mh + mt][nt], 0, 0, 0);
                    __builtin_amdgcn_sched_barrier(0);
                }
            }
            asm volatile("s_waitcnt vmcnt(0) lgkmcnt(0)" ::: "memory");
            __builtin_amdgcn_s_barrier();
            asm volatile("" ::: "memory");
        }
        int r16e = r16, q4e = q4;
        asm volatile("" : "+v"(r16e), "+v"(q4e));
        if constexpr (Epi::STAGED) {
            epi.staged(lds, acc, um, un, wm, wn, r16e, q4e);
        } else {
#pragma unroll
            for (int mt = 0; mt < 8; ++mt) { epi.row(um * 256 + 128 * wm + 16 * mt + r16e, un * 256 + 64 * wn, q4e, acc[mt]); asm volatile("" ::: "memory"); }
        }
    }
#undef G_ISSUE
}

struct EpiIn {
    static constexpr bool STAGED = true;
    float* hyT; bf16_t* projb;
    template <int HF> static DI void hy_half(float* st, const f32x4 (&acc)[8][4], float* dst, int r16, int q4, int lane) {
#pragma unroll
        for (int mt = 0; mt < 4; ++mt)
#pragma unroll
            for (int nt = 0; nt < 4; ++nt)
#pragma unroll
                for (int i = 0; i < 4; ++i) st[(16 * nt + 4 * q4 + i) * 65 + 16 * mt + r16] = acc[4 * HF + mt][nt][i];
        asm volatile("s_waitcnt lgkmcnt(0)" ::: "memory");
#pragma unroll 4
        for (int n = 0; n < 64; ++n) dst[(size_t)n * T_] = st[n * 65 + lane];
        asm volatile("s_waitcnt lgkmcnt(0)" ::: "memory");
    }
    DI void staged(unsigned char* lds, const f32x4 (&acc)[8][4], int um, int un, int wm, int wn, int r16, int q4) const {
        if (un < 3) {
            float* st = (float*)lds + (wm + 2 * wn) * (64 * 65);
            const int lane = r16 + 16 * q4;
            float* dst = hyT + (size_t)(un * 256 + 64 * wn) * T_ + um * 256 + 128 * wm + lane;
            hy_half<0>(st, acc, dst, r16, q4, lane);
            hy_half<1>(st, acc, dst + 64, r16, q4, lane);
        } else {
#pragma unroll
            for (int mt = 0; mt < 8; ++mt) {
                const int tok = um * 256 + 128 * wm + 16 * mt + r16;
#pragma unroll
                for (int nt = 0; nt < 4; ++nt) {
                    const int col = un * 256 + 64 * wn + 16 * nt + 4 * q4;
                    if (col < 1952) {
                        u32x2 w; w.x = pack2(acc[mt][nt][0], acc[mt][nt][1]); w.y = pack2(acc[mt][nt][2], acc[mt][nt][3]);
                        *(u32x2*)(projb + (unsigned)(tok * 1184 + (col - 768))) = w;
                    }
                }
            }
        }
    }
};
struct EpiF32 {
    static constexpr bool STAGED = false;
    float* C; int ldc;
    DI void row(int tok, int colbase, int q4, const f32x4 (&a)[4]) const {
#pragma unroll
        for (int nt = 0; nt < 4; ++nt) *(f32x4*)(C + (size_t)tok * ldc + colbase + 16 * nt + 4 * q4) = a[nt];
    }
};
struct EpiResid {
    static constexpr bool STAGED = true;
    const float* xold; float* xout; bf16_t* xn; const float* g; float* slots; XcdBarrier xb; bool want_xn;
    DI void staged(unsigned char* lds, f32x4 (&acc)[8][4], int um, int un, int wm, int wn, int r16, int q4) const {
        float* P = (float*)lds;
        const int tid = threadIdx.x;
#pragma unroll
        for (int mt = 0; mt < 8; ++mt) {
            float ss = 0.f;
#pragma unroll
            for (int nt = 0; nt < 4; ++nt) ss += acc[mt][nt][0] * acc[mt][nt][0] + acc[mt][nt][1] * acc[mt][nt][1] + acc[mt][nt][2] * acc[mt][nt][2] + acc[mt][nt][3] * acc[mt][nt][3];
            ss += __shfl_xor(ss, 16); ss += __shfl_xor(ss, 32);
            if (q4 == 0) P[(128 * wm + 16 * mt + r16) * 4 + wn] = ss;
        }
        __syncthreads();
        if (tid < 256) slots[(size_t)(um * 256 + tid) * 4 + un] = (P[tid * 4] + P[tid * 4 + 1]) + (P[tid * 4 + 2] + P[tid * 4 + 3]);
        xcd_barrier(xb);
#pragma unroll
        for (int mt = 0; mt < 8; ++mt) {
            const int tok = um * 256 + 128 * wm + 16 * mt + r16;
            const f32x4 sl = *(const f32x4*)(slots + (size_t)tok * 4);
            const float rr = rsqrtf(((sl[0] + sl[1]) + (sl[2] + sl[3])) * (1.0f / 1024.0f) + 1e-6f);
            float ss = 0.f;
#pragma unroll
            for (int nt = 0; nt < 4; ++nt) {
                const int col = un * 256 + 64 * wn + 16 * nt + 4 * q4;
                const f32x4 xo = *(const f32x4*)(xold + (size_t)tok * 1024 + col);
                const f32x4 gg = *(const f32x4*)(g + col);
                const f32x4 v = xo + acc[mt][nt] * rr * gg;
                acc[mt][nt] = v;
                *(f32x4*)(xout + (size_t)tok * 1024 + col) = v;
                ss += v[0] * v[0] + v[1] * v[1] + v[2] * v[2] + v[3] * v[3];
            }
            ss += __shfl_xor(ss, 16); ss += __shfl_xor(ss, 32);
            if (q4 == 0) P[(128 * wm + 16 * mt + r16) * 4 + wn] = ss;
            asm volatile("" ::: "memory");
        }
        if (want_xn) {
            __syncthreads();
            float* slots2 = slots + (size_t)T_ * 4;
            if (tid < 256) slots2[(size_t)(um * 256 + tid) * 4 + un] = (P[tid * 4] + P[tid * 4 + 1]) + (P[tid * 4 + 2] + P[tid * 4 + 3]);
            xcd_barrier(xb);
#pragma unroll
            for (int mt = 0; mt < 8; ++mt) {
                const int tok = um * 256 + 128 * wm + 16 * mt + r16;
                const f32x4 sl = *(const f32x4*)(slots2 + (size_t)tok * 4);
                const float rr = rsqrtf(((sl[0] + sl[1]) + (sl[2] + sl[3])) * (1.0f / 1024.0f) + 1e-6f);
#pragma unroll
                for (int nt = 0; nt < 4; ++nt) {
                    const int col = un * 256 + 64 * wn + 16 * nt + 4 * q4;
                    u32x2 w; w.x = pack2(acc[mt][nt][0] * rr, acc[mt][nt][1] * rr); w.y = pack2(acc[mt][nt][2] * rr, acc[mt][nt][3] * rr);
                    *(u32x2*)(xn + (size_t)tok * 1024 + col) = w;
                }
            }
        }
        __syncthreads();
    }
};
struct EpiUq {
    static constexpr bool STAGED = false;
    bf16_t* Qm; const float* rq; float sc;
    DI void row(int tok, int colbase, int q4, const f32x4 (&a)[4]) const {
        const float r = rq[tok] * sc;
        const int b = tok >> 13, t = tok & (L_ - 1);
#pragma unroll
        for (int nt = 0; nt < 4; ++nt) {
            const int col = colbase + 16 * nt + 4 * q4;
            if (col >= 384) continue;
            const int head = col / 96, j = col - head * 96;
            bf16_t* dst = Qm + ((size_t)(b * 4 + head) * L_ + t) * 96;
            if (j < 64) {
                u32x2 w; w.x = pack2(a[nt][0] * r, a[nt][1] * r); w.y = pack2(a[nt][2] * r, a[nt][3] * r);
                *(u32x2*)(dst + j) = w;
            } else if (j < 80) {
                if (nt < 3) {
                    const int p0 = j - 64;
                    float o1[4], o2[4];
#pragma unroll
                    for (int i = 0; i < 4; ++i) {
                        const int pp = p0 + i;
                        const float inv = __expf(-(float)(pp & 7) * (9.210340371976184f / 8.0f));
                        const float ang = (float)((pp < 8) ? (t >> 6) : (t & 63)) * inv;
                        float sn, cs; fast_sincos(ang, &sn, &cs);
                        const float x1 = a[nt][i] * r, x2 = a[(nt < 3) ? nt + 1 : 3][i] * r;
                        o1[i] = x1 * cs - x2 * sn; o2[i] = x1 * sn + x2 * cs;
                    }
                    u32x2 w; w.x = pack2(o1[0], o1[1]); w.y = pack2(o1[2], o1[3]);
                    *(u32x2*)(dst + j) = w;
                    w.x = pack2(o2[0], o2[1]); w.y = pack2(o2[2], o2[3]);
                    *(u32x2*)(dst + j + 16) = w;
                }
            }
        }
    }
};
struct EpiUkv {
    static constexpr bool STAGED = false;
    bf16_t* Km; bf16_t* VmT; const float* rkv;
    DI void row(int tok, int colbase, int q4, const f32x4 (&a)[4]) const {
        const float r = rkv[tok];
        const int b = tok >> 13, t = tok & (L_ - 1);
#pragma unroll
        for (int nt = 0; nt < 4; ++nt) {
            const int col = colbase + 16 * nt + 4 * q4;
            const int head = col >> 7, j = col & 127;
            if (j < 64) {
                u32x2 w; w.x = pack2(a[nt][0] * r, a[nt][1] * r); w.y = pack2(a[nt][2] * r, a[nt][3] * r);
                *(u32x2*)(Km + ((size_t)(b * 4 + head) * L_ + t) * 96 + j) = w;
            } else {
#pragma unroll
                for (int i = 0; i < 4; ++i) VmT[((size_t)(b * 4 + head) * 64 + (j - 64 + i)) * L_ + perm16(t)] = f2bf(a[nt][i] * r);
            }
        }
    }
};
DI float gelu_tanh(float x) {
    const float x2 = x * x;
    const float w = x * (-2.302208198f - 0.1029432397f * x2);
    return x * __builtin_amdgcn_rcpf(1.0f + __builtin_amdgcn_exp2f(w));
}
struct EpiUp {
    static constexpr bool STAGED = true;
    bf16_t* act; const float* cw; const float* cb;
    DI void staged(unsigned char* lds, const f32x4 (&acc)[8][4], int um, int un, int wm, int wn, int r16, int q4) const {
        bf16_t* st = (bf16_t*)lds;
#pragma unroll
        for (int mt = 0; mt < 8; ++mt)
#pragma unroll
            for (int nt = 0; nt < 4; ++nt) {
                u32x2 w; w.x = pack2(acc[mt][nt][0], acc[mt][nt][1]); w.y = pack2(acc[mt][nt][2], acc[mt][nt][3]);
                *(u32x2*)(st + (128 * wm + 16 * mt + r16) * 264 + 64 * wn + 16 * nt + 4 * q4) = w;
            }
        __syncthreads();
        const int tid = threadIdx.x, jp = tid & 31, hf = (tid >> 5) & 1, seg = __builtin_amdgcn_readfirstlane(tid >> 6);
        const int bb = um / 33, t0 = 254 * (um % 33) - 1;
        const int r0 = 32 * seg;
        const int ch = 64 * (2 * un + hf) + 2 * jp;
        float g0[2], g1[2], g2[2], gb[2], v0[2], v1[2], v2[2], vb[2];
#pragma unroll
        for (int e = 0; e < 2; ++e) {
            g0[e] = cw[ch + e]; g1[e] = cw[5632 + ch + e]; g2[e] = cw[2 * 5632 + ch + e]; gb[e] = cb[ch + e];
            v0[e] = cw[2816 + ch + e]; v1[e] = cw[5632 + 2816 + ch + e]; v2[e] = cw[2 * 5632 + 2816 + ch + e]; vb[e] = cb[2816 + ch + e];
        }
        const int rlo = (t0 < 0) ? -t0 : 0, rhi = (L_ - 1 - t0 < 255) ? (L_ - 1 - t0) : 255;
        const bf16_t* sp = st + r0 * 264 + 128 * hf + 2 * jp;
        const bool pv = (r0 - 1 >= rlo) && (r0 - 1 <= rhi), cvd = (r0 >= rlo) && (r0 <= rhi);
        unsigned gpw = pv ? *(const unsigned*)(sp - 264) : 0u, vpw = pv ? *(const unsigned*)(sp - 264 + 64) : 0u;
        unsigned gcw = cvd ? *(const unsigned*)sp : 0u, vcw = cvd ? *(const unsigned*)(sp + 64) : 0u;
        bf16_t* dst = act + (size_t)(bb * L_ + t0 + r0) * 2816 + ch;
#define LO(w) __uint_as_float((w) << 16)
#define HI(w) __uint_as_float((w) & 0xffff0000u)
#pragma unroll 4
        for (int i = 0; i < 32; ++i) {
            const int r = r0 + i;
            const bool nv = (r + 1 >= rlo) && (r + 1 <= rhi);
            const unsigned gnw = nv ? *(const unsigned*)(sp + (i + 1) * 264) : 0u, vnw = nv ? *(const unsigned*)(sp + (i + 1) * 264 + 64) : 0u;
            if (r >= 1 && r <= 254 && r <= rhi) {
                const float cg0 = g0[0] * LO(gpw) + g1[0] * LO(gcw) + g2[0] * LO(gnw) + gb[0];
                const float cv0 = v0[0] * LO(vpw) + v1[0] * LO(vcw) + v2[0] * LO(vnw) + vb[0];
                const float cg1 = g0[1] * HI(gpw) + g1[1] * HI(gcw) + g2[1] * HI(gnw) + gb[1];
                const float cv1 = v0[1] * HI(vpw) + v1[1] * HI(vcw) + v2[1] * HI(vnw) + vb[1];
                *(unsigned*)(dst + (size_t)i * 2816) = pack2(gelu_tanh(cg0) * cv0, gelu_tanh(cg1) * cv1);
            }
            gpw = gcw; gcw = gnw; vpw = vcw; vcw = vnw;
        }
#undef LO
#undef HI
        __syncthreads();
    }
};

DI void prep_phase(const Params& p, int l) {
    const int tid_ = tid_fresh(); const int lane = tid_ & 63, wid = tid_ >> 6;
    const bf16_t* projb = (const bf16_t*)(p.ws + O_PROJB);
    bf16_t* Qg = (bf16_t*)(p.ws + O_QG); bf16_t* Kg = (bf16_t*)(p.ws + O_KG); bf16_t* VgT = (bf16_t*)(p.ws + O_VGT);
    bf16_t* Km = (bf16_t*)(p.ws + O_KM);
    float* rq = (float*)(p.ws + O_RQ); float* rkv = (float*)(p.ws + O_RKV);
    const float* gq = p.in[13] + l * 64; const float* gk = p.in[14] + l * 64;
    const int hd = lane >> 3, sub = lane & 7;
    float gq1[4], gq2[4], gk1[4], gk2[4];
#pragma unroll
    for (int i = 0; i < 4; ++i) { gq1[i] = gq[4 * sub + i]; gq2[i] = gq[32 + 4 * sub + i]; gk1[i] = gk[4 * sub + i]; gk2[i] = gk[32 + 4 * sub + i]; }
    const float qscale = 0.125f * 1.4426950408889634f;
    for (int tok = blockIdx.x * 8 + wid; tok < T_; tok += gridDim.x * 8) {
        const int b = tok >> 13, t = tok & (L_ - 1);
        const bf16_t* pr = projb + (size_t)tok * 1184;
        float cs[4], sn[4];
#pragma unroll
        for (int i = 0; i < 4; ++i) {
            const int pp = 4 * sub + i;
            const float inv = __expf(-(float)(pp & 15) * (9.210340371976184f / 16.0f));
            const float ang = (float)((pp < 16) ? (t >> 6) : (t & 63)) * inv;
            fast_sincos(ang, &sn[i], &cs[i]);
        }
        {
            const u32x2 w1 = *(const u32x2*)(pr + hd * 64 + 4 * sub), w2 = *(const u32x2*)(pr + hd * 64 + 32 + 4 * sub);
            float x1[4] = {bf2f((bf16_t)(w1.x & 0xffff)), bf2f((bf16_t)(w1.x >> 16)), bf2f((bf16_t)(w1.y & 0xffff)), bf2f((bf16_t)(w1.y >> 16))};
            float x2[4] = {bf2f((bf16_t)(w2.x & 0xffff)), bf2f((bf16_t)(w2.x >> 16)), bf2f((bf16_t)(w2.y & 0xffff)), bf2f((bf16_t)(w2.y >> 16))};
            float ss = 0.f;
#pragma unroll
            for (int i = 0; i < 4; ++i) ss += x1[i] * x1[i] + x2[i] * x2[i];
            ss += __shfl_xor(ss, 1); ss += __shfl_xor(ss, 2); ss += __shfl_xor(ss, 4);
            const float r = rsqrtf(ss * (1.0f / 64.0f) + 1e-6f);
            float o1[4], o2[4];
#pragma unroll
            for (int i = 0; i < 4; ++i) { const float a = x1[i] * r * gq1[i], c = x2[i] * r * gq2[i]; o1[i] = (a * cs[i] - c * sn[i]) * qscale; o2[i] = (a * sn[i] + c * cs[i]) * qscale; }
            bf16_t* dst = Qg + ((size_t)(b * 8 + hd) * L_ + t) * 64;
            u32x2 w; w.x = pack2(o1[0], o1[1]); w.y = pack2(o1[2], o1[3]); *(u32x2*)(dst + 4 * sub) = w;
            w.x = pack2(o2[0], o2[1]); w.y = pack2(o2[2], o2[3]); *(u32x2*)(dst + 32 + 4 * sub) = w;
        }
        if (lane < 16) {
            const u32x2 w1 = *(const u32x2*)(pr + 512 + hd * 64 + 4 * sub), w2 = *(const u32x2*)(pr + 512 + hd * 64 + 32 + 4 * sub);
            float x1[4] = {bf2f((bf16_t)(w1.x & 0xffff)), bf2f((bf16_t)(w1.x >> 16)), bf2f((bf16_t)(w1.y & 0xffff)), bf2f((bf16_t)(w1.y >> 16))};
            float x2[4] = {bf2f((bf16_t)(w2.x & 0xffff)), bf2f((bf16_t)(w2.x >> 16)), bf2f((bf16_t)(w2.y & 0xffff)), bf2f((bf16_t)(w2.y >> 16))};
            float ss = 0.f;
#pragma unroll
            for (int i = 0; i < 4; ++i) ss += x1[i] * x1[i] + x2[i] * x2[i];
            ss += __shfl_xor(ss, 1); ss += __shfl_xor(ss, 2); ss += __shfl_xor(ss, 4);
            const float r = rsqrtf(ss * (1.0f / 64.0f) + 1e-6f);
            float o1[4], o2[4];
#pragma unroll
            for (int i = 0; i < 4; ++i) { const float a = x1[i] * r * gk1[i], c = x2[i] * r * gk2[i]; o1[i] = a * cs[i] - c * sn[i]; o2[i] = a * sn[i] + c * cs[i]; }
            bf16_t* dst = Kg + ((size_t)(b * 2 + hd) * L_ + t) * 64;
            u32x2 w; w.x = pack2(o1[0], o1[1]); w.y = pack2(o1[2], o1[3]); *(u32x2*)(dst + 4 * sub) = w;
            w.x = pack2(o2[0], o2[1]); w.y = pack2(o2[2], o2[3]); *(u32x2*)(dst + 32 + 4 * sub) = w;
        }
        {
            const unsigned w = *(const unsigned*)(pr + 640 + 2 * lane);
            const int c0 = 2 * lane, kh = c0 >> 6, d = c0 & 63;
            bf16_t* dst = VgT + ((size_t)(b * 2 + kh) * 64 + d) * L_ + perm16(t);
            dst[0] = (bf16_t)(w & 0xffff); dst[L_] = (bf16_t)(w >> 16);
        }
        {
            const u32x2 w = *(const u32x2*)(pr + 768 + 4 * lane);
            const float a0 = bf2f((bf16_t)(w.x & 0xffff)), a1 = bf2f((bf16_t)(w.x >> 16)), a2 = bf2f((bf16_t)(w.y & 0xffff)), a3 = bf2f((bf16_t)(w.y >> 16));
            float ss = wave_sum(a0 * a0 + a1 * a1 + a2 * a2 + a3 * a3);
            if (lane == 0) rq[tok] = rsqrtf(ss * (1.0f / 256.0f) + 1e-6f);
        }
        {
            const unsigned w = *(const unsigned*)(pr + 1024 + 2 * lane);
            const float a0 = bf2f((bf16_t)(w & 0xffff)), a1 = bf2f((bf16_t)(w >> 16));
            float ss = wave_sum(a0 * a0 + a1 * a1);
            if (lane == 0) rkv[tok] = rsqrtf(ss * (1.0f / 128.0f) + 1e-6f);
        }
        if (lane < 16) {
            const float x1 = bf2f(pr[1152 + lane]), x2 = bf2f(pr[1152 + 16 + lane]);
            const float inv = __expf(-(float)(lane & 7) * (9.210340371976184f / 8.0f));
            const float ang = (float)((lane < 8) ? (t >> 6) : (t & 63)) * inv;
            float s1, c1; fast_sincos(ang, &s1, &c1);
            const bf16_t o1 = f2bf(x1 * c1 - x2 * s1), o2 = f2bf(x1 * s1 + x2 * c1);
#pragma unroll
            for (int hh = 0; hh < 4; ++hh) { bf16_t* dst = Km + ((size_t)(b * 4 + hh) * L_ + t) * 96 + 64; dst[lane] = o1; dst[16 + lane] = o2; }
        }
    }
}

template <int DQK> DI int kswz(int row, int chunk) {
    if (DQK == 64) return row * 128 + ((chunk ^ ((row >> 1) & 7)) << 4);
    else return row * 192 + ((chunk ^ ((row >> 2) & 3)) << 4);
}
template <int DQK>
DI void attn_unit(unsigned char* lds, const bf16_t* __restrict__ Qp, const bf16_t* __restrict__ Kp, const bf16_t* __restrict__ VTp, bf16_t* __restrict__ Yp  ) {
    constexpr int NS = DQK / 16, NC = DQK / 8, KB = 64 * DQK * 2, KVB = KB + 8192;
    const int tid = tid_fresh(), lane = tid & 63, w = tid >> 6, r = lane & 31, h = lane >> 5;
    bf16x8 qf[NS];
#pragma unroll
    for (int s = 0; s < NS; ++s) qf[s] = *(const bf16x8*)(Qp + (size_t)(32 * w + r) * DQK + 16 * s + 8 * h);
    f32x16 o0, o1;
#pragma unroll
    for (int i = 0; i < 16; ++i) { o0[i] = 0.f; o1[i] = 0.f; }
    float m = 0.f, lsum = 0.f;
    const int k_row0 = tid / NC, k_c0 = tid % NC;
    const int k_row1 = (tid + 512) / NC, k_c1 = (tid + 512) % NC;
    const bool k_two = (DQK == 96) && (tid < 256);
    const int v_row = tid >> 3, v_c = tid & 7;
    u32x4 rkA0, rkA1, rvA, rkB0, rkB1, rvB;
    rkA1 = (u32x4){0u, 0u, 0u, 0u}; rkB1 = rkA1;
#define A_LOAD(kt, R0, R1, RV) do { R0 = *(const u32x4*)(Kp + (size_t)((kt) * 64 + k_row0) * DQK + k_c0 * 8); \
                        if (k_two) R1 = *(const u32x4*)(Kp + (size_t)((kt) * 64 + k_row1) * DQK + k_c1 * 8); \
                        RV = *(const u32x4*)(VTp + (size_t)v_row * L_ + (kt) * 64 + v_c * 8); } while (0)
#define A_STORE(buf, R0, R1, RV) do { *(u32x4*)(lds + (buf) * KVB + kswz<DQK>(k_row0, k_c0)) = R0; \
                          if (k_two) *(u32x4*)(lds + (buf) * KVB + kswz<DQK>(k_row1, k_c1)) = R1; \
                          *(u32x4*)(lds + (buf) * KVB + KB + swz128(v_row, v_c)) = RV; } while (0)
    A_LOAD(0, rkA0, rkA1, rvA);
    A_LOAD(1, rkB0, rkB1, rvB);
    A_STORE(0, rkA0, rkA1, rvA);
    __syncthreads();
    constexpr int NKT = L_ / 64;
#pragma unroll 1
    for (int kt2 = 0; kt2 < NKT; kt2 += 2) {
#pragma unroll
      for (int cur = 0; cur < 2; ++cur) {
        const int kt = kt2 + cur;
        if (kt + 2 < NKT) { if (cur == 0) A_LOAD(kt + 2, rkA0, rkA1, rvA); else A_LOAD(kt + 2, rkB0, rkB1, rvB); }
        const unsigned char* lk = lds + cur * KVB;
        const unsigned char* lv = lk + KB;
        f32x16 s0, s1;
        const float negm = -m;
#pragma unroll
        for (int i = 0; i < 16; ++i) { s0[i] = negm; s1[i] = negm; }
#pragma unroll
        for (int s = 0; s < NS; ++s) {
            const bf16x8 k0 = *(const bf16x8*)(lk + kswz<DQK>(r, 2 * s + h));
            const bf16x8 k1 = *(const bf16x8*)(lk + kswz<DQK>(32 + r, 2 * s + h));
            s0 = __builtin_amdgcn_mfma_f32_32x32x16_bf16(k0, qf[s], s0, 0, 0, 0);
            s1 = __builtin_amdgcn_mfma_f32_32x32x16_bf16(k1, qf[s], s1, 0, 0, 0);
        }
        float mx = fmaxf(fmaxf(s0[0], s0[1]), s0[2]);
#pragma unroll
        for (int i = 3; i < 15; i += 2) mx = fmaxf(fmaxf(mx, s0[i]), s0[i + 1]);
        mx = fmaxf(mx, s0[15]);
#pragma unroll
        for (int i = 0; i < 16; i += 2) mx = fmaxf(fmaxf(mx, s1[i]), s1[i + 1]);
        mx = fmaxf(mx, __shfl_xor(mx, 32));
        if (kt == 0 || __any(mx > 8.0f)) {
            const float dm = (kt == 0) ? mx : fmaxf(mx, 0.f);
            const float alpha = (kt == 0) ? 0.f : __builtin_amdgcn_exp2f(-dm);
            m += dm;
            lsum *= alpha;
#pragma unroll
            for (int i = 0; i < 16; ++i) { o0[i] *= alpha; o1[i] *= alpha; s0[i] -= dm; s1[i] -= dm; }
        }
        float ps = 0.f;
#pragma unroll
        for (int i = 0; i < 16; ++i) { s0[i] = __builtin_amdgcn_exp2f(s0[i]); ps += s0[i]; }
#pragma unroll
        for (int i = 0; i < 16; ++i) { s1[i] = __builtin_amdgcn_exp2f(s1[i]); ps += s1[i]; }
        lsum += ps;
#pragma unroll
        for (int sub = 0; sub < 2; ++sub)
#pragma unroll
            for (int s2 = 0; s2 < 2; ++s2) {
                u32x4 pw;
                if (sub == 0) { pw.x = pack2(s0[8 * s2 + 0], s0[8 * s2 + 1]); pw.y = pack2(s0[8 * s2 + 2], s0[8 * s2 + 3]); pw.z = pack2(s0[8 * s2 + 4], s0[8 * s2 + 5]); pw.w = pack2(s0[8 * s2 + 6], s0[8 * s2 + 7]); }
                else          { pw.x = pack2(s1[8 * s2 + 0], s1[8 * s2 + 1]); pw.y = pack2(s1[8 * s2 + 2], s1[8 * s2 + 3]); pw.z = pack2(s1[8 * s2 + 4], s1[8 * s2 + 5]); pw.w = pack2(s1[8 * s2 + 6], s1[8 * s2 + 7]); }
                const bf16x8 pf = __builtin_bit_cast(bf16x8, pw);
                const bf16x8 vf0 = *(const bf16x8*)(lv + swz128(r, 4 * sub + 2 * s2 + h));
                const bf16x8 vf1 = *(const bf16x8*)(lv + swz128(32 + r, 4 * sub + 2 * s2 + h));
                o0 = __builtin_amdgcn_mfma_f32_32x32x16_bf16(vf0, pf, o0, 0, 0, 0);
                o1 = __builtin_amdgcn_mfma_f32_32x32x16_bf16(vf1, pf, o1, 0, 0, 0);
            }
        if (kt + 1 < NKT) { if (cur == 0) A_STORE(1, rkB0, rkB1, rvB); else A_STORE(0, rkA0, rkA1, rvA); }
        __syncthreads();
      }
    }
#undef A_LOAD
#undef A_STORE
    const float lt = lsum + __shfl_xor(lsum, 32);
    const float inv = 1.0f / lt;
    bf16_t* yr = Yp + (size_t)(32 * w + r) * 768;
#pragma unroll
    for (int g = 0; g < 4; ++g) {
        u32x2 wv; wv.x = pack2(o0[4 * g] * inv, o0[4 * g + 1] * inv); wv.y = pack2(o0[4 * g + 2] * inv, o0[4 * g + 3] * inv);
        *(u32x2*)(yr + 8 * g + 4 * h) = wv;
        wv.x = pack2(o1[4 * g] * inv, o1[4 * g + 1] * inv); wv.y = pack2(o1[4 * g + 2] * inv, o1[4 * g + 3] * inv);
        *(u32x2*)(yr + 32 + 8 * g + 4 * h) = wv;
    }
}

DI int pa(int e) { return e + (e >> 4); }
DI float2 cmul(float2 a, float2 b) { return make_float2(a.x * b.x - a.y * b.y, a.x * b.y + a.y * b.x); }
DI float2 cadd(float2 a, float2 b) { return make_float2(a.x + b.x, a.y + b.y); }
DI float2 csub(float2 a, float2 b) { return make_float2(a.x - b.x, a.y - b.y); }
template <bool INV> DI void dft4(float2& a, float2& b, float2& c, float2& d) {
    const float2 t0 = cadd(a, c), t1 = csub(a, c), t2 = cadd(b, d), t3 = csub(b, d);
    const float2 jt3 = INV ? make_float2(-t3.y, t3.x) : make_float2(t3.y, -t3.x);
    a = cadd(t0, t2); c = csub(t0, t2); b = cadd(t1, jt3); d = csub(t1, jt3);
}
template <bool INV> DI float2 tw16(float2 v, int k) {
    const float c1 = 0.9238795325112867f, s1 = 0.3826834323650898f, c2 = 0.7071067811865476f;
    float wr = 1.f, wi = 0.f;
    switch (k) {
        case 0: wr = 1.f; wi = 0.f; break;
        case 1: wr = c1; wi = -s1; break;
        case 2: wr = c2; wi = -c2; break;
        case 3: wr = s1; wi = -c1; break;
        case 4: wr = 0.f; wi = -1.f; break;
        case 6: wr = -c2; wi = -c2; break;
        case 9: wr = -c1; wi = s1; break;
        default: break;
    }
    if (INV) wi = -wi;
    return make_float2(v.x * wr - v.y * wi, v.x * wi + v.y * wr);
}
template <bool INV> DI void dft16(float2 (&x)[16]) {
#pragma unroll
    for (int b = 0; b < 4; ++b) dft4<INV>(x[b], x[b + 4], x[b + 8], x[b + 12]);
#pragma unroll
    for (int b = 1; b < 4; ++b)
#pragma unroll
        for (int pq = 1; pq < 4; ++pq) x[b + 4 * pq] = tw16<INV>(x[b + 4 * pq], b * pq);
#pragma unroll
    for (int pq = 0; pq < 4; ++pq) dft4<INV>(x[4 * pq], x[4 * pq + 1], x[4 * pq + 2], x[4 * pq + 3]);
#pragma unroll
    for (int a = 0; a < 4; ++a)
#pragma unroll
        for (int b = a + 1; b < 4; ++b) { const float2 tmp = x[4 * a + b]; x[4 * a + b] = x[4 * b + a]; x[4 * b + a] = tmp; }
}
template <bool INV> DI void pass_a(float2* Z, const float2* T1, int tid) {
#pragma unroll
    for (int i = 0; i < 8; ++i) {
        const int j = tid + 512 * i;
        float2* zp = Z + pa(j);
        float2 x0 = zp[0], x1 = zp[4352], x2 = zp[8704], x3 = zp[13056];
        float2 w1 = tw16<false>(T1[j & 1023], i >> 1);
        if (INV) w1.y = -w1.y;
        const float2 w2 = cmul(w1, w1), w3 = cmul(w2, w1);
        if (!INV) { dft4<false>(x0, x1, x2, x3); x1 = cmul(x1, w1); x2 = cmul(x2, w2); x3 = cmul(x3, w3); }
        else { x1 = cmul(x1, w1); x2 = cmul(x2, w2); x3 = cmul(x3, w3); dft4<true>(x0, x1, x2, x3); }
        zp[0] = x0; zp[4352] = x1; zp[8704] = x2; zp[13056] = x3;
    }
}
template <bool INV, int LS, int TS> DI void pass16(float2* Z, const float2* T1, int tid) {
#pragma unroll 1
    for (int i = 0; i < 2; ++i) {
        const int id = tid + 512 * i, j = id & ((1 << LS) - 1), base = (id >> LS) << (LS + 4);
        float2* zp = Z + pa(base + j);
        float2 x[16];
#pragma unroll
        for (int mm = 0; mm < 16; ++mm) x[mm] = zp[mm * ((1 << LS) + (1 << (LS - 4)))];
        float2 w1 = T1[j << TS];
        if (INV) w1.y = -w1.y;
        if (!INV) dft16<false>(x);
        float2 wq = w1;
#pragma unroll
        for (int qq = 1; qq < 16; ++qq) { x[qq] = cmul(x[qq], wq); wq = cmul(wq, w1); }
        if (INV) dft16<true>(x);
#pragma unroll
        for (int mm = 0; mm < 16; ++mm) zp[mm * ((1 << LS) + (1 << (LS - 4)))] = x[mm];
    }
}
DI void pass_d_store(const float2* Z, float2* __restrict__ Kf, int tid, float scale) {
#pragma unroll 1
    for (int i = 0; i < 2; ++i) {
        const int id = tid + 512 * i, base = id * 16;
        float2 x[16];
#pragma unroll
        for (int mm = 0; mm < 16; ++mm) x[mm] = Z[17 * id + mm];
        dft16<false>(x);
#pragma unroll
        for (int mm = 0; mm < 16; mm += 2) *(f32x4*)(Kf + base + mm) = (f32x4){x[mm].x * scale, x[mm].y * scale, x[mm + 1].x * scale, x[mm + 1].y * scale};
    }
}
DI void pass_d_lds(float2* Z, int tid) {
#pragma unroll 1
    for (int i = 0; i < 2; ++i) {
        const int id = tid + 512 * i, base = id * 16;
        float2 x[16];
#pragma unroll
        for (int mm = 0; mm < 16; ++mm) x[mm] = Z[17 * id + mm];
        dft16<false>(x);
#pragma unroll
        for (int mm = 0; mm < 16; ++mm) Z[17 * id + mm] = x[mm];
    }
}
DI void pass_d_mul(float2* Z, const float2* __restrict__ Kf, int tid) {
#pragma unroll 1
    for (int i = 0; i < 2; ++i) {
        const int id = tid + 512 * i, base = id * 16;
        float2 x[16];
#pragma unroll
        for (int mm = 0; mm < 16; ++mm) x[mm] = Z[17 * id + mm];
        dft16<false>(x);
#pragma unroll
        for (int mm = 0; mm < 16; mm += 2) {
            const f32x4 kk = *(const f32x4*)(Kf + base + mm);
            x[mm] = cmul(x[mm], make_float2(kk[0], kk[1])); x[mm + 1] = cmul(x[mm + 1], make_float2(kk[2], kk[3]));
        }
        dft16<true>(x);
#pragma unroll
        for (int mm = 0; mm < 16; ++mm) Z[17 * id + mm] = x[mm];
    }
}
DI void fft_conv(float2* Z, const float2* T1, const float2* Kf, int tid) {
    pass_a<false>(Z, T1, tid); __syncthreads();
    pass16<false, 8, 2>(Z, T1, tid); __syncthreads();
    pass16<false, 4, 6>(Z, T1, tid); __syncthreads();
    pass_d_mul(Z, Kf, tid); __syncthreads();
    pass16<true, 4, 6>(Z, T1, tid); __syncthreads();
    pass16<true, 8, 2>(Z, T1, tid); __syncthreads();
    pass_a<true>(Z, T1, tid); __syncthreads();
}

DI void hyena_unit(unsigned char* lds, const Params& p, int l, int c) {
    float2* Z = (float2*)lds;
    float2* T1 = (float2*)(lds + 139264);
    const int tid = tid_fresh();
    const float* hyT = (const float*)(p.ws + O_HYT);
    float2* Kf0 = (float2*)(p.ws + O_R1) + (size_t)c * 32768;
    float2* Kf1 = Kf0 + 16384;
    bf16_t* hyout = (bf16_t*)(p.ws + O_HYOUT) + (size_t)c * T_;
    for (int k = tid; k < 1024; k += NTHR) { float sn, cs; sincospif((float)k * (1.0f / 8192.0f), &sn, &cs); T1[k] = make_float2(cs, -sn); }
    __syncthreads();
    {
        const float* taps = (const float*)Kf1;
#pragma unroll 4
        for (int t = tid; t < L_; t += NTHR) { Z[pa(t)] = make_float2(taps[t], taps[2 * L_ + t]); Z[pa(16383 - t)] = make_float2(taps[L_ + t], taps[3 * L_ + t]); }
        __syncthreads();
        pass_a<false>(Z, T1, tid); __syncthreads();
        pass16<false, 8, 2>(Z, T1, tid); __syncthreads();
        pass16<false, 4, 6>(Z, T1, tid); __syncthreads();
        pass_d_lds(Z, tid); __syncthreads();
        const float sc = 0.5f / 16384.0f;
#pragma unroll 2
        for (int e = tid; e < 16384; e += NTHR) {
            const int a = e >> 12, b = (e >> 8) & 15, c4 = (e >> 4) & 15, d = e & 15;
            const int k = a + 4 * (b + 16 * (c4 + 16 * d));
            const int k2 = (16384 - k) & 16383;
            const int e2 = ((k2 & 3) << 12) | (((k2 >> 2) & 15) << 8) | (((k2 >> 6) & 15) << 4) | (k2 >> 10);
            const float2 z = Z[pa(e)], z2 = Z[pa(e2)];
            const float sx = z.x + z2.x, sy = z.y - z2.y, dx = z.x - z2.x, dy = z.y + z2.y;
            Kf0[e] = make_float2(sx * sc, sy * sc);
            Kf1[e] = make_float2(dy * sc, -dx * sc);
        }
        __syncthreads();
    }
    const float* cw = p.in[3] + (size_t)l * 3 * 768; const float* cb = p.in[4] + (size_t)l * 768;
    const float* skip = p.in[12] + (size_t)l * 2 * 256;
    float2* z1buf = Kf0;
    const float vw0 = cw[c], vw1 = cw[768 + c], vw2 = cw[1536 + c], vbb = cb[c];
    const float* uv = hyT + (size_t)c * T_;
#pragma unroll 2
    for (int t = tid; t < L_; t += NTHR) {
        float vv[2];
#pragma unroll
        for (int b = 0; b < 2; ++b) {
            const float* ub = uv + b * L_;
            const float um = (t > 0) ? ub[t - 1] : 0.f, uc = ub[t], up = (t < L_ - 1) ? ub[t + 1] : 0.f;
            vv[b] = vw0 * um + vw1 * uc + vw2 * up + vbb;
        }
        Z[pa(t)] = make_float2(vv[0], vv[1]); Z[pa(t + L_)] = make_float2(0.f, 0.f);
    }
    __syncthreads();
    __threadfence();
    fft_conv(Z, T1, Kf0, tid);
    {
        const int ch = 256 + c;
        const float w0 = cw[ch], w1 = cw[768 + ch], w2 = cw[1536 + ch], bb = cb[ch], sk = skip[c];
        const float* u0 = hyT + (size_t)ch * T_;
#pragma unroll 2
        for (int t = tid; t < L_; t += NTHR) {
            const float2 y = Z[pa(t)];
            float zz[2];
#pragma unroll
            for (int b = 0; b < 2; ++b) {
                const float* ub = u0 + b * L_;
                const float um = (t > 0) ? ub[t - 1] : 0.f, uc = ub[t], up = (t < L_ - 1) ? ub[t + 1] : 0.f;
                const float g = w0 * um + w1 * uc + w2 * up + bb;
                const float* vb = uv + b * L_;
                const float vm = (t > 0) ? vb[t - 1] : 0.f, vc = vb[t], vp = (t < L_ - 1) ? vb[t + 1] : 0.f;
                const float v = vw0 * vm + vw1 * vc + vw2 * vp + vbb;
                zz[b] = g * ((b ? y.y : y.x) + sk * v);
            }
            const float2 z1 = make_float2(zz[0], zz[1]);
            Z[pa(t)] = z1; Z[pa(t + L_)] = make_float2(0.f, 0.f);
            z1buf[t] = z1;
        }
    }
    __syncthreads();
    fft_conv(Z, T1, Kf1, tid);
    {
        const int ch = 512 + c;
        const float w0 = cw[ch], w1 = cw[768 + ch], w2 = cw[1536 + ch], bb = cb[ch], sk = skip[256 + c];
        const float* u0 = hyT + (size_t)ch * T_;
#pragma unroll 2
        for (int t = tid; t < L_; t += NTHR) {
            const float2 y = Z[pa(t)];
            const float2 z1 = z1buf[t];
#pragma unroll
            for (int b = 0; b < 2; ++b) {
                const float* ub = u0 + b * L_;
                const float um = (t > 0) ? ub[t - 1] : 0.f, uc = ub[t], up = (t < L_ - 1) ? ub[t + 1] : 0.f;
                const float g = w0 * um + w1 * uc + w2 * up + bb;
                hyout[b * L_ + t] = f2bf(g * ((b ? y.y : y.x) + sk * (b ? z1.y : z1.x)));
            }
        }
    }
    __syncthreads();
}

DI void groups_phase(unsigned char* lds, const Params& p) {
    bf16_t* tile = (bf16_t*)lds;
    const int tid = tid_fresh(), lane = tid & 63, wid = tid >> 6;
    const bf16_t* hyout = (const bf16_t*)(p.ws + O_HYOUT);
    const bf16_t* Y = (const bf16_t*)(p.ws + O_PROJB);
    bf16_t* G = (bf16_t*)(p.ws + O_HYT);
    for (int u = blockIdx.x; u < T_ / 64; u += gridDim.x) {
        const int tok0 = u * 64;
        {
            const int c = tid >> 1, hf = tid & 1;
            const u32x4* src = (const u32x4*)(hyout + (size_t)c * T_ + tok0 + hf * 32);
#pragma unroll
            for (int i = 0; i < 4; ++i) {
                const u32x4 v = src[i];
                unsigned* d = (unsigned*)(tile + c * 66 + hf * 32 + i * 8);
                d[0] = v.x; d[1] = v.y; d[2] = v.z; d[3] = v.w;
            }
        }
        __syncthreads();
#pragma unroll 1
        for (int i = 0; i < 8; ++i) {
            const int tl = wid * 8 + i, tok = tok0 + tl;
            float hv[4]; float sh = 0.f;
#pragma unroll
            for (int k = 0; k < 4; ++k) { hv[k] = bf2f(tile[(lane + 64 * k) * 66 + tl]); sh += hv[k] * hv[k]; }
            sh = wave_sum(sh);
            const float rh = rsqrtf(sh * (1.0f / 256.0f) + 1e-6f);
            bf16_t* gr = G + (size_t)tok * 1024;
#pragma unroll
            for (int k = 0; k < 4; ++k) gr[lane + 64 * k] = f2bf(hv[k] * rh);
            const bf16_t* yr = Y + (size_t)tok * 768;
            {
                const u32x4 v = *(const u32x4*)(yr + lane * 8);
                float a[8] = {bf2f((bf16_t)(v.x & 0xffff)), bf2f((bf16_t)(v.x >> 16)), bf2f((bf16_t)(v.y & 0xffff)), bf2f((bf16_t)(v.y >> 16)),
                              bf2f((bf16_t)(v.z & 0xffff)), bf2f((bf16_t)(v.z >> 16)), bf2f((bf16_t)(v.w & 0xffff)), bf2f((bf16_t)(v.w >> 16))};
                float ss = 0.f;
#pragma unroll
                for (int k = 0; k < 8; ++k) ss += a[k] * a[k];
                ss = wave_sum(ss);
                const float rr = rsqrtf(ss * (1.0f / 512.0f) + 1e-6f);
                u32x4 w; w.x = pack2(a[0] * rr, a[1] * rr); w.y = pack2(a[2] * rr, a[3] * rr); w.z = pack2(a[4] * rr, a[5] * rr); w.w = pack2(a[6] * rr, a[7] * rr);
                *(u32x4*)(gr + 256 + lane * 8) = w;
            }
            {
                const u32x2 v = *(const u32x2*)(yr + 512 + lane * 4);
                float a[4] = {bf2f((bf16_t)(v.x & 0xffff)), bf2f((bf16_t)(v.x >> 16)), bf2f((bf16_t)(v.y & 0xffff)), bf2f((bf16_t)(v.y >> 16))};
                float ss = wave_sum(a[0] * a[0] + a[1] * a[1] + a[2] * a[2] + a[3] * a[3]);
                const float rr = rsqrtf(ss * (1.0f / 256.0f) + 1e-6f);
                u32x2 w; w.x = pack2(a[0] * rr, a[1] * rr); w.y = pack2(a[2] * rr, a[3] * rr);
                *(u32x2*)(gr + 768 + lane * 4) = w;
            }
        }
        __syncthreads();
    }
}


extern __shared__ __attribute__((aligned(16))) unsigned char smem[];

__global__ void __launch_bounds__(512) fwd_megakernel(Params p) {
    cg::grid_group grid = cg::this_grid();
    unsigned char* lds = smem;
    unsigned char* ws = p.ws;
    unsigned* bar = (unsigned*)(ws + O_BAR);
    volatile LAS unsigned* xb_st = (volatile LAS unsigned*)(smem + LDS_BYTES - 16);
    if (threadIdx.x < 4) xb_st[threadIdx.x] = 0u;
    __syncthreads();
    const XcdBarrier xb = xcd_barrier_post(bar, xb_st);
    if (p.ws == nullptr) grid.sync();
#pragma unroll 1
    for (int l2 = 0; l2 < 2 * REP_PRO; ++l2) { const int l = l2 & 1;
        convT(lds, p.in[2] + (size_t)l * 1024 * 1952, 1024, 1952, 2048, p.in[1] + l * 1024, (bf16_t*)(ws + O_WIN) + (size_t)l * 2048 * 1024, 0);
        convT(lds, p.in[16] + (size_t)l * 256 * 384, 256, 384, 512, p.in[15] + l * 256, (bf16_t*)(ws + O_WUQ) + (size_t)l * 512 * 256, 0);
        convT(lds, p.in[18] + (size_t)l * 128 * 512, 128, 512, 512, p.in[17] + l * 128, (bf16_t*)(ws + O_WUKV) + (size_t)l * 512 * 128, 0);
        convT(lds, p.in[22] + (size_t)l * 1024 * 1024, 1024, 1024, 1024, p.in[19] + l * 256, (bf16_t*)(ws + O_WOUT) + (size_t)l * 1024 * 1024, 2, p.in[20] + l * 512, p.in[21] + l * 256);
        convT(lds, p.in[25] + (size_t)l * 1024 * 5632, 1024, 5632, 5632, p.in[24] + l * 1024, (bf16_t*)(ws + O_WUP) + (size_t)l * 5632 * 1024, 1);
        convT(lds, p.in[28] + (size_t)l * 2816 * 1024, 2816, 1024, 1024, nullptr, (bf16_t*)(ws + O_WDOWN) + (size_t)l * 1024 * 2816, 0);
    }
#ifndef REP_MISC
#define REP_MISC 1
#endif
#pragma unroll 1
    for (int rep = 0; rep < REP_MISC; ++rep) { hy_h2_phase(lds, p);
    rownorm_phase(p.in[0], (bf16_t*)(ws + O_XN)); }
    XSYNC();


#pragma unroll 1
    for (int l = 0; l < 2; ++l) {
        {
            EpiIn e; e.hyT = (float*)(ws + O_HYT); e.projb = (bf16_t*)(ws + O_PROJB);
            gemm_phase<false>(lds, (const bf16_t*)(ws + O_XN), 1024, (const bf16_t*)(ws + O_WIN) + (size_t)l * 2048 * 1024, 1024, 64, 8, e);
        }
        XSYNC();
#pragma unroll 1
        for (int rep = 0; rep < REP_EW; ++rep) prep_phase(p, l);
#pragma unroll 1
        for (int rep = 0; rep < REP_MISC; ++rep) ft_phase(lds, p, l);
        XSYNC();
        {
            EpiUq e; e.Qm = (bf16_t*)(ws + O_QM); e.rq = (const float*)(ws + O_RQ); e.sc = 0.10206207261596577f * 1.4426950408889634f;
            const int hb = gridDim.x >> 1;
            if ((int)blockIdx.x < hb) gemm_phase<false>(lds, (const bf16_t*)(ws + O_PROJB) + 768, 1184, (const bf16_t*)(ws + O_WUQ) + (size_t)l * 512 * 256, 256, 64, 2, e, blockIdx.x, hb);
            EpiUkv e2; e2.Km = (bf16_t*)(ws + O_KM); e2.VmT = (bf16_t*)(ws + O_VMT); e2.rkv = (const float*)(ws + O_RKV);
            if ((int)blockIdx.x >= hb) gemm_phase<false>(lds, (const bf16_t*)(ws + O_PROJB) + 1024, 1184, (const bf16_t*)(ws + O_WUKV) + (size_t)l * 512 * 128, 128, 64, 2, e2, blockIdx.x - hb, gridDim.x - hb);
        }
        XSYNC();
#pragma unroll 1
        for (int rep = 0; rep < REP_HY; ++rep)
        for (int c = blockIdx.x; c < 256; c += gridDim.x) hyena_unit(lds, p, l, c);
#pragma unroll 1
        for (int rep = 0; rep < REP_ATTN; ++rep)
        for (int u = blockIdx.x; u < 512; u += gridDim.x) {
            const int qt = u & 31, hh = (u >> 5) & 7, b = u >> 8, hk = hh >> 2;
            attn_unit<64>(lds, (const bf16_t*)(ws + O_QG) + ((size_t)(b * 8 + hh) * L_ + qt * 256) * 64,
                          (const bf16_t*)(ws + O_KG) + (size_t)(b * 2 + hk) * L_ * 64,
                          (const bf16_t*)(ws + O_VGT) + (size_t)(b * 2 + hk) * 64 * L_,
                          (bf16_t*)(ws + O_PROJB) + (size_t)(b * L_ + qt * 256) * 768 + hh * 64);
        }
#pragma unroll 1
        for (int rep = 0; rep < REP_ATTN; ++rep)
        for (int u = blockIdx.x; u < 256; u += gridDim.x) {
            const int qt = u & 31, hh = (u >> 5) & 3, b = u >> 7;
            attn_unit<96>(lds, (const bf16_t*)(ws + O_QM) + ((size_t)(b * 4 + hh) * L_ + qt * 256) * 96,
                          (const bf16_t*)(ws + O_KM) + (size_t)(b * 4 + hh) * L_ * 96,
                          (const bf16_t*)(ws + O_VMT) + (size_t)(b * 4 + hh) * 64 * L_,
                          (bf16_t*)(ws + O_PROJB) + (size_t)(b * L_ + qt * 256) * 768 + 512 + hh * 64);
        }
        XSYNC();
#pragma unroll 1
        for (int rep = 0; rep < REP_EW; ++rep) groups_phase(lds, p);
        XSYNC();
        if (gridDim.x == 256) {
            EpiResid e; e.xold = (l == 0) ? p.in[0] : p.out; e.xout = p.out; e.xn = (bf16_t*)(ws + O_XN); e.g = p.in[23] + l * 1024; e.slots = (float*)(ws + O_SLOTS); e.xb = xb; e.want_xn = true;
            gemm_phase<false>(lds, (const bf16_t*)(ws + O_HYT), 1024, (const bf16_t*)(ws + O_WOUT) + (size_t)l * 1024 * 1024, 1024, 64, 4, e);
            XSYNC();
        } else {
            EpiF32 e; e.C = (float*)(ws + O_R1); e.ldc = 1024;
            gemm_phase<false>(lds, (const bf16_t*)(ws + O_HYT), 1024, (const bf16_t*)(ws + O_WOUT) + (size_t)l * 1024 * 1024, 1024, 64, 4, e);
            XSYNC();
            resid_phase((const float*)(ws + O_R1), l == 0 ? p.in[0] : p.out, p.in[23] + l * 1024, p.out, (bf16_t*)(ws + O_XN), true);
            XSYNC();
        }
        {
            EpiUp e; e.act = (bf16_t*)(ws + O_HYT); e.cw = p.in[26] + (size_t)l * 3 * 5632; e.cb = p.in[27] + (size_t)l * 5632;
            gemm_phase<true>(lds, (const bf16_t*)(ws + O_XN), 1024, (const bf16_t*)(ws + O_WUP) + (size_t)l * 5632 * 1024, 1024, 66, 22, e);
        }
        XSYNC();
        if (gridDim.x == 256) {
            EpiResid e; e.xold = p.out; e.xout = p.out; e.xn = (bf16_t*)(ws + O_XN); e.g = p.in[29] + l * 1024; e.slots = (float*)(ws + O_SLOTS); e.xb = xb; e.want_xn = (l == 0);
            gemm_phase<false>(lds, (const bf16_t*)(ws + O_HYT), 2816, (const bf16_t*)(ws + O_WDOWN) + (size_t)l * 1024 * 2816, 2816, 64, 4, e);
            if (l == 0) XSYNC();
        } else {
            EpiF32 e; e.C = (float*)(ws + O_R1); e.ldc = 1024;
            gemm_phase<false>(lds, (const bf16_t*)(ws + O_HYT), 2816, (const bf16_t*)(ws + O_WDOWN) + (size_t)l * 1024 * 2816, 2816, 64, 4, e);
            XSYNC();
            resid_phase((const float*)(ws + O_R1), p.out, p.in[29] + l * 1024, p.out, (bf16_t*)(ws + O_XN), l == 0);
            if (l == 0) XSYNC();
        }
    }
}

extern "C" void kernel_launch(void* const* d_in, const int* in_sizes, int n_in,
                              void* d_out, int out_size, void* d_ws, size_t ws_size,
                              hipStream_t stream) {
    static int grid_blocks = 0;
    if (!grid_blocks) {
        int dev = 0, cus = 0, per_cu = 0;
        (void)hipGetDevice(&dev);
        (void)hipDeviceGetAttribute(&cus, hipDeviceAttributeMultiprocessorCount, dev);
        (void)hipFuncSetAttribute((const void*)fwd_megakernel, hipFuncAttributeMaxDynamicSharedMemorySize, (int)LDS_BYTES);
        (void)hipOccupancyMaxActiveBlocksPerMultiprocessor(&per_cu, fwd_megakernel, NTHR, LDS_BYTES);
        if (per_cu < 1) per_cu = 1;
        grid_blocks = cus;
        if (grid_blocks > 256) grid_blocks = 256;
    }
    Params p{};
    for (int i = 0; i < 30; ++i) p.in[i] = (const float*)d_in[i];
    p.out = (float*)d_out; p.ws = (unsigned char*)d_ws;
    void* args[] = {&p};
    (void)hipMemsetAsync((unsigned char*)d_ws + O_BAR, 0, XCD_BAR_WORDS * sizeof(unsigned), stream);
    hipError_t e = hipLaunchCooperativeKernel((void*)fwd_megakernel, dim3(grid_blocks), dim3(NTHR), args, LDS_BYTES, stream);
    if (e != hipSuccess) fprintf(stderr, "cooperative launch failed: %s (grid %d)\n", hipGetErrorString(e), grid_blocks);
}
```

```cpp
#include <hip/hip_runtime.h>
#include <hip/hip_cooperative_groups.h>
#include <cstdio>
#include <cstdint>
namespace cg = cooperative_groups;

typedef unsigned short bf16_t;
typedef short bf16x8 __attribute__((ext_vector_type(8)));
typedef float f32x4 __attribute__((ext_vector_type(4)));
typedef float f32x16 __attribute__((ext_vector_type(16)));
typedef unsigned u32x2 __attribute__((ext_vector_type(2)));
typedef unsigned u32x4 __attribute__((ext_vector_type(4)));

#define DI __device__ __forceinline__
#ifndef REP_ATTN
#define REP_ATTN 1
#endif
#ifndef REP_HY
#define REP_HY 1
#endif
#ifndef REP_GEMM
#define REP_GEMM 1
#endif
#ifndef REP_PRO
#define REP_PRO 1
#endif
#ifndef REP_SYNC
#define REP_SYNC 1
#endif
#define XSYNC() do { _Pragma("unroll 1") for (int r_ = 0; r_ < REP_SYNC; ++r_) xcd_barrier(xb); } while (0)
#ifndef REP_EW
#define REP_EW 1
#endif
constexpr int L_ = 8192, T_ = 16384, NTHR = 512;
constexpr size_t MiB = 1u << 20;
constexpr size_t O_WIN = 0, O_WUQ = 8 * MiB, O_WUKV = 8 * MiB + 512 * 1024, O_RQ = 8 * MiB + 768 * 1024, O_RKV = 8 * MiB + 832 * 1024;
constexpr size_t O_BAR = 8 * MiB + 896 * 1024;
constexpr size_t O_WOUT = 9 * MiB, O_WUP = 13 * MiB, O_WDOWN = 35 * MiB, O_H2 = 46 * MiB;
constexpr size_t O_R1 = 50 * MiB;
constexpr size_t O_HYT = 114 * MiB;
constexpr size_t O_PROJB = 162 * MiB;
constexpr size_t O_HYOUT = 186 * MiB;
constexpr size_t O_QG = 199 * MiB, O_KG = 215 * MiB, O_VGT = 219 * MiB, O_QM = 223 * MiB, O_KM = 235 * MiB, O_VMT = 247 * MiB;
constexpr size_t O_XN = 223 * MiB;
constexpr size_t O_SLOTS = 255 * MiB;
constexpr size_t LDS_BYTES = 150 * 1024;

struct Params { const float* in[30]; float* out; unsigned char* ws; };

typedef __bf16 bf16v2_t __attribute__((ext_vector_type(2)));
typedef float f32v2_t __attribute__((ext_vector_type(2)));
DI bf16_t f2bf(float x) { const __bf16 b = (__bf16)x; return __builtin_bit_cast(bf16_t, b); }
DI float bf2f(bf16_t v) { return __uint_as_float(((unsigned)v) << 16); }
DI unsigned pack2(float lo, float hi) { const f32v2_t v = {lo, hi}; const bf16v2_t b = __builtin_convertvector(v, bf16v2_t); return __builtin_bit_cast(unsigned, b); }
DI float wave_sum(float v) {
#pragma unroll
    for (int o = 32; o >= 1; o >>= 1) v += __shfl_xor(v, o);
    return v;
}
DI int tid_fresh() { int t = threadIdx.x; asm volatile("" : "+v"(t)); return t; }
DI void fast_sincos(float ang, float* s, float* c) {
    float rev = ang * 0.15915494309189535f; rev -= rintf(rev);
    *s = __builtin_amdgcn_sinf(rev); *c = __builtin_amdgcn_cosf(rev);
}
DI float fast_sin(float a) { float rev = a * 0.15915494309189535f; rev -= rintf(rev); return __builtin_amdgcn_sinf(rev); }
DI int perm16(int t) { return (t & ~15) | (t & 3) | (((t >> 3) & 1) << 2) | (((t >> 2) & 1) << 3); }

DI void convT(unsigned char* lds, const float* __restrict__ W, int K, int N, int Npad, const float* __restrict__ gain, bf16_t* __restrict__ dst, int mode, const float* __restrict__ gain_b = nullptr, const float* __restrict__ gain_c = nullptr) {
    float* tile = (float*)lds;
    const int tid = tid_fresh();
    const int nkt = K >> 6, nnt = Npad >> 8;
    for (int u = blockIdx.x; u < nkt * nnt; u += gridDim.x) {
        const int kt = u % nkt, ntile = u / nkt;
        const int k0 = kt * 64, n0 = ntile * 256;
        const int cl = 4 * (tid & 63);
        int src = n0 + cl;
        if (mode == 1) { const int nq = n0 + (cl & ~63), jt = nq >> 7, half = (nq >> 6) & 1; src = (half ? 2816 + 64 * jt : 64 * jt) + (cl & 63); }
        const bool valid = src < N;
        f32x4 v[8];
#pragma unroll
        for (int i = 0; i < 8; ++i) {
            const int kk = (tid >> 6) + 8 * i;
            v[i] = valid ? *(const f32x4*)(W + (size_t)(k0 + kk) * N + src) : (f32x4){0.f, 0.f, 0.f, 0.f};
        }
#pragma unroll
        for (int i = 0; i < 8; ++i) {
            const int kk = (tid >> 6) + 8 * i;
            const int kq = k0 + kk;
            const float g = (mode == 2) ? ((kq < 256) ? gain[kq] : (kq < 768) ? gain_b[kq - 256] : gain_c[kq - 768]) : (gain ? gain[kq] : 1.0f);
            *(f32x4*)(tile + kk * 260 + cl) = v[i] * g;
        }
        __syncthreads();
        {
            const int nn = tid >> 1, kh = (tid & 1) * 32;
#pragma unroll
            for (int c = 0; c < 4; ++c) {
                const int kb = kh + 8 * c;
                u32x4 w;
                w.x = pack2(tile[(kb + 0) * 260 + nn], tile[(kb + 1) * 260 + nn]);
                w.y = pack2(tile[(kb + 2) * 260 + nn], tile[(kb + 3) * 260 + nn]);
                w.z = pack2(tile[(kb + 4) * 260 + nn], tile[(kb + 5) * 260 + nn]);
                w.w = pack2(tile[(kb + 6) * 260 + nn], tile[(kb + 7) * 260 + nn]);
                *(u32x4*)(dst + (size_t)(n0 + nn) * K + k0 + kb) = w;
            }
        }
        __syncthreads();
    }
}

DI void hy_h2_phase(unsigned char* lds, const Params& p) {
    float* zs = (float*)lds;
    float* h1s = zs + 64 * 36;
    const int tid = tid_fresh(), rg = tid >> 6, j = tid & 63;
    float* h2 = (float*)(p.ws + O_H2);
    for (int u = blockIdx.x; u < 2 * (L_ / 64); u += gridDim.x) {
        const int l = u / (L_ / 64), t0 = (u % (L_ / 64)) * 64;
#pragma unroll 1
        for (int e = tid; e < 64 * 16; e += NTHR) {
            const int row = e >> 4, bnd = e & 15, t = t0 + row;
            const float w = 2.0f * 3.14159265358979323846f * (float)t / (float)L_;
            const float f = 1e-4f + (15.0f - 1e-4f) * (float)bnd / 15.0f;
            const float a = f * w;
            float sn, cs; fast_sincos(a, &sn, &cs);
            zs[row * 36 + 1 + bnd] = cs;
            zs[row * 36 + 17 + bnd] = -sn;
            if (bnd == 0) zs[row * 36] = (float)t / (float)(L_ - 1);
        }
        __syncthreads();
        {
            const float* w1 = p.in[5] + (size_t)l * 33 * 64;
            float wc[33];
#pragma unroll
            for (int e = 0; e < 33; ++e) wc[e] = w1[e * 64 + j];
            const float b1 = p.in[6][l * 64 + j], f1 = p.in[7][l * 64 + j];
#pragma unroll 2
            for (int i = 0; i < 8; ++i) {
                const int row = 8 * rg + i;
                float s = b1;
#pragma unroll
                for (int e = 0; e < 33; ++e) s += zs[row * 36 + e] * wc[e];
                h1s[row * 64 + j] = fast_sin(f1 * s);
            }
        }
        __syncthreads();
        {
            const float* w2 = p.in[8] + (size_t)l * 64 * 64;
            float wc[64];
#pragma unroll
            for (int e = 0; e < 64; ++e) wc[e] = w2[e * 64 + j];
            const float b2 = p.in[9][l * 64 + j], f2 = p.in[10][l * 64 + j];
#pragma unroll 2
            for (int i = 0; i < 8; ++i) {
                const int row = 8 * rg + i;
                float s = b2;
#pragma unroll
                for (int e = 0; e < 64; e += 4) { const f32x4 hv = *(const f32x4*)(h1s + row * 64 + e); s += hv[0] * wc[e] + hv[1] * wc[e + 1] + hv[2] * wc[e + 2] + hv[3] * wc[e + 3]; }
                h2[((size_t)l * L_ + t0 + row) * 64 + j] = fast_sin(f2 * s);
            }
        }
        __syncthreads();
    }
}

DI void ft_phase(unsigned char* lds, const Params& p, int l) {
    const int tid = tid_fresh(), lane = tid & 63, w = tid >> 6, r16 = lane & 15, q4 = lane >> 4;
    const float* h2 = (const float*)(p.ws + O_H2) + (size_t)l * L_ * 64;
    const float* w3 = p.in[11] + (size_t)l * 64 * 1024;
    const float min_decay = -4.605170185988091f / 1.5f, max_decay = -4.605170185988091f / 0.3f;
    for (int u = blockIdx.x; u < L_ / 32; u += gridDim.x) {
        const int t0 = u * 32;
        bf16x8 hb[2][2];
#pragma unroll
        for (int tt = 0; tt < 2; ++tt)
#pragma unroll
            for (int ks = 0; ks < 2; ++ks) {
                const float* hp = h2 + (size_t)(t0 + 16 * tt + r16) * 64 + 32 * ks + 8 * q4;
                const f32x4 a = *(const f32x4*)hp, b = *(const f32x4*)(hp + 4);
                u32x4 pw; pw.x = pack2(a[0], a[1]); pw.y = pack2(a[2], a[3]); pw.z = pack2(b[0], b[1]); pw.w = pack2(b[2], b[3]);
                hb[tt][ks] = __builtin_bit_cast(bf16x8, pw);
            }
#pragma unroll 1
        for (int nt = 0; nt < 8; ++nt) {
            const int n0 = 128 * w + 16 * nt;
            f32x4 acc0 = {0.f, 0.f, 0.f, 0.f}, acc1 = {0.f, 0.f, 0.f, 0.f};
#pragma unroll
            for (int ks = 0; ks < 2; ++ks) {
                const float* wp = w3 + (size_t)(32 * ks + 8 * q4) * 1024 + n0 + r16;
                u32x4 pw;
                pw.x = pack2(wp[0], wp[1024]); pw.y = pack2(wp[2048], wp[3072]); pw.z = pack2(wp[4096], wp[5120]); pw.w = pack2(wp[6144], wp[7168]);
                const bf16x8 wf = __builtin_bit_cast(bf16x8, pw);
                acc0 = __builtin_amdgcn_mfma_f32_16x16x32_bf16(wf, hb[0][ks], acc0, 0, 0, 0);
                acc1 = __builtin_amdgcn_mfma_f32_16x16x32_bf16(wf, hb[1][ks], acc1, 0, 0, 0);
            }
#pragma unroll
            for (int i = 0; i < 4; ++i) {
                const int col = n0 + 4 * q4 + i, c = col & 255, od = col >> 8;
                const float dlt = fabsf(min_decay + (max_decay - min_decay) * (float)c / 255.0f);
                float* dst = (float*)(p.ws + O_R1 + (size_t)c * 262144 + 131072) + od * L_ + t0 + r16;
                dst[0] = acc0[i] * expf(-((float)(t0 + r16) / (float)(L_ - 1)) * dlt);
                dst[16] = acc1[i] * expf(-((float)(t0 + 16 + r16) / (float)(L_ - 1)) * dlt);
            }
        }
    }
}

DI void rownorm_phase(const float* __restrict__ x, bf16_t* __restrict__ xn) {
    const int tid_ = tid_fresh(); const int lane = tid_ & 63, wid = tid_ >> 6;
    for (int row = blockIdx.x * 8 + wid; row < T_; row += gridDim.x * 8) {
        const float* xr = x + (size_t)row * 1024;
        f32x4 v[4]; float ss = 0.f;
#pragma unroll
        for (int i = 0; i < 4; ++i) { v[i] = *(const f32x4*)(xr + i * 256 + lane * 4); ss += v[i][0] * v[i][0] + v[i][1] * v[i][1] + v[i][2] * v[i][2] + v[i][3] * v[i][3]; }
        ss = wave_sum(ss);
        const float r = rsqrtf(ss * (1.0f / 1024.0f) + 1e-6f);
#pragma unroll
        for (int i = 0; i < 4; ++i) { u32x2 w; w.x = pack2(v[i][0] * r, v[i][1] * r); w.y = pack2(v[i][2] * r, v[i][3] * r); *(u32x2*)(xn + (size_t)row * 1024 + i * 256 + lane * 4) = w; }
    }
}

DI void resid_phase(const float* __restrict__ y, const float* __restrict__ xres, const float* __restrict__ g, float* __restrict__ xout, bf16_t* __restrict__ xn, bool want_xn) {
    const int tid_ = tid_fresh(); const int lane = tid_ & 63, wid = tid_ >> 6;
    for (int row = blockIdx.x * 8 + wid; row < T_; row += gridDim.x * 8) {
        const size_t ro = (size_t)row * 1024;
        f32x4 v[4]; float ss = 0.f;
#pragma unroll
        for (int i = 0; i < 4; ++i) { v[i] = *(const f32x4*)(y + ro + i * 256 + lane * 4); ss += v[i][0] * v[i][0] + v[i][1] * v[i][1] + v[i][2] * v[i][2] + v[i][3] * v[i][3]; }
        ss = wave_sum(ss);
        const float r = rsqrtf(ss * (1.0f / 1024.0f) + 1e-6f);
        float s2 = 0.f;
#pragma unroll
        for (int i = 0; i < 4; ++i) {
            const f32x4 xr = *(const f32x4*)(xres + ro + i * 256 + lane * 4);
            const f32x4 gg = *(const f32x4*)(g + i * 256 + lane * 4);
            v[i] = xr + v[i] * r * gg;
            s2 += v[i][0] * v[i][0] + v[i][1] * v[i][1] + v[i][2] * v[i][2] + v[i][3] * v[i][3];
            *(f32x4*)(xout + ro + i * 256 + lane * 4) = v[i];
        }
        if (want_xn) {
            s2 = wave_sum(s2);
            const float r2 = rsqrtf(s2 * (1.0f / 1024.0f) + 1e-6f);
#pragma unroll
            for (int i = 0; i < 4; ++i) { u32x2 w; w.x = pack2(v[i][0] * r2, v[i][1] * r2); w.y = pack2(v[i][2] * r2, v[i][3] * r2); *(u32x2*)(xn + ro + i * 256 + lane * 4) = w; }
        }
    }
}

#define XB_TMO      128
#define XB_XCNT(j)  (256  + 64 * (j))
#define XB_XSUB(j)  (1280 + 64 * (j))
#define XB_XGEN(j)  (2304 + 64 * (j))
#define XB_TOP      3328
#define XB_TOPGEN   3392
#define XCD_BAR_WORDS 3456
#define XB_SPIN_CAP (1u << 22)
#define LAS __attribute__((address_space(3)))
DI unsigned xb_ld(unsigned* p)              { return __hip_atomic_load(p, __ATOMIC_RELAXED, __HIP_MEMORY_SCOPE_AGENT); }
DI unsigned xb_add(unsigned* p, unsigned v) { return __hip_atomic_fetch_add(p, v, __ATOMIC_RELAXED, __HIP_MEMORY_SCOPE_AGENT); }
DI unsigned xb_xcc_id() { return (unsigned)__builtin_amdgcn_s_getreg((3 << 11) | 20) & 0xFu; }
#define XB_SPIN(cond, bar) do { unsigned _sp = 0; while (cond) { __builtin_amdgcn_s_sleep(1); \
    if ((++_sp & 255u) == 0u) { if (xb_ld(&(bar)[XB_TMO])) break; if (_sp > XB_SPIN_CAP) { atomicAdd(&(bar)[XB_TMO], 1u); break; } } } } while (0)
struct XcdBarrier { unsigned* bar; unsigned x; volatile LAS unsigned* st; };
DI XcdBarrier xcd_barrier_post(unsigned* bar, volatile LAS unsigned* st) {
    XcdBarrier b; b.bar = bar; b.x = xb_xcc_id(); b.st = st;
    if (threadIdx.x == 0) (void)xb_add(&bar[XB_XCNT(b.x)], 1u);
    return b;
}
DI void xcd_barrier_complete(unsigned* bar, unsigned x, unsigned& nloc, unsigned& nx) {
    const unsigned G = gridDim.x * gridDim.y * gridDim.z;
    unsigned sum, cnt, mine, sp = 0u;
    for (;;) {
        sum = 0u; cnt = 0u; mine = 0u;
#pragma unroll
        for (unsigned j = 0; j < 16; ++j) { const unsigned c = xb_ld(&bar[XB_XCNT(j)]); sum += c; cnt += (c > 0u) ? 1u : 0u; mine = (j == x) ? c : mine; }
        if (sum == G) break;
        __builtin_amdgcn_s_sleep(1);
        if ((++sp & 255u) == 0u) { if (xb_ld(&bar[XB_TMO])) break; if (sp > XB_SPIN_CAP) { atomicAdd(&bar[XB_TMO], 1u); break; } }
    }
    nloc = mine > 0u ? mine : 1u; nx = cnt > 0u ? cnt : 1u;
}
DI void xcd_barrier(const XcdBarrier& b) {
    asm volatile("s_waitcnt vmcnt(0)" ::: "memory");
    __syncthreads();
    if (threadIdx.x == 0) {
        unsigned* bar = b.bar;
        __builtin_amdgcn_s_waitcnt(0);
        unsigned nloc = b.st[0], nx = b.st[1];
        if (nloc == 0u) { xcd_barrier_complete(bar, b.x, nloc, nx); b.st[0] = nloc; b.st[1] = nx; }
        const unsigned old = xb_add(&bar[XB_XSUB(b.x)], 1u);
        const unsigned gen = old / nloc;
        if (old + 1u == (gen + 1u) * nloc) {
            __builtin_amdgcn_fence(__ATOMIC_RELEASE, "agent");
            asm volatile("s_waitcnt vmcnt(0)" ::: "memory");
            const unsigned og = xb_add(&bar[XB_TOP], 1u);
            const unsigned tg = og / nx;
            if (og + 1u == (tg + 1u) * nx) xb_add(&bar[XB_TOPGEN], 1u);
            else XB_SPIN(xb_ld(&bar[XB_TOPGEN]) == tg, bar);
            __builtin_amdgcn_fence(__ATOMIC_ACQUIRE, "agent");
            xb_add(&bar[XB_XGEN(b.x)], 1u);
            asm volatile("s_waitcnt vmcnt(0)" ::: "memory");
        } else {
            XB_SPIN(xb_ld(&bar[XB_XGEN(b.x)]) == gen, bar);
            __builtin_amdgcn_fence(__ATOMIC_ACQUIRE, "agent");
            asm volatile("s_waitcnt vmcnt(0)" ::: "memory");
        }
    }
    __syncthreads();
}

DI int swz128(int row, int chunk) { return row * 128 + ((chunk ^ ((row >> 1) & 7)) << 4); }

template <bool OVL, class Epi>
DI void gemm_phase(unsigned char* lds, const bf16_t* __restrict__ A, int lda, const bf16_t* __restrict__ Bt, int K, int nMt, int nNt, const Epi& epi, int bid = -1, int nb = 0) {
    if (bid < 0) { bid = blockIdx.x; nb = gridDim.x; }
    typedef __attribute__((address_space(3))) unsigned char lds_uc;
    lds_uc* ldsl = (lds_uc*)lds;
    const int tid = tid_fresh(), lane = tid & 63, wid = tid >> 6, wm = wid & 1, wn = wid >> 1;
    const int r16 = lane & 15, q4 = lane >> 4;
    const int nk = K >> 6;
    const int xr = (r16 >> 1) & 7;
    const int ab0 = (128 * wm + r16) * 128 + ((q4 ^ xr) << 4), ab1 = (128 * wm + r16) * 128 + (((4 + q4) ^ xr) << 4);
    const int bb0 = 32768 + (64 * wn + r16) * 128 + ((q4 ^ xr) << 4), bb1 = 32768 + (64 * wn + r16) * 128 + (((4 + q4) ^ xr) << 4);
#pragma unroll 1
    for (int rep = 0; rep < REP_GEMM; ++rep)
    for (int u = bid; u < nMt * nNt; u += nb) {
        const int um = u % nMt, un = u / nMt;
        const bf16_t* ap[4]; const bf16_t* bp[4];
        int t0 = 0, bb = 0;
        if (OVL) { bb = um / 33; t0 = 254 * (um % 33) - 1; }
#pragma unroll
        for (int i = 0; i < 4; ++i) {
            const int P = (wid * 4 + i) * 64 + lane, row = P >> 3, c = (P & 7) ^ ((row >> 1) & 7);
            int grow;
            if (OVL) { int t = t0 + row; t = t < 0 ? 0 : (t > L_ - 1 ? L_ - 1 : t); grow = bb * L_ + t; }
            else grow = um * 256 + row;
            ap[i] = A + (size_t)grow * lda + c * 8;
            bp[i] = Bt + (size_t)(un * 256 + row) * K + c * 8;
        }
        f32x4 acc[8][4];
#pragma unroll
        for (int a = 0; a < 8; ++a)
#pragma unroll
            for (int b = 0; b < 4; ++b) acc[a][b] = (f32x4){0.f, 0.f, 0.f, 0.f};
#define G_ISSUE(bufoff) do { _Pragma("unroll") for (int i = 0; i < 4; ++i) { __builtin_amdgcn_global_load_lds((const unsigned*)ap[i], (__attribute__((address_space(3))) unsigned*)(ldsl + (bufoff) + (wid * 4 + i) * 1024), 16, 0, 0); ap[i] += 64; } \
                             _Pragma("unroll") for (int i = 0; i < 4; ++i) { __builtin_amdgcn_global_load_lds((const unsigned*)bp[i], (__attribute__((address_space(3))) unsigned*)(ldsl + (bufoff) + 32768 + (wid * 4 + i) * 1024), 16, 0, 0); bp[i] += 64; } } while (0)
        __syncthreads();
        G_ISSUE(0);
        asm volatile("s_waitcnt vmcnt(0)" ::: "memory");
        __builtin_amdgcn_s_barrier();
        asm volatile("" ::: "memory");
#pragma unroll 1
        for (int kt = 0; kt < nk; ++kt) {
            const int cb = (kt & 1) * 65536;
            const unsigned char* lb = lds + cb;
#pragma unroll
            for (int ks = 0; ks < 2; ++ks) {
                bf16x8 af[4], bfr[4];
#pragma unroll
                for (int nt = 0; nt < 4; ++nt) bfr[nt] = *(const bf16x8*)(lb + (ks ? bb1 : bb0) + nt * 2048);
#pragma unroll
                for (int mh = 0; mh < 2; ++mh) {
#pragma unroll
                    for (int mt = 0; mt < 4; ++mt) af[mt] = *(const bf16x8*)(lb + (ks ? ab1 : ab0) + (4 * mh + mt) * 2048);
                    __builtin_amdgcn_sched_barrier(0);
#pragma unroll
                    for (int mt = 0; mt < 4; ++mt)
#pragma unroll
                        for (int nt = 0; nt < 4; ++nt) acc[4 * mh + mt][nt] = __builtin_amdgcn_mfma_f32_16x16x32_bf16(bfr[nt], af[mt], acc[4 * mh + mt][nt], 0, 0, 0);
                    __builtin_amdgcn_sched_barrier(0);
                    if (ks == 0 && mh == (wid >= 4 ? 1 : 0) && kt + 1 < nk) G_ISSUE(65536 - cb);
                }
            }
            asm volatile("s_waitcnt vmcnt(0) lgkmcnt(0)" ::: "memory");
            __builtin_amdgcn_s_barrier();
            asm volatile("" ::: "memory");
        }
        int r16e = r16, q4e = q4;
        asm volatile("" : "+v"(r16e), "+v"(q4e));
        if constexpr (Epi::STAGED) {
            epi.staged(lds, acc, um, un, wm, wn, r16e, q4e);
        } else {
#pragma unroll
            for (int mt = 0; mt < 8; ++mt) { epi.row(um * 256 + 128 * wm + 16 * mt + r16e, un * 256 + 64 * wn, q4e, acc[mt]); asm volatile("" ::: "memory"); }
        }
    }
#undef G_ISSUE
}

struct EpiIn {
    static constexpr bool STAGED = true;
    float* hyT; bf16_t* projb;
    template <int HF> static DI void hy_half(float* st, const f32x4 (&acc)[8][4], float* dst, int r16, int q4, int lane) {
#pragma unroll
        for (int mt = 0; mt < 4; ++mt)
#pragma unroll
            for (int nt = 0; nt < 4; ++nt)
#pragma unroll
                for (int i = 0; i < 4; ++i) st[(16 * nt + 4 * q4 + i) * 65 + 16 * mt + r16] = acc[4 * HF + mt][nt][i];
        asm volatile("s_waitcnt lgkmcnt(0)" ::: "memory");
#pragma unroll 4
        for (int n = 0; n < 64; ++n) dst[(size_t)n * T_] = st[n * 65 + lane];
        asm volatile("s_waitcnt lgkmcnt(0)" ::: "memory");
    }
    DI void staged(unsigned char* lds, const f32x4 (&acc)[8][4], int um, int un, int wm, int wn, int r16, int q4) const {
        if (un < 3) {
            float* st = (float*)lds + (wm + 2 * wn) * (64 * 65);
            const int lane = r16 + 16 * q4;
            float* dst = hyT + (size_t)(un * 256 + 64 * wn) * T_ + um * 256 + 128 * wm + lane;
            hy_half<0>(st, acc, dst, r16, q4, lane);
            hy_half<1>(st, acc, dst + 64, r16, q4, lane);
        } else {
#pragma unroll
            for (int mt = 0; mt < 8; ++mt) {
                const int tok = um * 256 + 128 * wm + 16 * mt + r16;
#pragma unroll
                for (int nt = 0; nt < 4; ++nt) {
                    const int col = un * 256 + 64 * wn + 16 * nt + 4 * q4;
                    if (col < 1952) {
                        u32x2 w; w.x = pack2(acc[mt][nt][0], acc[mt][nt][1]); w.y = pack2(acc[mt][nt][2], acc[mt][nt][3]);
                        *(u32x2*)(projb + (unsigned)(tok * 1184 + (col - 768))) = w;
                    }
                }
            }
        }
    }
};
struct EpiF32 {
    static constexpr bool STAGED = false;
    float* C; int ldc;
    DI void row(int tok, int colbase, int q4, const f32x4 (&a)[4]) const {
#pragma unroll
        for (int nt = 0; nt < 4; ++nt) *(f32x4*)(C + (size_t)tok * ldc + colbase + 16 * nt + 4 * q4) = a[nt];
    }
};
struct EpiResid {
    static constexpr bool STAGED = true;
    const float* xold; float* xout; bf16_t* xn; const float* g; float* slots; XcdBarrier xb; bool want_xn;
    DI void staged(unsigned char* lds, f32x4 (&acc)[8][4], int um, int un, int wm, int wn, int r16, int q4) const {
        float* P = (float*)lds;
        const int tid = threadIdx.x;
#pragma unroll
        for (int mt = 0; mt < 8; ++mt) {
            float ss = 0.f;
#pragma unroll
            for (int nt = 0; nt < 4; ++nt) ss += acc[mt][nt][0] * acc[mt][nt][0] + acc[mt][nt][1] * acc[mt][nt][1] + acc[mt][nt][2] * acc[mt][nt][2] + acc[mt][nt][3] * acc[mt][nt][3];
            ss += __shfl_xor(ss, 16); ss += __shfl_xor(ss, 32);
            if (q4 == 0) P[(128 * wm + 16 * mt + r16) * 4 + wn] = ss;
        }
        __syncthreads();
        if (tid < 256) slots[(size_t)(um * 256 + tid) * 4 + un] = (P[tid * 4] + P[tid * 4 + 1]) + (P[tid * 4 + 2] + P[tid * 4 + 3]);
        xcd_barrier(xb);
#pragma unroll
        for (int mt = 0; mt < 8; ++mt) {
            const int tok = um * 256 + 128 * wm + 16 * mt + r16;
            const f32x4 sl = *(const f32x4*)(slots + (size_t)tok * 4);
            const float rr = rsqrtf(((sl[0] + sl[1]) + (sl[2] + sl[3])) * (1.0f / 1024.0f) + 1e-6f);
            float ss = 0.f;
#pragma unroll
            for (int nt = 0; nt < 4; ++nt) {
                const int col = un * 256 + 64 * wn + 16 * nt + 4 * q4;
                const f32x4 xo = *(const f32x4*)(xold + (size_t)tok * 1024 + col);
                const f32x4 gg = *(const f32x4*)(g + col);
                const f32x4 v = xo + acc[mt][nt] * rr * gg;
                acc[mt][nt] = v;
                *(f32x4*)(xout + (size_t)tok * 1024 + col) = v;
                ss += v[0] * v[0] + v[1] * v[1] + v[2] * v[2] + v[3] * v[3];
            }
            ss += __shfl_xor(ss, 16); ss += __shfl_xor(ss, 32);
            if (q4 == 0) P[(128 * wm + 16 * mt + r16) * 4 + wn] = ss;
            asm volatile("" ::: "memory");
        }
        if (want_xn) {
            __syncthreads();
            float* slots2 = slots + (size_t)T_ * 4;
            if (tid < 256) slots2[(size_t)(um * 256 + tid) * 4 + un] = (P[tid * 4] + P[tid * 4 + 1]) + (P[tid * 4 + 2] + P[tid * 4 + 3]);
            xcd_barrier(xb);
#pragma unroll
            for (int mt = 0; mt < 8; ++mt) {
                const int tok = um * 256 + 128 * wm + 16 * mt + r16;
                const f32x4 sl = *(const f32x4*)(slots2 + (size_t)tok * 4);
                const float rr = rsqrtf(((sl[0] + sl[1]) + (sl[2] + sl[3])) * (1.0f / 1024.0f) + 1e-6f);
#pragma unroll
                for (int nt = 0; nt < 4; ++nt) {
                    const int col = un * 256 + 64 * wn + 16 * nt + 4 * q4;
                    u32x2 w; w.x = pack2(acc[mt][nt][0] * rr, acc[mt][nt][1] * rr); w.y = pack2(acc[mt][nt][2] * rr, acc[mt][nt][3] * rr);
                    *(u32x2*)(xn + (size_t)tok * 1024 + col) = w;
                }
            }
        }
        __syncthreads();
    }
};
struct EpiUq {
    static constexpr bool STAGED = false;
    bf16_t* Qm; const float* rq; float sc;
    DI void row(int tok, int colbase, int q4, const f32x4 (&a)[4]) const {
        const float r = rq[tok] * sc;
        const int b = tok >> 13, t = tok & (L_ - 1);
#pragma unroll
        for (int nt = 0; nt < 4; ++nt) {
            const int col = colbase + 16 * nt + 4 * q4;
            if (col >= 384) continue;
            const int head = col / 96, j = col - head * 96;
            bf16_t* dst = Qm + ((size_t)(b * 4 + head) * L_ + t) * 96;
            if (j < 64) {
                u32x2 w; w.x = pack2(a[nt][0] * r, a[nt][1] * r); w.y = pack2(a[nt][2] * r, a[nt][3] * r);
                *(u32x2*)(dst + j) = w;
            } else if (j < 80) {
                if (nt < 3) {
                    const int p0 = j - 64;
                    float o1[4], o2[4];
#pragma unroll
                    for (int i = 0; i < 4; ++i) {
                        const int pp = p0 + i;
                        const float inv = __expf(-(float)(pp & 7) * (9.210340371976184f / 8.0f));
                        const float ang = (float)((pp < 8) ? (t >> 6) : (t & 63)) * inv;
                        float sn, cs; fast_sincos(ang, &sn, &cs);
                        const float x1 = a[nt][i] * r, x2 = a[(nt < 3) ? nt + 1 : 3][i] * r;
                        o1[i] = x1 * cs - x2 * sn; o2[i] = x1 * sn + x2 * cs;
                    }
                    u32x2 w; w.x = pack2(o1[0], o1[1]); w.y = pack2(o1[2], o1[3]);
                    *(u32x2*)(dst + j) = w;
                    w.x = pack2(o2[0], o2[1]); w.y = pack2(o2[2], o2[3]);
                    *(u32x2*)(dst + j + 16) = w;
                }
            }
        }
    }
};
struct EpiUkv {
    static constexpr bool STAGED = false;
    bf16_t* Km; bf16_t* VmT; const float* rkv;
    DI void row(int tok, int colbase, int q4, const f32x4 (&a)[4]) const {
        const float r = rkv[tok];
        const int b = tok >> 13, t = tok & (L_ - 1);
#pragma unroll
        for (int nt = 0; nt < 4; ++nt) {
            const int col = colbase + 16 * nt + 4 * q4;
            const int head = col >> 7, j = col & 127;
            if (j < 64) {
                u32x2 w; w.x = pack2(a[nt][0] * r, a[nt][1] * r); w.y = pack2(a[nt][2] * r, a[nt][3] * r);
                *(u32x2*)(Km + ((size_t)(b * 4 + head) * L_ + t) * 96 + j) = w;
            } else {
#pragma unroll
                for (int i = 0; i < 4; ++i) VmT[((size_t)(b * 4 + head) * 64 + (j - 64 + i)) * L_ + perm16(t)] = f2bf(a[nt][i] * r);
            }
        }
    }
};
DI float gelu_tanh(float x) {
    const float x2 = x * x;
    const float w = x * (-2.302208198f - 0.1029432397f * x2);
    return x * __builtin_amdgcn_rcpf(1.0f + __builtin_amdgcn_exp2f(w));
}
struct EpiUp {
    static constexpr bool STAGED = true;
    bf16_t* act; const float* cw; const float* cb;
    DI void staged(unsigned char* lds, const f32x4 (&acc)[8][4], int um, int un, int wm, int wn, int r16, int q4) const {
        bf16_t* st = (bf16_t*)lds;
#pragma unroll
        for (int mt = 0; mt < 8; ++mt)
#pragma unroll
            for (int nt = 0; nt < 4; ++nt) {
                u32x2 w; w.x = pack2(acc[mt][nt][0], acc[mt][nt][1]); w.y = pack2(acc[mt][nt][2], acc[mt][nt][3]);
                *(u32x2*)(st + (128 * wm + 16 * mt + r16) * 264 + 64 * wn + 16 * nt + 4 * q4) = w;
            }
        __syncthreads();
        const int tid = threadIdx.x, jp = tid & 31, hf = (tid >> 5) & 1, seg = __builtin_amdgcn_readfirstlane(tid >> 6);
        const int bb = um / 33, t0 = 254 * (um % 33) - 1;
        const int r0 = 32 * seg;
        const int ch = 64 * (2 * un + hf) + 2 * jp;
        float g0[2], g1[2], g2[2], gb[2], v0[2], v1[2], v2[2], vb[2];
#pragma unroll
        for (int e = 0; e < 2; ++e) {
            g0[e] = cw[ch + e]; g1[e] = cw[5632 + ch + e]; g2[e] = cw[2 * 5632 + ch + e]; gb[e] = cb[ch + e];
            v0[e] = cw[2816 + ch + e]; v1[e] = cw[5632 + 2816 + ch + e]; v2[e] = cw[2 * 5632 + 2816 + ch + e]; vb[e] = cb[2816 + ch + e];
        }
        const int rlo = (t0 < 0) ? -t0 : 0, rhi = (L_ - 1 - t0 < 255) ? (L_ - 1 - t0) : 255;
        const bf16_t* sp = st + r0 * 264 + 128 * hf + 2 * jp;
        const bool pv = (r0 - 1 >= rlo) && (r0 - 1 <= rhi), cvd = (r0 >= rlo) && (r0 <= rhi);
        unsigned gpw = pv ? *(const unsigned*)(sp - 264) : 0u, vpw = pv ? *(const unsigned*)(sp - 264 + 64) : 0u;
        unsigned gcw = cvd ? *(const unsigned*)sp : 0u, vcw = cvd ? *(const unsigned*)(sp + 64) : 0u;
        bf16_t* dst = act + (size_t)(bb * L_ + t0 + r0) * 2816 + ch;
#define LO(w) __uint_as_float((w) << 16)
#define HI(w) __uint_as_float((w) & 0xffff0000u)
#pragma unroll 4
        for (int i = 0; i < 32; ++i) {
            const int r = r0 + i;
            const bool nv = (r + 1 >= rlo) && (r + 1 <= rhi);
            const unsigned gnw = nv ? *(const unsigned*)(sp + (i + 1) * 264) : 0u, vnw = nv ? *(const unsigned*)(sp + (i + 1) * 264 + 64) : 0u;
            if (r >= 1 && r <= 254 && r <= rhi) {
                const float cg0 = g0[0] * LO(gpw) + g1[0] * LO(gcw) + g2[0] * LO(gnw) + gb[0];
                const float cv0 = v0[0] * LO(vpw) + v1[0] * LO(vcw) + v2[0] * LO(vnw) + vb[0];
                const float cg1 = g0[1] * HI(gpw) + g1[1] * HI(gcw) + g2[1] * HI(gnw) + gb[1];
                const float cv1 = v0[1] * HI(vpw) + v1[1] * HI(vcw) + v2[1] * HI(vnw) + vb[1];
                *(unsigned*)(dst + (size_t)i * 2816) = pack2(gelu_tanh(cg0) * cv0, gelu_tanh(cg1) * cv1);
            }
            gpw = gcw; gcw = gnw; vpw = vcw; vcw = vnw;
        }
#undef LO
#undef HI
        __syncthreads();
    }
};

DI void prep_phase(const Params& p, int l) {
    const int tid_ = tid_fresh(); const int lane = tid_ & 63, wid = tid_ >> 6;
    const bf16_t* projb = (const bf16_t*)(p.ws + O_PROJB);
    bf16_t* Qg = (bf16_t*)(p.ws + O_QG); bf16_t* Kg = (bf16_t*)(p.ws + O_KG); bf16_t* VgT = (bf16_t*)(p.ws + O_VGT);
    bf16_t* Km = (bf16_t*)(p.ws + O_KM);
    float* rq = (float*)(p.ws + O_RQ); float* rkv = (float*)(p.ws + O_RKV);
    const float* gq = p.in[13] + l * 64; const float* gk = p.in[14] + l * 64;
    const int hd = lane >> 3, sub = lane & 7;
    float gq1[4], gq2[4], gk1[4], gk2[4];
#pragma unroll
    for (int i = 0; i < 4; ++i) { gq1[i] = gq[4 * sub + i]; gq2[i] = gq[32 + 4 * sub + i]; gk1[i] = gk[4 * sub + i]; gk2[i] = gk[32 + 4 * sub + i]; }
    const float qscale = 0.125f * 1.4426950408889634f;
    for (int tok = blockIdx.x * 8 + wid; tok < T_; tok += gridDim.x * 8) {
        const int b = tok >> 13, t = tok & (L_ - 1);
        const bf16_t* pr = projb + (size_t)tok * 1184;
        float cs[4], sn[4];
#pragma unroll
        for (int i = 0; i < 4; ++i) {
            const int pp = 4 * sub + i;
            const float inv = __expf(-(float)(pp & 15) * (9.210340371976184f / 16.0f));
            const float ang = (float)((pp < 16) ? (t >> 6) : (t & 63)) * inv;
            fast_sincos(ang, &sn[i], &cs[i]);
        }
        {
            const u32x2 w1 = *(const u32x2*)(pr + hd * 64 + 4 * sub), w2 = *(const u32x2*)(pr + hd * 64 + 32 + 4 * sub);
            float x1[4] = {bf2f((bf16_t)(w1.x & 0xffff)), bf2f((bf16_t)(w1.x >> 16)), bf2f((bf16_t)(w1.y & 0xffff)), bf2f((bf16_t)(w1.y >> 16))};
            float x2[4] = {bf2f((bf16_t)(w2.x & 0xffff)), bf2f((bf16_t)(w2.x >> 16)), bf2f((bf16_t)(w2.y & 0xffff)), bf2f((bf16_t)(w2.y >> 16))};
            float ss = 0.f;
#pragma unroll
            for (int i = 0; i < 4; ++i) ss += x1[i] * x1[i] + x2[i] * x2[i];
            ss += __shfl_xor(ss, 1); ss += __shfl_xor(ss, 2); ss += __shfl_xor(ss, 4);
            const float r = rsqrtf(ss * (1.0f / 64.0f) + 1e-6f);
            float o1[4], o2[4];
#pragma unroll
            for (int i = 0; i < 4; ++i) { const float a = x1[i] * r * gq1[i], c = x2[i] * r * gq2[i]; o1[i] = (a * cs[i] - c * sn[i]) * qscale; o2[i] = (a * sn[i] + c * cs[i]) * qscale; }
            bf16_t* dst = Qg + ((size_t)(b * 8 + hd) * L_ + t) * 64;
            u32x2 w; w.x = pack2(o1[0], o1[1]); w.y = pack2(o1[2], o1[3]); *(u32x2*)(dst + 4 * sub) = w;
            w.x = pack2(o2[0], o2[1]); w.y = pack2(o2[2], o2[3]); *(u32x2*)(dst + 32 + 4 * sub) = w;
        }
        if (lane < 16) {
            const u32x2 w1 = *(const u32x2*)(pr + 512 + hd * 64 + 4 * sub), w2 = *(const u32x2*)(pr + 512 + hd * 64 + 32 + 4 * sub);
            float x1[4] = {bf2f((bf16_t)(w1.x & 0xffff)), bf2f((bf16_t)(w1.x >> 16)), bf2f((bf16_t)(w1.y & 0xffff)), bf2f((bf16_t)(w1.y >> 16))};
            float x2[4] = {bf2f((bf16_t)(w2.x & 0xffff)), bf2f((bf16_t)(w2.x >> 16)), bf2f((bf16_t)(w2.y & 0xffff)), bf2f((bf16_t)(w2.y >> 16))};
            float ss = 0.f;
#pragma unroll
            for (int i = 0; i < 4; ++i) ss += x1[i] * x1[i] + x2[i] * x2[i];
            ss += __shfl_xor(ss, 1); ss += __shfl_xor(ss, 2); ss += __shfl_xor(ss, 4);
            const float r = rsqrtf(ss * (1.0f / 64.0f) + 1e-6f);
            float o1[4], o2[4];
#pragma unroll
            for (int i = 0; i < 4; ++i) { const float a = x1[i] * r * gk1[i], c = x2[i] * r * gk2[i]; o1[i] = a * cs[i] - c * sn[i]; o2[i] = a * sn[i] + c * cs[i]; }
            bf16_t* dst = Kg + ((size_t)(b * 2 + hd) * L_ + t) * 64;
            u32x2 w; w.x = pack2(o1[0], o1[1]); w.y = pack2(o1[2], o1[3]); *(u32x2*)(dst + 4 * sub) = w;
            w.x = pack2(o2[0], o2[1]); w.y = pack2(o2[2], o2[3]); *(u32x2*)(dst + 32 + 4 * sub) = w;
        }
        {
            const unsigned w = *(const unsigned*)(pr + 640 + 2 * lane);
            const int c0 = 2 * lane, kh = c0 >> 6, d = c0 & 63;
            bf16_t* dst = VgT + ((size_t)(b * 2 + kh) * 64 + d) * L_ + perm16(t);
            dst[0] = (bf16_t)(w & 0xffff); dst[L_] = (bf16_t)(w >> 16);
        }
        {
            const u32x2 w = *(const u32x2*)(pr + 768 + 4 * lane);
            const float a0 = bf2f((bf16_t)(w.x & 0xffff)), a1 = bf2f((bf16_t)(w.x >> 16)), a2 = bf2f((bf16_t)(w.y & 0xffff)), a3 = bf2f((bf16_t)(w.y >> 16));
            float ss = wave_sum(a0 * a0 + a1 * a1 + a2 * a2 + a3 * a3);
            if (lane == 0) rq[tok] = rsqrtf(ss * (1.0f / 256.0f) + 1e-6f);
        }
        {
            const unsigned w = *(const unsigned*)(pr + 1024 + 2 * lane);
            const float a0 = bf2f((bf16_t)(w & 0xffff)), a1 = bf2f((bf16_t)(w >> 16));
            float ss = wave_sum(a0 * a0 + a1 * a1);
            if (lane == 0) rkv[tok] = rsqrtf(ss * (1.0f / 128.0f) + 1e-6f);
        }
        if (lane < 16) {
            const float x1 = bf2f(pr[1152 + lane]), x2 = bf2f(pr[1152 + 16 + lane]);
            const float inv = __expf(-(float)(lane & 7) * (9.210340371976184f / 8.0f));
            const float ang = (float)((lane < 8) ? (t >> 6) : (t & 63)) * inv;
            float s1, c1; fast_sincos(ang, &s1, &c1);
            const bf16_t o1 = f2bf(x1 * c1 - x2 * s1), o2 = f2bf(x1 * s1 + x2 * c1);
#pragma unroll
            for (int hh = 0; hh < 4; ++hh) { bf16_t* dst = Km + ((size_t)(b * 4 + hh) * L_ + t) * 96 + 64; dst[lane] = o1; dst[16 + lane] = o2; }
        }
    }
}

template <int DQK> DI int kswz(int row, int chunk) {
    if (DQK == 64) return row * 128 + ((chunk ^ ((row >> 1) & 7)) << 4);
    else return row * 192 + ((chunk ^ ((row >> 2) & 3)) << 4);
}
template <int DQK>
DI void attn_unit(unsigned char* lds, const bf16_t* __restrict__ Qp, const bf16_t* __restrict__ Kp, const bf16_t* __restrict__ VTp, bf16_t* __restrict__ Yp  ) {
    constexpr int NS = DQK / 16, NC = DQK / 8, KB = 64 * DQK * 2, KVB = KB + 8192;
    const int tid = tid_fresh(), lane = tid & 63, w = tid >> 6, r = lane & 31, h = lane >> 5;
    bf16x8 qf[NS];
#pragma unroll
    for (int s = 0; s < NS; ++s) qf[s] = *(const bf16x8*)(Qp + (size_t)(32 * w + r) * DQK + 16 * s + 8 * h);
    f32x16 o0, o1;
#pragma unroll
    for (int i = 0; i < 16; ++i) { o0[i] = 0.f; o1[i] = 0.f; }
    float m = 0.f, lsum = 0.f;
    const int k_row0 = tid / NC, k_c0 = tid % NC;
    const int k_row1 = (tid + 512) / NC, k_c1 = (tid + 512) % NC;
    const bool k_two = (DQK == 96) && (tid < 256);
    const int v_row = tid >> 3, v_c = tid & 7;
    u32x4 rkA0, rkA1, rvA, rkB0, rkB1, rvB;
    rkA1 = (u32x4){0u, 0u, 0u, 0u}; rkB1 = rkA1;
#define A_LOAD(kt, R0, R1, RV) do { R0 = *(const u32x4*)(Kp + (size_t)((kt) * 64 + k_row0) * DQK + k_c0 * 8); \
                        if (k_two) R1 = *(const u32x4*)(Kp + (size_t)((kt) * 64 + k_row1) * DQK + k_c1 * 8); \
                        RV = *(const u32x4*)(VTp + (size_t)v_row * L_ + (kt) * 64 + v_c * 8); } while (0)
#define A_STORE(buf, R0, R1, RV) do { *(u32x4*)(lds + (buf) * KVB + kswz<DQK>(k_row0, k_c0)) = R0; \
                          if (k_two) *(u32x4*)(lds + (buf) * KVB + kswz<DQK>(k_row1, k_c1)) = R1; \
                          *(u32x4*)(lds + (buf) * KVB + KB + swz128(v_row, v_c)) = RV; } while (0)
    A_LOAD(0, rkA0, rkA1, rvA);
    A_LOAD(1, rkB0, rkB1, rvB);
    A_STORE(0, rkA0, rkA1, rvA);
    __syncthreads();
    constexpr int NKT = L_ / 64;
#pragma unroll 1
    for (int kt2 = 0; kt2 < NKT; kt2 += 2) {
#pragma unroll
      for (int cur = 0; cur < 2; ++cur) {
        const int kt = kt2 + cur;
        if (kt + 2 < NKT) { if (cur == 0) A_LOAD(kt + 2, rkA0, rkA1, rvA); else A_LOAD(kt + 2, rkB0, rkB1, rvB); }
        const unsigned char* lk = lds + cur * KVB;
        const unsigned char* lv = lk + KB;
        f32x16 s0, s1;
        const float negm = -m;
#pragma unroll
        for (int i = 0; i < 16; ++i) { s0[i] = negm; s1[i] = negm; }
#pragma unroll
        for (int s = 0; s < NS; ++s) {
            const bf16x8 k0 = *(const bf16x8*)(lk + kswz<DQK>(r, 2 * s + h));
            const bf16x8 k1 = *(const bf16x8*)(lk + kswz<DQK>(32 + r, 2 * s + h));
            s0 = __builtin_amdgcn_mfma_f32_32x32x16_bf16(k0, qf[s], s0, 0, 0, 0);
            s1 = __builtin_amdgcn_mfma_f32_32x32x16_bf16(k1, qf[s], s1, 0, 0, 0);
        }
        float mx = fmaxf(fmaxf(s0[0], s0[1]), s0[2]);
#pragma unroll
        for (int i = 3; i < 15; i += 2) mx = fmaxf(fmaxf(mx, s0[i]), s0[i + 1]);
        mx = fmaxf(mx, s0[15]);
#pragma unroll
        for (int i = 0; i < 16; i += 2) mx = fmaxf(fmaxf(mx, s1[i]), s1[i + 1]);
        mx = fmaxf(mx, __shfl_xor(mx, 32));
        if (kt == 0 || __any(mx > 8.0f)) {
            const float dm = (kt == 0) ? mx : fmaxf(mx, 0.f);
            const float alpha = (kt == 0) ? 0.f : __builtin_amdgcn_exp2f(-dm);
            m += dm;
            lsum *= alpha;
#pragma unroll
            for (int i = 0; i < 16; ++i) { o0[i] *= alpha; o1[i] *= alpha; s0[i] -= dm; s1[i] -= dm; }
        }
        float ps = 0.f;
#pragma unroll
        for (int i = 0; i < 16; ++i) { s0[i] = __builtin_amdgcn_exp2f(s0[i]); ps += s0[i]; }
#pragma unroll
        for (int i = 0; i < 16; ++i) { s1[i] = __builtin_amdgcn_exp2f(s1[i]); ps += s1[i]; }
        lsum += ps;
#pragma unroll
        for (int sub = 0; sub < 2; ++sub)
#pragma unroll
            for (int s2 = 0; s2 < 2; ++s2) {
                u32x4 pw;
                if (sub == 0) { pw.x = pack2(s0[8 * s2 + 0], s0[8 * s2 + 1]); pw.y = pack2(s0[8 * s2 + 2], s0[8 * s2 + 3]); pw.z = pack2(s0[8 * s2 + 4], s0[8 * s2 + 5]); pw.w = pack2(s0[8 * s2 + 6], s0[8 * s2 + 7]); }
                else          { pw.x = pack2(s1[8 * s2 + 0], s1[8 * s2 + 1]); pw.y = pack2(s1[8 * s2 + 2], s1[8 * s2 + 3]); pw.z = pack2(s1[8 * s2 + 4], s1[8 * s2 + 5]); pw.w = pack2(s1[8 * s2 + 6], s1[8 * s2 + 7]); }
                const bf16x8 pf = __builtin_bit_cast(bf16x8, pw);
                const bf16x8 vf0 = *(const bf16x8*)(lv + swz128(r, 4 * sub + 2 * s2 + h));
                const bf16x8 vf1 = *(const bf16x8*)(lv + swz128(32 + r, 4 * sub + 2 * s2 + h));
                o0 = __builtin_amdgcn_mfma_f32_32x32x16_bf16(vf0, pf, o0, 0, 0, 0);
                o1 = __builtin_amdgcn_mfma_f32_32x32x16_bf16(vf1, pf, o1, 0, 0, 0);
            }
        if (kt + 1 < NKT) { if (cur == 0) A_STORE(1, rkB0, rkB1, rvB); else A_STORE(0, rkA0, rkA1, rvA); }
        __syncthreads();
      }
    }
#undef A_LOAD
#undef A_STORE
    const float lt = lsum + __shfl_xor(lsum, 32);
    const float inv = 1.0f / lt;
    bf16_t* yr = Yp + (size_t)(32 * w + r) * 768;
#pragma unroll
    for (int g = 0; g < 4; ++g) {
        u32x2 wv; wv.x = pack2(o0[4 * g] * inv, o0[4 * g + 1] * inv); wv.y = pack2(o0[4 * g + 2] * inv, o0[4 * g + 3] * inv);
        *(u32x2*)(yr + 8 * g + 4 * h) = wv;
        wv.x = pack2(o1[4 * g] * inv, o1[4 * g + 1] * inv); wv.y = pack2(o1[4 * g + 2] * inv, o1[4 * g + 3] * inv);
        *(u32x2*)(yr + 32 + 8 * g + 4 * h) = wv;
    }
}

DI int pa(int e) { return e + (e >> 4); }
DI float2 cmul(float2 a, float2 b) { return make_float2(a.x * b.x - a.y * b.y, a.x * b.y + a.y * b.x); }
DI float2 cadd(float2 a, float2 b) { return make_float2(a.x + b.x, a.y + b.y); }
DI float2 csub(float2 a, float2 b) { return make_float2(a.x - b.x, a.y - b.y); }
template <bool INV> DI void dft4(float2& a, float2& b, float2& c, float2& d) {
    const float2 t0 = cadd(a, c), t1 = csub(a, c), t2 = cadd(b, d), t3 = csub(b, d);
    const float2 jt3 = INV ? make_float2(-t3.y, t3.x) : make_float2(t3.y, -t3.x);
    a = cadd(t0, t2); c = csub(t0, t2); b = cadd(t1, jt3); d = csub(t1, jt3);
}
template <bool INV> DI float2 tw16(float2 v, int k) {
    const float c1 = 0.9238795325112867f, s1 = 0.3826834323650898f, c2 = 0.7071067811865476f;
    float wr = 1.f, wi = 0.f;
    switch (k) {
        case 0: wr = 1.f; wi = 0.f; break;
        case 1: wr = c1; wi = -s1; break;
        case 2: wr = c2; wi = -c2; break;
        case 3: wr = s1; wi = -c1; break;
        case 4: wr = 0.f; wi = -1.f; break;
        case 6: wr = -c2; wi = -c2; break;
        case 9: wr = -c1; wi = s1; break;
        default: break;
    }
    if (INV) wi = -wi;
    return make_float2(v.x * wr - v.y * wi, v.x * wi + v.y * wr);
}
template <bool INV> DI void dft16(float2 (&x)[16]) {
#pragma unroll
    for (int b = 0; b < 4; ++b) dft4<INV>(x[b], x[b + 4], x[b + 8], x[b + 12]);
#pragma unroll
    for (int b = 1; b < 4; ++b)
#pragma unroll
        for (int pq = 1; pq < 4; ++pq) x[b + 4 * pq] = tw16<INV>(x[b + 4 * pq], b * pq);
#pragma unroll
    for (int pq = 0; pq < 4; ++pq) dft4<INV>(x[4 * pq], x[4 * pq + 1], x[4 * pq + 2], x[4 * pq + 3]);
#pragma unroll
    for (int a = 0; a < 4; ++a)
#pragma unroll
        for (int b = a + 1; b < 4; ++b) { const float2 tmp = x[4 * a + b]; x[4 * a + b] = x[4 * b + a]; x[4 * b + a] = tmp; }
}
template <bool INV> DI void pass_a(float2* Z, const float2* T1, int tid) {
#pragma unroll
    for (int i = 0; i < 8; ++i) {
        const int j = tid + 512 * i;
        float2* zp = Z + pa(j);
        float2 x0 = zp[0], x1 = zp[4352], x2 = zp[8704], x3 = zp[13056];
        float2 w1 = tw16<false>(T1[j & 1023], i >> 1);
        if (INV) w1.y = -w1.y;
        const float2 w2 = cmul(w1, w1), w3 = cmul(w2, w1);
        if (!INV) { dft4<false>(x0, x1, x2, x3); x1 = cmul(x1, w1); x2 = cmul(x2, w2); x3 = cmul(x3, w3); }
        else { x1 = cmul(x1, w1); x2 = cmul(x2, w2); x3 = cmul(x3, w3); dft4<true>(x0, x1, x2, x3); }
        zp[0] = x0; zp[4352] = x1; zp[8704] = x2; zp[13056] = x3;
    }
}
template <bool INV, int LS, int TS> DI void pass16(float2* Z, const float2* T1, int tid) {
#pragma unroll 1
    for (int i = 0; i < 2; ++i) {
        const int id = tid + 512 * i, j = id & ((1 << LS) - 1), base = (id >> LS) << (LS + 4);
        float2* zp = Z + pa(base + j);
        float2 x[16];
#pragma unroll
        for (int mm = 0; mm < 16; ++mm) x[mm] = zp[mm * ((1 << LS) + (1 << (LS - 4)))];
        float2 w1 = T1[j << TS];
        if (INV) w1.y = -w1.y;
        if (!INV) dft16<false>(x);
        float2 wq = w1;
#pragma unroll
        for (int qq = 1; qq < 16; ++qq) { x[qq] = cmul(x[qq], wq); wq = cmul(wq, w1); }
        if (INV) dft16<true>(x);
#pragma unroll
        for (int mm = 0; mm < 16; ++mm) zp[mm * ((1 << LS) + (1 << (LS - 4)))] = x[mm];
    }
}
DI void pass_d_store(const float2* Z, float2* __restrict__ Kf, int tid, float scale) {
#pragma unroll 1
    for (int i = 0; i < 2; ++i) {
        const int id = tid + 512 * i, base = id * 16;
        float2 x[16];
#pragma unroll
        for (int mm = 0; mm < 16; ++mm) x[mm] = Z[17 * id + mm];
        dft16<false>(x);
#pragma unroll
        for (int mm = 0; mm < 16; mm += 2) *(f32x4*)(Kf + base + mm) = (f32x4){x[mm].x * scale, x[mm].y * scale, x[mm + 1].x * scale, x[mm + 1].y * scale};
    }
}
DI void pass_d_lds(float2* Z, int tid) {
#pragma unroll 1
    for (int i = 0; i < 2; ++i) {
        const int id = tid + 512 * i, base = id * 16;
        float2 x[16];
#pragma unroll
        for (int mm = 0; mm < 16; ++mm) x[mm] = Z[17 * id + mm];
        dft16<false>(x);
#pragma unroll
        for (int mm = 0; mm < 16; ++mm) Z[17 * id + mm] = x[mm];
    }
}
DI void pass_d_mul(float2* Z, const float2* __restrict__ Kf, int tid) {
#pragma unroll 1
    for (int i = 0; i < 2; ++i) {
        const int id = tid + 512 * i, base = id * 16;
        float2 x[16];
#pragma unroll
        for (int mm = 0; mm < 16; ++mm) x[mm] = Z[17 * id + mm];
        dft16<false>(x);
#pragma unroll
        for (int mm = 0; mm < 16; mm += 2) {
            const f32x4 kk = *(const f32x4*)(Kf + base + mm);
            x[mm] = cmul(x[mm], make_float2(kk[0], kk[1])); x[mm + 1] = cmul(x[mm + 1], make_float2(kk[2], kk[3]));
        }
        dft16<true>(x);
#pragma unroll
        for (int mm = 0; mm < 16; ++mm) Z[17 * id + mm] = x[mm];
    }
}
DI void fft_conv(float2* Z, const float2* T1, const float2* Kf, int tid) {
    pass_a<false>(Z, T1, tid); __syncthreads();
    pass16<false, 8, 2>(Z, T1, tid); __syncthreads();
    pass16<false, 4, 6>(Z, T1, tid); __syncthreads();
    pass_d_mul(Z, Kf, tid); __syncthreads();
    pass16<true, 4, 6>(Z, T1, tid); __syncthreads();
    pass16<true, 8, 2>(Z, T1, tid); __syncthreads();
    pass_a<true>(Z, T1, tid); __syncthreads();
}

DI void hyena_unit(unsigned char* lds, const Params& p, int l, int c) {
    float2* Z = (float2*)lds;
    float2* T1 = (float2*)(lds + 139264);
    const int tid = tid_fresh();
    const float* hyT = (const float*)(p.ws + O_HYT);
    float2* Kf0 = (float2*)(p.ws + O_R1) + (size_t)c * 32768;
    float2* Kf1 = Kf0 + 16384;
    bf16_t* hyout = (bf16_t*)(p.ws + O_HYOUT) + (size_t)c * T_;
    for (int k = tid; k < 1024; k += NTHR) { float sn, cs; sincospif((float)k * (1.0f / 8192.0f), &sn, &cs); T1[k] = make_float2(cs, -sn); }
    __syncthreads();
    {
        const float* taps = (const float*)Kf1;
#pragma unroll 4
        for (int t = tid; t < L_; t += NTHR) { Z[pa(t)] = make_float2(taps[t], taps[2 * L_ + t]); Z[pa(16383 - t)] = make_float2(taps[L_ + t], taps[3 * L_ + t]); }
        __syncthreads();
        pass_a<false>(Z, T1, tid); __syncthreads();
        pass16<false, 8, 2>(Z, T1, tid); __syncthreads();
        pass16<false, 4, 6>(Z, T1, tid); __syncthreads();
        pass_d_lds(Z, tid); __syncthreads();
        const float sc = 0.5f / 16384.0f;
#pragma unroll 2
        for (int e = tid; e < 16384; e += NTHR) {
            const int a = e >> 12, b = (e >> 8) & 15, c4 = (e >> 4) & 15, d = e & 15;
            const int k = a + 4 * (b + 16 * (c4 + 16 * d));
            const int k2 = (16384 - k) & 16383;
            const int e2 = ((k2 & 3) << 12) | (((k2 >> 2) & 15) << 8) | (((k2 >> 6) & 15) << 4) | (k2 >> 10);
            const float2 z = Z[pa(e)], z2 = Z[pa(e2)];
            const float sx = z.x + z2.x, sy = z.y - z2.y, dx = z.x - z2.x, dy = z.y + z2.y;
            Kf0[e] = make_float2(sx * sc, sy * sc);
            Kf1[e] = make_float2(dy * sc, -dx * sc);
        }
        __syncthreads();
    }
    const float* cw = p.in[3] + (size_t)l * 3 * 768; const float* cb = p.in[4] + (size_t)l * 768;
    const float* skip = p.in[12] + (size_t)l * 2 * 256;
    float2* z1buf = Kf0;
    const float vw0 = cw[c], vw1 = cw[768 + c], vw2 = cw[1536 + c], vbb = cb[c];
    const float* uv = hyT + (size_t)c * T_;
#pragma unroll 2
    for (int t = tid; t < L_; t += NTHR) {
        float vv[2];
#pragma unroll
        for (int b = 0; b < 2; ++b) {
            const float* ub = uv + b * L_;
            const float um = (t > 0) ? ub[t - 1] : 0.f, uc = ub[t], up = (t < L_ - 1) ? ub[t + 1] : 0.f;
            vv[b] = vw0 * um + vw1 * uc + vw2 * up + vbb;
        }
        Z[pa(t)] = make_float2(vv[0], vv[1]); Z[pa(t + L_)] = make_float2(0.f, 0.f);
    }
    __syncthreads();
    __threadfence();
    fft_conv(Z, T1, Kf0, tid);
    {
        const int ch = 256 + c;
        const float w0 = cw[ch], w1 = cw[768 + ch], w2 = cw[1536 + ch], bb = cb[ch], sk = skip[c];
        const float* u0 = hyT + (size_t)ch * T_;
#pragma unroll 2
        for (int t = tid; t < L_; t += NTHR) {
            const float2 y = Z[pa(t)];
            float zz[2];
#pragma unroll
            for (int b = 0; b < 2; ++b) {
                const float* ub = u0 + b * L_;
                const float um = (t > 0) ? ub[t - 1] : 0.f, uc = ub[t], up = (t < L_ - 1) ? ub[t + 1] : 0.f;
                const float g = w0 * um + w1 * uc + w2 * up + bb;
                const float* vb = uv + b * L_;
                const float vm = (t > 0) ? vb[t - 1] : 0.f, vc = vb[t], vp = (t < L_ - 1) ? vb[t + 1] : 0.f;
                const float v = vw0 * vm + vw1 * vc + vw2 * vp + vbb;
                zz[b] = g * ((b ? y.y : y.x) + sk * v);
            }
            const float2 z1 = make_float2(zz[0], zz[1]);
            Z[pa(t)] = z1; Z[pa(t + L_)] = make_float2(0.f, 0.f);
            z1buf[t] = z1;
        }
    }
    __syncthreads();
    fft_conv(Z, T1, Kf1, tid);
    {
        const int ch = 512 + c;
        const float w0 = cw[ch], w1 = cw[768 + ch], w2 = cw[1536 + ch], bb = cb[ch], sk = skip[256 + c];
        const float* u0 = hyT + (size_t)ch * T_;
#pragma unroll 2
        for (int t = tid; t < L_; t += NTHR) {
            const float2 y = Z[pa(t)];
            const float2 z1 = z1buf[t];
#pragma unroll
            for (int b = 0; b < 2; ++b) {
                const float* ub = u0 + b * L_;
                const float um = (t > 0) ? ub[t - 1] : 0.f, uc = ub[t], up = (t < L_ - 1) ? ub[t + 1] : 0.f;
                const float g = w0 * um + w1 * uc + w2 * up + bb;
                hyout[b * L_ + t] = f2bf(g * ((b ? y.y : y.x) + sk * (b ? z1.y : z1.x)));
            }
        }
    }
    __syncthreads();
}

DI void groups_phase(unsigned char* lds, const Params& p) {
    bf16_t* tile = (bf16_t*)lds;
    const int tid = tid_fresh(), lane = tid & 63, wid = tid >> 6;
    const bf16_t* hyout = (const bf16_t*)(p.ws + O_HYOUT);
    const bf16_t* Y = (const bf16_t*)(p.ws + O_PROJB);
    bf16_t* G = (bf16_t*)(p.ws + O_HYT);
    for (int u = blockIdx.x; u < T_ / 64; u += gridDim.x) {
        const int tok0 = u * 64;
        {
            const int c = tid >> 1, hf = tid & 1;
            const u32x4* src = (const u32x4*)(hyout + (size_t)c * T_ + tok0 + hf * 32);
#pragma unroll
            for (int i = 0; i < 4; ++i) {
                const u32x4 v = src[i];
                unsigned* d = (unsigned*)(tile + c * 66 + hf * 32 + i * 8);
                d[0] = v.x; d[1] = v.y; d[2] = v.z; d[3] = v.w;
            }
        }
        __syncthreads();
#pragma unroll 1
        for (int i = 0; i < 8; ++i) {
            const int tl = wid * 8 + i, tok = tok0 + tl;
            float hv[4]; float sh = 0.f;
#pragma unroll
            for (int k = 0; k < 4; ++k) { hv[k] = bf2f(tile[(lane + 64 * k) * 66 + tl]); sh += hv[k] * hv[k]; }
            sh = wave_sum(sh);
            const float rh = rsqrtf(sh * (1.0f / 256.0f) + 1e-6f);
            bf16_t* gr = G + (size_t)tok * 1024;
#pragma unroll
            for (int k = 0; k < 4; ++k) gr[lane + 64 * k] = f2bf(hv[k] * rh);
            const bf16_t* yr = Y + (size_t)tok * 768;
            {
                const u32x4 v = *(const u32x4*)(yr + lane * 8);
                float a[8] = {bf2f((bf16_t)(v.x & 0xffff)), bf2f((bf16_t)(v.x >> 16)), bf2f((bf16_t)(v.y & 0xffff)), bf2f((bf16_t)(v.y >> 16)),
                              bf2f((bf16_t)(v.z & 0xffff)), bf2f((bf16_t)(v.z >> 16)), bf2f((bf16_t)(v.w & 0xffff)), bf2f((bf16_t)(v.w >> 16))};
                float ss = 0.f;
#pragma unroll
                for (int k = 0; k < 8; ++k) ss += a[k] * a[k];
                ss = wave_sum(ss);
                const float rr = rsqrtf(ss * (1.0f / 512.0f) + 1e-6f);
                u32x4 w; w.x = pack2(a[0] * rr, a[1] * rr); w.y = pack2(a[2] * rr, a[3] * rr); w.z = pack2(a[4] * rr, a[5] * rr); w.w = pack2(a[6] * rr, a[7] * rr);
                *(u32x4*)(gr + 256 + lane * 8) = w;
            }
            {
                const u32x2 v = *(const u32x2*)(yr + 512 + lane * 4);
                float a[4] = {bf2f((bf16_t)(v.x & 0xffff)), bf2f((bf16_t)(v.x >> 16)), bf2f((bf16_t)(v.y & 0xffff)), bf2f((bf16_t)(v.y >> 16))};
                float ss = wave_sum(a[0] * a[0] + a[1] * a[1] + a[2] * a[2] + a[3] * a[3]);
                const float rr = rsqrtf(ss * (1.0f / 256.0f) + 1e-6f);
                u32x2 w; w.x = pack2(a[0] * rr, a[1] * rr); w.y = pack2(a[2] * rr, a[3] * rr);
                *(u32x2*)(gr + 768 + lane * 4) = w;
            }
        }
        __syncthreads();
    }
}


extern __shared__ __attribute__((aligned(16))) unsigned char smem[];

__global__ void __launch_bounds__(512) fwd_megakernel(Params p) {
    cg::grid_group grid = cg::this_grid();
    unsigned char* lds = smem;
    unsigned char* ws = p.ws;
    unsigned* bar = (unsigned*)(ws + O_BAR);
    volatile LAS unsigned* xb_st = (volatile LAS unsigned*)(smem + LDS_BYTES - 16);
    if (threadIdx.x < 4) xb_st[threadIdx.x] = 0u;
    __syncthreads();
    const XcdBarrier xb = xcd_barrier_post(bar, xb_st);
    if (p.ws == nullptr) grid.sync();
#pragma unroll 1
    for (int l2 = 0; l2 < 2 * REP_PRO; ++l2) { const int l = l2 & 1;
        convT(lds, p.in[2] + (size_t)l * 1024 * 1952, 1024, 1952, 2048, p.in[1] + l * 1024, (bf16_t*)(ws + O_WIN) + (size_t)l * 2048 * 1024, 0);
        convT(lds, p.in[16] + (size_t)l * 256 * 384, 256, 384, 512, p.in[15] + l * 256, (bf16_t*)(ws + O_WUQ) + (size_t)l * 512 * 256, 0);
        convT(lds, p.in[18] + (size_t)l * 128 * 512, 128, 512, 512, p.in[17] + l * 128, (bf16_t*)(ws + O_WUKV) + (size_t)l * 512 * 128, 0);
        convT(lds, p.in[22] + (size_t)l * 1024 * 1024, 1024, 1024, 1024, p.in[19] + l * 256, (bf16_t*)(ws + O_WOUT) + (size_t)l * 1024 * 1024, 2, p.in[20] + l * 512, p.in[21] + l * 256);
        convT(lds, p.in[25] + (size_t)l * 1024 * 5632, 1024, 5632, 5632, p.in[24] + l * 1024, (bf16_t*)(ws + O_WUP) + (size_t)l * 5632 * 1024, 1);
        convT(lds, p.in[28] + (size_t)l * 2816 * 1024, 2816, 1024, 1024, nullptr, (bf16_t*)(ws + O_WDOWN) + (size_t)l * 1024 * 2816, 0);
    }
#ifndef REP_MISC
#define REP_MISC 1
#endif
#pragma unroll 1
    for (int rep = 0; rep < REP_MISC; ++rep) { hy_h2_phase(lds, p);
    rownorm_phase(p.in[0], (bf16_t*)(ws + O_XN)); }
    XSYNC();


#pragma unroll 1
    for (int l = 0; l < 2; ++l) {
        {
            EpiIn e; e.hyT = (float*)(ws + O_HYT); e.projb = (bf16_t*)(ws + O_PROJB);
            gemm_phase<false>(lds, (const bf16_t*)(ws + O_XN), 1024, (const bf16_t*)(ws + O_WIN) + (size_t)l * 2048 * 1024, 1024, 64, 8, e);
        }
        XSYNC();
#pragma unroll 1
        for (int rep = 0; rep < REP_EW; ++rep) prep_phase(p, l);
#pragma unroll 1
        for (int rep = 0; rep < REP_MISC; ++rep) ft_phase(lds, p, l);
        XSYNC();
        {
            EpiUq e; e.Qm = (bf16_t*)(ws + O_QM); e.rq = (const float*)(ws + O_RQ); e.sc = 0.10206207261596577f * 1.4426950408889634f;
            const int hb = gridDim.x >> 1;
            if ((int)blockIdx.x < hb) gemm_phase<false>(lds, (const bf16_t*)(ws + O_PROJB) + 768, 1184, (const bf16_t*)(ws + O_WUQ) + (size_t)l * 512 * 256, 256, 64, 2, e, blockIdx.x, hb);
            EpiUkv e2; e2.Km = (bf16_t*)(ws + O_KM); e2.VmT = (bf16_t*)(ws + O_VMT); e2.rkv = (const float*)(ws + O_RKV);
            if ((int)blockIdx.x >= hb) gemm_phase<false>(lds, (const bf16_t*)(ws + O_PROJB) + 1024, 1184, (const bf16_t*)(ws + O_WUKV) + (size_t)l * 512 * 128, 128, 64, 2, e2, blockIdx.x - hb, gridDim.x - hb);
        }
        XSYNC();
#pragma unroll 1
        for (int rep = 0; rep < REP_HY; ++rep)
        for (int c = blockIdx.x; c < 256; c += gridDim.x) hyena_unit(lds, p, l, c);
#pragma unroll 1
        for (int rep = 0; rep < REP_ATTN; ++rep)
        for (int u = blockIdx.x; u < 512; u += gridDim.x) {
            const int qt = u & 31, hh = (u >> 5) & 7, b = u >> 8, hk = hh >> 2;
            attn_unit<64>(lds, (const bf16_t*)(ws + O_QG) + ((size_t)(b * 8 + hh) * L_ + qt * 256) * 64,
                          (const bf16_t*)(ws + O_KG) + (size_t)(b * 2 + hk) * L_ * 64,
                          (const bf16_t*)(ws + O_VGT) + (size_t)(b * 2 + hk) * 64 * L_,
                          (bf16_t*)(ws + O_PROJB) + (size_t)(b * L_ + qt * 256) * 768 + hh * 64);
        }
#pragma unroll 1
        for (int rep = 0; rep < REP_ATTN; ++rep)
        for (int u = blockIdx.x; u < 256; u += gridDim.x) {
            const int qt = u & 31, hh = (u >> 5) & 3, b = u >> 7;
            attn_unit<96>(lds, (const bf16_t*)(ws + O_QM) + ((size_t)(b * 4 + hh) * L_ + qt * 256) * 96,
                          (const bf16_t*)(ws + O_KM) + (size_t)(b * 4 + hh) * L_ * 96,
                          (const bf16_t*)(ws + O_VMT) + (size_t)(b * 4 + hh) * 64 * L_,
                          (bf16_t*)(ws + O_PROJB) + (size_t)(b * L_ + qt * 256) * 768 + 512 + hh * 64);
        }
        XSYNC();
#pragma unroll 1
        for (int rep = 0; rep < REP_EW; ++rep) groups_phase(lds, p);
        XSYNC();
        if (gridDim.x == 256) {
            EpiResid e; e.xold = (l == 0) ? p.in[0] : p.out; e.xout = p.out; e.xn = (bf16_t*)(ws + O_XN); e.g = p.in[23] + l * 1024; e.slots = (float*)(ws + O_SLOTS); e.xb = xb; e.want_xn = true;
            gemm_phase<false>(lds, (const bf16_t*)(ws + O_HYT), 1024, (const bf16_t*)(ws + O_WOUT) + (size_t)l * 1024 * 1024, 1024, 64, 4, e);
            XSYNC();
        } else {
            EpiF32 e; e.C = (float*)(ws + O_R1); e.ldc = 1024;
            gemm_phase<false>(lds, (const bf16_t*)(ws + O_HYT), 1024, (const bf16_t*)(ws + O_WOUT) + (size_t)l * 1024 * 1024, 1024, 64, 4, e);
            XSYNC();
            resid_phase((const float*)(ws + O_R1), l == 0 ? p.in[0] : p.out, p.in[23] + l * 1024, p.out, (bf16_t*)(ws + O_XN), true);
            XSYNC();
        }
        {
            EpiUp e; e.act = (bf16_t*)(ws + O_HYT); e.cw = p.in[26] + (size_t)l * 3 * 5632; e.cb = p.in[27] + (size_t)l * 5632;
            gemm_phase<true>(lds, (const bf16_t*)(ws + O_XN), 1024, (const bf16_t*)(ws + O_WUP) + (size_t)l * 5632 * 1024, 1024, 66, 22, e);
        }
        XSYNC();
        if (gridDim.x == 256) {
            EpiResid e; e.xold = p.out; e.xout = p.out; e.xn = (bf16_t*)(ws + O_XN); e.g = p.in[29] + l * 1024; e.slots = (float*)(ws + O_SLOTS); e.xb = xb; e.want_xn = (l == 0);
            gemm_phase<false>(lds, (const bf16_t*)(ws + O_HYT), 2816, (const bf16_t*)(ws + O_WDOWN) + (size_t)l * 1024 * 2816, 2816, 64, 4, e);
            if (l == 0) XSYNC();
        } else {
            EpiF32 e; e.C = (float*)(ws + O_R1); e.ldc = 1024;
            gemm_phase<false>(lds, (const bf16_t*)(ws + O_HYT), 2816, (const bf16_t*)(ws + O_WDOWN) + (size_t)l * 1024 * 2816, 2816, 64, 4, e);
            XSYNC();
            resid_phase((const float*)(ws + O_R1), p.out, p.in[29] + l * 1024, p.out, (bf16_t*)(ws + O_XN), l == 0);
            if (l == 0) XSYNC();
        }
    }
}

extern "C" void kernel_launch(void* const* d_in, const int* in_sizes, int n_in,
                              void* d_out, int out_size, void* d_ws, size_t ws_size,
                              hipStream_t stream) {
    static int grid_blocks = 0;
    if (!grid_blocks) {
        int dev = 0, cus = 0, per_cu = 0;
        (void)hipGetDevice(&dev);
        (void)hipDeviceGetAttribute(&cus, hipDeviceAttributeMultiprocessorCount, dev);
        (void)hipFuncSetAttribute((const void*)fwd_megakernel, hipFuncAttributeMaxDynamicSharedMemorySize, (int)LDS_BYTES);
        (void)hipOccupancyMaxActiveBlocksPerMultiprocessor(&per_cu, fwd_megakernel, NTHR, LDS_BYTES);
        if (per_cu < 1) per_cu = 1;
        grid_blocks = cus;
        if (grid_blocks > 256) grid_blocks = 256;
    }
    Params p{};
    for (int i = 0; i < 30; ++i) p.in[i] = (const float*)d_in[i];
    p.out = (float*)d_out; p.ws = (unsigned char*)d_ws;
    void* args[] = {&p};
    (void)hipMemsetAsync((unsigned char*)d_ws + O_BAR, 0, XCD_BAR_WORDS * sizeof(unsigned), stream);
    hipError_t e = hipLaunchCooperativeKernel((void*)fwd_megakernel, dim3(grid_blocks), dim3(NTHR), args, LDS_BYTES, stream);
    if (e != hipSuccess) fprintf(stderr, "cooperative launch failed: %s (grid %d)\n", hipGetErrorString(e), grid_blocks);
}
```

```cpp
#include <hip/hip_runtime.h>
#include <hip/hip_cooperative_groups.h>
#include <cstdio>
#include <cstdint>
namespace cg = cooperative_groups;

typedef unsigned short bf16_t;
typedef short bf16x8 __attribute__((ext_vector_type(8)));
typedef float f32x4 __attribute__((ext_vector_type(4)));
typedef float f32x16 __attribute__((ext_vector_type(16)));
typedef unsigned u32x2 __attribute__((ext_vector_type(2)));
typedef unsigned u32x4 __attribute__((ext_vector_type(4)));

#define DI __device__ __forceinline__
#ifndef REP_ATTN
#define REP_ATTN 1
#endif
#ifndef REP_HY
#define REP_HY 1
#endif
#ifndef REP_GEMM
#define REP_GEMM 1
#endif
#ifndef REP_PRO
#define REP_PRO 1
#endif
#ifndef REP_SYNC
#define REP_SYNC 1
#endif
#define XSYNC() do { _Pragma("unroll 1") for (int r_ = 0; r_ < REP_SYNC; ++r_) xcd_barrier(xb); } while (0)
#ifndef REP_EW
#define REP_EW 1
#endif
constexpr int L_ = 8192, T_ = 16384, NTHR = 512;
constexpr size_t MiB = 1u << 20;
constexpr size_t O_WIN = 0, O_WUQ = 8 * MiB, O_WUKV = 8 * MiB + 512 * 1024, O_RQ = 8 * MiB + 768 * 1024, O_RKV = 8 * MiB + 832 * 1024;
constexpr size_t O_BAR = 8 * MiB + 896 * 1024;
constexpr size_t O_WOUT = 9 * MiB, O_WUP = 13 * MiB, O_WDOWN = 35 * MiB, O_H2 = 46 * MiB;
constexpr size_t O_R1 = 50 * MiB;
constexpr size_t O_HYT = 114 * MiB;
constexpr size_t O_PROJB = 162 * MiB;
constexpr size_t O_HYOUT = 186 * MiB;
constexpr size_t O_QG = 199 * MiB, O_KG = 215 * MiB, O_VGT = 219 * MiB, O_QM = 223 * MiB, O_KM = 235 * MiB, O_VMT = 247 * MiB;
constexpr size_t O_XN = 223 * MiB;
constexpr size_t O_SLOTS = 255 * MiB;
constexpr size_t LDS_BYTES = 150 * 1024;

struct Params { const float* in[30]; float* out; unsigned char* ws; };

typedef __bf16 bf16v2_t __attribute__((ext_vector_type(2)));
typedef float f32v2_t __attribute__((ext_vector_type(2)));
DI bf16_t f2bf(float x) { const __bf16 b = (__bf16)x; return __builtin_bit_cast(bf16_t, b); }
DI float bf2f(bf16_t v) { return __uint_as_float(((unsigned)v) << 16); }
DI unsigned pack2(float lo, float hi) { const f32v2_t v = {lo, hi}; const bf16v2_t b = __builtin_convertvector(v, bf16v2_t); return __builtin_bit_cast(unsigned, b); }
DI float wave_sum(float v) {
#pragma unroll
    for (int o = 32; o >= 1; o >>= 1) v += __shfl_xor(v, o);
    return v;
}
DI int tid_fresh() { int t = threadIdx.x; asm volatile("" : "+v"(t)); return t; }
DI void fast_sincos(float ang, float* s, float* c) {
    float rev = ang * 0.15915494309189535f; rev -= rintf(rev);
    *s = __builtin_amdgcn_sinf(rev); *c = __builtin_amdgcn_cosf(rev);
}
DI float fast_sin(float a) { float rev = a * 0.15915494309189535f; rev -= rintf(rev); return __builtin_amdgcn_sinf(rev); }
DI int perm16(int t) { return (t & ~15) | (t & 3) | (((t >> 3) & 1) << 2) | (((t >> 2) & 1) << 3); }

DI void convT(unsigned char* lds, const float* __restrict__ W, int K, int N, int Npad, const float* __restrict__ gain, bf16_t* __restrict__ dst, int mode, const float* __restrict__ gain_b = nullptr, const float* __restrict__ gain_c = nullptr) {
    float* tile = (float*)lds;
    const int tid = tid_fresh();
    const int nkt = K >> 6, nnt = Npad >> 8;
    for (int u = blockIdx.x; u < nkt * nnt; u += gridDim.x) {
        const int kt = u % nkt, ntile = u / nkt;
        const int k0 = kt * 64, n0 = ntile * 256;
        const int cl = 4 * (tid & 63);
        int src = n0 + cl;
        if (mode == 1) { const int nq = n0 + (cl & ~63), jt = nq >> 7, half = (nq >> 6) & 1; src = (half ? 2816 + 64 * jt : 64 * jt) + (cl & 63); }
        const bool valid = src < N;
        f32x4 v[8];
#pragma unroll
        for (int i = 0; i < 8; ++i) {
            const int kk = (tid >> 6) + 8 * i;
            v[i] = valid ? *(const f32x4*)(W + (size_t)(k0 + kk) * N + src) : (f32x4){0.f, 0.f, 0.f, 0.f};
        }
#pragma unroll
        for (int i = 0; i < 8; ++i) {
            const int kk = (tid >> 6) + 8 * i;
            const int kq = k0 + kk;
            const float g = (mode == 2) ? ((kq < 256) ? gain[kq] : (kq < 768) ? gain_b[kq - 256] : gain_c[kq - 768]) : (gain ? gain[kq] : 1.0f);
            *(f32x4*)(tile + kk * 260 + cl) = v[i] * g;
        }
        __syncthreads();
        {
            const int nn = tid >> 1, kh = (tid & 1) * 32;
#pragma unroll
            for (int c = 0; c < 4; ++c) {
                const int kb = kh + 8 * c;
                u32x4 w;
                w.x = pack2(tile[(kb + 0) * 260 + nn], tile[(kb + 1) * 260 + nn]);
                w.y = pack2(tile[(kb + 2) * 260 + nn], tile[(kb + 3) * 260 + nn]);
                w.z = pack2(tile[(kb + 4) * 260 + nn], tile[(kb + 5) * 260 + nn]);
                w.w = pack2(tile[(kb + 6) * 260 + nn], tile[(kb + 7) * 260 + nn]);
                *(u32x4*)(dst + (size_t)(n0 + nn) * K + k0 + kb) = w;
            }
        }
        __syncthreads();
    }
}

DI void hy_h2_phase(unsigned char* lds, const Params& p) {
    float* zs = (float*)lds;
    float* h1s = zs + 64 * 36;
    const int tid = tid_fresh(), rg = tid >> 6, j = tid & 63;
    float* h2 = (float*)(p.ws + O_H2);
    for (int u = blockIdx.x; u < 2 * (L_ / 64); u += gridDim.x) {
        const int l = u / (L_ / 64), t0 = (u % (L_ / 64)) * 64;
#pragma unroll 1
        for (int e = tid; e < 64 * 16; e += NTHR) {
            const int row = e >> 4, bnd = e & 15, t = t0 + row;
            const float w = 2.0f * 3.14159265358979323846f * (float)t / (float)L_;
            const float f = 1e-4f + (15.0f - 1e-4f) * (float)bnd / 15.0f;
            const float a = f * w;
            float sn, cs; fast_sincos(a, &sn, &cs);
            zs[row * 36 + 1 + bnd] = cs;
            zs[row * 36 + 17 + bnd] = -sn;
            if (bnd == 0) zs[row * 36] = (float)t / (float)(L_ - 1);
        }
        __syncthreads();
        {
            const float* w1 = p.in[5] + (size_t)l * 33 * 64;
            float wc[33];
#pragma unroll
            for (int e = 0; e < 33; ++e) wc[e] = w1[e * 64 + j];
            const float b1 = p.in[6][l * 64 + j], f1 = p.in[7][l * 64 + j];
#pragma unroll 2
            for (int i = 0; i < 8; ++i) {
                const int row = 8 * rg + i;
                float s = b1;
#pragma unroll
                for (int e = 0; e < 33; ++e) s += zs[row * 36 + e] * wc[e];
                h1s[row * 64 + j] = fast_sin(f1 * s);
            }
        }
        __syncthreads();
        {
            const float* w2 = p.in[8] + (size_t)l * 64 * 64;
            float wc[64];
#pragma unroll
            for (int e = 0; e < 64; ++e) wc[e] = w2[e * 64 + j];
            const float b2 = p.in[9][l * 64 + j], f2 = p.in[10][l * 64 + j];
#pragma unroll 2
            for (int i = 0; i < 8; ++i) {
                const int row = 8 * rg + i;
                float s = b2;
#pragma unroll
                for (int e = 0; e < 64; e += 4) { const f32x4 hv = *(const f32x4*)(h1s + row * 64 + e); s += hv[0] * wc[e] + hv[1] * wc[e + 1] + hv[2] * wc[e + 2] + hv[3] * wc[e + 3]; }
                h2[((size_t)l * L_ + t0 + row) * 64 + j] = fast_sin(f2 * s);
            }
        }
        __syncthreads();
    }
}

DI void ft_phase(unsigned char* lds, const Params& p, int l) {
    const int tid = tid_fresh(), lane = tid & 63, w = tid >> 6, r16 = lane & 15, q4 = lane >> 4;
    const float* h2 = (const float*)(p.ws + O_H2) + (size_t)l * L_ * 64;
    const float* w3 = p.in[11] + (size_t)l * 64 * 1024;
    const float min_decay = -4.605170185988091f / 1.5f, max_decay = -4.605170185988091f / 0.3f;
    for (int u = blockIdx.x; u < L_ / 32; u += gridDim.x) {
        const int t0 = u * 32;
        bf16x8 hb[2][2];
#pragma unroll
        for (int tt = 0; tt < 2; ++tt)
#pragma unroll
            for (int ks = 0; ks < 2; ++ks) {
                const float* hp = h2 + (size_t)(t0 + 16 * tt + r16) * 64 + 32 * ks + 8 * q4;
                const f32x4 a = *(const f32x4*)hp, b = *(const f32x4*)(hp + 4);
                u32x4 pw; pw.x = pack2(a[0], a[1]); pw.y = pack2(a[2], a[3]); pw.z = pack2(b[0], b[1]); pw.w = pack2(b[2], b[3]);
                hb[tt][ks] = __builtin_bit_cast(bf16x8, pw);
            }
#pragma unroll 1
        for (int nt = 0; nt < 8; ++nt) {
            const int n0 = 128 * w + 16 * nt;
            f32x4 acc0 = {0.f, 0.f, 0.f, 0.f}, acc1 = {0.f, 0.f, 0.f, 0.f};
#pragma unroll
            for (int ks = 0; ks < 2; ++ks) {
                const float* wp = w3 + (size_t)(32 * ks + 8 * q4) * 1024 + n0 + r16;
                u32x4 pw;
                pw.x = pack2(wp[0], wp[1024]); pw.y = pack2(wp[2048], wp[3072]); pw.z = pack2(wp[4096], wp[5120]); pw.w = pack2(wp[6144], wp[7168]);
                const bf16x8 wf = __builtin_bit_cast(bf16x8, pw);
                acc0 = __builtin_amdgcn_mfma_f32_16x16x32_bf16(wf, hb[0][ks], acc0, 0, 0, 0);
                acc1 = __builtin_amdgcn_mfma_f32_16x16x32_bf16(wf, hb[1][ks], acc1, 0, 0, 0);
            }
#pragma unroll
            for (int i = 0; i < 4; ++i) {
                const int col = n0 + 4 * q4 + i, c = col & 255, od = col >> 8;
                const float dlt = fabsf(min_decay + (max_decay - min_decay) * (float)c / 255.0f);
                float* dst = (float*)(p.ws + O_R1 + (size_t)c * 262144 + 131072) + od * L_ + t0 + r16;
                dst[0] = acc0[i] * expf(-((float)(t0 + r16) / (float)(L_ - 1)) * dlt);
                dst[16] = acc1[i] * expf(-((float)(t0 + 16 + r16) / (float)(L_ - 1)) * dlt);
            }
        }
    }
}

DI void rownorm_phase(const float* __restrict__ x, bf16_t* __restrict__ xn) {
    const int tid_ = tid_fresh(); const int lane = tid_ & 63, wid = tid_ >> 6;
    for (int row = blockIdx.x * 8 + wid; row < T_; row += gridDim.x * 8) {
        const float* xr = x + (size_t)row * 1024;
        f32x4 v[4]; float ss = 0.f;
#pragma unroll
        for (int i = 0; i < 4; ++i) { v[i] = *(const f32x4*)(xr + i * 256 + lane * 4); ss += v[i][0] * v[i][0] + v[i][1] * v[i][1] + v[i][2] * v[i][2] + v[i][3] * v[i][3]; }
        ss = wave_sum(ss);
        const float r = rsqrtf(ss * (1.0f / 1024.0f) + 1e-6f);
#pragma unroll
        for (int i = 0; i < 4; ++i) { u32x2 w; w.x = pack2(v[i][0] * r, v[i][1] * r); w.y = pack2(v[i][2] * r, v[i][3] * r); *(u32x2*)(xn + (size_t)row * 1024 + i * 256 + lane * 4) = w; }
    }
}

DI void resid_phase(const float* __restrict__ y, const float* __restrict__ xres, const float* __restrict__ g, float* __restrict__ xout, bf16_t* __restrict__ xn, bool want_xn) {
    const int tid_ = tid_fresh(); const int lane = tid_ & 63, wid = tid_ >> 6;
    for (int row = blockIdx.x * 8 + wid; row < T_; row += gridDim.x * 8) {
        const size_t ro = (size_t)row * 1024;
        f32x4 v[4]; float ss = 0.f;
#pragma unroll
        for (int i = 0; i < 4; ++i) { v[i] = *(const f32x4*)(y + ro + i * 256 + lane * 4); ss += v[i][0] * v[i][0] + v[i][1] * v[i][1] + v[i][2] * v[i][2] + v[i][3] * v[i][3]; }
        ss = wave_sum(ss);
        const float r = rsqrtf(ss * (1.0f / 1024.0f) + 1e-6f);
        float s2 = 0.f;
#pragma unroll
        for (int i = 0; i < 4; ++i) {
            const f32x4 xr = *(const f32x4*)(xres + ro + i * 256 + lane * 4);
            const f32x4 gg = *(const f32x4*)(g + i * 256 + lane * 4);
            v[i] = xr + v[i] * r * gg;
            s2 += v[i][0] * v[i][0] + v[i][1] * v[i][1] + v[i][2] * v[i][2] + v[i][3] * v[i][3];
            *(f32x4*)(xout + ro + i * 256 + lane * 4) = v[i];
        }
        if (want_xn) {
            s2 = wave_sum(s2);
            const float r2 = rsqrtf(s2 * (1.0f / 1024.0f) + 1e-6f);
#pragma unroll
            for (int i = 0; i < 4; ++i) { u32x2 w; w.x = pack2(v[i][0] * r2, v[i][1] * r2); w.y = pack2(v[i][2] * r2, v[i][3] * r2); *(u32x2*)(xn + ro + i * 256 + lane * 4) = w; }
        }
    }
}

#define XB_TMO      128
#define XB_XCNT(j)  (256  + 64 * (j))
#define XB_XSUB(j)  (1280 + 64 * (j))
#define XB_XGEN(j)  (2304 + 64 * (j))
#define XB_TOP      3328
#define XB_TOPGEN   3392
#define XCD_BAR_WORDS 3456
#define XB_SPIN_CAP (1u << 22)
#define LAS __attribute__((address_space(3)))
DI unsigned xb_ld(unsigned* p)              { return __hip_atomic_load(p, __ATOMIC_RELAXED, __HIP_MEMORY_SCOPE_AGENT); }
DI unsigned xb_add(unsigned* p, unsigned v) { return __hip_atomic_fetch_add(p, v, __ATOMIC_RELAXED, __HIP_MEMORY_SCOPE_AGENT); }
DI unsigned xb_xcc_id() { return (unsigned)__builtin_amdgcn_s_getreg((3 << 11) | 20) & 0xFu; }
#define XB_SPIN(cond, bar) do { unsigned _sp = 0; while (cond) { __builtin_amdgcn_s_sleep(1); \
    if ((++_sp & 255u) == 0u) { if (xb_ld(&(bar)[XB_TMO])) break; if (_sp > XB_SPIN_CAP) { atomicAdd(&(bar)[XB_TMO], 1u); break; } } } } while (0)
struct XcdBarrier { unsigned* bar; unsigned x; volatile LAS unsigned* st; };
DI XcdBarrier xcd_barrier_post(unsigned* bar, volatile LAS unsigned* st) {
    XcdBarrier b; b.bar = bar; b.x = xb_xcc_id(); b.st = st;
    if (threadIdx.x == 0) (void)xb_add(&bar[XB_XCNT(b.x)], 1u);
    return b;
}
DI void xcd_barrier_complete(unsigned* bar, unsigned x, unsigned& nloc, unsigned& nx) {
    const unsigned G = gridDim.x * gridDim.y * gridDim.z;
    unsigned sum, cnt, mine, sp = 0u;
    for (;;) {
        sum = 0u; cnt = 0u; mine = 0u;
#pragma unroll
        for (unsigned j = 0; j < 16; ++j) { const unsigned c = xb_ld(&bar[XB_XCNT(j)]); sum += c; cnt += (c > 0u) ? 1u : 0u; mine = (j == x) ? c : mine; }
        if (sum == G) break;
        __builtin_amdgcn_s_sleep(1);
        if ((++sp & 255u) == 0u) { if (xb_ld(&bar[XB_TMO])) break; if (sp > XB_SPIN_CAP) { atomicAdd(&bar[XB_TMO], 1u); break; } }
    }
    nloc = mine > 0u ? mine : 1u; nx = cnt > 0u ? cnt : 1u;
}
DI void xcd_barrier(const XcdBarrier& b) {
    asm volatile("s_waitcnt vmcnt(0)" ::: "memory");
    __syncthreads();
    if (threadIdx.x == 0) {
        unsigned* bar = b.bar;
        __builtin_amdgcn_s_waitcnt(0);
        unsigned nloc = b.st[0], nx = b.st[1];
        if (nloc == 0u) { xcd_barrier_complete(bar, b.x, nloc, nx); b.st[0] = nloc; b.st[1] = nx; }
        const unsigned old = xb_add(&bar[XB_XSUB(b.x)], 1u);
        const unsigned gen = old / nloc;
        if (old + 1u == (gen + 1u) * nloc) {
            __builtin_amdgcn_fence(__ATOMIC_RELEASE, "agent");
            asm volatile("s_waitcnt vmcnt(0)" ::: "memory");
            const unsigned og = xb_add(&bar[XB_TOP], 1u);
            const unsigned tg = og / nx;
            if (og + 1u == (tg + 1u) * nx) xb_add(&bar[XB_TOPGEN], 1u);
            else XB_SPIN(xb_ld(&bar[XB_TOPGEN]) == tg, bar);
            __builtin_amdgcn_fence(__ATOMIC_ACQUIRE, "agent");
            xb_add(&bar[XB_XGEN(b.x)], 1u);
            asm volatile("s_waitcnt vmcnt(0)" ::: "memory");
        } else {
            XB_SPIN(xb_ld(&bar[XB_XGEN(b.x)]) == gen, bar);
            __builtin_amdgcn_fence(__ATOMIC_ACQUIRE, "agent");
            asm volatile("s_waitcnt vmcnt(0)" ::: "memory");
        }
    }
    __syncthreads();
}

DI int swz128(int row, int chunk) { return row * 128 + ((chunk ^ ((row >> 1) & 7)) << 4); }

template <bool OVL, class Epi>
DI void gemm_phase(unsigned char* lds, const bf16_t* __restrict__ A, int lda, const bf16_t* __restrict__ Bt, int K, int nMt, int nNt, const Epi& epi, int bid = -1, int nb = 0) {
    if (bid < 0) { bid = blockIdx.x; nb = gridDim.x; }
    typedef __attribute__((address_space(3))) unsigned char lds_uc;
    lds_uc* ldsl = (lds_uc*)lds;
    const int tid = tid_fresh(), lane = tid & 63, wid = tid >> 6, wm = wid & 1, wn = wid >> 1;
    const int r16 = lane & 15, q4 = lane >> 4;
    const int nk = K >> 6;
    const int xr = (r16 >> 1) & 7;
    const int ab0 = (128 * wm + r16) * 128 + ((q4 ^ xr) << 4), ab1 = (128 * wm + r16) * 128 + (((4 + q4) ^ xr) << 4);
    const int bb0 = 32768 + (64 * wn + r16) * 128 + ((q4 ^ xr) << 4), bb1 = 32768 + (64 * wn + r16) * 128 + (((4 + q4) ^ xr) << 4);
#pragma unroll 1
    for (int rep = 0; rep < REP_GEMM; ++rep)
    for (int u = bid; u < nMt * nNt; u += nb) {
        int um, un;
        { const int nM8 = nMt & ~7, nmain = nM8 * nNt;
          if (u < nmain) { um = u % nM8; un = u / nM8; } else { const int v = u - nmain, rem = nMt - nM8; um = nM8 + v % rem; un = v / rem; } }
        const bf16_t* ap[4]; const bf16_t* bp[4];
        int t0 = 0, bb = 0;
        if (OVL) { bb = um / 33; t0 = 254 * (um % 33) - 1; }
#pragma unroll
        for (int i = 0; i < 4; ++i) {
            const int P = (wid * 4 + i) * 64 + lane, row = P >> 3, c = (P & 7) ^ ((row >> 1) & 7);
            int grow;
            if (OVL) { int t = t0 + row; t = t < 0 ? 0 : (t > L_ - 1 ? L_ - 1 : t); grow = bb * L_ + t; }
            else grow = um * 256 + row;
            ap[i] = A + (size_t)grow * lda + c * 8;
            bp[i] = Bt + (size_t)(un * 256 + row) * K + c * 8;
        }
        f32x4 acc[8][4];
#pragma unroll
        for (int a = 0; a < 8; ++a)
#pragma unroll
            for (int b = 0; b < 4; ++b) acc[a][b] = (f32x4){0.f, 0.f, 0.f, 0.f};
#define G_ISSUE(bufoff) do { _Pragma("unroll") for (int i = 0; i < 4; ++i) { __builtin_amdgcn_global_load_lds((const unsigned*)ap[i], (__attribute__((address_space(3))) unsigned*)(ldsl + (bufoff) + (wid * 4 + i) * 1024), 16, 0, 0); ap[i] += 64; } \
                             _Pragma("unroll") for (int i = 0; i < 4; ++i) { __builtin_amdgcn_global_load_lds((const unsigned*)bp[i], (__attribute__((address_space(3))) unsigned*)(ldsl + (bufoff) + 32768 + (wid * 4 + i) * 1024), 16, 0, 0); bp[i] += 64; } } while (0)
        __syncthreads();
        G_ISSUE(0);
        asm volatile("s_waitcnt vmcnt(0)" ::: "memory");
        __builtin_amdgcn_s_barrier();
        asm volatile("" ::: "memory");
#pragma unroll 1
        for (int kt = 0; kt < nk; ++kt) {
            const int cb = (kt & 1) * 65536;
            const unsigned char* lb = lds + cb;
#pragma unroll
            for (int ks = 0; ks < 2; ++ks) {
                bf16x8 af[4], bfr[4];
#pragma unroll
                for (int nt = 0; nt < 4; ++nt) bfr[nt] = *(const bf16x8*)(lb + (ks ? bb1 : bb0) + nt * 2048);
#pragma unroll
                for (int mh = 0; mh < 2; ++mh) {
#pragma unroll
                    for (int mt = 0; mt < 4; ++mt) af[mt] = *(const bf16x8*)(lb + (ks ? ab1 : ab0) + (4 * mh + mt) * 2048);
                    __builtin_amdgcn_sched_barrier(0);
#pragma unroll
                    for (int mt = 0; mt < 4; ++mt)
#pragma unroll
                        for (int nt = 0; nt < 4; ++nt) acc[4 * mh + mt][nt] = __builtin_amdgcn_mfma_f32_16x16x32_bf16(bfr[nt], af[mt], acc[4 * mh + mt][nt], 0, 0, 0);
                    __builtin_amdgcn_sched_barrier(0);
                    if (ks == 0 && mh == (wid >= 4 ? 1 : 0) && kt + 1 < nk) G_ISSUE(65536 - cb);
                }
            }
            asm volatile("s_waitcnt vmcnt(0) lgkmcnt(0)" ::: "memory");
            __builtin_amdgcn_s_barrier();
            asm volatile("" ::: "memory");
        }
        int r16e = r16, q4e = q4;
        asm volatile("" : "+v"(r16e), "+v"(q4e));
        if constexpr (Epi::STAGED) {
            epi.staged(lds, acc, um, un, wm, wn, r16e, q4e);
        } else {
#pragma unroll
            for (int mt = 0; mt < 8; ++mt) { epi.row(um * 256 + 128 * wm + 16 * mt + r16e, un * 256 + 64 * wn, q4e, acc[mt]); asm volatile("" ::: "memory"); }
        }
    }
#undef G_ISSUE
}

struct EpiIn {
    static constexpr bool STAGED = true;
    float* hyT; bf16_t* projb;
    template <int HF> static DI void hy_half(float* st, const f32x4 (&acc)[8][4], float* dst, int r16, int q4, int lane) {
#pragma unroll
        for (int mt = 0; mt < 4; ++mt)
#pragma unroll
            for (int nt = 0; nt < 4; ++nt)
#pragma unroll
                for (int i = 0; i < 4; ++i) st[(16 * nt + 4 * q4 + i) * 65 + 16 * mt + r16] = acc[4 * HF + mt][nt][i];
        asm volatile("s_waitcnt lgkmcnt(0)" ::: "memory");
#pragma unroll 4
        for (int n = 0; n < 64; ++n) dst[(size_t)n * T_] = st[n * 65 + lane];
        asm volatile("s_waitcnt lgkmcnt(0)" ::: "memory");
    }
    DI void staged(unsigned char* lds, const f32x4 (&acc)[8][4], int um, int un, int wm, int wn, int r16, int q4) const {
        if (un < 3) {
            float* st = (float*)lds + (wm + 2 * wn) * (64 * 65);
            const int lane = r16 + 16 * q4;
            float* dst = hyT + (size_t)(un * 256 + 64 * wn) * T_ + um * 256 + 128 * wm + lane;
            hy_half<0>(st, acc, dst, r16, q4, lane);
            hy_half<1>(st, acc, dst + 64, r16, q4, lane);
        } else {
#pragma unroll
            for (int mt = 0; mt < 8; ++mt) {
                const int tok = um * 256 + 128 * wm + 16 * mt + r16;
#pragma unroll
                for (int nt = 0; nt < 4; ++nt) {
                    const int col = un * 256 + 64 * wn + 16 * nt + 4 * q4;
                    if (col < 1952) {
                        u32x2 w; w.x = pack2(acc[mt][nt][0], acc[mt][nt][1]); w.y = pack2(acc[mt][nt][2], acc[mt][nt][3]);
                        *(u32x2*)(projb + (unsigned)(tok * 1184 + (col - 768))) = w;
                    }
                }
            }
        }
    }
};
struct EpiF32 {
    static constexpr bool STAGED = false;
    float* C; int ldc;
    DI void row(int tok, int colbase, int q4, const f32x4 (&a)[4]) const {
#pragma unroll
        for (int nt = 0; nt < 4; ++nt) *(f32x4*)(C + (size_t)tok * ldc + colbase + 16 * nt + 4 * q4) = a[nt];
    }
};
struct EpiResid {
    static constexpr bool STAGED = true;
    const float* xold; float* xout; bf16_t* xn; const float* g; float* slots; XcdBarrier xb; bool want_xn;
    DI void staged(unsigned char* lds, f32x4 (&acc)[8][4], int um, int un, int wm, int wn, int r16, int q4) const {
        float* P = (float*)lds;
        const int tid = threadIdx.x;
#pragma unroll
        for (int mt = 0; mt < 8; ++mt) {
            float ss = 0.f;
#pragma unroll
            for (int nt = 0; nt < 4; ++nt) ss += acc[mt][nt][0] * acc[mt][nt][0] + acc[mt][nt][1] * acc[mt][nt][1] + acc[mt][nt][2] * acc[mt][nt][2] + acc[mt][nt][3] * acc[mt][nt][3];
            ss += __shfl_xor(ss, 16); ss += __shfl_xor(ss, 32);
            if (q4 == 0) P[(128 * wm + 16 * mt + r16) * 4 + wn] = ss;
        }
        __syncthreads();
        if (tid < 256) slots[(size_t)(um * 256 + tid) * 4 + un] = (P[tid * 4] + P[tid * 4 + 1]) + (P[tid * 4 + 2] + P[tid * 4 + 3]);
        xcd_barrier(xb);
#pragma unroll
        for (int mt = 0; mt < 8; ++mt) {
            const int tok = um * 256 + 128 * wm + 16 * mt + r16;
            const f32x4 sl = *(const f32x4*)(slots + (size_t)tok * 4);
            const float rr = rsqrtf(((sl[0] + sl[1]) + (sl[2] + sl[3])) * (1.0f / 1024.0f) + 1e-6f);
            float ss = 0.f;
#pragma unroll
            for (int nt = 0; nt < 4; ++nt) {
                const int col = un * 256 + 64 * wn + 16 * nt + 4 * q4;
                const f32x4 xo = *(const f32x4*)(xold + (size_t)tok * 1024 + col);
                const f32x4 gg = *(const f32x4*)(g + col);
                const f32x4 v = xo + acc[mt][nt] * rr * gg;
                acc[mt][nt] = v;
                *(f32x4*)(xout + (size_t)tok * 1024 + col) = v;
                ss += v[0] * v[0] + v[1] * v[1] + v[2] * v[2] + v[3] * v[3];
            }
            ss += __shfl_xor(ss, 16); ss += __shfl_xor(ss, 32);
            if (q4 == 0) P[(128 * wm + 16 * mt + r16) * 4 + wn] = ss;
            asm volatile("" ::: "memory");
        }
        if (want_xn) {
            __syncthreads();
            float* slots2 = slots + (size_t)T_ * 4;
            if (tid < 256) slots2[(size_t)(um * 256 + tid) * 4 + un] = (P[tid * 4] + P[tid * 4 + 1]) + (P[tid * 4 + 2] + P[tid * 4 + 3]);
            xcd_barrier(xb);
#pragma unroll
            for (int mt = 0; mt < 8; ++mt) {
                const int tok = um * 256 + 128 * wm + 16 * mt + r16;
                const f32x4 sl = *(const f32x4*)(slots2 + (size_t)tok * 4);
                const float rr = rsqrtf(((sl[0] + sl[1]) + (sl[2] + sl[3])) * (1.0f / 1024.0f) + 1e-6f);
#pragma unroll
                for (int nt = 0; nt < 4; ++nt) {
                    const int col = un * 256 + 64 * wn + 16 * nt + 4 * q4;
                    u32x2 w; w.x = pack2(acc[mt][nt][0] * rr, acc[mt][nt][1] * rr); w.y = pack2(acc[mt][nt][2] * rr, acc[mt][nt][3] * rr);
                    *(u32x2*)(xn + (size_t)tok * 1024 + col) = w;
                }
            }
        }
        __syncthreads();
    }
};
struct EpiUq {
    static constexpr bool STAGED = false;
    bf16_t* Qm; const float* rq; float sc;
    DI void row(int tok, int colbase, int q4, const f32x4 (&a)[4]) const {
        const float r = rq[tok] * sc;
        const int b = tok >> 13, t = tok & (L_ - 1);
#pragma unroll
        for (int nt = 0; nt < 4; ++nt) {
            const int col = colbase + 16 * nt + 4 * q4;
            if (col >= 384) continue;
            const int head = col / 96, j = col - head * 96;
            bf16_t* dst = Qm + ((size_t)(b * 4 + head) * L_ + t) * 96;
            if (j < 64) {
                u32x2 w; w.x = pack2(a[nt][0] * r, a[nt][1] * r); w.y = pack2(a[nt][2] * r, a[nt][3] * r);
                *(u32x2*)(dst + j) = w;
            } else if (j < 80) {
                if (nt < 3) {
                    const int p0 = j - 64;
                    float o1[4], o2[4];
#pragma unroll
                    for (int i = 0; i < 4; ++i) {
                        const int pp = p0 + i;
                        const float inv = __expf(-(float)(pp & 7) * (9.210340371976184f / 8.0f));
                        const float ang = (float)((pp < 8) ? (t >> 6) : (t & 63)) * inv;
                        float sn, cs; fast_sincos(ang, &sn, &cs);
                        const float x1 = a[nt][i] * r, x2 = a[(nt < 3) ? nt + 1 : 3][i] * r;
                        o1[i] = x1 * cs - x2 * sn; o2[i] = x1 * sn + x2 * cs;
                    }
                    u32x2 w; w.x = pack2(o1[0], o1[1]); w.y = pack2(o1[2], o1[3]);
                    *(u32x2*)(dst + j) = w;
                    w.x = pack2(o2[0], o2[1]); w.y = pack2(o2[2], o2[3]);
                    *(u32x2*)(dst + j + 16) = w;
                }
            }
        }
    }
};
struct EpiUkv {
    static constexpr bool STAGED = false;
    bf16_t* Km; bf16_t* VmT; const float* rkv;
    DI void row(int tok, int colbase, int q4, const f32x4 (&a)[4]) const {
        const float r = rkv[tok];
        const int b = tok >> 13, t = tok & (L_ - 1);
#pragma unroll
        for (int nt = 0; nt < 4; ++nt) {
            const int col = colbase + 16 * nt + 4 * q4;
            const int head = col >> 7, j = col & 127;
            if (j < 64) {
                u32x2 w; w.x = pack2(a[nt][0] * r, a[nt][1] * r); w.y = pack2(a[nt][2] * r, a[nt][3] * r);
                *(u32x2*)(Km + ((size_t)(b * 4 + head) * L_ + t) * 96 + j) = w;
            } else {
#pragma unroll
                for (int i = 0; i < 4; ++i) VmT[((size_t)(b * 4 + head) * 64 + (j - 64 + i)) * L_ + perm16(t)] = f2bf(a[nt][i] * r);
            }
        }
    }
};
DI float gelu_tanh(float x) {
    const float x2 = x * x;
    const float w = x * (-2.302208198f - 0.1029432397f * x2);
    return x * __builtin_amdgcn_rcpf(1.0f + __builtin_amdgcn_exp2f(w));
}
struct EpiUp {
    static constexpr bool STAGED = true;
    bf16_t* act; const float* cw; const float* cb;
    DI void staged(unsigned char* lds, const f32x4 (&acc)[8][4], int um, int un, int wm, int wn, int r16, int q4) const {
        bf16_t* st = (bf16_t*)lds;
#pragma unroll
        for (int mt = 0; mt < 8; ++mt)
#pragma unroll
            for (int nt = 0; nt < 4; ++nt) {
                u32x2 w; w.x = pack2(acc[mt][nt][0], acc[mt][nt][1]); w.y = pack2(acc[mt][nt][2], acc[mt][nt][3]);
                *(u32x2*)(st + (128 * wm + 16 * mt + r16) * 264 + 64 * wn + 16 * nt + 4 * q4) = w;
            }
        __syncthreads();
        const int tid = threadIdx.x, jp = tid & 31, hf = (tid >> 5) & 1, seg = __builtin_amdgcn_readfirstlane(tid >> 6);
        const int bb = um / 33, t0 = 254 * (um % 33) - 1;
        const int r0 = 32 * seg;
        const int ch = 64 * (2 * un + hf) + 2 * jp;
        float g0[2], g1[2], g2[2], gb[2], v0[2], v1[2], v2[2], vb[2];
#pragma unroll
        for (int e = 0; e < 2; ++e) {
            g0[e] = cw[ch + e]; g1[e] = cw[5632 + ch + e]; g2[e] = cw[2 * 5632 + ch + e]; gb[e] = cb[ch + e];
            v0[e] = cw[2816 + ch + e]; v1[e] = cw[5632 + 2816 + ch + e]; v2[e] = cw[2 * 5632 + 2816 + ch + e]; vb[e] = cb[2816 + ch + e];
        }
        const int rlo = (t0 < 0) ? -t0 : 0, rhi = (L_ - 1 - t0 < 255) ? (L_ - 1 - t0) : 255;
        const bf16_t* sp = st + r0 * 264 + 128 * hf + 2 * jp;
        const bool pv = (r0 - 1 >= rlo) && (r0 - 1 <= rhi), cvd = (r0 >= rlo) && (r0 <= rhi);
        unsigned gpw = pv ? *(const unsigned*)(sp - 264) : 0u, vpw = pv ? *(const unsigned*)(sp - 264 + 64) : 0u;
        unsigned gcw = cvd ? *(const unsigned*)sp : 0u, vcw = cvd ? *(const unsigned*)(sp + 64) : 0u;
        bf16_t* dst = act + (size_t)(bb * L_ + t0 + r0) * 2816 + ch;
#define LO(w) __uint_as_float((w) << 16)
#define HI(w) __uint_as_float((w) & 0xffff0000u)
#pragma unroll 4
        for (int i = 0; i < 32; ++i) {
            const int r = r0 + i;
            const bool nv = (r + 1 >= rlo) && (r + 1 <= rhi);
            const unsigned gnw = nv ? *(const unsigned*)(sp + (i + 1) * 264) : 0u, vnw = nv ? *(const unsigned*)(sp + (i + 1) * 264 + 64) : 0u;
            if (r >= 1 && r <= 254 && r <= rhi) {
                const float cg0 = g0[0] * LO(gpw) + g1[0] * LO(gcw) + g2[0] * LO(gnw) + gb[0];
                const float cv0 = v0[0] * LO(vpw) + v1[0] * LO(vcw) + v2[0] * LO(vnw) + vb[0];
                const float cg1 = g0[1] * HI(gpw) + g1[1] * HI(gcw) + g2[1] * HI(gnw) + gb[1];
                const float cv1 = v0[1] * HI(vpw) + v1[1] * HI(vcw) + v2[1] * HI(vnw) + vb[1];
                *(unsigned*)(dst + (size_t)i * 2816) = pack2(gelu_tanh(cg0) * cv0, gelu_tanh(cg1) * cv1);
            }
            gpw = gcw; gcw = gnw; vpw = vcw; vcw = vnw;
        }
#undef LO
#undef HI
        __syncthreads();
    }
};

DI void prep_phase(const Params& p, int l) {
    const int tid_ = tid_fresh(); const int lane = tid_ & 63, wid = tid_ >> 6;
    const bf16_t* projb = (const bf16_t*)(p.ws + O_PROJB);
    bf16_t* Qg = (bf16_t*)(p.ws + O_QG); bf16_t* Kg = (bf16_t*)(p.ws + O_KG); bf16_t* VgT = (bf16_t*)(p.ws + O_VGT);
    bf16_t* Km = (bf16_t*)(p.ws + O_KM);
    float* rq = (float*)(p.ws + O_RQ); float* rkv = (float*)(p.ws + O_RKV);
    const float* gq = p.in[13] + l * 64; const float* gk = p.in[14] + l * 64;
    const int hd = lane >> 3, sub = lane & 7;
    float gq1[4], gq2[4], gk1[4], gk2[4];
#pragma unroll
    for (int i = 0; i < 4; ++i) { gq1[i] = gq[4 * sub + i]; gq2[i] = gq[32 + 4 * sub + i]; gk1[i] = gk[4 * sub + i]; gk2[i] = gk[32 + 4 * sub + i]; }
    const float qscale = 0.125f * 1.4426950408889634f;
    for (int tok = blockIdx.x * 8 + wid; tok < T_; tok += gridDim.x * 8) {
        const int b = tok >> 13, t = tok & (L_ - 1);
        const bf16_t* pr = projb + (size_t)tok * 1184;
        float cs[4], sn[4];
#pragma unroll
        for (int i = 0; i < 4; ++i) {
            const int pp = 4 * sub + i;
            const float inv = __expf(-(float)(pp & 15) * (9.210340371976184f / 16.0f));
            const float ang = (float)((pp < 16) ? (t >> 6) : (t & 63)) * inv;
            fast_sincos(ang, &sn[i], &cs[i]);
        }
        {
            const u32x2 w1 = *(const u32x2*)(pr + hd * 64 + 4 * sub), w2 = *(const u32x2*)(pr + hd * 64 + 32 + 4 * sub);
            float x1[4] = {bf2f((bf16_t)(w1.x & 0xffff)), bf2f((bf16_t)(w1.x >> 16)), bf2f((bf16_t)(w1.y & 0xffff)), bf2f((bf16_t)(w1.y >> 16))};
            float x2[4] = {bf2f((bf16_t)(w2.x & 0xffff)), bf2f((bf16_t)(w2.x >> 16)), bf2f((bf16_t)(w2.y & 0xffff)), bf2f((bf16_t)(w2.y >> 16))};
            float ss = 0.f;
#pragma unroll
            for (int i = 0; i < 4; ++i) ss += x1[i] * x1[i] + x2[i] * x2[i];
            ss += __shfl_xor(ss, 1); ss += __shfl_xor(ss, 2); ss += __shfl_xor(ss, 4);
            const float r = rsqrtf(ss * (1.0f / 64.0f) + 1e-6f);
            float o1[4], o2[4];
#pragma unroll
            for (int i = 0; i < 4; ++i) { const float a = x1[i] * r * gq1[i], c = x2[i] * r * gq2[i]; o1[i] = (a * cs[i] - c * sn[i]) * qscale; o2[i] = (a * sn[i] + c * cs[i]) * qscale; }
            bf16_t* dst = Qg + ((size_t)(b * 8 + hd) * L_ + t) * 64;
            u32x2 w; w.x = pack2(o1[0], o1[1]); w.y = pack2(o1[2], o1[3]); *(u32x2*)(dst + 4 * sub) = w;
            w.x = pack2(o2[0], o2[1]); w.y = pack2(o2[2], o2[3]); *(u32x2*)(dst + 32 + 4 * sub) = w;
        }
        if (lane < 16) {
            const u32x2 w1 = *(const u32x2*)(pr + 512 + hd * 64 + 4 * sub), w2 = *(const u32x2*)(pr + 512 + hd * 64 + 32 + 4 * sub);
            float x1[4] = {bf2f((bf16_t)(w1.x & 0xffff)), bf2f((bf16_t)(w1.x >> 16)), bf2f((bf16_t)(w1.y & 0xffff)), bf2f((bf16_t)(w1.y >> 16))};
            float x2[4] = {bf2f((bf16_t)(w2.x & 0xffff)), bf2f((bf16_t)(w2.x >> 16)), bf2f((bf16_t)(w2.y & 0xffff)), bf2f((bf16_t)(w2.y >> 16))};
            float ss = 0.f;
#pragma unroll
            for (int i = 0; i < 4; ++i) ss += x1[i] * x1[i] + x2[i] * x2[i];
            ss += __shfl_xor(ss, 1); ss += __shfl_xor(ss, 2); ss += __shfl_xor(ss, 4);
            const float r = rsqrtf(ss * (1.0f / 64.0f) + 1e-6f);
            float o1[4], o2[4];
#pragma unroll
            for (int i = 0; i < 4; ++i) { const float a = x1[i] * r * gk1[i], c = x2[i] * r * gk2[i]; o1[i] = a * cs[i] - c * sn[i]; o2[i] = a * sn[i] + c * cs[i]; }
            bf16_t* dst = Kg + ((size_t)(b * 2 + hd) * L_ + t) * 64;
            u32x2 w; w.x = pack2(o1[0], o1[1]); w.y = pack2(o1[2], o1[3]); *(u32x2*)(dst + 4 * sub) = w;
            w.x = pack2(o2[0], o2[1]); w.y = pack2(o2[2], o2[3]); *(u32x2*)(dst + 32 + 4 * sub) = w;
        }
        {
            const unsigned w = *(const unsigned*)(pr + 640 + 2 * lane);
            const int c0 = 2 * lane, kh = c0 >> 6, d = c0 & 63;
            bf16_t* dst = VgT + ((size_t)(b * 2 + kh) * 64 + d) * L_ + perm16(t);
            dst[0] = (bf16_t)(w & 0xffff); dst[L_] = (bf16_t)(w >> 16);
        }
        {
            const u32x2 w = *(const u32x2*)(pr + 768 + 4 * lane);
            const float a0 = bf2f((bf16_t)(w.x & 0xffff)), a1 = bf2f((bf16_t)(w.x >> 16)), a2 = bf2f((bf16_t)(w.y & 0xffff)), a3 = bf2f((bf16_t)(w.y >> 16));
            float ss = wave_sum(a0 * a0 + a1 * a1 + a2 * a2 + a3 * a3);
            if (lane == 0) rq[tok] = rsqrtf(ss * (1.0f / 256.0f) + 1e-6f);
        }
        {
            const unsigned w = *(const unsigned*)(pr + 1024 + 2 * lane);
            const float a0 = bf2f((bf16_t)(w & 0xffff)), a1 = bf2f((bf16_t)(w >> 16));
            float ss = wave_sum(a0 * a0 + a1 * a1);
            if (lane == 0) rkv[tok] = rsqrtf(ss * (1.0f / 128.0f) + 1e-6f);
        }
        if (lane < 16) {
            const float x1 = bf2f(pr[1152 + lane]), x2 = bf2f(pr[1152 + 16 + lane]);
            const float inv = __expf(-(float)(lane & 7) * (9.210340371976184f / 8.0f));
            const float ang = (float)((lane < 8) ? (t >> 6) : (t & 63)) * inv;
            float s1, c1; fast_sincos(ang, &s1, &c1);
            const bf16_t o1 = f2bf(x1 * c1 - x2 * s1), o2 = f2bf(x1 * s1 + x2 * c1);
#pragma unroll
            for (int hh = 0; hh < 4; ++hh) { bf16_t* dst = Km + ((size_t)(b * 4 + hh) * L_ + t) * 96 + 64; dst[lane] = o1; dst[16 + lane] = o2; }
        }
    }
}

template <int DQK> DI int kswz(int row, int chunk) {
    if (DQK == 64) return row * 128 + ((chunk ^ ((row >> 1) & 7)) << 4);
    else return row * 192 + ((chunk ^ ((row >> 2) & 3)) << 4);
}
template <int DQK>
DI void attn_unit(unsigned char* lds, const bf16_t* __restrict__ Qp, const bf16_t* __restrict__ Kp, const bf16_t* __restrict__ VTp, bf16_t* __restrict__ Yp  ) {
    constexpr int NS = DQK / 16, NC = DQK / 8, KB = 64 * DQK * 2, KVB = KB + 8192;
    const int tid = tid_fresh(), lane = tid & 63, w = tid >> 6, r = lane & 31, h = lane >> 5;
    bf16x8 qf[NS];
#pragma unroll
    for (int s = 0; s < NS; ++s) qf[s] = *(const bf16x8*)(Qp + (size_t)(32 * w + r) * DQK + 16 * s + 8 * h);
    f32x16 o0, o1;
#pragma unroll
    for (int i = 0; i < 16; ++i) { o0[i] = 0.f; o1[i] = 0.f; }
    float m = 0.f, lsum = 0.f;
    const int k_row0 = tid / NC, k_c0 = tid % NC;
    const int k_row1 = (tid + 512) / NC, k_c1 = (tid + 512) % NC;
    const bool k_two = (DQK == 96) && (tid < 256);
    const int v_row = tid >> 3, v_c = tid & 7;
    u32x4 rkA0, rkA1, rvA, rkB0, rkB1, rvB;
    rkA1 = (u32x4){0u, 0u, 0u, 0u}; rkB1 = rkA1;
#define A_LOAD(kt, R0, R1, RV) do { R0 = *(const u32x4*)(Kp + (size_t)((kt) * 64 + k_row0) * DQK + k_c0 * 8); \
                        if (k_two) R1 = *(const u32x4*)(Kp + (size_t)((kt) * 64 + k_row1) * DQK + k_c1 * 8); \
                        RV = *(const u32x4*)(VTp + (size_t)v_row * L_ + (kt) * 64 + v_c * 8); } while (0)
#define A_STORE(buf, R0, R1, RV) do { *(u32x4*)(lds + (buf) * KVB + kswz<DQK>(k_row0, k_c0)) = R0; \
                          if (k_two) *(u32x4*)(lds + (buf) * KVB + kswz<DQK>(k_row1, k_c1)) = R1; \
                          *(u32x4*)(lds + (buf) * KVB + KB + swz128(v_row, v_c)) = RV; } while (0)
    A_LOAD(0, rkA0, rkA1, rvA);
    A_LOAD(1, rkB0, rkB1, rvB);
    A_STORE(0, rkA0, rkA1, rvA);
    __syncthreads();
    constexpr int NKT = L_ / 64;
#pragma unroll 1
    for (int kt2 = 0; kt2 < NKT; kt2 += 2) {
#pragma unroll
      for (int cur = 0; cur < 2; ++cur) {
        const int kt = kt2 + cur;
        if (kt + 2 < NKT) { if (cur == 0) A_LOAD(kt + 2, rkA0, rkA1, rvA); else A_LOAD(kt + 2, rkB0, rkB1, rvB); }
        const unsigned char* lk = lds + cur * KVB;
        const unsigned char* lv = lk + KB;
        f32x16 s0, s1;
        const float negm = -m;
#pragma unroll
        for (int i = 0; i < 16; ++i) { s0[i] = negm; s1[i] = negm; }
#pragma unroll
        for (int s = 0; s < NS; ++s) {
            const bf16x8 k0 = *(const bf16x8*)(lk + kswz<DQK>(r, 2 * s + h));
            const bf16x8 k1 = *(const bf16x8*)(lk + kswz<DQK>(32 + r, 2 * s + h));
            s0 = __builtin_amdgcn_mfma_f32_32x32x16_bf16(k0, qf[s], s0, 0, 0, 0);
            s1 = __builtin_amdgcn_mfma_f32_32x32x16_bf16(k1, qf[s], s1, 0, 0, 0);
        }
        float mx = fmaxf(fmaxf(s0[0], s0[1]), s0[2]);
#pragma unroll
        for (int i = 3; i < 15; i += 2) mx = fmaxf(fmaxf(mx, s0[i]), s0[i + 1]);
        mx = fmaxf(mx, s0[15]);
#pragma unroll
        for (int i = 0; i < 16; i += 2) mx = fmaxf(fmaxf(mx, s1[i]), s1[i + 1]);
        mx = fmaxf(mx, __shfl_xor(mx, 32));
        if (kt == 0 || __any(mx > 8.0f)) {
            const float dm = (kt == 0) ? mx : fmaxf(mx, 0.f);
            const float alpha = (kt == 0) ? 0.f : __builtin_amdgcn_exp2f(-dm);
            m += dm;
            lsum *= alpha;
#pragma unroll
            for (int i = 0; i < 16; ++i) { o0[i] *= alpha; o1[i] *= alpha; s0[i] -= dm; s1[i] -= dm; }
        }
        float ps = 0.f;
#pragma unroll
        for (int i = 0; i < 16; ++i) { s0[i] = __builtin_amdgcn_exp2f(s0[i]); ps += s0[i]; }
#pragma unroll
        for (int i = 0; i < 16; ++i) { s1[i] = __builtin_amdgcn_exp2f(s1[i]); ps += s1[i]; }
        lsum += ps;
#pragma unroll
        for (int sub = 0; sub < 2; ++sub)
#pragma unroll
            for (int s2 = 0; s2 < 2; ++s2) {
                u32x4 pw;
                if (sub == 0) { pw.x = pack2(s0[8 * s2 + 0], s0[8 * s2 + 1]); pw.y = pack2(s0[8 * s2 + 2], s0[8 * s2 + 3]); pw.z = pack2(s0[8 * s2 + 4], s0[8 * s2 + 5]); pw.w = pack2(s0[8 * s2 + 6], s0[8 * s2 + 7]); }
                else          { pw.x = pack2(s1[8 * s2 + 0], s1[8 * s2 + 1]); pw.y = pack2(s1[8 * s2 + 2], s1[8 * s2 + 3]); pw.z = pack2(s1[8 * s2 + 4], s1[8 * s2 + 5]); pw.w = pack2(s1[8 * s2 + 6], s1[8 * s2 + 7]); }
                const bf16x8 pf = __builtin_bit_cast(bf16x8, pw);
                const bf16x8 vf0 = *(const bf16x8*)(lv + swz128(r, 4 * sub + 2 * s2 + h));
                const bf16x8 vf1 = *(const bf16x8*)(lv + swz128(32 + r, 4 * sub + 2 * s2 + h));
                o0 = __builtin_amdgcn_mfma_f32_32x32x16_bf16(vf0, pf, o0, 0, 0, 0);
                o1 = __builtin_amdgcn_mfma_f32_32x32x16_bf16(vf1, pf, o1, 0, 0, 0);
            }
        if (kt + 1 < NKT) { if (cur == 0) A_STORE(1, rkB0, rkB1, rvB); else A_STORE(0, rkA0, rkA1, rvA); }
        __syncthreads();
      }
    }
#undef A_LOAD
#undef A_STORE
    const float lt = lsum + __shfl_xor(lsum, 32);
    const float inv = 1.0f / lt;
    bf16_t* yr = Yp + (size_t)(32 * w + r) * 768;
#pragma unroll
    for (int g = 0; g < 4; ++g) {
        u32x2 wv; wv.x = pack2(o0[4 * g] * inv, o0[4 * g + 1] * inv); wv.y = pack2(o0[4 * g + 2] * inv, o0[4 * g + 3] * inv);
        *(u32x2*)(yr + 8 * g + 4 * h) = wv;
        wv.x = pack2(o1[4 * g] * inv, o1[4 * g + 1] * inv); wv.y = pack2(o1[4 * g + 2] * inv, o1[4 * g + 3] * inv);
        *(u32x2*)(yr + 32 + 8 * g + 4 * h) = wv;
    }
}

DI int pa(int e) { return e + (e >> 4); }
DI float2 cmul(float2 a, float2 b) { return make_float2(a.x * b.x - a.y * b.y, a.x * b.y + a.y * b.x); }
DI float2 cadd(float2 a, float2 b) { return make_float2(a.x + b.x, a.y + b.y); }
DI float2 csub(float2 a, float2 b) { return make_float2(a.x - b.x, a.y - b.y); }
template <bool INV> DI void dft4(float2& a, float2& b, float2& c, float2& d) {
    const float2 t0 = cadd(a, c), t1 = csub(a, c), t2 = cadd(b, d), t3 = csub(b, d);
    const float2 jt3 = INV ? make_float2(-t3.y, t3.x) : make_float2(t3.y, -t3.x);
    a = cadd(t0, t2); c = csub(t0, t2); b = cadd(t1, jt3); d = csub(t1, jt3);
}
template <bool INV> DI float2 tw16(float2 v, int k) {
    const float c1 = 0.9238795325112867f, s1 = 0.3826834323650898f, c2 = 0.7071067811865476f;
    float wr = 1.f, wi = 0.f;
    switch (k) {
        case 0: wr = 1.f; wi = 0.f; break;
        case 1: wr = c1; wi = -s1; break;
        case 2: wr = c2; wi = -c2; break;
        case 3: wr = s1; wi = -c1; break;
        case 4: wr = 0.f; wi = -1.f; break;
        case 6: wr = -c2; wi = -c2; break;
        case 9: wr = -c1; wi = s1; break;
        default: break;
    }
    if (INV) wi = -wi;
    return make_float2(v.x * wr - v.y * wi, v.x * wi + v.y * wr);
}
template <bool INV> DI void dft16(float2 (&x)[16]) {
#pragma unroll
    for (int b = 0; b < 4; ++b) dft4<INV>(x[b], x[b + 4], x[b + 8], x[b + 12]);
#pragma unroll
    for (int b = 1; b < 4; ++b)
#pragma unroll
        for (int pq = 1; pq < 4; ++pq) x[b + 4 * pq] = tw16<INV>(x[b + 4 * pq], b * pq);
#pragma unroll
    for (int pq = 0; pq < 4; ++pq) dft4<INV>(x[4 * pq], x[4 * pq + 1], x[4 * pq + 2], x[4 * pq + 3]);
#pragma unroll
    for (int a = 0; a < 4; ++a)
#pragma unroll
        for (int b = a + 1; b < 4; ++b) { const float2 tmp = x[4 * a + b]; x[4 * a + b] = x[4 * b + a]; x[4 * b + a] = tmp; }
}
template <bool INV> DI void pass_a(float2* Z, const float2* T1, int tid) {
#pragma unroll
    for (int i = 0; i < 8; ++i) {
        const int j = tid + 512 * i;
        float2* zp = Z + pa(j);
        float2 x0 = zp[0], x1 = zp[4352], x2 = zp[8704], x3 = zp[13056];
        float2 w1 = tw16<false>(T1[j & 1023], i >> 1);
        if (INV) w1.y = -w1.y;
        const float2 w2 = cmul(w1, w1), w3 = cmul(w2, w1);
        if (!INV) { dft4<false>(x0, x1, x2, x3); x1 = cmul(x1, w1); x2 = cmul(x2, w2); x3 = cmul(x3, w3); }
        else { x1 = cmul(x1, w1); x2 = cmul(x2, w2); x3 = cmul(x3, w3); dft4<true>(x0, x1, x2, x3); }
        zp[0] = x0; zp[4352] = x1; zp[8704] = x2; zp[13056] = x3;
    }
}
template <bool INV, int LS, int TS> DI void pass16(float2* Z, const float2* T1, int tid) {
#pragma unroll 1
    for (int i = 0; i < 2; ++i) {
        const int id = tid + 512 * i, j = id & ((1 << LS) - 1), base = (id >> LS) << (LS + 4);
        float2* zp = Z + pa(base + j);
        float2 x[16];
#pragma unroll
        for (int mm = 0; mm < 16; ++mm) x[mm] = zp[mm * ((1 << LS) + (1 << (LS - 4)))];
        float2 w1 = T1[j << TS];
        if (INV) w1.y = -w1.y;
        if (!INV) dft16<false>(x);
        float2 wq = w1;
#pragma unroll
        for (int qq = 1; qq < 16; ++qq) { x[qq] = cmul(x[qq], wq); wq = cmul(wq, w1); }
        if (INV) dft16<true>(x);
#pragma unroll
        for (int mm = 0; mm < 16; ++mm) zp[mm * ((1 << LS) + (1 << (LS - 4)))] = x[mm];
    }
}
DI void pass_d_store(const float2* Z, float2* __restrict__ Kf, int tid, float scale) {
#pragma unroll 1
    for (int i = 0; i < 2; ++i) {
        const int id = tid + 512 * i, base = id * 16;
        float2 x[16];
#pragma unroll
        for (int mm = 0; mm < 16; ++mm) x[mm] = Z[17 * id + mm];
        dft16<false>(x);
#pragma unroll
        for (int mm = 0; mm < 16; mm += 2) *(f32x4*)(Kf + base + mm) = (f32x4){x[mm].x * scale, x[mm].y * scale, x[mm + 1].x * scale, x[mm + 1].y * scale};
    }
}
DI void pass_d_lds(float2* Z, int tid) {
#pragma unroll 1
    for (int i = 0; i < 2; ++i) {
        const int id = tid + 512 * i, base = id * 16;
        float2 x[16];
#pragma unroll
        for (int mm = 0; mm < 16; ++mm) x[mm] = Z[17 * id + mm];
        dft16<false>(x);
#pragma unroll
        for (int mm = 0; mm < 16; ++mm) Z[17 * id + mm] = x[mm];
    }
}
DI void pass_d_mul(float2* Z, const float2* __restrict__ Kf, int tid) {
#pragma unroll 1
    for (int i = 0; i < 2; ++i) {
        const int id = tid + 512 * i, base = id * 16;
        float2 x[16];
#pragma unroll
        for (int mm = 0; mm < 16; ++mm) x[mm] = Z[17 * id + mm];
        dft16<false>(x);
#pragma unroll
        for (int mm = 0; mm < 16; mm += 2) {
            const f32x4 kk = *(const f32x4*)(Kf + base + mm);
            x[mm] = cmul(x[mm], make_float2(kk[0], kk[1])); x[mm + 1] = cmul(x[mm + 1], make_float2(kk[2], kk[3]));
        }
        dft16<true>(x);
#pragma unroll
        for (int mm = 0; mm < 16; ++mm) Z[17 * id + mm] = x[mm];
    }
}
DI void fft_conv(float2* Z, const float2* T1, const float2* Kf, int tid) {
    pass_a<false>(Z, T1, tid); __syncthreads();
    pass16<false, 8, 2>(Z, T1, tid); __syncthreads();
    pass16<false, 4, 6>(Z, T1, tid); __syncthreads();
    pass_d_mul(Z, Kf, tid); __syncthreads();
    pass16<true, 4, 6>(Z, T1, tid); __syncthreads();
    pass16<true, 8, 2>(Z, T1, tid); __syncthreads();
    pass_a<true>(Z, T1, tid); __syncthreads();
}

DI void hyena_unit(unsigned char* lds, const Params& p, int l, int c) {
    float2* Z = (float2*)lds;
    float2* T1 = (float2*)(lds + 139264);
    const int tid = tid_fresh();
    const float* hyT = (const float*)(p.ws + O_HYT);
    float2* Kf0 = (float2*)(p.ws + O_R1) + (size_t)c * 32768;
    float2* Kf1 = Kf0 + 16384;
    bf16_t* hyout = (bf16_t*)(p.ws + O_HYOUT) + (size_t)c * T_;
    for (int k = tid; k < 1024; k += NTHR) { float sn, cs; sincospif((float)k * (1.0f / 8192.0f), &sn, &cs); T1[k] = make_float2(cs, -sn); }
    __syncthreads();
    {
        const float* taps = (const float*)Kf1;
#pragma unroll 4
        for (int t = tid; t < L_; t += NTHR) { Z[pa(t)] = make_float2(taps[t], taps[2 * L_ + t]); Z[pa(16383 - t)] = make_float2(taps[L_ + t], taps[3 * L_ + t]); }
        __syncthreads();
        pass_a<false>(Z, T1, tid); __syncthreads();
        pass16<false, 8, 2>(Z, T1, tid); __syncthreads();
        pass16<false, 4, 6>(Z, T1, tid); __syncthreads();
        pass_d_lds(Z, tid); __syncthreads();
        const float sc = 0.5f / 16384.0f;
#pragma unroll 2
        for (int e = tid; e < 16384; e += NTHR) {
            const int a = e >> 12, b = (e >> 8) & 15, c4 = (e >> 4) & 15, d = e & 15;
            const int k = a + 4 * (b + 16 * (c4 + 16 * d));
            const int k2 = (16384 - k) & 16383;
            const int e2 = ((k2 & 3) << 12) | (((k2 >> 2) & 15) << 8) | (((k2 >> 6) & 15) << 4) | (k2 >> 10);
            const float2 z = Z[pa(e)], z2 = Z[pa(e2)];
            const float sx = z.x + z2.x, sy = z.y - z2.y, dx = z.x - z2.x, dy = z.y + z2.y;
            Kf0[e] = make_float2(sx * sc, sy * sc);
            Kf1[e] = make_float2(dy * sc, -dx * sc);
        }
        __syncthreads();
    }
    const float* cw = p.in[3] + (size_t)l * 3 * 768; const float* cb = p.in[4] + (size_t)l * 768;
    const float* skip = p.in[12] + (size_t)l * 2 * 256;
    float2* z1buf = Kf0;
    const float vw0 = cw[c], vw1 = cw[768 + c], vw2 = cw[1536 + c], vbb = cb[c];
    const float* uv = hyT + (size_t)c * T_;
#pragma unroll 2
    for (int t = tid; t < L_; t += NTHR) {
        float vv[2];
#pragma unroll
        for (int b = 0; b < 2; ++b) {
            const float* ub = uv + b * L_;
            const float um = (t > 0) ? ub[t - 1] : 0.f, uc = ub[t], up = (t < L_ - 1) ? ub[t + 1] : 0.f;
            vv[b] = vw0 * um + vw1 * uc + vw2 * up + vbb;
        }
        Z[pa(t)] = make_float2(vv[0], vv[1]); Z[pa(t + L_)] = make_float2(0.f, 0.f);
    }
    __syncthreads();
    __threadfence();
    fft_conv(Z, T1, Kf0, tid);
    {
        const int ch = 256 + c;
        const float w0 = cw[ch], w1 = cw[768 + ch], w2 = cw[1536 + ch], bb = cb[ch], sk = skip[c];
        const float* u0 = hyT + (size_t)ch * T_;
#pragma unroll 2
        for (int t = tid; t < L_; t += NTHR) {
            const float2 y = Z[pa(t)];
            float zz[2];
#pragma unroll
            for (int b = 0; b < 2; ++b) {
                const float* ub = u0 + b * L_;
                const float um = (t > 0) ? ub[t - 1] : 0.f, uc = ub[t], up = (t < L_ - 1) ? ub[t + 1] : 0.f;
                const float g = w0 * um + w1 * uc + w2 * up + bb;
                const float* vb = uv + b * L_;
                const float vm = (t > 0) ? vb[t - 1] : 0.f, vc = vb[t], vp = (t < L_ - 1) ? vb[t + 1] : 0.f;
                const float v = vw0 * vm + vw1 * vc + vw2 * vp + vbb;
                zz[b] = g * ((b ? y.y : y.x) + sk * v);
            }
            const float2 z1 = make_float2(zz[0], zz[1]);
            Z[pa(t)] = z1; Z[pa(t + L_)] = make_float2(0.f, 0.f);
            z1buf[t] = z1;
        }
    }
    __syncthreads();
    fft_conv(Z, T1, Kf1, tid);
    {
        const int ch = 512 + c;
        const float w0 = cw[ch], w1 = cw[768 + ch], w2 = cw[1536 + ch], bb = cb[ch], sk = skip[256 + c];
        const float* u0 = hyT + (size_t)ch * T_;
#pragma unroll 2
        for (int t = tid; t < L_; t += NTHR) {
            const float2 y = Z[pa(t)];
            const float2 z1 = z1buf[t];
#pragma unroll
            for (int b = 0; b < 2; ++b) {
                const float* ub = u0 + b * L_;
                const float um = (t > 0) ? ub[t - 1] : 0.f, uc = ub[t], up = (t < L_ - 1) ? ub[t + 1] : 0.f;
                const float g = w0 * um + w1 * uc + w2 * up + bb;
                hyout[b * L_ + t] = f2bf(g * ((b ? y.y : y.x) + sk * (b ? z1.y : z1.x)));
            }
        }
    }
    __syncthreads();
}

DI void groups_phase(unsigned char* lds, const Params& p) {
    bf16_t* tile = (bf16_t*)lds;
    const int tid = tid_fresh(), lane = tid & 63, wid = tid >> 6;
    const bf16_t* hyout = (const bf16_t*)(p.ws + O_HYOUT);
    const bf16_t* Y = (const bf16_t*)(p.ws + O_PROJB);
    bf16_t* G = (bf16_t*)(p.ws + O_HYT);
    for (int u = blockIdx.x; u < T_ / 64; u += gridDim.x) {
        const int tok0 = u * 64;
        {
            const int c = tid >> 1, hf = tid & 1;
            const u32x4* src = (const u32x4*)(hyout + (size_t)c * T_ + tok0 + hf * 32);
#pragma unroll
            for (int i = 0; i < 4; ++i) {
                const u32x4 v = src[i];
                unsigned* d = (unsigned*)(tile + c * 66 + hf * 32 + i * 8);
                d[0] = v.x; d[1] = v.y; d[2] = v.z; d[3] = v.w;
            }
        }
        __syncthreads();
#pragma unroll 1
        for (int i = 0; i < 8; ++i) {
            const int tl = wid * 8 + i, tok = tok0 + tl;
            float hv[4]; float sh = 0.f;
#pragma unroll
            for (int k = 0; k < 4; ++k) { hv[k] = bf2f(tile[(lane + 64 * k) * 66 + tl]); sh += hv[k] * hv[k]; }
            sh = wave_sum(sh);
            const float rh = rsqrtf(sh * (1.0f / 256.0f) + 1e-6f);
            bf16_t* gr = G + (size_t)tok * 1024;
#pragma unroll
            for (int k = 0; k < 4; ++k) gr[lane + 64 * k] = f2bf(hv[k] * rh);
            const bf16_t* yr = Y + (size_t)tok * 768;
            {
                const u32x4 v = *(const u32x4*)(yr + lane * 8);
                float a[8] = {bf2f((bf16_t)(v.x & 0xffff)), bf2f((bf16_t)(v.x >> 16)), bf2f((bf16_t)(v.y & 0xffff)), bf2f((bf16_t)(v.y >> 16)),
                              bf2f((bf16_t)(v.z & 0xffff)), bf2f((bf16_t)(v.z >> 16)), bf2f((bf16_t)(v.w & 0xffff)), bf2f((bf16_t)(v.w >> 16))};
                float ss = 0.f;
#pragma unroll
                for (int k = 0; k < 8; ++k) ss += a[k] * a[k];
                ss = wave_sum(ss);
                const float rr = rsqrtf(ss * (1.0f / 512.0f) + 1e-6f);
                u32x4 w; w.x = pack2(a[0] * rr, a[1] * rr); w.y = pack2(a[2] * rr, a[3] * rr); w.z = pack2(a[4] * rr, a[5] * rr); w.w = pack2(a[6] * rr, a[7] * rr);
                *(u32x4*)(gr + 256 + lane * 8) = w;
            }
            {
                const u32x2 v = *(const u32x2*)(yr + 512 + lane * 4);
                float a[4] = {bf2f((bf16_t)(v.x & 0xffff)), bf2f((bf16_t)(v.x >> 16)), bf2f((bf16_t)(v.y & 0xffff)), bf2f((bf16_t)(v.y >> 16))};
                float ss = wave_sum(a[0] * a[0] + a[1] * a[1] + a[2] * a[2] + a[3] * a[3]);
                const float rr = rsqrtf(ss * (1.0f / 256.0f) + 1e-6f);
                u32x2 w; w.x = pack2(a[0] * rr, a[1] * rr); w.y = pack2(a[2] * rr, a[3] * rr);
                *(u32x2*)(gr + 768 + lane * 4) = w;
            }
        }
        __syncthreads();
    }
}


extern __shared__ __attribute__((aligned(16))) unsigned char smem[];

__global__ void __launch_bounds__(512) fwd_megakernel(Params p) {
    cg::grid_group grid = cg::this_grid();
    unsigned char* lds = smem;
    unsigned char* ws = p.ws;
    unsigned* bar = (unsigned*)(ws + O_BAR);
    volatile LAS unsigned* xb_st = (volatile LAS unsigned*)(smem + LDS_BYTES - 16);
    if (threadIdx.x < 4) xb_st[threadIdx.x] = 0u;
    __syncthreads();
    const XcdBarrier xb = xcd_barrier_post(bar, xb_st);
    if (p.ws == nullptr) grid.sync();
#pragma unroll 1
    for (int l2 = 0; l2 < 2 * REP_PRO; ++l2) { const int l = l2 & 1;
        convT(lds, p.in[2] + (size_t)l * 1024 * 1952, 1024, 1952, 2048, p.in[1] + l * 1024, (bf16_t*)(ws + O_WIN) + (size_t)l * 2048 * 1024, 0);
        convT(lds, p.in[16] + (size_t)l * 256 * 384, 256, 384, 512, p.in[15] + l * 256, (bf16_t*)(ws + O_WUQ) + (size_t)l * 512 * 256, 0);
        convT(lds, p.in[18] + (size_t)l * 128 * 512, 128, 512, 512, p.in[17] + l * 128, (bf16_t*)(ws + O_WUKV) + (size_t)l * 512 * 128, 0);
        convT(lds, p.in[22] + (size_t)l * 1024 * 1024, 1024, 1024, 1024, p.in[19] + l * 256, (bf16_t*)(ws + O_WOUT) + (size_t)l * 1024 * 1024, 2, p.in[20] + l * 512, p.in[21] + l * 256);
        convT(lds, p.in[25] + (size_t)l * 1024 * 5632, 1024, 5632, 5632, p.in[24] + l * 1024, (bf16_t*)(ws + O_WUP) + (size_t)l * 5632 * 1024, 1);
        convT(lds, p.in[28] + (size_t)l * 2816 * 1024, 2816, 1024, 1024, nullptr, (bf16_t*)(ws + O_WDOWN) + (size_t)l * 1024 * 2816, 0);
    }
#ifndef REP_MISC
#define REP_MISC 1
#endif
#pragma unroll 1
    for (int rep = 0; rep < REP_MISC; ++rep) { hy_h2_phase(lds, p);
    rownorm_phase(p.in[0], (bf16_t*)(ws + O_XN)); }
    XSYNC();


#pragma unroll 1
    for (int l = 0; l < 2; ++l) {
        {
            EpiIn e; e.hyT = (float*)(ws + O_HYT); e.projb = (bf16_t*)(ws + O_PROJB);
            gemm_phase<false>(lds, (const bf16_t*)(ws + O_XN), 1024, (const bf16_t*)(ws + O_WIN) + (size_t)l * 2048 * 1024, 1024, 64, 8, e);
        }
        XSYNC();
#pragma unroll 1
        for (int rep = 0; rep < REP_EW; ++rep) prep_phase(p, l);
#pragma unroll 1
        for (int rep = 0; rep < REP_MISC; ++rep) ft_phase(lds, p, l);
        XSYNC();
        {
            EpiUq e; e.Qm = (bf16_t*)(ws + O_QM); e.rq = (const float*)(ws + O_RQ); e.sc = 0.10206207261596577f * 1.4426950408889634f;
            const int hb = gridDim.x >> 1;
            if ((int)blockIdx.x < hb) gemm_phase<false>(lds, (const bf16_t*)(ws + O_PROJB) + 768, 1184, (const bf16_t*)(ws + O_WUQ) + (size_t)l * 512 * 256, 256, 64, 2, e, blockIdx.x, hb);
            EpiUkv e2; e2.Km = (bf16_t*)(ws + O_KM); e2.VmT = (bf16_t*)(ws + O_VMT); e2.rkv = (const float*)(ws + O_RKV);
            if ((int)blockIdx.x >= hb) gemm_phase<false>(lds, (const bf16_t*)(ws + O_PROJB) + 1024, 1184, (const bf16_t*)(ws + O_WUKV) + (size_t)l * 512 * 128, 128, 64, 2, e2, blockIdx.x - hb, gridDim.x - hb);
        }
        XSYNC();
#pragma unroll 1
        for (int rep = 0; rep < REP_HY; ++rep)
        for (int c = blockIdx.x; c < 256; c += gridDim.x) hyena_unit(lds, p, l, c);
#pragma unroll 1
        for (int rep = 0; rep < REP_ATTN; ++rep)
        for (int u = blockIdx.x; u < 512; u += gridDim.x) {
            const int qt = u & 31, hh = (u >> 5) & 7, b = u >> 8, hk = hh >> 2;
            attn_unit<64>(lds, (const bf16_t*)(ws + O_QG) + ((size_t)(b * 8 + hh) * L_ + qt * 256) * 64,
                          (const bf16_t*)(ws + O_KG) + (size_t)(b * 2 + hk) * L_ * 64,
                          (const bf16_t*)(ws + O_VGT) + (size_t)(b * 2 + hk) * 64 * L_,
                          (bf16_t*)(ws + O_PROJB) + (size_t)(b * L_ + qt * 256) * 768 + hh * 64);
        }
#pragma unroll 1
        for (int rep = 0; rep < REP_ATTN; ++rep)
        for (int u = blockIdx.x; u < 256; u += gridDim.x) {
            const int qt = u & 31, hh = (u >> 5) & 3, b = u >> 7;
            attn_unit<96>(lds, (const bf16_t*)(ws + O_QM) + ((size_t)(b * 4 + hh) * L_ + qt * 256) * 96,
                          (const bf16_t*)(ws + O_KM) + (size_t)(b * 4 + hh) * L_ * 96,
                          (const bf16_t*)(ws + O_VMT) + (size_t)(b * 4 + hh) * 64 * L_,
                          (bf16_t*)(ws + O_PROJB) + (size_t)(b * L_ + qt * 256) * 768 + 512 + hh * 64);
        }
        XSYNC();
#pragma unroll 1
        for (int rep = 0; rep < REP_EW; ++rep) groups_phase(lds, p);
        XSYNC();
        if (gridDim.x == 256) {
            EpiResid e; e.xold = (l == 0) ? p.in[0] : p.out; e.xout = p.out; e.xn = (bf16_t*)(ws + O_XN); e.g = p.in[23] + l * 1024; e.slots = (float*)(ws + O_SLOTS); e.xb = xb; e.want_xn = true;
            gemm_phase<false>(lds, (const bf16_t*)(ws + O_HYT), 1024, (const bf16_t*)(ws + O_WOUT) + (size_t)l * 1024 * 1024, 1024, 64, 4, e);
            XSYNC();
        } else {
            EpiF32 e; e.C = (float*)(ws + O_R1); e.ldc = 1024;
            gemm_phase<false>(lds, (const bf16_t*)(ws + O_HYT), 1024, (const bf16_t*)(ws + O_WOUT) + (size_t)l * 1024 * 1024, 1024, 64, 4, e);
            XSYNC();
            resid_phase((const float*)(ws + O_R1), l == 0 ? p.in[0] : p.out, p.in[23] + l * 1024, p.out, (bf16_t*)(ws + O_XN), true);
            XSYNC();
        }
        {
            EpiUp e; e.act = (bf16_t*)(ws + O_HYT); e.cw = p.in[26] + (size_t)l * 3 * 5632; e.cb = p.in[27] + (size_t)l * 5632;
            gemm_phase<true>(lds, (const bf16_t*)(ws + O_XN), 1024, (const bf16_t*)(ws + O_WUP) + (size_t)l * 5632 * 1024, 1024, 66, 22, e);
        }
        XSYNC();
        if (gridDim.x == 256) {
            EpiResid e; e.xold = p.out; e.xout = p.out; e.xn = (bf16_t*)(ws + O_XN); e.g = p.in[29] + l * 1024; e.slots = (float*)(ws + O_SLOTS); e.xb = xb; e.want_xn = (l == 0);
            gemm_phase<false>(lds, (const bf16_t*)(ws + O_HYT), 2816, (const bf16_t*)(ws + O_WDOWN) + (size_t)l * 1024 * 2816, 2816, 64, 4, e);
            if (l == 0) XSYNC();
        } else {
            EpiF32 e; e.C = (float*)(ws + O_R1); e.ldc = 1024;
            gemm_phase<false>(lds, (const bf16_t*)(ws + O_HYT), 2816, (const bf16_t*)(ws + O_WDOWN) + (size_t)l * 1024 * 2816, 2816, 64, 4, e);
            XSYNC();
            resid_phase((const float*)(ws + O_R1), p.out, p.in[29] + l * 1024, p.out, (bf16_t*)(ws + O_XN), l == 0);
            if (l == 0) XSYNC();
        }
    }
}

extern "C" void kernel_launch(void* const* d_in, const int* in_sizes, int n_in,
                              void* d_out, int out_size, void* d_ws, size_t ws_size,
                              hipStream_t stream) {
    static int grid_blocks = 0;
    if (!grid_blocks) {
        int dev = 0, cus = 0, per_cu = 0;
        (void)hipGetDevice(&dev);
        (void)hipDeviceGetAttribute(&cus, hipDeviceAttributeMultiprocessorCount, dev);
        (void)hipFuncSetAttribute((const void*)fwd_megakernel, hipFuncAttributeMaxDynamicSharedMemorySize, (int)LDS_BYTES);
        (void)hipOccupancyMaxActiveBlocksPerMultiprocessor(&per_cu, fwd_megakernel, NTHR, LDS_BYTES);
        if (per_cu < 1) per_cu = 1;
        grid_blocks = cus;
        if (grid_blocks > 256) grid_blocks = 256;
    }
    Params p{};
    for (int i = 0; i < 30; ++i) p.in[i] = (const float*)d_in[i];
    p.out = (float*)d_out; p.ws = (unsigned char*)d_ws;
    void* args[] = {&p};
    (void)hipMemsetAsync((unsigned char*)d_ws + O_BAR, 0, XCD_BAR_WORDS * sizeof(unsigned), stream);
    hipError_t e = hipLaunchCooperativeKernel((void*)fwd_megakernel, dim3(grid_blocks), dim3(NTHR), args, LDS_BYTES, stream);
    if (e != hipSuccess) fprintf(stderr, "cooperative launch failed: %s (grid %d)\n", hipGetErrorString(e), grid_blocks);
}
```

```cpp
#include <hip/hip_runtime.h>
#include <hip/hip_cooperative_groups.h>
#include <cstdio>
#include <cstdint>
namespace cg = cooperative_groups;

typedef unsigned short bf16_t;
typedef short bf16x8 __attribute__((ext_vector_type(8)));
typedef float f32x4 __attribute__((ext_vector_type(4)));
typedef float f32x16 __attribute__((ext_vector_type(16)));
typedef unsigned u32x2 __attribute__((ext_vector_type(2)));
typedef unsigned u32x4 __attribute__((ext_vector_type(4)));

#define DI __device__ __forceinline__
#ifndef REP_ATTN
#define REP_ATTN 1
#endif
#ifndef REP_HY
#define REP_HY 1
#endif
#ifndef REP_GEMM
#define REP_GEMM 1
#endif
#ifndef REP_PRO
#define REP_PRO 1
#endif
#ifndef REP_SYNC
#define REP_SYNC 1
#endif
#define XSYNC() do { _Pragma("unroll 1") for (int r_ = 0; r_ < REP_SYNC; ++r_) xcd_barrier(xb); } while (0)
#ifndef REP_EW
#define REP_EW 1
#endif
constexpr int L_ = 8192, T_ = 16384, NTHR = 512;
constexpr size_t MiB = 1u << 20;
constexpr size_t O_WIN = 0, O_WUQ = 8 * MiB, O_WUKV = 8 * MiB + 512 * 1024, O_RQ = 8 * MiB + 768 * 1024, O_RKV = 8 * MiB + 832 * 1024;
constexpr size_t O_BAR = 8 * MiB + 896 * 1024;
constexpr size_t O_WOUT = 9 * MiB, O_WUP = 13 * MiB, O_WDOWN = 35 * MiB, O_H2 = 46 * MiB;
constexpr size_t O_R1 = 50 * MiB;
constexpr size_t O_HYT = 114 * MiB;
constexpr size_t O_PROJB = 162 * MiB;
constexpr size_t O_HYOUT = 186 * MiB;
constexpr size_t O_QG = 199 * MiB, O_KG = 215 * MiB, O_VGT = 219 * MiB, O_QM = 223 * MiB, O_KM = 235 * MiB, O_VMT = 247 * MiB;
constexpr size_t O_XN = 223 * MiB;
constexpr size_t O_SLOTS = 255 * MiB;
constexpr size_t LDS_BYTES = 150 * 1024;

struct Params { const float* in[30]; float* out; unsigned char* ws; };

typedef __bf16 bf16v2_t __attribute__((ext_vector_type(2)));
typedef float f32v2_t __attribute__((ext_vector_type(2)));
DI bf16_t f2bf(float x) { const __bf16 b = (__bf16)x; return __builtin_bit_cast(bf16_t, b); }
DI float bf2f(bf16_t v) { return __uint_as_float(((unsigned)v) << 16); }
DI unsigned pack2(float lo, float hi) { const f32v2_t v = {lo, hi}; const bf16v2_t b = __builtin_convertvector(v, bf16v2_t); return __builtin_bit_cast(unsigned, b); }
DI float wave_sum(float v) {
#pragma unroll
    for (int o = 32; o >= 1; o >>= 1) v += __shfl_xor(v, o);
    return v;
}
DI int tid_fresh() { int t = threadIdx.x; asm volatile("" : "+v"(t)); return t; }
DI void fast_sincos(float ang, float* s, float* c) {
    float rev = ang * 0.15915494309189535f; rev -= rintf(rev);
    *s = __builtin_amdgcn_sinf(rev); *c = __builtin_amdgcn_cosf(rev);
}
DI float fast_sin(float a) { float rev = a * 0.15915494309189535f; rev -= rintf(rev); return __builtin_amdgcn_sinf(rev); }
DI int perm16(int t) { return (t & ~15) | (t & 3) | (((t >> 3) & 1) << 2) | (((t >> 2) & 1) << 3); }

DI void convT(unsigned char* lds, const float* __restrict__ W, int K, int N, int Npad, const float* __restrict__ gain, bf16_t* __restrict__ dst, int mode, const float* __restrict__ gain_b = nullptr, const float* __restrict__ gain_c = nullptr) {
    float* tile = (float*)lds;
    const int tid = tid_fresh();
    const int nkt = K >> 6, nnt = Npad >> 8;
    for (int u = blockIdx.x; u < nkt * nnt; u += gridDim.x) {
        const int kt = u % nkt, ntile = u / nkt;
        const int k0 = kt * 64, n0 = ntile * 256;
        const int cl = 4 * (tid & 63);
        int src = n0 + cl;
        if (mode == 1) { const int nq = n0 + (cl & ~63), jt = nq >> 7, half = (nq >> 6) & 1; src = (half ? 2816 + 64 * jt : 64 * jt) + (cl & 63); }
        const bool valid = src < N;
        f32x4 v[8];
#pragma unroll
        for (int i = 0; i < 8; ++i) {
            const int kk = (tid >> 6) + 8 * i;
            v[i] = valid ? *(const f32x4*)(W + (size_t)(k0 + kk) * N + src) : (f32x4){0.f, 0.f, 0.f, 0.f};
        }
#pragma unroll
        for (int i = 0; i < 8; ++i) {
            const int kk = (tid >> 6) + 8 * i;
            const int kq = k0 + kk;
            const float g = (mode == 2) ? ((kq < 256) ? gain[kq] : (kq < 768) ? gain_b[kq - 256] : gain_c[kq - 768]) : (gain ? gain[kq] : 1.0f);
            *(f32x4*)(tile + kk * 260 + cl) = v[i] * g;
        }
        __syncthreads();
        {
            const int nn = tid >> 1, kh = (tid & 1) * 32;
#pragma unroll
            for (int c = 0; c < 4; ++c) {
                const int kb = kh + 8 * c;
                u32x4 w;
                w.x = pack2(tile[(kb + 0) * 260 + nn], tile[(kb + 1) * 260 + nn]);
                w.y = pack2(tile[(kb + 2) * 260 + nn], tile[(kb + 3) * 260 + nn]);
                w.z = pack2(tile[(kb + 4) * 260 + nn], tile[(kb + 5) * 260 + nn]);
                w.w = pack2(tile[(kb + 6) * 260 + nn], tile[(kb + 7) * 260 + nn]);
                *(u32x4*)(dst + (size_t)(n0 + nn) * K + k0 + kb) = w;
            }
        }
        __syncthreads();
    }
}

DI void hy_h2_phase(unsigned char* lds, const Params& p) {
    float* zs = (float*)lds;
    float* h1s = zs + 64 * 36;
    const int tid = tid_fresh(), rg = tid >> 6, j = tid & 63;
    float* h2 = (float*)(p.ws + O_H2);
    for (int u = blockIdx.x; u < 2 * (L_ / 64); u += gridDim.x) {
        const int l = u / (L_ / 64), t0 = (u % (L_ / 64)) * 64;
#pragma unroll 1
        for (int e = tid; e < 64 * 16; e += NTHR) {
            const int row = e >> 4, bnd = e & 15, t = t0 + row;
            const float w = 2.0f * 3.14159265358979323846f * (float)t / (float)L_;
            const float f = 1e-4f + (15.0f - 1e-4f) * (float)bnd / 15.0f;
            const float a = f * w;
            float sn, cs; fast_sincos(a, &sn, &cs);
            zs[row * 36 + 1 + bnd] = cs;
            zs[row * 36 + 17 + bnd] = -sn;
            if (bnd == 0) zs[row * 36] = (float)t / (float)(L_ - 1);
        }
        __syncthreads();
        {
            const float* w1 = p.in[5] + (size_t)l * 33 * 64;
            float wc[33];
#pragma unroll
            for (int e = 0; e < 33; ++e) wc[e] = w1[e * 64 + j];
            const float b1 = p.in[6][l * 64 + j], f1 = p.in[7][l * 64 + j];
#pragma unroll 2
            for (int i = 0; i < 8; ++i) {
                const int row = 8 * rg + i;
                float s = b1;
#pragma unroll
                for (int e = 0; e < 33; ++e) s += zs[row * 36 + e] * wc[e];
                h1s[row * 64 + j] = fast_sin(f1 * s);
            }
        }
        __syncthreads();
        {
            const float* w2 = p.in[8] + (size_t)l * 64 * 64;
            float wc[64];
#pragma unroll
            for (int e = 0; e < 64; ++e) wc[e] = w2[e * 64 + j];
            const float b2 = p.in[9][l * 64 + j], f2 = p.in[10][l * 64 + j];
#pragma unroll 2
            for (int i = 0; i < 8; ++i) {
                const int row = 8 * rg + i;
                float s = b2;
#pragma unroll
                for (int e = 0; e < 64; e += 4) { const f32x4 hv = *(const f32x4*)(h1s + row * 64 + e); s += hv[0] * wc[e] + hv[1] * wc[e + 1] + hv[2] * wc[e + 2] + hv[3] * wc[e + 3]; }
                h2[((size_t)l * L_ + t0 + row) * 64 + j] = fast_sin(f2 * s);
            }
        }
        __syncthreads();
    }
}

DI void ft_phase(unsigned char* lds, const Params& p, int l) {
    const int tid = tid_fresh(), lane = tid & 63, w = tid >> 6, r16 = lane & 15, q4 = lane >> 4;
    const float* h2 = (const float*)(p.ws + O_H2) + (size_t)l * L_ * 64;
    const float* w3 = p.in[11] + (size_t)l * 64 * 1024;
    const float min_decay = -4.605170185988091f / 1.5f, max_decay = -4.605170185988091f / 0.3f;
    for (int u = blockIdx.x; u < L_ / 32; u += gridDim.x) {
        const int t0 = u * 32;
        bf16x8 hb[2][2];
#pragma unroll
        for (int tt = 0; tt < 2; ++tt)
#pragma unroll
            for (int ks = 0; ks < 2; ++ks) {
                const float* hp = h2 + (size_t)(t0 + 16 * tt + r16) * 64 + 32 * ks + 8 * q4;
                const f32x4 a = *(const f32x4*)hp, b = *(const f32x4*)(hp + 4);
                u32x4 pw; pw.x = pack2(a[0], a[1]); pw.y = pack2(a[2], a[3]); pw.z = pack2(b[0], b[1]); pw.w = pack2(b[2], b[3]);
                hb[tt][ks] = __builtin_bit_cast(bf16x8, pw);
            }
#pragma unroll 1
        for (int nt = 0; nt < 8; ++nt) {
            const int n0 = 128 * w + 16 * nt;
            f32x4 acc0 = {0.f, 0.f, 0.f, 0.f}, acc1 = {0.f, 0.f, 0.f, 0.f};
#pragma unroll
            for (int ks = 0; ks < 2; ++ks) {
                const float* wp = w3 + (size_t)(32 * ks + 8 * q4) * 1024 + n0 + r16;
                u32x4 pw;
                pw.x = pack2(wp[0], wp[1024]); pw.y = pack2(wp[2048], wp[3072]); pw.z = pack2(wp[4096], wp[5120]); pw.w = pack2(wp[6144], wp[7168]);
                const bf16x8 wf = __builtin_bit_cast(bf16x8, pw);
                acc0 = __builtin_amdgcn_mfma_f32_16x16x32_bf16(wf, hb[0][ks], acc0, 0, 0, 0);
                acc1 = __builtin_amdgcn_mfma_f32_16x16x32_bf16(wf, hb[1][ks], acc1, 0, 0, 0);
            }
#pragma unroll
            for (int i = 0; i < 4; ++i) {
                const int col = n0 + 4 * q4 + i, c = col & 255, od = col >> 8;
                const float dlt = fabsf(min_decay + (max_decay - min_decay) * (float)c / 255.0f);
                float* dst = (float*)(p.ws + O_R1 + (size_t)c * 262144 + 131072) + od * L_ + t0 + r16;
                dst[0] = acc0[i] * expf(-((float)(t0 + r16) / (float)(L_ - 1)) * dlt);
                dst[16] = acc1[i] * expf(-((float)(t0 + 16 + r16) / (float)(L_ - 1)) * dlt);
            }
        }
    }
}

DI void rownorm_phase(const float* __restrict__ x, bf16_t* __restrict__ xn) {
    const int tid_ = tid_fresh(); const int lane = tid_ & 63, wid = tid_ >> 6;
    for (int row = blockIdx.x * 8 + wid; row < T_; row += gridDim.x * 8) {
        const float* xr = x + (size_t)row * 1024;
        f32x4 v[4]; float ss = 0.f;
#pragma unroll
        for (int i = 0; i < 4; ++i) { v[i] = *(const f32x4*)(xr + i * 256 + lane * 4); ss += v[i][0] * v[i][0] + v[i][1] * v[i][1] + v[i][2] * v[i][2] + v[i][3] * v[i][3]; }
        ss = wave_sum(ss);
        const float r = rsqrtf(ss * (1.0f / 1024.0f) + 1e-6f);
#pragma unroll
        for (int i = 0; i < 4; ++i) { u32x2 w; w.x = pack2(v[i][0] * r, v[i][1] * r); w.y = pack2(v[i][2] * r, v[i][3] * r); *(u32x2*)(xn + (size_t)row * 1024 + i * 256 + lane * 4) = w; }
    }
}

DI void resid_phase(const float* __restrict__ y, const float* __restrict__ xres, const float* __restrict__ g, float* __restrict__ xout, bf16_t* __restrict__ xn, bool want_xn) {
    const int tid_ = tid_fresh(); const int lane = tid_ & 63, wid = tid_ >> 6;
    for (int row = blockIdx.x * 8 + wid; row < T_; row += gridDim.x * 8) {
        const size_t ro = (size_t)row * 1024;
        f32x4 v[4]; float ss = 0.f;
#pragma unroll
        for (int i = 0; i < 4; ++i) { v[i] = *(const f32x4*)(y + ro + i * 256 + lane * 4); ss += v[i][0] * v[i][0] + v[i][1] * v[i][1] + v[i][2] * v[i][2] + v[i][3] * v[i][3]; }
        ss = wave_sum(ss);
        const float r = rsqrtf(ss * (1.0f / 1024.0f) + 1e-6f);
        float s2 = 0.f;
#pragma unroll
        for (int i = 0; i < 4; ++i) {
            const f32x4 xr = *(const f32x4*)(xres + ro + i * 256 + lane * 4);
            const f32x4 gg = *(const f32x4*)(g + i * 256 + lane * 4);
            v[i] = xr + v[i] * r * gg;
            s2 += v[i][0] * v[i][0] + v[i][1] * v[i][1] + v[i][2] * v[i][2] + v[i][3] * v[i][3];
            *(f32x4*)(xout + ro + i * 256 + lane * 4) = v[i];
        }
        if (want_xn) {
            s2 = wave_sum(s2);
            const float r2 = rsqrtf(s2 * (1.0f / 1024.0f) + 1e-6f);
#pragma unroll
            for (int i = 0; i < 4; ++i) { u32x2 w; w.x = pack2(v[i][0] * r2, v[i][1] * r2); w.y = pack2(v[i][2] * r2, v[i][3] * r2); *(u32x2*)(xn + ro + i * 256 + lane * 4) = w; }
        }
    }
}

#define XB_TMO      128
#define XB_XCNT(j)  (256  + 64 * (j))
#define XB_XSUB(j)  (1280 + 64 * (j))
#define XB_XGEN(j)  (2304 + 64 * (j))
#define XB_TOP      3328
#define XB_TOPGEN   3392
#define XCD_BAR_WORDS 3456
#define XB_SPIN_CAP (1u << 22)
#define LAS __attribute__((address_space(3)))
DI unsigned xb_ld(unsigned* p)              { return __hip_atomic_load(p, __ATOMIC_RELAXED, __HIP_MEMORY_SCOPE_AGENT); }
DI unsigned xb_add(unsigned* p, unsigned v) { return __hip_atomic_fetch_add(p, v, __ATOMIC_RELAXED, __HIP_MEMORY_SCOPE_AGENT); }
DI unsigned xb_xcc_id() { return (unsigned)__builtin_amdgcn_s_getreg((3 << 11) | 20) & 0xFu; }
#define XB_SPIN(cond, bar) do { unsigned _sp = 0; while (cond) { __builtin_amdgcn_s_sleep(1); \
    if ((++_sp & 255u) == 0u) { if (xb_ld(&(bar)[XB_TMO])) break; if (_sp > XB_SPIN_CAP) { atomicAdd(&(bar)[XB_TMO], 1u); break; } } } } while (0)
struct XcdBarrier { unsigned* bar; unsigned x; volatile LAS unsigned* st; };
DI XcdBarrier xcd_barrier_post(unsigned* bar, volatile LAS unsigned* st) {
    XcdBarrier b; b.bar = bar; b.x = xb_xcc_id(); b.st = st;
    if (threadIdx.x == 0) (void)xb_add(&bar[XB_XCNT(b.x)], 1u);
    return b;
}
DI void xcd_barrier_complete(unsigned* bar, unsigned x, unsigned& nloc, unsigned& nx) {
    const unsigned G = gridDim.x * gridDim.y * gridDim.z;
    unsigned sum, cnt, mine, sp = 0u;
    for (;;) {
        sum = 0u; cnt = 0u; mine = 0u;
#pragma unroll
        for (unsigned j = 0; j < 16; ++j) { const unsigned c = xb_ld(&bar[XB_XCNT(j)]); sum += c; cnt += (c > 0u) ? 1u : 0u; mine = (j == x) ? c : mine; }
        if (sum == G) break;
        __builtin_amdgcn_s_sleep(1);
        if ((++sp & 255u) == 0u) { if (xb_ld(&bar[XB_TMO])) break; if (sp > XB_SPIN_CAP) { atomicAdd(&bar[XB_TMO], 1u); break; } }
    }
    nloc = mine > 0u ? mine : 1u; nx = cnt > 0u ? cnt : 1u;
}
DI void xcd_barrier(const XcdBarrier& b) {
    asm volatile("s_waitcnt vmcnt(0)" ::: "memory");
    __syncthreads();
    if (threadIdx.x == 0) {
        unsigned* bar = b.bar;
        __builtin_amdgcn_s_waitcnt(0);
        unsigned nloc = b.st[0], nx = b.st[1];
        if (nloc == 0u) { xcd_barrier_complete(bar, b.x, nloc, nx); b.st[0] = nloc; b.st[1] = nx; }
        const unsigned old = xb_add(&bar[XB_XSUB(b.x)], 1u);
        const unsigned gen = old / nloc;
        if (old + 1u == (gen + 1u) * nloc) {
            __builtin_amdgcn_fence(__ATOMIC_RELEASE, "agent");
            asm volatile("s_waitcnt vmcnt(0)" ::: "memory");
            const unsigned og = xb_add(&bar[XB_TOP], 1u);
            const unsigned tg = og / nx;
            if (og + 1u == (tg + 1u) * nx) xb_add(&bar[XB_TOPGEN], 1u);
            else XB_SPIN(xb_ld(&bar[XB_TOPGEN]) == tg, bar);
            __builtin_amdgcn_fence(__ATOMIC_ACQUIRE, "agent");
            xb_add(&bar[XB_XGEN(b.x)], 1u);
            asm volatile("s_waitcnt vmcnt(0)" ::: "memory");
        } else {
            XB_SPIN(xb_ld(&bar[XB_XGEN(b.x)]) == gen, bar);
            __builtin_amdgcn_fence(__ATOMIC_ACQUIRE, "agent");
            asm volatile("s_waitcnt vmcnt(0)" ::: "memory");
        }
    }
    __syncthreads();
}

DI int swz128(int row, int chunk) { return row * 128 + ((chunk ^ ((row >> 1) & 7)) << 4); }

template <bool OVL, class Epi>
DI void gemm_phase(unsigned char* lds, const bf16_t* __restrict__ A, int lda, const bf16_t* __restrict__ Bt, int K, int nMt, int nNt, const Epi& epi, int bid = -1, int nb = 0) {
    if (bid < 0) { bid = blockIdx.x; nb = gridDim.x; }
    typedef __attribute__((address_space(3))) unsigned char lds_uc;
    lds_uc* ldsl = (lds_uc*)lds;
    const int tid = tid_fresh(), lane = tid & 63, wid = tid >> 6, wm = wid & 1, wn = wid >> 1;
    const int r16 = lane & 15, q4 = lane >> 4;
    const int nk = K >> 6;
    const int xr = (r16 >> 1) & 7;
    const int ab0 = (128 * wm + r16) * 128 + ((q4 ^ xr) << 4), ab1 = (128 * wm + r16) * 128 + (((4 + q4) ^ xr) << 4);
    const int bb0 = 32768 + (64 * wn + r16) * 128 + ((q4 ^ xr) << 4), bb1 = 32768 + (64 * wn + r16) * 128 + (((4 + q4) ^ xr) << 4);
#pragma unroll 1
    for (int rep = 0; rep < REP_GEMM; ++rep)
    for (int u = bid; u < nMt * nNt; u += nb) {
        int um, un;
        { const int nM8 = nMt & ~7, nmain = nM8 * nNt;
          if (u < nmain) { um = u % nM8; un = u / nM8; } else { const int v = u - nmain, rem = nMt - nM8; um = nM8 + v % rem; un = v / rem; } }
        const bf16_t* ap[4]; const bf16_t* bp[4];
        int t0 = 0, bb = 0;
        if (OVL) { bb = um / 33; t0 = 254 * (um % 33) - 1; }
#pragma unroll
        for (int i = 0; i < 4; ++i) {
            const int P = (wid * 4 + i) * 64 + lane, row = P >> 3, c = (P & 7) ^ ((row >> 1) & 7);
            int grow;
            if (OVL) { int t = t0 + row; t = t < 0 ? 0 : (t > L_ - 1 ? L_ - 1 : t); grow = bb * L_ + t; }
            else grow = um * 256 + row;
            ap[i] = A + (size_t)grow * lda + c * 8;
            bp[i] = Bt + (size_t)(un * 256 + row) * K + c * 8;
        }
        f32x4 acc[8][4];
#pragma unroll
        for (int a = 0; a < 8; ++a)
#pragma unroll
            for (int b = 0; b < 4; ++b) acc[a][b] = (f32x4){0.f, 0.f, 0.f, 0.f};
#define G_ISSUE(bufoff) do { _Pragma("unroll") for (int i = 0; i < 4; ++i) { __builtin_amdgcn_global_load_lds((const unsigned*)ap[i], (__attribute__((address_space(3))) unsigned*)(ldsl + (bufoff) + (wid * 4 + i) * 1024), 16, 0, 0); ap[i] += 64; } \
                             _Pragma("unroll") for (int i = 0; i < 4; ++i) { __builtin_amdgcn_global_load_lds((const unsigned*)bp[i], (__attribute__((address_space(3))) unsigned*)(ldsl + (bufoff) + 32768 + (wid * 4 + i) * 1024), 16, 0, 0); bp[i] += 64; } } while (0)
        __syncthreads();
        G_ISSUE(0);
        asm volatile("s_waitcnt vmcnt(0)" ::: "memory");
        __builtin_amdgcn_s_barrier();
        asm volatile("" ::: "memory");
#pragma unroll 1
        for (int kt = 0; kt < nk; ++kt) {
            const int cb = (kt & 1) * 65536;
            const unsigned char* lb = lds + cb;
#pragma unroll
            for (int ks = 0; ks < 2; ++ks) {
                bf16x8 af[4], bfr[4];
#pragma unroll
                for (int nt = 0; nt < 4; ++nt) bfr[nt] = *(const bf16x8*)(lb + (ks ? bb1 : bb0) + nt * 2048);
#pragma unroll
                for (int mh = 0; mh < 2; ++mh) {
#pragma unroll
                    for (int mt = 0; mt < 4; ++mt) af[mt] = *(const bf16x8*)(lb + (ks ? ab1 : ab0) + (4 * mh + mt) * 2048);
                    __builtin_amdgcn_sched_barrier(0);
#pragma unroll
                    for (int mt = 0; mt < 4; ++mt)
#pragma unroll
                        for (int nt = 0; nt < 4; ++nt) acc[4 * mh + mt][nt] = __builtin_amdgcn_mfma_f32_16x16x32_bf16(bfr[nt], af[mt], acc[4 * mh + mt][nt], 0, 0, 0);
                    __builtin_amdgcn_sched_barrier(0);
                    if (ks == 0 && mh == (wid >= 4 ? 1 : 0) && kt + 1 < nk) G_ISSUE(65536 - cb);
                }
            }
            asm volatile("s_waitcnt vmcnt(0) lgkmcnt(0)" ::: "memory");
            __builtin_amdgcn_s_barrier();
            asm volatile("" ::: "memory");
        }
        int r16e = r16, q4e = q4;
        asm volatile("" : "+v"(r16e), "+v"(q4e));
        if constexpr (Epi::STAGED) {
            epi.staged(lds, acc, um, un, wm, wn, r16e, q4e);
        } else {
#pragma unroll
            for (int mt = 0; mt < 8; ++mt) { epi.row(um * 256 + 128 * wm + 16 * mt + r16e, un * 256 + 64 * wn, q4e, acc[mt]); asm volatile("" ::: "memory"); }
        }
    }
#undef G_ISSUE
}

struct EpiIn {
    static constexpr bool STAGED = true;
    float* hyT; bf16_t* projb;
    template <int HF> static DI void hy_half(float* st, const f32x4 (&acc)[8][4], float* dst, int r16, int q4, int lane) {
#pragma unroll
        for (int mt = 0; mt < 4; ++mt)
#pragma unroll
            for (int nt = 0; nt < 4; ++nt)
#pragma unroll
                for (int i = 0; i < 4; ++i) st[(16 * nt + 4 * q4 + i) * 65 + 16 * mt + r16] = acc[4 * HF + mt][nt][i];
        asm volatile("s_waitcnt lgkmcnt(0)" ::: "memory");
#pragma unroll 4
        for (int n = 0; n < 64; ++n) dst[(size_t)n * T_] = st[n * 65 + lane];
        asm volatile("s_waitcnt lgkmcnt(0)" ::: "memory");
    }
    DI void staged(unsigned char* lds, const f32x4 (&acc)[8][4], int um, int un, int wm, int wn, int r16, int q4) const {
        if (un < 3) {
            float* st = (float*)lds + (wm + 2 * wn) * (64 * 65);
            const int lane = r16 + 16 * q4;
            float* dst = hyT + (size_t)(un * 256 + 64 * wn) * T_ + um * 256 + 128 * wm + lane;
            hy_half<0>(st, acc, dst, r16, q4, lane);
            hy_half<1>(st, acc, dst + 64, r16, q4, lane);
        } else {
#pragma unroll
            for (int mt = 0; mt < 8; ++mt) {
                const int tok = um * 256 + 128 * wm + 16 * mt + r16;
#pragma unroll
                for (int nt = 0; nt < 4; ++nt) {
                    const int col = un * 256 + 64 * wn + 16 * nt + 4 * q4;
                    if (col < 1952) {
                        u32x2 w; w.x = pack2(acc[mt][nt][0], acc[mt][nt][1]); w.y = pack2(acc[mt][nt][2], acc[mt][nt][3]);
                        *(u32x2*)(projb + (unsigned)(tok * 1184 + (col - 768))) = w;
                    }
                }
            }
        }
    }
};
struct EpiF32 {
    static constexpr bool STAGED = false;
    float* C; int ldc;
    DI void row(int tok, int colbase, int q4, const f32x4 (&a)[4]) const {
#pragma unroll
        for (int nt = 0; nt < 4; ++nt) *(f32x4*)(C + (size_t)tok * ldc + colbase + 16 * nt + 4 * q4) = a[nt];
    }
};
struct EpiResid {
    static constexpr bool STAGED = true;
    const float* xold; float* xout; bf16_t* xn; const float* g; float* slots; XcdBarrier xb; bool want_xn;
    DI void staged(unsigned char* lds, f32x4 (&acc)[8][4], int um, int un, int wm, int wn, int r16, int q4) const {
        float* P = (float*)lds;
        const int tid = threadIdx.x;
#pragma unroll
        for (int mt = 0; mt < 8; ++mt) {
            float ss = 0.f;
#pragma unroll
            for (int nt = 0; nt < 4; ++nt) ss += acc[mt][nt][0] * acc[mt][nt][0] + acc[mt][nt][1] * acc[mt][nt][1] + acc[mt][nt][2] * acc[mt][nt][2] + acc[mt][nt][3] * acc[mt][nt][3];
            ss += __shfl_xor(ss, 16); ss += __shfl_xor(ss, 32);
            if (q4 == 0) P[(128 * wm + 16 * mt + r16) * 4 + wn] = ss;
        }
        __syncthreads();
        if (tid < 256) slots[(size_t)(um * 256 + tid) * 4 + un] = (P[tid * 4] + P[tid * 4 + 1]) + (P[tid * 4 + 2] + P[tid * 4 + 3]);
        xcd_barrier(xb);
#pragma unroll
        for (int mt = 0; mt < 8; ++mt) {
            const int tok = um * 256 + 128 * wm + 16 * mt + r16;
            const f32x4 sl = *(const f32x4*)(slots + (size_t)tok * 4);
            const float rr = rsqrtf(((sl[0] + sl[1]) + (sl[2] + sl[3])) * (1.0f / 1024.0f) + 1e-6f);
            float ss = 0.f;
#pragma unroll
            for (int nt = 0; nt < 4; ++nt) {
                const int col = un * 256 + 64 * wn + 16 * nt + 4 * q4;
                const f32x4 xo = *(const f32x4*)(xold + (size_t)tok * 1024 + col);
                const f32x4 gg = *(const f32x4*)(g + col);
                const f32x4 v = xo + acc[mt][nt] * rr * gg;
                acc[mt][nt] = v;
                *(f32x4*)(xout + (size_t)tok * 1024 + col) = v;
                ss += v[0] * v[0] + v[1] * v[1] + v[2] * v[2] + v[3] * v[3];
            }
            ss += __shfl_xor(ss, 16); ss += __shfl_xor(ss, 32);
            if (q4 == 0) P[(128 * wm + 16 * mt + r16) * 4 + wn] = ss;
            asm volatile("" ::: "memory");
        }
        if (want_xn) {
            __syncthreads();
            float* slots2 = slots + (size_t)T_ * 4;
            if (tid < 256) slots2[(size_t)(um * 256 + tid) * 4 + un] = (P[tid * 4] + P[tid * 4 + 1]) + (P[tid * 4 + 2] + P[tid * 4 + 3]);
            xcd_barrier(xb);
#pragma unroll
            for (int mt = 0; mt < 8; ++mt) {
                const int tok = um * 256 + 128 * wm + 16 * mt + r16;
                const f32x4 sl = *(const f32x4*)(slots2 + (size_t)tok * 4);
                const float rr = rsqrtf(((sl[0] + sl[1]) + (sl[2] + sl[3])) * (1.0f / 1024.0f) + 1e-6f);
#pragma unroll
                for (int nt = 0; nt < 4; ++nt) {
                    const int col = un * 256 + 64 * wn + 16 * nt + 4 * q4;
                    u32x2 w; w.x = pack2(acc[mt][nt][0] * rr, acc[mt][nt][1] * rr); w.y = pack2(acc[mt][nt][2] * rr, acc[mt][nt][3] * rr);
                    *(u32x2*)(xn + (size_t)tok * 1024 + col) = w;
                }
            }
        }
        __syncthreads();
    }
};
struct EpiUq {
    static constexpr bool STAGED = false;
    bf16_t* Qm; const float* rq; float sc;
    DI void row(int tok, int colbase, int q4, const f32x4 (&a)[4]) const {
        const float r = rq[tok] * sc;
        const int b = tok >> 13, t = tok & (L_ - 1);
#pragma unroll
        for (int nt = 0; nt < 4; ++nt) {
            const int col = colbase + 16 * nt + 4 * q4;
            if (col >= 384) continue;
            const int head = col / 96, j = col - head * 96;
            bf16_t* dst = Qm + ((size_t)(b * 4 + head) * L_ + t) * 96;
            if (j < 64) {
                u32x2 w; w.x = pack2(a[nt][0] * r, a[nt][1] * r); w.y = pack2(a[nt][2] * r, a[nt][3] * r);
                *(u32x2*)(dst + j) = w;
            } else if (j < 80) {
                if (nt < 3) {
                    const int p0 = j - 64;
                    float o1[4], o2[4];
#pragma unroll
                    for (int i = 0; i < 4; ++i) {
                        const int pp = p0 + i;
                        const float inv = __expf(-(float)(pp & 7) * (9.210340371976184f / 8.0f));
                        const float ang = (float)((pp < 8) ? (t >> 6) : (t & 63)) * inv;
                        float sn, cs; fast_sincos(ang, &sn, &cs);
                        const float x1 = a[nt][i] * r, x2 = a[(nt < 3) ? nt + 1 : 3][i] * r;
                        o1[i] = x1 * cs - x2 * sn; o2[i] = x1 * sn + x2 * cs;
                    }
                    u32x2 w; w.x = pack2(o1[0], o1[1]); w.y = pack2(o1[2], o1[3]);
                    *(u32x2*)(dst + j) = w;
                    w.x = pack2(o2[0], o2[1]); w.y = pack2(o2[2], o2[3]);
                    *(u32x2*)(dst + j + 16) = w;
                }
            }
        }
    }
};
struct EpiUkv {
    static constexpr bool STAGED = false;
    bf16_t* Km; bf16_t* VmT; const float* rkv;
    DI void row(int tok, int colbase, int q4, const f32x4 (&a)[4]) const {
        const float r = rkv[tok];
        const int b = tok >> 13, t = tok & (L_ - 1);
#pragma unroll
        for (int nt = 0; nt < 4; ++nt) {
            const int col = colbase + 16 * nt + 4 * q4;
            const int head = col >> 7, j = col & 127;
            if (j < 64) {
                u32x2 w; w.x = pack2(a[nt][0] * r, a[nt][1] * r); w.y = pack2(a[nt][2] * r, a[nt][3] * r);
                *(u32x2*)(Km + ((size_t)(b * 4 + head) * L_ + t) * 96 + j) = w;
            } else {
#pragma unroll
                for (int i = 0; i < 4; ++i) VmT[((size_t)(b * 4 + head) * 64 + (j - 64 + i)) * L_ + perm16(t)] = f2bf(a[nt][i] * r);
            }
        }
    }
};
DI float gelu_tanh(float x) {
    const float x2 = x * x;
    const float w = x * (-2.302208198f - 0.1029432397f * x2);
    return x * __builtin_amdgcn_rcpf(1.0f + __builtin_amdgcn_exp2f(w));
}
struct EpiUp {
    static constexpr bool STAGED = true;
    bf16_t* act; const float* cw; const float* cb;
    DI void staged(unsigned char* lds, const f32x4 (&acc)[8][4], int um, int un, int wm, int wn, int r16, int q4) const {
        bf16_t* st = (bf16_t*)lds;
#pragma unroll
        for (int mt = 0; mt < 8; ++mt)
#pragma unroll
            for (int nt = 0; nt < 4; ++nt) {
                u32x2 w; w.x = pack2(acc[mt][nt][0], acc[mt][nt][1]); w.y = pack2(acc[mt][nt][2], acc[mt][nt][3]);
                *(u32x2*)(st + (128 * wm + 16 * mt + r16) * 264 + 64 * wn + 16 * nt + 4 * q4) = w;
            }
        __syncthreads();
        const int tid = threadIdx.x, jp = tid & 31, hf = (tid >> 5) & 1, seg = __builtin_amdgcn_readfirstlane(tid >> 6);
        const int bb = um / 33, t0 = 254 * (um % 33) - 1;
        const int r0 = 32 * seg;
        const int ch = 64 * (2 * un + hf) + 2 * jp;
        float g0[2], g1[2], g2[2], gb[2], v0[2], v1[2], v2[2], vb[2];
#pragma unroll
        for (int e = 0; e < 2; ++e) {
            g0[e] = cw[ch + e]; g1[e] = cw[5632 + ch + e]; g2[e] = cw[2 * 5632 + ch + e]; gb[e] = cb[ch + e];
            v0[e] = cw[2816 + ch + e]; v1[e] = cw[5632 + 2816 + ch + e]; v2[e] = cw[2 * 5632 + 2816 + ch + e]; vb[e] = cb[2816 + ch + e];
        }
        const int rlo = (t0 < 0) ? -t0 : 0, rhi = (L_ - 1 - t0 < 255) ? (L_ - 1 - t0) : 255;
        const bf16_t* sp = st + r0 * 264 + 128 * hf + 2 * jp;
        const bool pv = (r0 - 1 >= rlo) && (r0 - 1 <= rhi), cvd = (r0 >= rlo) && (r0 <= rhi);
        unsigned gpw = pv ? *(const unsigned*)(sp - 264) : 0u, vpw = pv ? *(const unsigned*)(sp - 264 + 64) : 0u;
        unsigned gcw = cvd ? *(const unsigned*)sp : 0u, vcw = cvd ? *(const unsigned*)(sp + 64) : 0u;
        bf16_t* dst = act + (size_t)(bb * L_ + t0 + r0) * 2816 + ch;
#define LO(w) __uint_as_float((w) << 16)
#define HI(w) __uint_as_float((w) & 0xffff0000u)
#pragma unroll 4
        for (int i = 0; i < 32; ++i) {
            const int r = r0 + i;
            const bool nv = (r + 1 >= rlo) && (r + 1 <= rhi);
            const unsigned gnw = nv ? *(const unsigned*)(sp + (i + 1) * 264) : 0u, vnw = nv ? *(const unsigned*)(sp + (i + 1) * 264 + 64) : 0u;
            if (r >= 1 && r <= 254 && r <= rhi) {
                const float cg0 = g0[0] * LO(gpw) + g1[0] * LO(gcw) + g2[0] * LO(gnw) + gb[0];
                const float cv0 = v0[0] * LO(vpw) + v1[0] * LO(vcw) + v2[0] * LO(vnw) + vb[0];
                const float cg1 = g0[1] * HI(gpw) + g1[1] * HI(gcw) + g2[1] * HI(gnw) + gb[1];
                const float cv1 = v0[1] * HI(vpw) + v1[1] * HI(vcw) + v2[1] * HI(vnw) + vb[1];
                *(unsigned*)(dst + (size_t)i * 2816) = pack2(gelu_tanh(cg0) * cv0, gelu_tanh(cg1) * cv1);
            }
            gpw = gcw; gcw = gnw; vpw = vcw; vcw = vnw;
        }
#undef LO
#undef HI
        __syncthreads();
    }
};

DI void prep_phase(const Params& p, int l) {
    const int tid_ = tid_fresh(); const int lane = tid_ & 63, wid = tid_ >> 6;
    const bf16_t* projb = (const bf16_t*)(p.ws + O_PROJB);
    bf16_t* Qg = (bf16_t*)(p.ws + O_QG); bf16_t* Kg = (bf16_t*)(p.ws + O_KG); bf16_t* VgT = (bf16_t*)(p.ws + O_VGT);
    bf16_t* Km = (bf16_t*)(p.ws + O_KM);
    float* rq = (float*)(p.ws + O_RQ); float* rkv = (float*)(p.ws + O_RKV);
    const float* gq = p.in[13] + l * 64; const float* gk = p.in[14] + l * 64;
    const int hd = lane >> 3, sub = lane & 7;
    float gq1[4], gq2[4], gk1[4], gk2[4];
#pragma unroll
    for (int i = 0; i < 4; ++i) { gq1[i] = gq[4 * sub + i]; gq2[i] = gq[32 + 4 * sub + i]; gk1[i] = gk[4 * sub + i]; gk2[i] = gk[32 + 4 * sub + i]; }
    const float qscale = 0.125f * 1.4426950408889634f;
    for (int tok = blockIdx.x * 8 + wid; tok < T_; tok += gridDim.x * 8) {
        const int b = tok >> 13, t = tok & (L_ - 1);
        const bf16_t* pr = projb + (size_t)tok * 1184;
        float cs[4], sn[4];
#pragma unroll
        for (int i = 0; i < 4; ++i) {
            const int pp = 4 * sub + i;
            const float inv = __expf(-(float)(pp & 15) * (9.210340371976184f / 16.0f));
            const float ang = (float)((pp < 16) ? (t >> 6) : (t & 63)) * inv;
            fast_sincos(ang, &sn[i], &cs[i]);
        }
        {
            const u32x2 w1 = *(const u32x2*)(pr + hd * 64 + 4 * sub), w2 = *(const u32x2*)(pr + hd * 64 + 32 + 4 * sub);
            float x1[4] = {bf2f((bf16_t)(w1.x & 0xffff)), bf2f((bf16_t)(w1.x >> 16)), bf2f((bf16_t)(w1.y & 0xffff)), bf2f((bf16_t)(w1.y >> 16))};
            float x2[4] = {bf2f((bf16_t)(w2.x & 0xffff)), bf2f((bf16_t)(w2.x >> 16)), bf2f((bf16_t)(w2.y & 0xffff)), bf2f((bf16_t)(w2.y >> 16))};
            float ss = 0.f;
#pragma unroll
            for (int i = 0; i < 4; ++i) ss += x1[i] * x1[i] + x2[i] * x2[i];
            ss += __shfl_xor(ss, 1); ss += __shfl_xor(ss, 2); ss += __shfl_xor(ss, 4);
            const float r = rsqrtf(ss * (1.0f / 64.0f) + 1e-6f);
            float o1[4], o2[4];
#pragma unroll
            for (int i = 0; i < 4; ++i) { const float a = x1[i] * r * gq1[i], c = x2[i] * r * gq2[i]; o1[i] = (a * cs[i] - c * sn[i]) * qscale; o2[i] = (a * sn[i] + c * cs[i]) * qscale; }
            bf16_t* dst = Qg + ((size_t)(b * 8 + hd) * L_ + t) * 64;
            u32x2 w; w.x = pack2(o1[0], o1[1]); w.y = pack2(o1[2], o1[3]); *(u32x2*)(dst + 4 * sub) = w;
            w.x = pack2(o2[0], o2[1]); w.y = pack2(o2[2], o2[3]); *(u32x2*)(dst + 32 + 4 * sub) = w;
        }
        if (lane < 16) {
            const u32x2 w1 = *(const u32x2*)(pr + 512 + hd * 64 + 4 * sub), w2 = *(const u32x2*)(pr + 512 + hd * 64 + 32 + 4 * sub);
            float x1[4] = {bf2f((bf16_t)(w1.x & 0xffff)), bf2f((bf16_t)(w1.x >> 16)), bf2f((bf16_t)(w1.y & 0xffff)), bf2f((bf16_t)(w1.y >> 16))};
            float x2[4] = {bf2f((bf16_t)(w2.x & 0xffff)), bf2f((bf16_t)(w2.x >> 16)), bf2f((bf16_t)(w2.y & 0xffff)), bf2f((bf16_t)(w2.y >> 16))};
            float ss = 0.f;
#pragma unroll
            for (int i = 0; i < 4; ++i) ss += x1[i] * x1[i] + x2[i] * x2[i];
            ss += __shfl_xor(ss, 1); ss += __shfl_xor(ss, 2); ss += __shfl_xor(ss, 4);
            const float r = rsqrtf(ss * (1.0f / 64.0f) + 1e-6f);
            float o1[4], o2[4];
#pragma unroll
            for (int i = 0; i < 4; ++i) { const float a = x1[i] * r * gk1[i], c = x2[i] * r * gk2[i]; o1[i] = a * cs[i] - c * sn[i]; o2[i] = a * sn[i] + c * cs[i]; }
            bf16_t* dst = Kg + ((size_t)(b * 2 + hd) * L_ + t) * 64;
            u32x2 w; w.x = pack2(o1[0], o1[1]); w.y = pack2(o1[2], o1[3]); *(u32x2*)(dst + 4 * sub) = w;
            w.x = pack2(o2[0], o2[1]); w.y = pack2(o2[2], o2[3]); *(u32x2*)(dst + 32 + 4 * sub) = w;
        }
        {
            const unsigned w = *(const unsigned*)(pr + 640 + 2 * lane);
            const int c0 = 2 * lane, kh = c0 >> 6, d = c0 & 63;
            bf16_t* dst = VgT + ((size_t)(b * 2 + kh) * 64 + d) * L_ + perm16(t);
            dst[0] = (bf16_t)(w & 0xffff); dst[L_] = (bf16_t)(w >> 16);
        }
        {
            const u32x2 w = *(const u32x2*)(pr + 768 + 4 * lane);
            const float a0 = bf2f((bf16_t)(w.x & 0xffff)), a1 = bf2f((bf16_t)(w.x >> 16)), a2 = bf2f((bf16_t)(w.y & 0xffff)), a3 = bf2f((bf16_t)(w.y >> 16));
            float ss = wave_sum(a0 * a0 + a1 * a1 + a2 * a2 + a3 * a3);
            if (lane == 0) rq[tok] = rsqrtf(ss * (1.0f / 256.0f) + 1e-6f);
        }
        {
            const unsigned w = *(const unsigned*)(pr + 1024 + 2 * lane);
            const float a0 = bf2f((bf16_t)(w & 0xffff)), a1 = bf2f((bf16_t)(w >> 16));
            float ss = wave_sum(a0 * a0 + a1 * a1);
            if (lane == 0) rkv[tok] = rsqrtf(ss * (1.0f / 128.0f) + 1e-6f);
        }
        if (lane < 16) {
            const float x1 = bf2f(pr[1152 + lane]), x2 = bf2f(pr[1152 + 16 + lane]);
            const float inv = __expf(-(float)(lane & 7) * (9.210340371976184f / 8.0f));
            const float ang = (float)((lane < 8) ? (t >> 6) : (t & 63)) * inv;
            float s1, c1; fast_sincos(ang, &s1, &c1);
            const bf16_t o1 = f2bf(x1 * c1 - x2 * s1), o2 = f2bf(x1 * s1 + x2 * c1);
#pragma unroll
            for (int hh = 0; hh < 4; ++hh) { bf16_t* dst = Km + ((size_t)(b * 4 + hh) * L_ + t) * 96 + 64; dst[lane] = o1; dst[16 + lane] = o2; }
        }
    }
}

template <int DQK> DI int kswz(int row, int chunk) {
    if (DQK == 64) return row * 128 + ((chunk ^ ((row >> 1) & 7)) << 4);
    else return row * 192 + ((chunk ^ ((row >> 2) & 3)) << 4);
}
template <int DQK>
DI void attn_unit(unsigned char* lds, const bf16_t* __restrict__ Qp, const bf16_t* __restrict__ Kp, const bf16_t* __restrict__ VTp, bf16_t* __restrict__ Yp  ) {
    constexpr int NS = DQK / 16, NC = DQK / 8, KB = 64 * DQK * 2, KVB = KB + 8192;
    const int tid = tid_fresh(), lane = tid & 63, w = tid >> 6, r = lane & 31, h = lane >> 5;
    bf16x8 qf[NS];
#pragma unroll
    for (int s = 0; s < NS; ++s) qf[s] = *(const bf16x8*)(Qp + (size_t)(32 * w + r) * DQK + 16 * s + 8 * h);
    f32x16 o0, o1;
#pragma unroll
    for (int i = 0; i < 16; ++i) { o0[i] = 0.f; o1[i] = 0.f; }
    float m = 0.f, lsum = 0.f;
    const int k_row0 = tid / NC, k_c0 = tid % NC;
    const int k_row1 = (tid + 512) / NC, k_c1 = (tid + 512) % NC;
    const bool k_two = (DQK == 96) && (tid < 256);
    const int v_row = tid >> 3, v_c = tid & 7;
    u32x4 rkA0, rkA1, rvA, rkB0, rkB1, rvB;
    rkA1 = (u32x4){0u, 0u, 0u, 0u}; rkB1 = rkA1;
#define A_LOAD(kt, R0, R1, RV) do { R0 = *(const u32x4*)(Kp + (size_t)((kt) * 64 + k_row0) * DQK + k_c0 * 8); \
                        if (k_two) R1 = *(const u32x4*)(Kp + (size_t)((kt) * 64 + k_row1) * DQK + k_c1 * 8); \
                        RV = *(const u32x4*)(VTp + (size_t)v_row * L_ + (kt) * 64 + v_c * 8); } while (0)
#define A_STORE(buf, R0, R1, RV) do { *(u32x4*)(lds + (buf) * KVB + kswz<DQK>(k_row0, k_c0)) = R0; \
                          if (k_two) *(u32x4*)(lds + (buf) * KVB + kswz<DQK>(k_row1, k_c1)) = R1; \
                          *(u32x4*)(lds + (buf) * KVB + KB + swz128(v_row, v_c)) = RV; } while (0)
    A_LOAD(0, rkA0, rkA1, rvA);
    A_LOAD(1, rkB0, rkB1, rvB);
    A_STORE(0, rkA0, rkA1, rvA);
    __syncthreads();
    constexpr int NKT = L_ / 64;
#pragma unroll 1
    for (int kt2 = 0; kt2 < NKT; kt2 += 2) {
#pragma unroll
      for (int cur = 0; cur < 2; ++cur) {
        const int kt = kt2 + cur;
        if (kt + 2 < NKT) { if (cur == 0) A_LOAD(kt + 2, rkA0, rkA1, rvA); else A_LOAD(kt + 2, rkB0, rkB1, rvB); }
        const unsigned char* lk = lds + cur * KVB;
        const unsigned char* lv = lk + KB;
        f32x16 s0, s1;
        const float negm = -m;
#pragma unroll
        for (int i = 0; i < 16; ++i) { s0[i] = negm; s1[i] = negm; }
#pragma unroll
        for (int s = 0; s < NS; ++s) {
            const bf16x8 k0 = *(const bf16x8*)(lk + kswz<DQK>(r, 2 * s + h));
            const bf16x8 k1 = *(const bf16x8*)(lk + kswz<DQK>(32 + r, 2 * s + h));
            s0 = __builtin_amdgcn_mfma_f32_32x32x16_bf16(k0, qf[s], s0, 0, 0, 0);
            s1 = __builtin_amdgcn_mfma_f32_32x32x16_bf16(k1, qf[s], s1, 0, 0, 0);
        }
        float mx = fmaxf(fmaxf(s0[0], s0[1]), s0[2]);
#pragma unroll
        for (int i = 3; i < 15; i += 2) mx = fmaxf(fmaxf(mx, s0[i]), s0[i + 1]);
        mx = fmaxf(mx, s0[15]);
#pragma unroll
        for (int i = 0; i < 16; i += 2) mx = fmaxf(fmaxf(mx, s1[i]), s1[i + 1]);
        mx = fmaxf(mx, __shfl_xor(mx, 32));
        if (kt == 0 || __any(mx > 8.0f)) {
            const float dm = (kt == 0) ? mx : fmaxf(mx, 0.f);
            const float alpha = (kt == 0) ? 0.f : __builtin_amdgcn_exp2f(-dm);
            m += dm;
            lsum *= alpha;
#pragma unroll
            for (int i = 0; i < 16; ++i) { o0[i] *= alpha; o1[i] *= alpha; s0[i] -= dm; s1[i] -= dm; }
        }
        float ps = 0.f;
#pragma unroll
        for (int i = 0; i < 16; ++i) { s0[i] = __builtin_amdgcn_exp2f(s0[i]); ps += s0[i]; }
#pragma unroll
        for (int i = 0; i < 16; ++i) { s1[i] = __builtin_amdgcn_exp2f(s1[i]); ps += s1[i]; }
        lsum += ps;
#pragma unroll
        for (int sub = 0; sub < 2; ++sub)
#pragma unroll
            for (int s2 = 0; s2 < 2; ++s2) {
                u32x4 pw;
                if (sub == 0) { pw.x = pack2(s0[8 * s2 + 0], s0[8 * s2 + 1]); pw.y = pack2(s0[8 * s2 + 2], s0[8 * s2 + 3]); pw.z = pack2(s0[8 * s2 + 4], s0[8 * s2 + 5]); pw.w = pack2(s0[8 * s2 + 6], s0[8 * s2 + 7]); }
                else          { pw.x = pack2(s1[8 * s2 + 0], s1[8 * s2 + 1]); pw.y = pack2(s1[8 * s2 + 2], s1[8 * s2 + 3]); pw.z = pack2(s1[8 * s2 + 4], s1[8 * s2 + 5]); pw.w = pack2(s1[8 * s2 + 6], s1[8 * s2 + 7]); }
                const bf16x8 pf = __builtin_bit_cast(bf16x8, pw);
                const bf16x8 vf0 = *(const bf16x8*)(lv + swz128(r, 4 * sub + 2 * s2 + h));
                const bf16x8 vf1 = *(const bf16x8*)(lv + swz128(32 + r, 4 * sub + 2 * s2 + h));
                o0 = __builtin_amdgcn_mfma_f32_32x32x16_bf16(vf0, pf, o0, 0, 0, 0);
                o1 = __builtin_amdgcn_mfma_f32_32x32x16_bf16(vf1, pf, o1, 0, 0, 0);
            }
        if (kt + 1 < NKT) { if (cur == 0) A_STORE(1, rkB0, rkB1, rvB); else A_STORE(0, rkA0, rkA1, rvA); }
        __syncthreads();
      }
    }
#undef A_LOAD
#undef A_STORE
    const float lt = lsum + __shfl_xor(lsum, 32);
    const float inv = 1.0f / lt;
    bf16_t* yr = Yp + (size_t)(32 * w + r) * 768;
#pragma unroll
    for (int g = 0; g < 4; ++g) {
        u32x2 wv; wv.x = pack2(o0[4 * g] * inv, o0[4 * g + 1] * inv); wv.y = pack2(o0[4 * g + 2] * inv, o0[4 * g + 3] * inv);
        *(u32x2*)(yr + 8 * g + 4 * h) = wv;
        wv.x = pack2(o1[4 * g] * inv, o1[4 * g + 1] * inv); wv.y = pack2(o1[4 * g + 2] * inv, o1[4 * g + 3] * inv);
        *(u32x2*)(yr + 32 + 8 * g + 4 * h) = wv;
    }
}

DI int pa(int e) { return e + (e >> 4); }
DI float2 cmul(float2 a, float2 b) { return make_float2(a.x * b.x - a.y * b.y, a.x * b.y + a.y * b.x); }
DI float2 cadd(float2 a, float2 b) { return make_float2(a.x + b.x, a.y + b.y); }
DI float2 csub(float2 a, float2 b) { return make_float2(a.x - b.x, a.y - b.y); }
template <bool INV> DI void dft4(float2& a, float2& b, float2& c, float2& d) {
    const float2 t0 = cadd(a, c), t1 = csub(a, c), t2 = cadd(b, d), t3 = csub(b, d);
    const float2 jt3 = INV ? make_float2(-t3.y, t3.x) : make_float2(t3.y, -t3.x);
    a = cadd(t0, t2); c = csub(t0, t2); b = cadd(t1, jt3); d = csub(t1, jt3);
}
template <bool INV> DI float2 tw16(float2 v, int k) {
    const float c1 = 0.9238795325112867f, s1 = 0.3826834323650898f, c2 = 0.7071067811865476f;
    float wr = 1.f, wi = 0.f;
    switch (k) {
        case 0: wr = 1.f; wi = 0.f; break;
        case 1: wr = c1; wi = -s1; break;
        case 2: wr = c2; wi = -c2; break;
        case 3: wr = s1; wi = -c1; break;
        case 4: wr = 0.f; wi = -1.f; break;
        case 6: wr = -c2; wi = -c2; break;
        case 9: wr = -c1; wi = s1; break;
        default: break;
    }
    if (INV) wi = -wi;
    return make_float2(v.x * wr - v.y * wi, v.x * wi + v.y * wr);
}
template <bool INV> DI void dft16(float2 (&x)[16]) {
#pragma unroll
    for (int b = 0; b < 4; ++b) dft4<INV>(x[b], x[b + 4], x[b + 8], x[b + 12]);
#pragma unroll
    for (int b = 1; b < 4; ++b)
#pragma unroll
        for (int pq = 1; pq < 4; ++pq) x[b + 4 * pq] = tw16<INV>(x[b + 4 * pq], b * pq);
#pragma unroll
    for (int pq = 0; pq < 4; ++pq) dft4<INV>(x[4 * pq], x[4 * pq + 1], x[4 * pq + 2], x[4 * pq + 3]);
#pragma unroll
    for (int a = 0; a < 4; ++a)
#pragma unroll
        for (int b = a + 1; b < 4; ++b) { const float2 tmp = x[4 * a + b]; x[4 * a + b] = x[4 * b + a]; x[4 * b + a] = tmp; }
}
template <bool INV> DI void pass_a(float2* Z, const float2* T1, int tid) {
#pragma unroll
    for (int i = 0; i < 8; ++i) {
        const int j = tid + 512 * i;
        float2* zp = Z + pa(j);
        float2 x0 = zp[0], x1 = zp[4352], x2 = zp[8704], x3 = zp[13056];
        float2 w1 = tw16<false>(T1[j & 1023], i >> 1);
        if (INV) w1.y = -w1.y;
        const float2 w2 = cmul(w1, w1), w3 = cmul(w2, w1);
        if (!INV) { dft4<false>(x0, x1, x2, x3); x1 = cmul(x1, w1); x2 = cmul(x2, w2); x3 = cmul(x3, w3); }
        else { x1 = cmul(x1, w1); x2 = cmul(x2, w2); x3 = cmul(x3, w3); dft4<true>(x0, x1, x2, x3); }
        zp[0] = x0; zp[4352] = x1; zp[8704] = x2; zp[13056] = x3;
    }
}
template <bool INV, int LS, int TS> DI void pass16(float2* Z, const float2* T1, int tid) {
#pragma unroll 1
    for (int i = 0; i < 2; ++i) {
        const int id = tid + 512 * i, j = id & ((1 << LS) - 1), base = (id >> LS) << (LS + 4);
        float2* zp = Z + pa(base + j);
        float2 x[16];
#pragma unroll
        for (int mm = 0; mm < 16; ++mm) x[mm] = zp[mm * ((1 << LS) + (1 << (LS - 4)))];
        float2 w1 = T1[j << TS];
        if (INV) w1.y = -w1.y;
        if (!INV) dft16<false>(x);
        float2 wq = w1;
#pragma unroll
        for (int qq = 1; qq < 16; ++qq) { x[qq] = cmul(x[qq], wq); wq = cmul(wq, w1); }
        if (INV) dft16<true>(x);
#pragma unroll
        for (int mm = 0; mm < 16; ++mm) zp[mm * ((1 << LS) + (1 << (LS - 4)))] = x[mm];
    }
}
DI void pass_d_store(const float2* Z, float2* __restrict__ Kf, int tid, float scale) {
#pragma unroll 1
    for (int i = 0; i < 2; ++i) {
        const int id = tid + 512 * i, base = id * 16;
        float2 x[16];
#pragma unroll
        for (int mm = 0; mm < 16; ++mm) x[mm] = Z[17 * id + mm];
        dft16<false>(x);
#pragma unroll
        for (int mm = 0; mm < 16; mm += 2) *(f32x4*)(Kf + base + mm) = (f32x4){x[mm].x * scale, x[mm].y * scale, x[mm + 1].x * scale, x[mm + 1].y * scale};
    }
}
DI void pass_d_lds(float2* Z, int tid) {
#pragma unroll 1
    for (int i = 0; i < 2; ++i) {
        const int id = tid + 512 * i, base = id * 16;
        float2 x[16];
#pragma unroll
        for (int mm = 0; mm < 16; ++mm) x[mm] = Z[17 * id + mm];
        dft16<false>(x);
#pragma unroll
        for (int mm = 0; mm < 16; ++mm) Z[17 * id + mm] = x[mm];
    }
}
DI void pass_d_mul(float2* Z, const float2* __restrict__ Kf, int tid) {
#pragma unroll 1
    for (int i = 0; i < 2; ++i) {
        const int id = tid + 512 * i, base = id * 16;
        float2 x[16];
#pragma unroll
        for (int mm = 0; mm < 16; ++mm) x[mm] = Z[17 * id + mm];
        dft16<false>(x);
#pragma unroll
        for (int mm = 0; mm < 16; mm += 2) {
            const f32x4 kk = *(const f32x4*)(Kf + base + mm);
            x[mm] = cmul(x[mm], make_float2(kk[0], kk[1])); x[mm + 1] = cmul(x[mm + 1], make_float2(kk[2], kk[3]));
        }
        dft16<true>(x);
#pragma unroll
        for (int mm = 0; mm < 16; ++mm) Z[17 * id + mm] = x[mm];
    }
}
DI void fft_conv(float2* Z, const float2* T1, const float2* Kf, int tid) {
    pass_a<false>(Z, T1, tid); __syncthreads();
    pass16<false, 8, 2>(Z, T1, tid); __syncthreads();
    pass16<false, 4, 6>(Z, T1, tid); __syncthreads();
    pass_d_mul(Z, Kf, tid); __syncthreads();
    pass16<true, 4, 6>(Z, T1, tid); __syncthreads();
    pass16<true, 8, 2>(Z, T1, tid); __syncthreads();
    pass_a<true>(Z, T1, tid); __syncthreads();
}

DI void hyena_unit(unsigned char* lds, const Params& p, int l, int c) {
    float2* Z = (float2*)lds;
    float2* T1 = (float2*)(lds + 139264);
    const int tid = tid_fresh();
    const float* hyT = (const float*)(p.ws + O_HYT);
    float2* Kf0 = (float2*)(p.ws + O_R1) + (size_t)c * 32768;
    float2* Kf1 = Kf0 + 16384;
    bf16_t* hyout = (bf16_t*)(p.ws + O_HYOUT) + (size_t)c * T_;
    for (int k = tid; k < 1024; k += NTHR) { float sn, cs; sincospif((float)k * (1.0f / 8192.0f), &sn, &cs); T1[k] = make_float2(cs, -sn); }
    __syncthreads();
    {
        const float* taps = (const float*)Kf1;
#pragma unroll 4
        for (int t = tid; t < L_; t += NTHR) { Z[pa(t)] = make_float2(taps[t], taps[2 * L_ + t]); Z[pa(16383 - t)] = make_float2(taps[L_ + t], taps[3 * L_ + t]); }
        __syncthreads();
        pass_a<false>(Z, T1, tid); __syncthreads();
        pass16<false, 8, 2>(Z, T1, tid); __syncthreads();
        pass16<false, 4, 6>(Z, T1, tid); __syncthreads();
        pass_d_lds(Z, tid); __syncthreads();
        const float sc = 0.5f / 16384.0f;
#pragma unroll 4
        for (int e = tid; e < 16384; e += NTHR) {
            const int a = e >> 12, b = (e >> 8) & 15, c4 = (e >> 4) & 15, d = e & 15;
            const int k = a + 4 * (b + 16 * (c4 + 16 * d));
            const int k2 = (16384 - k) & 16383;
            const int e2 = ((k2 & 3) << 12) | (((k2 >> 2) & 15) << 8) | (((k2 >> 6) & 15) << 4) | (k2 >> 10);
            const float2 z = Z[pa(e)], z2 = Z[pa(e2)];
            const float sx = z.x + z2.x, sy = z.y - z2.y, dx = z.x - z2.x, dy = z.y + z2.y;
            Kf0[e] = make_float2(sx * sc, sy * sc);
            Kf1[e] = make_float2(dy * sc, -dx * sc);
        }
        __syncthreads();
    }
    const float* cw = p.in[3] + (size_t)l * 3 * 768; const float* cb = p.in[4] + (size_t)l * 768;
    const float* skip = p.in[12] + (size_t)l * 2 * 256;
    float2* z1buf = Kf0;
    const float vw0 = cw[c], vw1 = cw[768 + c], vw2 = cw[1536 + c], vbb = cb[c];
    const float* uv = hyT + (size_t)c * T_;
#pragma unroll 4
    for (int t = tid; t < L_; t += NTHR) {
        float vv[2];
#pragma unroll
        for (int b = 0; b < 2; ++b) {
            const float* ub = uv + b * L_;
            const float um = (t > 0) ? ub[t - 1] : 0.f, uc = ub[t], up = (t < L_ - 1) ? ub[t + 1] : 0.f;
            vv[b] = vw0 * um + vw1 * uc + vw2 * up + vbb;
        }
        Z[pa(t)] = make_float2(vv[0], vv[1]); Z[pa(t + L_)] = make_float2(0.f, 0.f);
    }
    __syncthreads();
    __threadfence();
    fft_conv(Z, T1, Kf0, tid);
    {
        const int ch = 256 + c;
        const float w0 = cw[ch], w1 = cw[768 + ch], w2 = cw[1536 + ch], bb = cb[ch], sk = skip[c];
        const float* u0 = hyT + (size_t)ch * T_;
#pragma unroll 4
        for (int t = tid; t < L_; t += NTHR) {
            const float2 y = Z[pa(t)];
            float zz[2];
#pragma unroll
            for (int b = 0; b < 2; ++b) {
                const float* ub = u0 + b * L_;
                const float um = (t > 0) ? ub[t - 1] : 0.f, uc = ub[t], up = (t < L_ - 1) ? ub[t + 1] : 0.f;
                const float g = w0 * um + w1 * uc + w2 * up + bb;
                const float* vb = uv + b * L_;
                const float vm = (t > 0) ? vb[t - 1] : 0.f, vc = vb[t], vp = (t < L_ - 1) ? vb[t + 1] : 0.f;
                const float v = vw0 * vm + vw1 * vc + vw2 * vp + vbb;
                zz[b] = g * ((b ? y.y : y.x) + sk * v);
            }
            const float2 z1 = make_float2(zz[0], zz[1]);
            Z[pa(t)] = z1; Z[pa(t + L_)] = make_float2(0.f, 0.f);
            z1buf[t] = z1;
        }
    }
    __syncthreads();
    fft_conv(Z, T1, Kf1, tid);
    {
        const int ch = 512 + c;
        const float w0 = cw[ch], w1 = cw[768 + ch], w2 = cw[1536 + ch], bb = cb[ch], sk = skip[256 + c];
        const float* u0 = hyT + (size_t)ch * T_;
#pragma unroll 4
        for (int t = tid; t < L_; t += NTHR) {
            const float2 y = Z[pa(t)];
            const float2 z1 = z1buf[t];
#pragma unroll
            for (int b = 0; b < 2; ++b) {
                const float* ub = u0 + b * L_;
                const float um = (t > 0) ? ub[t - 1] : 0.f, uc = ub[t], up = (t < L_ - 1) ? ub[t + 1] : 0.f;
                const float g = w0 * um + w1 * uc + w2 * up + bb;
                hyout[b * L_ + t] = f2bf(g * ((b ? y.y : y.x) + sk * (b ? z1.y : z1.x)));
            }
        }
    }
    __syncthreads();
}

DI void groups_phase(unsigned char* lds, const Params& p) {
    bf16_t* tile = (bf16_t*)lds;
    const int tid = tid_fresh(), lane = tid & 63, wid = tid >> 6;
    const bf16_t* hyout = (const bf16_t*)(p.ws + O_HYOUT);
    const bf16_t* Y = (const bf16_t*)(p.ws + O_PROJB);
    bf16_t* G = (bf16_t*)(p.ws + O_HYT);
    for (int u = blockIdx.x; u < T_ / 64; u += gridDim.x) {
        const int tok0 = u * 64;
        {
            const int c = tid >> 1, hf = tid & 1;
            const u32x4* src = (const u32x4*)(hyout + (size_t)c * T_ + tok0 + hf * 32);
#pragma unroll
            for (int i = 0; i < 4; ++i) {
                const u32x4 v = src[i];
                unsigned* d = (unsigned*)(tile + c * 66 + hf * 32 + i * 8);
                d[0] = v.x; d[1] = v.y; d[2] = v.z; d[3] = v.w;
            }
        }
        __syncthreads();
#pragma unroll 1
        for (int i = 0; i < 8; ++i) {
            const int tl = wid * 8 + i, tok = tok0 + tl;
            float hv[4]; float sh = 0.f;
#pragma unroll
            for (int k = 0; k < 4; ++k) { hv[k] = bf2f(tile[(lane + 64 * k) * 66 + tl]); sh += hv[k] * hv[k]; }
            sh = wave_sum(sh);
            const float rh = rsqrtf(sh * (1.0f / 256.0f) + 1e-6f);
            bf16_t* gr = G + (size_t)tok * 1024;
#pragma unroll
            for (int k = 0; k < 4; ++k) gr[lane + 64 * k] = f2bf(hv[k] * rh);
            const bf16_t* yr = Y + (size_t)tok * 768;
            {
                const u32x4 v = *(const u32x4*)(yr + lane * 8);
                float a[8] = {bf2f((bf16_t)(v.x & 0xffff)), bf2f((bf16_t)(v.x >> 16)), bf2f((bf16_t)(v.y & 0xffff)), bf2f((bf16_t)(v.y >> 16)),
                              bf2f((bf16_t)(v.z & 0xffff)), bf2f((bf16_t)(v.z >> 16)), bf2f((bf16_t)(v.w & 0xffff)), bf2f((bf16_t)(v.w >> 16))};
                float ss = 0.f;
#pragma unroll
                for (int k = 0; k < 8; ++k) ss += a[k] * a[k];
                ss = wave_sum(ss);
                const float rr = rsqrtf(ss * (1.0f / 512.0f) + 1e-6f);
                u32x4 w; w.x = pack2(a[0] * rr, a[1] * rr); w.y = pack2(a[2] * rr, a[3] * rr); w.z = pack2(a[4] * rr, a[5] * rr); w.w = pack2(a[6] * rr, a[7] * rr);
                *(u32x4*)(gr + 256 + lane * 8) = w;
            }
            {
                const u32x2 v = *(const u32x2*)(yr + 512 + lane * 4);
                float a[4] = {bf2f((bf16_t)(v.x & 0xffff)), bf2f((bf16_t)(v.x >> 16)), bf2f((bf16_t)(v.y & 0xffff)), bf2f((bf16_t)(v.y >> 16))};
                float ss = wave_sum(a[0] * a[0] + a[1] * a[1] + a[2] * a[2] + a[3] * a[3]);
                const float rr = rsqrtf(ss * (1.0f / 256.0f) + 1e-6f);
                u32x2 w; w.x = pack2(a[0] * rr, a[1] * rr); w.y = pack2(a[2] * rr, a[3] * rr);
                *(u32x2*)(gr + 768 + lane * 4) = w;
            }
        }
        __syncthreads();
    }
}


extern __shared__ __attribute__((aligned(16))) unsigned char smem[];

__global__ void __launch_bounds__(512) fwd_megakernel(Params p) {
    cg::grid_group grid = cg::this_grid();
    unsigned char* lds = smem;
    unsigned char* ws = p.ws;
    unsigned* bar = (unsigned*)(ws + O_BAR);
    volatile LAS unsigned* xb_st = (volatile LAS unsigned*)(smem + LDS_BYTES - 16);
    if (threadIdx.x < 4) xb_st[threadIdx.x] = 0u;
    __syncthreads();
    const XcdBarrier xb = xcd_barrier_post(bar, xb_st);
    if (p.ws == nullptr) grid.sync();
#pragma unroll 1
    for (int l2 = 0; l2 < 2 * REP_PRO; ++l2) { const int l = l2 & 1;
        convT(lds, p.in[2] + (size_t)l * 1024 * 1952, 1024, 1952, 2048, p.in[1] + l * 1024, (bf16_t*)(ws + O_WIN) + (size_t)l * 2048 * 1024, 0);
        convT(lds, p.in[16] + (size_t)l * 256 * 384, 256, 384, 512, p.in[15] + l * 256, (bf16_t*)(ws + O_WUQ) + (size_t)l * 512 * 256, 0);
        convT(lds, p.in[18] + (size_t)l * 128 * 512, 128, 512, 512, p.in[17] + l * 128, (bf16_t*)(ws + O_WUKV) + (size_t)l * 512 * 128, 0);
        convT(lds, p.in[22] + (size_t)l * 1024 * 1024, 1024, 1024, 1024, p.in[19] + l * 256, (bf16_t*)(ws + O_WOUT) + (size_t)l * 1024 * 1024, 2, p.in[20] + l * 512, p.in[21] + l * 256);
        convT(lds, p.in[25] + (size_t)l * 1024 * 5632, 1024, 5632, 5632, p.in[24] + l * 1024, (bf16_t*)(ws + O_WUP) + (size_t)l * 5632 * 1024, 1);
        convT(lds, p.in[28] + (size_t)l * 2816 * 1024, 2816, 1024, 1024, nullptr, (bf16_t*)(ws + O_WDOWN) + (size_t)l * 1024 * 2816, 0);
    }
#ifndef REP_MISC
#define REP_MISC 1
#endif
#pragma unroll 1
    for (int rep = 0; rep < REP_MISC; ++rep) { hy_h2_phase(lds, p);
    rownorm_phase(p.in[0], (bf16_t*)(ws + O_XN)); }
    XSYNC();


#pragma unroll 1
    for (int l = 0; l < 2; ++l) {
        {
            EpiIn e; e.hyT = (float*)(ws + O_HYT); e.projb = (bf16_t*)(ws + O_PROJB);
            gemm_phase<false>(lds, (const bf16_t*)(ws + O_XN), 1024, (const bf16_t*)(ws + O_WIN) + (size_t)l * 2048 * 1024, 1024, 64, 8, e);
        }
        XSYNC();
#pragma unroll 1
        for (int rep = 0; rep < REP_EW; ++rep) prep_phase(p, l);
#pragma unroll 1
        for (int rep = 0; rep < REP_MISC; ++rep) ft_phase(lds, p, l);
        XSYNC();
        {
            EpiUq e; e.Qm = (bf16_t*)(ws + O_QM); e.rq = (const float*)(ws + O_RQ); e.sc = 0.10206207261596577f * 1.4426950408889634f;
            const int hb = gridDim.x >> 1;
            if ((int)blockIdx.x < hb) gemm_phase<false>(lds, (const bf16_t*)(ws + O_PROJB) + 768, 1184, (const bf16_t*)(ws + O_WUQ) + (size_t)l * 512 * 256, 256, 64, 2, e, blockIdx.x, hb);
            EpiUkv e2; e2.Km = (bf16_t*)(ws + O_KM); e2.VmT = (bf16_t*)(ws + O_VMT); e2.rkv = (const float*)(ws + O_RKV);
            if ((int)blockIdx.x >= hb) gemm_phase<false>(lds, (const bf16_t*)(ws + O_PROJB) + 1024, 1184, (const bf16_t*)(ws + O_WUKV) + (size_t)l * 512 * 128, 128, 64, 2, e2, blockIdx.x - hb, gridDim.x - hb);
        }
        XSYNC();
#pragma unroll 1
        for (int rep = 0; rep < REP_HY; ++rep)
        for (int c = blockIdx.x; c < 256; c += gridDim.x) hyena_unit(lds, p, l, c);
#pragma unroll 1
        for (int rep = 0; rep < REP_ATTN; ++rep)
        for (int u = blockIdx.x; u < 512; u += gridDim.x) {
            const int qt = u & 31, hh = (u >> 5) & 7, b = u >> 8, hk = hh >> 2;
            attn_unit<64>(lds, (const bf16_t*)(ws + O_QG) + ((size_t)(b * 8 + hh) * L_ + qt * 256) * 64,
                          (const bf16_t*)(ws + O_KG) + (size_t)(b * 2 + hk) * L_ * 64,
                          (const bf16_t*)(ws + O_VGT) + (size_t)(b * 2 + hk) * 64 * L_,
                          (bf16_t*)(ws + O_PROJB) + (size_t)(b * L_ + qt * 256) * 768 + hh * 64);
        }
#pragma unroll 1
        for (int rep = 0; rep < REP_ATTN; ++rep)
        for (int u = blockIdx.x; u < 256; u += gridDim.x) {
            const int qt = u & 31, hh = (u >> 5) & 3, b = u >> 7;
            attn_unit<96>(lds, (const bf16_t*)(ws + O_QM) + ((size_t)(b * 4 + hh) * L_ + qt * 256) * 96,
                          (const bf16_t*)(ws + O_KM) + (size_t)(b * 4 + hh) * L_ * 96,
                          (const bf16_t*)(ws + O_VMT) + (size_t)(b * 4 + hh) * 64 * L_,
                          (bf16_t*)(ws + O_PROJB) + (size_t)(b * L_ + qt * 256) * 768 + 512 + hh * 64);
        }
        XSYNC();
#pragma unroll 1
        for (int rep = 0; rep < REP_EW; ++rep) groups_phase(lds, p);
        XSYNC();
        if (gridDim.x == 256) {
            EpiResid e; e.xold = (l == 0) ? p.in[0] : p.out; e.xout = p.out; e.xn = (bf16_t*)(ws + O_XN); e.g = p.in[23] + l * 1024; e.slots = (float*)(ws + O_SLOTS); e.xb = xb; e.want_xn = true;
            gemm_phase<false>(lds, (const bf16_t*)(ws + O_HYT), 1024, (const bf16_t*)(ws + O_WOUT) + (size_t)l * 1024 * 1024, 1024, 64, 4, e);
            XSYNC();
        } else {
            EpiF32 e; e.C = (float*)(ws + O_R1); e.ldc = 1024;
            gemm_phase<false>(lds, (const bf16_t*)(ws + O_HYT), 1024, (const bf16_t*)(ws + O_WOUT) + (size_t)l * 1024 * 1024, 1024, 64, 4, e);
            XSYNC();
            resid_phase((const float*)(ws + O_R1), l == 0 ? p.in[0] : p.out, p.in[23] + l * 1024, p.out, (bf16_t*)(ws + O_XN), true);
            XSYNC();
        }
        {
            EpiUp e; e.act = (bf16_t*)(ws + O_HYT); e.cw = p.in[26] + (size_t)l * 3 * 5632; e.cb = p.in[27] + (size_t)l * 5632;
            gemm_phase<true>(lds, (const bf16_t*)(ws + O_XN), 1024, (const bf16_t*)(ws + O_WUP) + (size_t)l * 5632 * 1024, 1024, 66, 22, e);
        }
        XSYNC();
        if (gridDim.x == 256) {
            EpiResid e; e.xold = p.out; e.xout = p.out; e.xn = (bf16_t*)(ws + O_XN); e.g = p.in[29] + l * 1024; e.slots = (float*)(ws + O_SLOTS); e.xb = xb; e.want_xn = (l == 0);
            gemm_phase<false>(lds, (const bf16_t*)(ws + O_HYT), 2816, (const bf16_t*)(ws + O_WDOWN) + (size_t)l * 1024 * 2816, 2816, 64, 4, e);
            if (l == 0) XSYNC();
        } else {
            EpiF32 e; e.C = (float*)(ws + O_R1); e.ldc = 1024;
            gemm_phase<false>(lds, (const bf16_t*)(ws + O_HYT), 2816, (const bf16_t*)(ws + O_WDOWN) + (size_t)l * 1024 * 2816, 2816, 64, 4, e);
            XSYNC();
            resid_phase((const float*)(ws + O_R1), p.out, p.in[29] + l * 1024, p.out, (bf16_t*)(ws + O_XN), l == 0);
            if (l == 0) XSYNC();
        }
    }
}

extern "C" void kernel_launch(void* const* d_in, const int* in_sizes, int n_in,
                              void* d_out, int out_size, void* d_ws, size_t ws_size,
                              hipStream_t stream) {
    static int grid_blocks = 0;
    if (!grid_blocks) {
        int dev = 0, cus = 0, per_cu = 0;
        (void)hipGetDevice(&dev);
        (void)hipDeviceGetAttribute(&cus, hipDeviceAttributeMultiprocessorCount, dev);
        (void)hipFuncSetAttribute((const void*)fwd_megakernel, hipFuncAttributeMaxDynamicSharedMemorySize, (int)LDS_BYTES);
        (void)hipOccupancyMaxActiveBlocksPerMultiprocessor(&per_cu, fwd_megakernel, NTHR, LDS_BYTES);
        if (per_cu < 1) per_cu = 1;
        grid_blocks = cus;
        if (grid_blocks > 256) grid_blocks = 256;
    }
    Params p{};
    for (int i = 0; i < 30; ++i) p.in[i] = (const float*)d_in[i];
    p.out = (float*)d_out; p.ws = (unsigned char*)d_ws;
    void* args[] = {&p};
    (void)hipMemsetAsync((unsigned char*)d_ws + O_BAR, 0, XCD_BAR_WORDS * sizeof(unsigned), stream);
    hipError_t e = hipLaunchCooperativeKernel((void*)fwd_megakernel, dim3(grid_blocks), dim3(NTHR), args, LDS_BYTES, stream);
    if (e != hipSuccess) fprintf(stderr, "cooperative launch failed: %s (grid %d)\n", hipGetErrorString(e), grid_blocks);
}
```

```cpp
#include <hip/hip_runtime.h>
#include <hip/hip_cooperative_groups.h>
#include <cstdio>
#include <cstdint>
namespace cg = cooperative_groups;

typedef unsigned short bf16_t;
typedef short bf16x8 __attribute__((ext_vector_type(8)));
typedef float f32x4 __attribute__((ext_vector_type(4)));
typedef float f32x16 __attribute__((ext_vector_type(16)));
typedef unsigned u32x2 __attribute__((ext_vector_type(2)));
typedef unsigned u32x4 __attribute__((ext_vector_type(4)));

#define DI __device__ __forceinline__
#ifndef REP_ATTN
#define REP_ATTN 1
#endif
#ifndef REP_HY
#define REP_HY 1
#endif
#ifndef REP_GEMM
#define REP_GEMM 1
#endif
#ifndef REP_PRO
#define REP_PRO 1
#endif
#ifndef REP_SYNC
#define REP_SYNC 1
#endif
#define XSYNC() do { _Pragma("unroll 1") for (int r_ = 0; r_ < REP_SYNC; ++r_) xcd_barrier(xb); } while (0)
#ifndef REP_EW
#define REP_EW 1
#endif
constexpr int L_ = 8192, T_ = 16384, NTHR = 512;
constexpr size_t MiB = 1u << 20;
constexpr size_t O_WIN = 0, O_WUQ = 8 * MiB, O_WUKV = 8 * MiB + 512 * 1024, O_RQ = 8 * MiB + 768 * 1024, O_RKV = 8 * MiB + 832 * 1024;
constexpr size_t O_BAR = 8 * MiB + 896 * 1024;
constexpr size_t O_WOUT = 9 * MiB, O_WUP = 13 * MiB, O_WDOWN = 35 * MiB, O_H2 = 46 * MiB;
constexpr size_t O_R1 = 50 * MiB;
constexpr size_t O_HYT = 114 * MiB;
constexpr size_t O_PROJB = 162 * MiB;
constexpr size_t O_HYOUT = 186 * MiB;
constexpr size_t O_QG = 199 * MiB, O_KG = 215 * MiB, O_VGT = 219 * MiB, O_QM = 223 * MiB, O_KM = 235 * MiB, O_VMT = 247 * MiB;
constexpr size_t O_XN = 223 * MiB;
constexpr size_t O_SLOTS = 255 * MiB;
constexpr size_t LDS_BYTES = 150 * 1024;

struct Params { const float* in[30]; float* out; unsigned char* ws; };

typedef __bf16 bf16v2_t __attribute__((ext_vector_type(2)));
typedef float f32v2_t __attribute__((ext_vector_type(2)));
DI bf16_t f2bf(float x) { const __bf16 b = (__bf16)x; return __builtin_bit_cast(bf16_t, b); }
DI float bf2f(bf16_t v) { return __uint_as_float(((unsigned)v) << 16); }
DI unsigned pack2(float lo, float hi) { const f32v2_t v = {lo, hi}; const bf16v2_t b = __builtin_convertvector(v, bf16v2_t); return __builtin_bit_cast(unsigned, b); }
DI float wave_sum(float v) {
#pragma unroll
    for (int o = 32; o >= 1; o >>= 1) v += __shfl_xor(v, o);
    return v;
}
DI int tid_fresh() { int t = threadIdx.x; asm volatile("" : "+v"(t)); return t; }
DI void fast_sincos(float ang, float* s, float* c) {
    float rev = ang * 0.15915494309189535f; rev -= rintf(rev);
    *s = __builtin_amdgcn_sinf(rev); *c = __builtin_amdgcn_cosf(rev);
}
DI float fast_sin(float a) { float rev = a * 0.15915494309189535f; rev -= rintf(rev); return __builtin_amdgcn_sinf(rev); }
DI int perm16(int t) { return (t & ~15) | (t & 3) | (((t >> 3) & 1) << 2) | (((t >> 2) & 1) << 3); }

DI void convT(unsigned char* lds, const float* __restrict__ W, int K, int N, int Npad, const float* __restrict__ gain, bf16_t* __restrict__ dst, int mode, const float* __restrict__ gain_b = nullptr, const float* __restrict__ gain_c = nullptr) {
    float* tile = (float*)lds;
    const int tid = tid_fresh();
    const int nkt = K >> 6, nnt = Npad >> 8;
    for (int u = blockIdx.x; u < nkt * nnt; u += gridDim.x) {
        const int kt = u % nkt, ntile = u / nkt;
        const int k0 = kt * 64, n0 = ntile * 256;
        const int cl = 4 * (tid & 63);
        int src = n0 + cl;
        if (mode == 1) { const int nq = n0 + (cl & ~63), jt = nq >> 7, half = (nq >> 6) & 1; src = (half ? 2816 + 64 * jt : 64 * jt) + (cl & 63); }
        const bool valid = src < N;
        f32x4 v[8];
#pragma unroll
        for (int i = 0; i < 8; ++i) {
            const int kk = (tid >> 6) + 8 * i;
            v[i] = valid ? *(const f32x4*)(W + (size_t)(k0 + kk) * N + src) : (f32x4){0.f, 0.f, 0.f, 0.f};
        }
#pragma unroll
        for (int i = 0; i < 8; ++i) {
            const int kk = (tid >> 6) + 8 * i;
            const int kq = k0 + kk;
            const float g = (mode == 2) ? ((kq < 256) ? gain[kq] : (kq < 768) ? gain_b[kq - 256] : gain_c[kq - 768]) : (gain ? gain[kq] : 1.0f);
            *(f32x4*)(tile + kk * 260 + cl) = v[i] * g;
        }
        __syncthreads();
        {
            const int nn = tid >> 1, kh = (tid & 1) * 32;
#pragma unroll
            for (int c = 0; c < 4; ++c) {
                const int kb = kh + 8 * c;
                u32x4 w;
                w.x = pack2(tile[(kb + 0) * 260 + nn], tile[(kb + 1) * 260 + nn]);
                w.y = pack2(tile[(kb + 2) * 260 + nn], tile[(kb + 3) * 260 + nn]);
                w.z = pack2(tile[(kb + 4) * 260 + nn], tile[(kb + 5) * 260 + nn]);
                w.w = pack2(tile[(kb + 6) * 260 + nn], tile[(kb + 7) * 260 + nn]);
                *(u32x4*)(dst + (size_t)(n0 + nn) * K + k0 + kb) = w;
            }
        }
        __syncthreads();
    }
}

DI void hy_h2_phase(unsigned char* lds, const Params& p) {
    float* zs = (float*)lds;
    float* h1s = zs + 64 * 36;
    const int tid = tid_fresh(), rg = tid >> 6, j = tid & 63;
    float* h2 = (float*)(p.ws + O_H2);
    for (int u = blockIdx.x; u < 2 * (L_ / 64); u += gridDim.x) {
        const int l = u / (L_ / 64), t0 = (u % (L_ / 64)) * 64;
#pragma unroll 1
        for (int e = tid; e < 64 * 16; e += NTHR) {
            const int row = e >> 4, bnd = e & 15, t = t0 + row;
            const float w = 2.0f * 3.14159265358979323846f * (float)t / (float)L_;
            const float f = 1e-4f + (15.0f - 1e-4f) * (float)bnd / 15.0f;
            const float a = f * w;
            float sn, cs; fast_sincos(a, &sn, &cs);
            zs[row * 36 + 1 + bnd] = cs;
            zs[row * 36 + 17 + bnd] = -sn;
            if (bnd == 0) zs[row * 36] = (float)t / (float)(L_ - 1);
        }
        __syncthreads();
        {
            const float* w1 = p.in[5] + (size_t)l * 33 * 64;
            float wc[33];
#pragma unroll
            for (int e = 0; e < 33; ++e) wc[e] = w1[e * 64 + j];
            const float b1 = p.in[6][l * 64 + j], f1 = p.in[7][l * 64 + j];
#pragma unroll 2
            for (int i = 0; i < 8; ++i) {
                const int row = 8 * rg + i;
                float s = b1;
#pragma unroll
                for (int e = 0; e < 33; ++e) s += zs[row * 36 + e] * wc[e];
                h1s[row * 64 + j] = fast_sin(f1 * s);
            }
        }
        __syncthreads();
        {
            const float* w2 = p.in[8] + (size_t)l * 64 * 64;
            float wc[64];
#pragma unroll
            for (int e = 0; e < 64; ++e) wc[e] = w2[e * 64 + j];
            const float b2 = p.in[9][l * 64 + j], f2 = p.in[10][l * 64 + j];
#pragma unroll 2
            for (int i = 0; i < 8; ++i) {
                const int row = 8 * rg + i;
                float s = b2;
#pragma unroll
                for (int e = 0; e < 64; e += 4) { const f32x4 hv = *(const f32x4*)(h1s + row * 64 + e); s += hv[0] * wc[e] + hv[1] * wc[e + 1] + hv[2] * wc[e + 2] + hv[3] * wc[e + 3]; }
                h2[((size_t)l * L_ + t0 + row) * 64 + j] = fast_sin(f2 * s);
            }
        }
        __syncthreads();
    }
}

DI void ft_phase(unsigned char* lds, const Params& p, int l) {
    const int tid = tid_fresh(), lane = tid & 63, w = tid >> 6, r16 = lane & 15, q4 = lane >> 4;
    const float* h2 = (const float*)(p.ws + O_H2) + (size_t)l * L_ * 64;
    const float* w3 = p.in[11] + (size_t)l * 64 * 1024;
    const float min_decay = -4.605170185988091f / 1.5f, max_decay = -4.605170185988091f / 0.3f;
    for (int u = blockIdx.x; u < L_ / 32; u += gridDim.x) {
        const int t0 = u * 32;
        bf16x8 hb[2][2];
#pragma unroll
        for (int tt = 0; tt < 2; ++tt)
#pragma unroll
            for (int ks = 0; ks < 2; ++ks) {
                const float* hp = h2 + (size_t)(t0 + 16 * tt + r16) * 64 + 32 * ks + 8 * q4;
                const f32x4 a = *(const f32x4*)hp, b = *(const f32x4*)(hp + 4);
                u32x4 pw; pw.x = pack2(a[0], a[1]); pw.y = pack2(a[2], a[3]); pw.z = pack2(b[0], b[1]); pw.w = pack2(b[2], b[3]);
                hb[tt][ks] = __builtin_bit_cast(bf16x8, pw);
            }
#pragma unroll 2
        for (int nt = 0; nt < 8; ++nt) {
            const int n0 = 128 * w + 16 * nt;
            f32x4 acc0 = {0.f, 0.f, 0.f, 0.f}, acc1 = {0.f, 0.f, 0.f, 0.f};
#pragma unroll
            for (int ks = 0; ks < 2; ++ks) {
                const float* wp = w3 + (size_t)(32 * ks + 8 * q4) * 1024 + n0 + r16;
                u32x4 pw;
                pw.x = pack2(wp[0], wp[1024]); pw.y = pack2(wp[2048], wp[3072]); pw.z = pack2(wp[4096], wp[5120]); pw.w = pack2(wp[6144], wp[7168]);
                const bf16x8 wf = __builtin_bit_cast(bf16x8, pw);
                acc0 = __builtin_amdgcn_mfma_f32_16x16x32_bf16(wf, hb[0][ks], acc0, 0, 0, 0);
                acc1 = __builtin_amdgcn_mfma_f32_16x16x32_bf16(wf, hb[1][ks], acc1, 0, 0, 0);
            }
#pragma unroll
            for (int i = 0; i < 4; ++i) {
                const int col = n0 + 4 * q4 + i, c = col & 255, od = col >> 8;
                const float dlt = fabsf(min_decay + (max_decay - min_decay) * (float)c / 255.0f);
                float* dst = (float*)(p.ws + O_R1 + (size_t)c * 262144 + 131072) + od * L_ + t0 + r16;
                dst[0] = acc0[i] * expf(-((float)(t0 + r16) / (float)(L_ - 1)) * dlt);
                dst[16] = acc1[i] * expf(-((float)(t0 + 16 + r16) / (float)(L_ - 1)) * dlt);
            }
        }
    }
}

DI void rownorm_phase(const float* __restrict__ x, bf16_t* __restrict__ xn) {
    const int tid_ = tid_fresh(); const int lane = tid_ & 63, wid = tid_ >> 6;
    for (int row = blockIdx.x * 8 + wid; row < T_; row += gridDim.x * 8) {
        const float* xr = x + (size_t)row * 1024;
        f32x4 v[4]; float ss = 0.f;
#pragma unroll
        for (int i = 0; i < 4; ++i) { v[i] = *(const f32x4*)(xr + i * 256 + lane * 4); ss += v[i][0] * v[i][0] + v[i][1] * v[i][1] + v[i][2] * v[i][2] + v[i][3] * v[i][3]; }
        ss = wave_sum(ss);
        const float r = rsqrtf(ss * (1.0f / 1024.0f) + 1e-6f);
#pragma unroll
        for (int i = 0; i < 4; ++i) { u32x2 w; w.x = pack2(v[i][0] * r, v[i][1] * r); w.y = pack2(v[i][2] * r, v[i][3] * r); *(u32x2*)(xn + (size_t)row * 1024 + i * 256 + lane * 4) = w; }
    }
}

DI void resid_phase(const float* __restrict__ y, const float* __restrict__ xres, const float* __restrict__ g, float* __restrict__ xout, bf16_t* __restrict__ xn, bool want_xn) {
    const int tid_ = tid_fresh(); const int lane = tid_ & 63, wid = tid_ >> 6;
    for (int row = blockIdx.x * 8 + wid; row < T_; row += gridDim.x * 8) {
        const size_t ro = (size_t)row * 1024;
        f32x4 v[4]; float ss = 0.f;
#pragma unroll
        for (int i = 0; i < 4; ++i) { v[i] = *(const f32x4*)(y + ro + i * 256 + lane * 4); ss += v[i][0] * v[i][0] + v[i][1] * v[i][1] + v[i][2] * v[i][2] + v[i][3] * v[i][3]; }
        ss = wave_sum(ss);
        const float r = rsqrtf(ss * (1.0f / 1024.0f) + 1e-6f);
        float s2 = 0.f;
#pragma unroll
        for (int i = 0; i < 4; ++i) {
            const f32x4 xr = *(const f32x4*)(xres + ro + i * 256 + lane * 4);
            const f32x4 gg = *(const f32x4*)(g + i * 256 + lane * 4);
            v[i] = xr + v[i] * r * gg;
            s2 += v[i][0] * v[i][0] + v[i][1] * v[i][1] + v[i][2] * v[i][2] + v[i][3] * v[i][3];
            *(f32x4*)(xout + ro + i * 256 + lane * 4) = v[i];
        }
        if (want_xn) {
            s2 = wave_sum(s2);
            const float r2 = rsqrtf(s2 * (1.0f / 1024.0f) + 1e-6f);
#pragma unroll
            for (int i = 0; i < 4; ++i) { u32x2 w; w.x = pack2(v[i][0] * r2, v[i][1] * r2); w.y = pack2(v[i][2] * r2, v[i][3] * r2); *(u32x2*)(xn + ro + i * 256 + lane * 4) = w; }
        }
    }
}

#define XB_TMO      128
#define XB_XCNT(j)  (256  + 64 * (j))
#define XB_XSUB(j)  (1280 + 64 * (j))
#define XB_XGEN(j)  (2304 + 64 * (j))
#define XB_TOP      3328
#define XB_TOPGEN   3392
#define XCD_BAR_WORDS 3456
#define XB_SPIN_CAP (1u << 22)
#define LAS __attribute__((address_space(3)))
DI unsigned xb_ld(unsigned* p)              { return __hip_atomic_load(p, __ATOMIC_RELAXED, __HIP_MEMORY_SCOPE_AGENT); }
DI unsigned xb_add(unsigned* p, unsigned v) { return __hip_atomic_fetch_add(p, v, __ATOMIC_RELAXED, __HIP_MEMORY_SCOPE_AGENT); }
DI unsigned xb_xcc_id() { return (unsigned)__builtin_amdgcn_s_getreg((3 << 11) | 20) & 0xFu; }
#define XB_SPIN(cond, bar) do { unsigned _sp = 0; while (cond) { __builtin_amdgcn_s_sleep(1); \
    if ((++_sp & 255u) == 0u) { if (xb_ld(&(bar)[XB_TMO])) break; if (_sp > XB_SPIN_CAP) { atomicAdd(&(bar)[XB_TMO], 1u); break; } } } } while (0)
struct XcdBarrier { unsigned* bar; unsigned x; volatile LAS unsigned* st; };
DI XcdBarrier xcd_barrier_post(unsigned* bar, volatile LAS unsigned* st) {
    XcdBarrier b; b.bar = bar; b.x = xb_xcc_id(); b.st = st;
    if (threadIdx.x == 0) (void)xb_add(&bar[XB_XCNT(b.x)], 1u);
    return b;
}
DI void xcd_barrier_complete(unsigned* bar, unsigned x, unsigned& nloc, unsigned& nx) {
    const unsigned G = gridDim.x * gridDim.y * gridDim.z;
    unsigned sum, cnt, mine, sp = 0u;
    for (;;) {
        sum = 0u; cnt = 0u; mine = 0u;
#pragma unroll
        for (unsigned j = 0; j < 16; ++j) { const unsigned c = xb_ld(&bar[XB_XCNT(j)]); sum += c; cnt += (c > 0u) ? 1u : 0u; mine = (j == x) ? c : mine; }
        if (sum == G) break;
        __builtin_amdgcn_s_sleep(1);
        if ((++sp & 255u) == 0u) { if (xb_ld(&bar[XB_TMO])) break; if (sp > XB_SPIN_CAP) { atomicAdd(&bar[XB_TMO], 1u); break; } }
    }
    nloc = mine > 0u ? mine : 1u; nx = cnt > 0u ? cnt : 1u;
}
DI void xcd_barrier(const XcdBarrier& b) {
    asm volatile("s_waitcnt vmcnt(0)" ::: "memory");
    __syncthreads();
    if (threadIdx.x == 0) {
        unsigned* bar = b.bar;
        __builtin_amdgcn_s_waitcnt(0);
        unsigned nloc = b.st[0], nx = b.st[1];
        if (nloc == 0u) { xcd_barrier_complete(bar, b.x, nloc, nx); b.st[0] = nloc; b.st[1] = nx; }
        const unsigned old = xb_add(&bar[XB_XSUB(b.x)], 1u);
        const unsigned gen = old / nloc;
        if (old + 1u == (gen + 1u) * nloc) {
            __builtin_amdgcn_fence(__ATOMIC_RELEASE, "agent");
            asm volatile("s_waitcnt vmcnt(0)" ::: "memory");
            const unsigned og = xb_add(&bar[XB_TOP], 1u);
            const unsigned tg = og / nx;
            if (og + 1u == (tg + 1u) * nx) xb_add(&bar[XB_TOPGEN], 1u);
            else XB_SPIN(xb_ld(&bar[XB_TOPGEN]) == tg, bar);
            __builtin_amdgcn_fence(__ATOMIC_ACQUIRE, "agent");
            xb_add(&bar[XB_XGEN(b.x)], 1u);
            asm volatile("s_waitcnt vmcnt(0)" ::: "memory");
        } else {
            XB_SPIN(xb_ld(&bar[XB_XGEN(b.x)]) == gen, bar);
            __builtin_amdgcn_fence(__ATOMIC_ACQUIRE, "agent");
            asm volatile("s_waitcnt vmcnt(0)" ::: "memory");
        }
    }
    __syncthreads();
}

DI int swz128(int row, int chunk) { return row * 128 + ((chunk ^ ((row >> 1) & 7)) << 4); }

template <bool OVL, class Epi>
DI void gemm_phase(unsigned char* lds, const bf16_t* __restrict__ A, int lda, const bf16_t* __restrict__ Bt, int K, int nMt, int nNt, const Epi& epi, int bid = -1, int nb = 0) {
    if (bid < 0) { bid = blockIdx.x; nb = gridDim.x; }
    typedef __attribute__((address_space(3))) unsigned char lds_uc;
    lds_uc* ldsl = (lds_uc*)lds;
    const int tid = tid_fresh(), lane = tid & 63, wid = tid >> 6, wm = wid & 1, wn = wid >> 1;
    const int r16 = lane & 15, q4 = lane >> 4;
    const int nk = K >> 6;
    const int xr = (r16 >> 1) & 7;
    const int ab0 = (128 * wm + r16) * 128 + ((q4 ^ xr) << 4), ab1 = (128 * wm + r16) * 128 + (((4 + q4) ^ xr) << 4);
    const int bb0 = 32768 + (64 * wn + r16) * 128 + ((q4 ^ xr) << 4), bb1 = 32768 + (64 * wn + r16) * 128 + (((4 + q4) ^ xr) << 4);
#pragma unroll 1
    for (int rep = 0; rep < REP_GEMM; ++rep)
    for (int u = bid; u < nMt * nNt; u += nb) {
        int um, un;
        { const int nM8 = nMt & ~7, nmain = nM8 * nNt;
          if (u < nmain) { um = u % nM8; un = u / nM8; } else { const int v = u - nmain, rem = nMt - nM8; um = nM8 + v % rem; un = v / rem; } }
        const bf16_t* ap[4]; const bf16_t* bp[4];
        int t0 = 0, bb = 0;
        if (OVL) { bb = um / 33; t0 = 254 * (um % 33) - 1; }
#pragma unroll
        for (int i = 0; i < 4; ++i) {
            const int P = (wid * 4 + i) * 64 + lane, row = P >> 3, c = (P & 7) ^ ((row >> 1) & 7);
            int grow;
            if (OVL) { int t = t0 + row; t = t < 0 ? 0 : (t > L_ - 1 ? L_ - 1 : t); grow = bb * L_ + t; }
            else grow = um * 256 + row;
            ap[i] = A + (size_t)grow * lda + c * 8;
            bp[i] = Bt + (size_t)(un * 256 + row) * K + c * 8;
        }
        f32x4 acc[8][4];
#pragma unroll
        for (int a = 0; a < 8; ++a)
#pragma unroll
            for (int b = 0; b < 4; ++b) acc[a][b] = (f32x4){0.f, 0.f, 0.f, 0.f};
#define G_ISSUE(bufoff) do { _Pragma("unroll") for (int i = 0; i < 4; ++i) { __builtin_amdgcn_global_load_lds((const unsigned*)ap[i], (__attribute__((address_space(3))) unsigned*)(ldsl + (bufoff) + (wid * 4 + i) * 1024), 16, 0, 0); ap[i] += 64; } \
                             _Pragma("unroll") for (int i = 0; i < 4; ++i) { __builtin_amdgcn_global_load_lds((const unsigned*)bp[i], (__attribute__((address_space(3))) unsigned*)(ldsl + (bufoff) + 32768 + (wid * 4 + i) * 1024), 16, 0, 0); bp[i] += 64; } } while (0)
        __syncthreads();
        G_ISSUE(0);
        asm volatile("s_waitcnt vmcnt(0)" ::: "memory");
        __builtin_amdgcn_s_barrier();
        asm volatile("" ::: "memory");
#pragma unroll 1
        for (int kt = 0; kt < nk; ++kt) {
            const int cb = (kt & 1) * 65536;
            const unsigned char* lb = lds + cb;
#pragma unroll
            for (int ks = 0; ks < 2; ++ks) {
                bf16x8 af[4], bfr[4];
#pragma unroll
                for (int nt = 0; nt < 4; ++nt) bfr[nt] = *(const bf16x8*)(lb + (ks ? bb1 : bb0) + nt * 2048);
#pragma unroll
                for (int mh = 0; mh < 2; ++mh) {
#pragma unroll
                    for (int mt = 0; mt < 4; ++mt) af[mt] = *(const bf16x8*)(lb + (ks ? ab1 : ab0) + (4 * mh + mt) * 2048);
                    __builtin_amdgcn_sched_barrier(0);
#pragma unroll
                    for (int mt = 0; mt < 4; ++mt)
#pragma unroll
                        for (int nt = 0; nt < 4; ++nt) acc[4 * mh + mt][nt] = __builtin_amdgcn_mfma_f32_16x16x32_bf16(bfr[nt], af[mt], acc[4 * mh + mt][nt], 0, 0, 0);
                    __builtin_amdgcn_sched_barrier(0);
                    if (ks == 0 && mh == (wid >= 4 ? 1 : 0) && kt + 1 < nk) G_ISSUE(65536 - cb);
                }
            }
            asm volatile("s_waitcnt vmcnt(0) lgkmcnt(0)" ::: "memory");
            __builtin_amdgcn_s_barrier();
            asm volatile("" ::: "memory");
        }
        int r16e = r16, q4e = q4;
        asm volatile("" : "+v"(r16e), "+v"(q4e));
        if constexpr (Epi::STAGED) {
            epi.staged(lds, acc, um, un, wm, wn, r16e, q4e);
        } else {
#pragma unroll
            for (int mt = 0; mt < 8; ++mt) { epi.row(um * 256 + 128 * wm + 16 * mt + r16e, un * 256 + 64 * wn, q4e, acc[mt]); asm volatile("" ::: "memory"); }
        }
    }
#undef G_ISSUE
}

struct EpiIn {
    static constexpr bool STAGED = true;
    float* hyT; bf16_t* projb;
    template <int HF> static DI void hy_half(float* st, const f32x4 (&acc)[8][4], float* dst, int r16, int q4, int lane) {
#pragma unroll
        for (int mt = 0; mt < 4; ++mt)
#pragma unroll
            for (int nt = 0; nt < 4; ++nt)
#pragma unroll
                for (int i = 0; i < 4; ++i) st[(16 * nt + 4 * q4 + i) * 65 + 16 * mt + r16] = acc[4 * HF + mt][nt][i];
        asm volatile("s_waitcnt lgkmcnt(0)" ::: "memory");
#pragma unroll 4
        for (int n = 0; n < 64; ++n) dst[(size_t)n * T_] = st[n * 65 + lane];
        asm volatile("s_waitcnt lgkmcnt(0)" ::: "memory");
    }
    DI void staged(unsigned char* lds, const f32x4 (&acc)[8][4], int um, int un, int wm, int wn, int r16, int q4) const {
        if (un < 3) {
            float* st = (float*)lds + (wm + 2 * wn) * (64 * 65);
            const int lane = r16 + 16 * q4;
            float* dst = hyT + (size_t)(un * 256 + 64 * wn) * T_ + um * 256 + 128 * wm + lane;
            hy_half<0>(st, acc, dst, r16, q4, lane);
            hy_half<1>(st, acc, dst + 64, r16, q4, lane);
        } else {
#pragma unroll
            for (int mt = 0; mt < 8; ++mt) {
                const int tok = um * 256 + 128 * wm + 16 * mt + r16;
#pragma unroll
                for (int nt = 0; nt < 4; ++nt) {
                    const int col = un * 256 + 64 * wn + 16 * nt + 4 * q4;
                    if (col < 1952) {
                        u32x2 w; w.x = pack2(acc[mt][nt][0], acc[mt][nt][1]); w.y = pack2(acc[mt][nt][2], acc[mt][nt][3]);
                        *(u32x2*)(projb + (unsigned)(tok * 1184 + (col - 768))) = w;
                    }
                }
            }
        }
    }
};
struct EpiF32 {
    static constexpr bool STAGED = false;
    float* C; int ldc;
    DI void row(int tok, int colbase, int q4, const f32x4 (&a)[4]) const {
#pragma unroll
        for (int nt = 0; nt < 4; ++nt) *(f32x4*)(C + (size_t)tok * ldc + colbase + 16 * nt + 4 * q4) = a[nt];
    }
};
struct EpiResid {
    static constexpr bool STAGED = true;
    const float* xold; float* xout; bf16_t* xn; const float* g; float* slots; XcdBarrier xb; bool want_xn;
    DI void staged(unsigned char* lds, f32x4 (&acc)[8][4], int um, int un, int wm, int wn, int r16, int q4) const {
        float* P = (float*)lds;
        const int tid = threadIdx.x;
#pragma unroll
        for (int mt = 0; mt < 8; ++mt) {
            float ss = 0.f;
#pragma unroll
            for (int nt = 0; nt < 4; ++nt) ss += acc[mt][nt][0] * acc[mt][nt][0] + acc[mt][nt][1] * acc[mt][nt][1] + acc[mt][nt][2] * acc[mt][nt][2] + acc[mt][nt][3] * acc[mt][nt][3];
            ss += __shfl_xor(ss, 16); ss += __shfl_xor(ss, 32);
            if (q4 == 0) P[(128 * wm + 16 * mt + r16) * 4 + wn] = ss;
        }
        __syncthreads();
        if (tid < 256) slots[(size_t)(um * 256 + tid) * 4 + un] = (P[tid * 4] + P[tid * 4 + 1]) + (P[tid * 4 + 2] + P[tid * 4 + 3]);
        xcd_barrier(xb);
#pragma unroll
        for (int mt = 0; mt < 8; ++mt) {
            const int tok = um * 256 + 128 * wm + 16 * mt + r16;
            const f32x4 sl = *(const f32x4*)(slots + (size_t)tok * 4);
            const float rr = rsqrtf(((sl[0] + sl[1]) + (sl[2] + sl[3])) * (1.0f / 1024.0f) + 1e-6f);
            float ss = 0.f;
#pragma unroll
            for (int nt = 0; nt < 4; ++nt) {
                const int col = un * 256 + 64 * wn + 16 * nt + 4 * q4;
                const f32x4 xo = *(const f32x4*)(xold + (size_t)tok * 1024 + col);
                const f32x4 gg = *(const f32x4*)(g + col);
                const f32x4 v = xo + acc[mt][nt] * rr * gg;
                acc[mt][nt] = v;
                *(f32x4*)(xout + (size_t)tok * 1024 + col) = v;
                ss += v[0] * v[0] + v[1] * v[1] + v[2] * v[2] + v[3] * v[3];
            }
            ss += __shfl_xor(ss, 16); ss += __shfl_xor(ss, 32);
            if (q4 == 0) P[(128 * wm + 16 * mt + r16) * 4 + wn] = ss;
            asm volatile("" ::: "memory");
        }
        if (want_xn) {
            __syncthreads();
            float* slots2 = slots + (size_t)T_ * 4;
            if (tid < 256) slots2[(size_t)(um * 256 + tid) * 4 + un] = (P[tid * 4] + P[tid * 4 + 1]) + (P[tid * 4 + 2] + P[tid * 4 + 3]);
            xcd_barrier(xb);
#pragma unroll
            for (int mt = 0; mt < 8; ++mt) {
                const int tok = um * 256 + 128 * wm + 16 * mt + r16;
                const f32x4 sl = *(const f32x4*)(slots2 + (size_t)tok * 4);
                const float rr = rsqrtf(((sl[0] + sl[1]) + (sl[2] + sl[3])) * (1.0f / 1024.0f) + 1e-6f);
#pragma unroll
                for (int nt = 0; nt < 4; ++nt) {
                    const int col = un * 256 + 64 * wn + 16 * nt + 4 * q4;
                    u32x2 w; w.x = pack2(acc[mt][nt][0] * rr, acc[mt][nt][1] * rr); w.y = pack2(acc[mt][nt][2] * rr, acc[mt][nt][3] * rr);
                    *(u32x2*)(xn + (size_t)tok * 1024 + col) = w;
                }
            }
        }
        __syncthreads();
    }
};
struct EpiUq {
    static constexpr bool STAGED = false;
    bf16_t* Qm; const float* rq; float sc;
    DI void row(int tok, int colbase, int q4, const f32x4 (&a)[4]) const {
        const float r = rq[tok] * sc;
        const int b = tok >> 13, t = tok & (L_ - 1);
#pragma unroll
        for (int nt = 0; nt < 4; ++nt) {
            const int col = colbase + 16 * nt + 4 * q4;
            if (col >= 384) continue;
            const int head = col / 96, j = col - head * 96;
            bf16_t* dst = Qm + ((size_t)(b * 4 + head) * L_ + t) * 96;
            if (j < 64) {
                u32x2 w; w.x = pack2(a[nt][0] * r, a[nt][1] * r); w.y = pack2(a[nt][2] * r, a[nt][3] * r);
                *(u32x2*)(dst + j) = w;
            } else if (j < 80) {
                if (nt < 3) {
                    const int p0 = j - 64;
                    float o1[4], o2[4];
#pragma unroll
                    for (int i = 0; i < 4; ++i) {
                        const int pp = p0 + i;
                        const float inv = __expf(-(float)(pp & 7) * (9.210340371976184f / 8.0f));
                        const float ang = (float)((pp < 8) ? (t >> 6) : (t & 63)) * inv;
                        float sn, cs; fast_sincos(ang, &sn, &cs);
                        const float x1 = a[nt][i] * r, x2 = a[(nt < 3) ? nt + 1 : 3][i] * r;
                        o1[i] = x1 * cs - x2 * sn; o2[i] = x1 * sn + x2 * cs;
                    }
                    u32x2 w; w.x = pack2(o1[0], o1[1]); w.y = pack2(o1[2], o1[3]);
                    *(u32x2*)(dst + j) = w;
                    w.x = pack2(o2[0], o2[1]); w.y = pack2(o2[2], o2[3]);
                    *(u32x2*)(dst + j + 16) = w;
                }
            }
        }
    }
};
struct EpiUkv {
    static constexpr bool STAGED = false;
    bf16_t* Km; bf16_t* VmT; const float* rkv;
    DI void row(int tok, int colbase, int q4, const f32x4 (&a)[4]) const {
        const float r = rkv[tok];
        const int b = tok >> 13, t = tok & (L_ - 1);
#pragma unroll
        for (int nt = 0; nt < 4; ++nt) {
            const int col = colbase + 16 * nt + 4 * q4;
            const int head = col >> 7, j = col & 127;
            if (j < 64) {
                u32x2 w; w.x = pack2(a[nt][0] * r, a[nt][1] * r); w.y = pack2(a[nt][2] * r, a[nt][3] * r);
                *(u32x2*)(Km + ((size_t)(b * 4 + head) * L_ + t) * 96 + j) = w;
            } else {
#pragma unroll
                for (int i = 0; i < 4; ++i) VmT[((size_t)(b * 4 + head) * 64 + (j - 64 + i)) * L_ + perm16(t)] = f2bf(a[nt][i] * r);
            }
        }
    }
};
DI float gelu_tanh(float x) {
    const float x2 = x * x;
    const float w = x * (-2.302208198f - 0.1029432397f * x2);
    return x * __builtin_amdgcn_rcpf(1.0f + __builtin_amdgcn_exp2f(w));
}
struct EpiUp {
    static constexpr bool STAGED = true;
    bf16_t* act; const float* cw; const float* cb;
    DI void staged(unsigned char* lds, const f32x4 (&acc)[8][4], int um, int un, int wm, int wn, int r16, int q4) const {
        bf16_t* st = (bf16_t*)lds;
#pragma unroll
        for (int mt = 0; mt < 8; ++mt)
#pragma unroll
            for (int nt = 0; nt < 4; ++nt) {
                u32x2 w; w.x = pack2(acc[mt][nt][0], acc[mt][nt][1]); w.y = pack2(acc[mt][nt][2], acc[mt][nt][3]);
                *(u32x2*)(st + (128 * wm + 16 * mt + r16) * 264 + 64 * wn + 16 * nt + 4 * q4) = w;
            }
        __syncthreads();
        const int tid = threadIdx.x, jp = tid & 31, hf = (tid >> 5) & 1, seg = __builtin_amdgcn_readfirstlane(tid >> 6);
        const int bb = um / 33, t0 = 254 * (um % 33) - 1;
        const int r0 = 32 * seg;
        const int ch = 64 * (2 * un + hf) + 2 * jp;
        float g0[2], g1[2], g2[2], gb[2], v0[2], v1[2], v2[2], vb[2];
#pragma unroll
        for (int e = 0; e < 2; ++e) {
            g0[e] = cw[ch + e]; g1[e] = cw[5632 + ch + e]; g2[e] = cw[2 * 5632 + ch + e]; gb[e] = cb[ch + e];
            v0[e] = cw[2816 + ch + e]; v1[e] = cw[5632 + 2816 + ch + e]; v2[e] = cw[2 * 5632 + 2816 + ch + e]; vb[e] = cb[2816 + ch + e];
        }
        const int rlo = (t0 < 0) ? -t0 : 0, rhi = (L_ - 1 - t0 < 255) ? (L_ - 1 - t0) : 255;
        const bf16_t* sp = st + r0 * 264 + 128 * hf + 2 * jp;
        const bool pv = (r0 - 1 >= rlo) && (r0 - 1 <= rhi), cvd = (r0 >= rlo) && (r0 <= rhi);
        unsigned gpw = pv ? *(const unsigned*)(sp - 264) : 0u, vpw = pv ? *(const unsigned*)(sp - 264 + 64) : 0u;
        unsigned gcw = cvd ? *(const unsigned*)sp : 0u, vcw = cvd ? *(const unsigned*)(sp + 64) : 0u;
        bf16_t* dst = act + (size_t)(bb * L_ + t0 + r0) * 2816 + ch;
#define LO(w) __uint_as_float((w) << 16)
#define HI(w) __uint_as_float((w) & 0xffff0000u)
#pragma unroll 4
        for (int i = 0; i < 32; ++i) {
            const int r = r0 + i;
            const bool nv = (r + 1 >= rlo) && (r + 1 <= rhi);
            const unsigned gnw = nv ? *(const unsigned*)(sp + (i + 1) * 264) : 0u, vnw = nv ? *(const unsigned*)(sp + (i + 1) * 264 + 64) : 0u;
            if (r >= 1 && r <= 254 && r <= rhi) {
                const float cg0 = g0[0] * LO(gpw) + g1[0] * LO(gcw) + g2[0] * LO(gnw) + gb[0];
                const float cv0 = v0[0] * LO(vpw) + v1[0] * LO(vcw) + v2[0] * LO(vnw) + vb[0];
                const float cg1 = g0[1] * HI(gpw) + g1[1] * HI(gcw) + g2[1] * HI(gnw) + gb[1];
                const float cv1 = v0[1] * HI(vpw) + v1[1] * HI(vcw) + v2[1] * HI(vnw) + vb[1];
                *(unsigned*)(dst + (size_t)i * 2816) = pack2(gelu_tanh(cg0) * cv0, gelu_tanh(cg1) * cv1);
            }
            gpw = gcw; gcw = gnw; vpw = vcw; vcw = vnw;
        }
#undef LO
#undef HI
        __syncthreads();
    }
};

DI void prep_phase(const Params& p, int l) {
    const int tid_ = tid_fresh(); const int lane = tid_ & 63, wid = tid_ >> 6;
    const bf16_t* projb = (const bf16_t*)(p.ws + O_PROJB);
    bf16_t* Qg = (bf16_t*)(p.ws + O_QG); bf16_t* Kg = (bf16_t*)(p.ws + O_KG); bf16_t* VgT = (bf16_t*)(p.ws + O_VGT);
    bf16_t* Km = (bf16_t*)(p.ws + O_KM);
    float* rq = (float*)(p.ws + O_RQ); float* rkv = (float*)(p.ws + O_RKV);
    const float* gq = p.in[13] + l * 64; const float* gk = p.in[14] + l * 64;
    const int hd = lane >> 3, sub = lane & 7;
    float gq1[4], gq2[4], gk1[4], gk2[4];
#pragma unroll
    for (int i = 0; i < 4; ++i) { gq1[i] = gq[4 * sub + i]; gq2[i] = gq[32 + 4 * sub + i]; gk1[i] = gk[4 * sub + i]; gk2[i] = gk[32 + 4 * sub + i]; }
    const float qscale = 0.125f * 1.4426950408889634f;
#pragma unroll 2
    for (int tok = blockIdx.x * 8 + wid; tok < T_; tok += gridDim.x * 8) {
        const int b = tok >> 13, t = tok & (L_ - 1);
        const bf16_t* pr = projb + (size_t)tok * 1184;
        float cs[4], sn[4];
#pragma unroll
        for (int i = 0; i < 4; ++i) {
            const int pp = 4 * sub + i;
            const float inv = __expf(-(float)(pp & 15) * (9.210340371976184f / 16.0f));
            const float ang = (float)((pp < 16) ? (t >> 6) : (t & 63)) * inv;
            fast_sincos(ang, &sn[i], &cs[i]);
        }
        {
            const u32x2 w1 = *(const u32x2*)(pr + hd * 64 + 4 * sub), w2 = *(const u32x2*)(pr + hd * 64 + 32 + 4 * sub);
            float x1[4] = {bf2f((bf16_t)(w1.x & 0xffff)), bf2f((bf16_t)(w1.x >> 16)), bf2f((bf16_t)(w1.y & 0xffff)), bf2f((bf16_t)(w1.y >> 16))};
            float x2[4] = {bf2f((bf16_t)(w2.x & 0xffff)), bf2f((bf16_t)(w2.x >> 16)), bf2f((bf16_t)(w2.y & 0xffff)), bf2f((bf16_t)(w2.y >> 16))};
            float ss = 0.f;
#pragma unroll
            for (int i = 0; i < 4; ++i) ss += x1[i] * x1[i] + x2[i] * x2[i];
            ss += __shfl_xor(ss, 1); ss += __shfl_xor(ss, 2); ss += __shfl_xor(ss, 4);
            const float r = rsqrtf(ss * (1.0f / 64.0f) + 1e-6f);
            float o1[4], o2[4];
#pragma unroll
            for (int i = 0; i < 4; ++i) { const float a = x1[i] * r * gq1[i], c = x2[i] * r * gq2[i]; o1[i] = (a * cs[i] - c * sn[i]) * qscale; o2[i] = (a * sn[i] + c * cs[i]) * qscale; }
            bf16_t* dst = Qg + ((size_t)(b * 8 + hd) * L_ + t) * 64;
            u32x2 w; w.x = pack2(o1[0], o1[1]); w.y = pack2(o1[2], o1[3]); *(u32x2*)(dst + 4 * sub) = w;
            w.x = pack2(o2[0], o2[1]); w.y = pack2(o2[2], o2[3]); *(u32x2*)(dst + 32 + 4 * sub) = w;
        }
        if (lane < 16) {
            const u32x2 w1 = *(const u32x2*)(pr + 512 + hd * 64 + 4 * sub), w2 = *(const u32x2*)(pr + 512 + hd * 64 + 32 + 4 * sub);
            float x1[4] = {bf2f((bf16_t)(w1.x & 0xffff)), bf2f((bf16_t)(w1.x >> 16)), bf2f((bf16_t)(w1.y & 0xffff)), bf2f((bf16_t)(w1.y >> 16))};
            float x2[4] = {bf2f((bf16_t)(w2.x & 0xffff)), bf2f((bf16_t)(w2.x >> 16)), bf2f((bf16_t)(w2.y & 0xffff)), bf2f((bf16_t)(w2.y >> 16))};
            float ss = 0.f;
#pragma unroll
            for (int i = 0; i < 4; ++i) ss += x1[i] * x1[i] + x2[i] * x2[i];
            ss += __shfl_xor(ss, 1); ss += __shfl_xor(ss, 2); ss += __shfl_xor(ss, 4);
            const float r = rsqrtf(ss * (1.0f / 64.0f) + 1e-6f);
            float o1[4], o2[4];
#pragma unroll
            for (int i = 0; i < 4; ++i) { const float a = x1[i] * r * gk1[i], c = x2[i] * r * gk2[i]; o1[i] = a * cs[i] - c * sn[i]; o2[i] = a * sn[i] + c * cs[i]; }
            bf16_t* dst = Kg + ((size_t)(b * 2 + hd) * L_ + t) * 64;
            u32x2 w; w.x = pack2(o1[0], o1[1]); w.y = pack2(o1[2], o1[3]); *(u32x2*)(dst + 4 * sub) = w;
            w.x = pack2(o2[0], o2[1]); w.y = pack2(o2[2], o2[3]); *(u32x2*)(dst + 32 + 4 * sub) = w;
        }
        {
            const unsigned w = *(const unsigned*)(pr + 640 + 2 * lane);
            const int c0 = 2 * lane, kh = c0 >> 6, d = c0 & 63;
            bf16_t* dst = VgT + ((size_t)(b * 2 + kh) * 64 + d) * L_ + perm16(t);
            dst[0] = (bf16_t)(w & 0xffff); dst[L_] = (bf16_t)(w >> 16);
        }
        {
            const u32x2 w = *(const u32x2*)(pr + 768 + 4 * lane);
            const float a0 = bf2f((bf16_t)(w.x & 0xffff)), a1 = bf2f((bf16_t)(w.x >> 16)), a2 = bf2f((bf16_t)(w.y & 0xffff)), a3 = bf2f((bf16_t)(w.y >> 16));
            float ss = wave_sum(a0 * a0 + a1 * a1 + a2 * a2 + a3 * a3);
            if (lane == 0) rq[tok] = rsqrtf(ss * (1.0f / 256.0f) + 1e-6f);
        }
        {
            const unsigned w = *(const unsigned*)(pr + 1024 + 2 * lane);
            const float a0 = bf2f((bf16_t)(w & 0xffff)), a1 = bf2f((bf16_t)(w >> 16));
            float ss = wave_sum(a0 * a0 + a1 * a1);
            if (lane == 0) rkv[tok] = rsqrtf(ss * (1.0f / 128.0f) + 1e-6f);
        }
        if (lane < 16) {
            const float x1 = bf2f(pr[1152 + lane]), x2 = bf2f(pr[1152 + 16 + lane]);
            const float inv = __expf(-(float)(lane & 7) * (9.210340371976184f / 8.0f));
            const float ang = (float)((lane < 8) ? (t >> 6) : (t & 63)) * inv;
            float s1, c1; fast_sincos(ang, &s1, &c1);
            const bf16_t o1 = f2bf(x1 * c1 - x2 * s1), o2 = f2bf(x1 * s1 + x2 * c1);
#pragma unroll
            for (int hh = 0; hh < 4; ++hh) { bf16_t* dst = Km + ((size_t)(b * 4 + hh) * L_ + t) * 96 + 64; dst[lane] = o1; dst[16 + lane] = o2; }
        }
    }
}

template <int DQK> DI int kswz(int row, int chunk) {
    if (DQK == 64) return row * 128 + ((chunk ^ ((row >> 1) & 7)) << 4);
    else return row * 192 + ((chunk ^ ((row >> 2) & 3)) << 4);
}
template <int DQK>
DI void attn_unit(unsigned char* lds, const bf16_t* __restrict__ Qp, const bf16_t* __restrict__ Kp, const bf16_t* __restrict__ VTp, bf16_t* __restrict__ Yp  ) {
    constexpr int NS = DQK / 16, NC = DQK / 8, KB = 64 * DQK * 2, KVB = KB + 8192;
    const int tid = tid_fresh(), lane = tid & 63, w = tid >> 6, r = lane & 31, h = lane >> 5;
    bf16x8 qf[NS];
#pragma unroll
    for (int s = 0; s < NS; ++s) qf[s] = *(const bf16x8*)(Qp + (size_t)(32 * w + r) * DQK + 16 * s + 8 * h);
    f32x16 o0, o1;
#pragma unroll
    for (int i = 0; i < 16; ++i) { o0[i] = 0.f; o1[i] = 0.f; }
    float m = 0.f, lsum = 0.f;
    const int k_row0 = tid / NC, k_c0 = tid % NC;
    const int k_row1 = (tid + 512) / NC, k_c1 = (tid + 512) % NC;
    const bool k_two = (DQK == 96) && (tid < 256);
    const int v_row = tid >> 3, v_c = tid & 7;
    u32x4 rkA0, rkA1, rvA, rkB0, rkB1, rvB;
    rkA1 = (u32x4){0u, 0u, 0u, 0u}; rkB1 = rkA1;
#define A_LOAD(kt, R0, R1, RV) do { R0 = *(const u32x4*)(Kp + (size_t)((kt) * 64 + k_row0) * DQK + k_c0 * 8); \
                        if (k_two) R1 = *(const u32x4*)(Kp + (size_t)((kt) * 64 + k_row1) * DQK + k_c1 * 8); \
                        RV = *(const u32x4*)(VTp + (size_t)v_row * L_ + (kt) * 64 + v_c * 8); } while (0)
#define A_STORE(buf, R0, R1, RV) do { *(u32x4*)(lds + (buf) * KVB + kswz<DQK>(k_row0, k_c0)) = R0; \
                          if (k_two) *(u32x4*)(lds + (buf) * KVB + kswz<DQK>(k_row1, k_c1)) = R1; \
                          *(u32x4*)(lds + (buf) * KVB + KB + swz128(v_row, v_c)) = RV; } while (0)
    A_LOAD(0, rkA0, rkA1, rvA);
    A_LOAD(1, rkB0, rkB1, rvB);
    A_STORE(0, rkA0, rkA1, rvA);
    __syncthreads();
    constexpr int NKT = L_ / 64;
#pragma unroll 1
    for (int kt2 = 0; kt2 < NKT; kt2 += 2) {
#pragma unroll
      for (int cur = 0; cur < 2; ++cur) {
        const int kt = kt2 + cur;
        if (kt + 2 < NKT) { if (cur == 0) A_LOAD(kt + 2, rkA0, rkA1, rvA); else A_LOAD(kt + 2, rkB0, rkB1, rvB); }
        const unsigned char* lk = lds + cur * KVB;
        const unsigned char* lv = lk + KB;
        f32x16 s0, s1;
        const float negm = -m;
#pragma unroll
        for (int i = 0; i < 16; ++i) { s0[i] = negm; s1[i] = negm; }
#pragma unroll
        for (int s = 0; s < NS; ++s) {
            const bf16x8 k0 = *(const bf16x8*)(lk + kswz<DQK>(r, 2 * s + h));
            const bf16x8 k1 = *(const bf16x8*)(lk + kswz<DQK>(32 + r, 2 * s + h));
            s0 = __builtin_amdgcn_mfma_f32_32x32x16_bf16(k0, qf[s], s0, 0, 0, 0);
            s1 = __builtin_amdgcn_mfma_f32_32x32x16_bf16(k1, qf[s], s1, 0, 0, 0);
        }
        float mx = fmaxf(fmaxf(s0[0], s0[1]), s0[2]);
#pragma unroll
        for (int i = 3; i < 15; i += 2) mx = fmaxf(fmaxf(mx, s0[i]), s0[i + 1]);
        mx = fmaxf(mx, s0[15]);
#pragma unroll
        for (int i = 0; i < 16; i += 2) mx = fmaxf(fmaxf(mx, s1[i]), s1[i + 1]);
        mx = fmaxf(mx, __shfl_xor(mx, 32));
        if (kt == 0 || __any(mx > 8.0f)) {
            const float dm = (kt == 0) ? mx : fmaxf(mx, 0.f);
            const float alpha = (kt == 0) ? 0.f : __builtin_amdgcn_exp2f(-dm);
            m += dm;
            lsum *= alpha;
#pragma unroll
            for (int i = 0; i < 16; ++i) { o0[i] *= alpha; o1[i] *= alpha; s0[i] -= dm; s1[i] -= dm; }
        }
        float ps = 0.f;
#pragma unroll
        for (int i = 0; i < 16; ++i) { s0[i] = __builtin_amdgcn_exp2f(s0[i]); ps += s0[i]; }
#pragma unroll
        for (int i = 0; i < 16; ++i) { s1[i] = __builtin_amdgcn_exp2f(s1[i]); ps += s1[i]; }
        lsum += ps;
#pragma unroll
        for (int sub = 0; sub < 2; ++sub)
#pragma unroll
            for (int s2 = 0; s2 < 2; ++s2) {
                u32x4 pw;
                if (sub == 0) { pw.x = pack2(s0[8 * s2 + 0], s0[8 * s2 + 1]); pw.y = pack2(s0[8 * s2 + 2], s0[8 * s2 + 3]); pw.z = pack2(s0[8 * s2 + 4], s0[8 * s2 + 5]); pw.w = pack2(s0[8 * s2 + 6], s0[8 * s2 + 7]); }
                else          { pw.x = pack2(s1[8 * s2 + 0], s1[8 * s2 + 1]); pw.y = pack2(s1[8 * s2 + 2], s1[8 * s2 + 3]); pw.z = pack2(s1[8 * s2 + 4], s1[8 * s2 + 5]); pw.w = pack2(s1[8 * s2 + 6], s1[8 * s2 + 7]); }
                const bf16x8 pf = __builtin_bit_cast(bf16x8, pw);
                const bf16x8 vf0 = *(const bf16x8*)(lv + swz128(r, 4 * sub + 2 * s2 + h));
                const bf16x8 vf1 = *(const bf16x8*)(lv + swz128(32 + r, 4 * sub + 2 * s2 + h));
                o0 = __builtin_amdgcn_mfma_f32_32x32x16_bf16(vf0, pf, o0, 0, 0, 0);
                o1 = __builtin_amdgcn_mfma_f32_32x32x16_bf16(vf1, pf, o1, 0, 0, 0);
            }
        if (kt + 1 < NKT) { if (cur == 0) A_STORE(1, rkB0, rkB1, rvB); else A_STORE(0, rkA0, rkA1, rvA); }
        __syncthreads();
      }
    }
#undef A_LOAD
#undef A_STORE
    const float lt = lsum + __shfl_xor(lsum, 32);
    const float inv = 1.0f / lt;
    bf16_t* yr = Yp + (size_t)(32 * w + r) * 768;
#pragma unroll
    for (int g = 0; g < 4; ++g) {
        u32x2 wv; wv.x = pack2(o0[4 * g] * inv, o0[4 * g + 1] * inv); wv.y = pack2(o0[4 * g + 2] * inv, o0[4 * g + 3] * inv);
        *(u32x2*)(yr + 8 * g + 4 * h) = wv;
        wv.x = pack2(o1[4 * g] * inv, o1[4 * g + 1] * inv); wv.y = pack2(o1[4 * g + 2] * inv, o1[4 * g + 3] * inv);
        *(u32x2*)(yr + 32 + 8 * g + 4 * h) = wv;
    }
}

DI int pa(int e) { return e + (e >> 4); }
DI float2 cmul(float2 a, float2 b) { return make_float2(a.x * b.x - a.y * b.y, a.x * b.y + a.y * b.x); }
DI float2 cadd(float2 a, float2 b) { return make_float2(a.x + b.x, a.y + b.y); }
DI float2 csub(float2 a, float2 b) { return make_float2(a.x - b.x, a.y - b.y); }
template <bool INV> DI void dft4(float2& a, float2& b, float2& c, float2& d) {
    const float2 t0 = cadd(a, c), t1 = csub(a, c), t2 = cadd(b, d), t3 = csub(b, d);
    const float2 jt3 = INV ? make_float2(-t3.y, t3.x) : make_float2(t3.y, -t3.x);
    a = cadd(t0, t2); c = csub(t0, t2); b = cadd(t1, jt3); d = csub(t1, jt3);
}
template <bool INV> DI float2 tw16(float2 v, int k) {
    const float c1 = 0.9238795325112867f, s1 = 0.3826834323650898f, c2 = 0.7071067811865476f;
    float wr = 1.f, wi = 0.f;
    switch (k) {
        case 0: wr = 1.f; wi = 0.f; break;
        case 1: wr = c1; wi = -s1; break;
        case 2: wr = c2; wi = -c2; break;
        case 3: wr = s1; wi = -c1; break;
        case 4: wr = 0.f; wi = -1.f; break;
        case 6: wr = -c2; wi = -c2; break;
        case 9: wr = -c1; wi = s1; break;
        default: break;
    }
    if (INV) wi = -wi;
    return make_float2(v.x * wr - v.y * wi, v.x * wi + v.y * wr);
}
template <bool INV> DI void dft16(float2 (&x)[16]) {
#pragma unroll
    for (int b = 0; b < 4; ++b) dft4<INV>(x[b], x[b + 4], x[b + 8], x[b + 12]);
#pragma unroll
    for (int b = 1; b < 4; ++b)
#pragma unroll
        for (int pq = 1; pq < 4; ++pq) x[b + 4 * pq] = tw16<INV>(x[b + 4 * pq], b * pq);
#pragma unroll
    for (int pq = 0; pq < 4; ++pq) dft4<INV>(x[4 * pq], x[4 * pq + 1], x[4 * pq + 2], x[4 * pq + 3]);
#pragma unroll
    for (int a = 0; a < 4; ++a)
#pragma unroll
        for (int b = a + 1; b < 4; ++b) { const float2 tmp = x[4 * a + b]; x[4 * a + b] = x[4 * b + a]; x[4 * b + a] = tmp; }
}
template <bool INV> DI void pass_a(float2* Z, const float2* T1, int tid) {
#pragma unroll
    for (int i = 0; i < 8; ++i) {
        const int j = tid + 512 * i;
        float2* zp = Z + pa(j);
        float2 x0 = zp[0], x1 = zp[4352], x2 = zp[8704], x3 = zp[13056];
        float2 w1 = tw16<false>(T1[j & 1023], i >> 1);
        if (INV) w1.y = -w1.y;
        const float2 w2 = cmul(w1, w1), w3 = cmul(w2, w1);
        if (!INV) { dft4<false>(x0, x1, x2, x3); x1 = cmul(x1, w1); x2 = cmul(x2, w2); x3 = cmul(x3, w3); }
        else { x1 = cmul(x1, w1); x2 = cmul(x2, w2); x3 = cmul(x3, w3); dft4<true>(x0, x1, x2, x3); }
        zp[0] = x0; zp[4352] = x1; zp[8704] = x2; zp[13056] = x3;
    }
}
template <bool INV, int LS, int TS> DI void pass16(float2* Z, const float2* T1, int tid) {
#pragma unroll 1
    for (int i = 0; i < 2; ++i) {
        const int id = tid + 512 * i, j = id & ((1 << LS) - 1), base = (id >> LS) << (LS + 4);
        float2* zp = Z + pa(base + j);
        float2 x[16];
#pragma unroll
        for (int mm = 0; mm < 16; ++mm) x[mm] = zp[mm * ((1 << LS) + (1 << (LS - 4)))];
        float2 w1 = T1[j << TS];
        if (INV) w1.y = -w1.y;
        if (!INV) dft16<false>(x);
        float2 wq = w1;
#pragma unroll
        for (int qq = 1; qq < 16; ++qq) { x[qq] = cmul(x[qq], wq); wq = cmul(wq, w1); }
        if (INV) dft16<true>(x);
#pragma unroll
        for (int mm = 0; mm < 16; ++mm) zp[mm * ((1 << LS) + (1 << (LS - 4)))] = x[mm];
    }
}
DI void pass_d_store(const float2* Z, float2* __restrict__ Kf, int tid, float scale) {
#pragma unroll 1
    for (int i = 0; i < 2; ++i) {
        const int id = tid + 512 * i, base = id * 16;
        float2 x[16];
#pragma unroll
        for (int mm = 0; mm < 16; ++mm) x[mm] = Z[17 * id + mm];
        dft16<false>(x);
#pragma unroll
        for (int mm = 0; mm < 16; mm += 2) *(f32x4*)(Kf + base + mm) = (f32x4){x[mm].x * scale, x[mm].y * scale, x[mm + 1].x * scale, x[mm + 1].y * scale};
    }
}
DI void pass_d_lds(float2* Z, int tid) {
#pragma unroll 1
    for (int i = 0; i < 2; ++i) {
        const int id = tid + 512 * i, base = id * 16;
        float2 x[16];
#pragma unroll
        for (int mm = 0; mm < 16; ++mm) x[mm] = Z[17 * id + mm];
        dft16<false>(x);
#pragma unroll
        for (int mm = 0; mm < 16; ++mm) Z[17 * id + mm] = x[mm];
    }
}
DI void pass_d_mul(float2* Z, const float2* __restrict__ Kf, int tid) {
#pragma unroll 1
    for (int i = 0; i < 2; ++i) {
        const int id = tid + 512 * i, base = id * 16;
        float2 x[16];
#pragma unroll
        for (int mm = 0; mm < 16; ++mm) x[mm] = Z[17 * id + mm];
        dft16<false>(x);
#pragma unroll
        for (int mm = 0; mm < 16; mm += 2) {
            const f32x4 kk = *(const f32x4*)(Kf + base + mm);
            x[mm] = cmul(x[mm], make_float2(kk[0], kk[1])); x[mm + 1] = cmul(x[mm + 1], make_float2(kk[2], kk[3]));
        }
        dft16<true>(x);
#pragma unroll
        for (int mm = 0; mm < 16; ++mm) Z[17 * id + mm] = x[mm];
    }
}
DI void fft_conv(float2* Z, const float2* T1, const float2* Kf, int tid) {
    pass_a<false>(Z, T1, tid); __syncthreads();
    pass16<false, 8, 2>(Z, T1, tid); __syncthreads();
    pass16<false, 4, 6>(Z, T1, tid); __syncthreads();
    pass_d_mul(Z, Kf, tid); __syncthreads();
    pass16<true, 4, 6>(Z, T1, tid); __syncthreads();
    pass16<true, 8, 2>(Z, T1, tid); __syncthreads();
    pass_a<true>(Z, T1, tid); __syncthreads();
}

DI void hyena_unit(unsigned char* lds, const Params& p, int l, int c) {
    float2* Z = (float2*)lds;
    float2* T1 = (float2*)(lds + 139264);
    const int tid = tid_fresh();
    const float* hyT = (const float*)(p.ws + O_HYT);
    float2* Kf0 = (float2*)(p.ws + O_R1) + (size_t)c * 32768;
    float2* Kf1 = Kf0 + 16384;
    bf16_t* hyout = (bf16_t*)(p.ws + O_HYOUT) + (size_t)c * T_;
    for (int k = tid; k < 1024; k += NTHR) { float sn, cs; sincospif((float)k * (1.0f / 8192.0f), &sn, &cs); T1[k] = make_float2(cs, -sn); }
    __syncthreads();
    {
        const float* taps = (const float*)Kf1;
#pragma unroll 4
        for (int t = tid; t < L_; t += NTHR) { Z[pa(t)] = make_float2(taps[t], taps[2 * L_ + t]); Z[pa(16383 - t)] = make_float2(taps[L_ + t], taps[3 * L_ + t]); }
        __syncthreads();
        pass_a<false>(Z, T1, tid); __syncthreads();
        pass16<false, 8, 2>(Z, T1, tid); __syncthreads();
        pass16<false, 4, 6>(Z, T1, tid); __syncthreads();
        pass_d_lds(Z, tid); __syncthreads();
        const float sc = 0.5f / 16384.0f;
#pragma unroll 4
        for (int e = tid; e < 16384; e += NTHR) {
            const int a = e >> 12, b = (e >> 8) & 15, c4 = (e >> 4) & 15, d = e & 15;
            const int k = a + 4 * (b + 16 * (c4 + 16 * d));
            const int k2 = (16384 - k) & 16383;
            const int e2 = ((k2 & 3) << 12) | (((k2 >> 2) & 15) << 8) | (((k2 >> 6) & 15) << 4) | (k2 >> 10);
            const float2 z = Z[pa(e)], z2 = Z[pa(e2)];
            const float sx = z.x + z2.x, sy = z.y - z2.y, dx = z.x - z2.x, dy = z.y + z2.y;
            Kf0[e] = make_float2(sx * sc, sy * sc);
            Kf1[e] = make_float2(dy * sc, -dx * sc);
        }
        __syncthreads();
    }
    const float* cw = p.in[3] + (size_t)l * 3 * 768; const float* cb = p.in[4] + (size_t)l * 768;
    const float* skip = p.in[12] + (size_t)l * 2 * 256;
    float2* z1buf = Kf0;
    const float vw0 = cw[c], vw1 = cw[768 + c], vw2 = cw[1536 + c], vbb = cb[c];
    const float* uv = hyT + (size_t)c * T_;
#pragma unroll 4
    for (int t = tid; t < L_; t += NTHR) {
        float vv[2];
#pragma unroll
        for (int b = 0; b < 2; ++b) {
            const float* ub = uv + b * L_;
            const float um = (t > 0) ? ub[t - 1] : 0.f, uc = ub[t], up = (t < L_ - 1) ? ub[t + 1] : 0.f;
            vv[b] = vw0 * um + vw1 * uc + vw2 * up + vbb;
        }
        Z[pa(t)] = make_float2(vv[0], vv[1]); Z[pa(t + L_)] = make_float2(0.f, 0.f);
    }
    __syncthreads();
    __threadfence();
    fft_conv(Z, T1, Kf0, tid);
    {
        const int ch = 256 + c;
        const float w0 = cw[ch], w1 = cw[768 + ch], w2 = cw[1536 + ch], bb = cb[ch], sk = skip[c];
        const float* u0 = hyT + (size_t)ch * T_;
#pragma unroll 4
        for (int t = tid; t < L_; t += NTHR) {
            const float2 y = Z[pa(t)];
            float zz[2];
#pragma unroll
            for (int b = 0; b < 2; ++b) {
                const float* ub = u0 + b * L_;
                const float um = (t > 0) ? ub[t - 1] : 0.f, uc = ub[t], up = (t < L_ - 1) ? ub[t + 1] : 0.f;
                const float g = w0 * um + w1 * uc + w2 * up + bb;
                const float* vb = uv + b * L_;
                const float vm = (t > 0) ? vb[t - 1] : 0.f, vc = vb[t], vp = (t < L_ - 1) ? vb[t + 1] : 0.f;
                const float v = vw0 * vm + vw1 * vc + vw2 * vp + vbb;
                zz[b] = g * ((b ? y.y : y.x) + sk * v);
            }
            const float2 z1 = make_float2(zz[0], zz[1]);
            Z[pa(t)] = z1; Z[pa(t + L_)] = make_float2(0.f, 0.f);
            z1buf[t] = z1;
        }
    }
    __syncthreads();
    fft_conv(Z, T1, Kf1, tid);
    {
        const int ch = 512 + c;
        const float w0 = cw[ch], w1 = cw[768 + ch], w2 = cw[1536 + ch], bb = cb[ch], sk = skip[256 + c];
        const float* u0 = hyT + (size_t)ch * T_;
#pragma unroll 4
        for (int t = tid; t < L_; t += NTHR) {
            const float2 y = Z[pa(t)];
            const float2 z1 = z1buf[t];
#pragma unroll
            for (int b = 0; b < 2; ++b) {
                const float* ub = u0 + b * L_;
                const float um = (t > 0) ? ub[t - 1] : 0.f, uc = ub[t], up = (t < L_ - 1) ? ub[t + 1] : 0.f;
                const float g = w0 * um + w1 * uc + w2 * up + bb;
                hyout[b * L_ + t] = f2bf(g * ((b ? y.y : y.x) + sk * (b ? z1.y : z1.x)));
            }
        }
    }
    __syncthreads();
}

DI void groups_phase(unsigned char* lds, const Params& p) {
    bf16_t* tile = (bf16_t*)lds;
    const int tid = tid_fresh(), lane = tid & 63, wid = tid >> 6;
    const bf16_t* hyout = (const bf16_t*)(p.ws + O_HYOUT);
    const bf16_t* Y = (const bf16_t*)(p.ws + O_PROJB);
    bf16_t* G = (bf16_t*)(p.ws + O_HYT);
    for (int u = blockIdx.x; u < T_ / 64; u += gridDim.x) {
        const int tok0 = u * 64;
        {
            const int c = tid >> 1, hf = tid & 1;
            const u32x4* src = (const u32x4*)(hyout + (size_t)c * T_ + tok0 + hf * 32);
#pragma unroll
            for (int i = 0; i < 4; ++i) {
                const u32x4 v = src[i];
                unsigned* d = (unsigned*)(tile + c * 66 + hf * 32 + i * 8);
                d[0] = v.x; d[1] = v.y; d[2] = v.z; d[3] = v.w;
            }
        }
        __syncthreads();
#pragma unroll 1
        for (int i = 0; i < 8; ++i) {
            const int tl = wid * 8 + i, tok = tok0 + tl;
            float hv[4]; float sh = 0.f;
#pragma unroll
            for (int k = 0; k < 4; ++k) { hv[k] = bf2f(tile[(lane + 64 * k) * 66 + tl]); sh += hv[k] * hv[k]; }
            sh = wave_sum(sh);
            const float rh = rsqrtf(sh * (1.0f / 256.0f) + 1e-6f);
            bf16_t* gr = G + (size_t)tok * 1024;
#pragma unroll
            for (int k = 0; k < 4; ++k) gr[lane + 64 * k] = f2bf(hv[k] * rh);
            const bf16_t* yr = Y + (size_t)tok * 768;
            {
                const u32x4 v = *(const u32x4*)(yr + lane * 8);
                float a[8] = {bf2f((bf16_t)(v.x & 0xffff)), bf2f((bf16_t)(v.x >> 16)), bf2f((bf16_t)(v.y & 0xffff)), bf2f((bf16_t)(v.y >> 16)),
                              bf2f((bf16_t)(v.z & 0xffff)), bf2f((bf16_t)(v.z >> 16)), bf2f((bf16_t)(v.w & 0xffff)), bf2f((bf16_t)(v.w >> 16))};
                float ss = 0.f;
#pragma unroll
                for (int k = 0; k < 8; ++k) ss += a[k] * a[k];
                ss = wave_sum(ss);
                const float rr = rsqrtf(ss * (1.0f / 512.0f) + 1e-6f);
                u32x4 w; w.x = pack2(a[0] * rr, a[1] * rr); w.y = pack2(a[2] * rr, a[3] * rr); w.z = pack2(a[4] * rr, a[5] * rr); w.w = pack2(a[6] * rr, a[7] * rr);
                *(u32x4*)(gr + 256 + lane * 8) = w;
            }
            {
                const u32x2 v = *(const u32x2*)(yr + 512 + lane * 4);
                float a[4] = {bf2f((bf16_t)(v.x & 0xffff)), bf2f((bf16_t)(v.x >> 16)), bf2f((bf16_t)(v.y & 0xffff)), bf2f((bf16_t)(v.y >> 16))};
                float ss = wave_sum(a[0] * a[0] + a[1] * a[1] + a[2] * a[2] + a[3] * a[3]);
                const float rr = rsqrtf(ss * (1.0f / 256.0f) + 1e-6f);
                u32x2 w; w.x = pack2(a[0] * rr, a[1] * rr); w.y = pack2(a[2] * rr, a[3] * rr);
                *(u32x2*)(gr + 768 + lane * 4) = w;
            }
        }
        __syncthreads();
    }
}


extern __shared__ __attribute__((aligned(16))) unsigned char smem[];

__global__ void __launch_bounds__(512) fwd_megakernel(Params p) {
    cg::grid_group grid = cg::this_grid();
    unsigned char* lds = smem;
    unsigned char* ws = p.ws;
    unsigned* bar = (unsigned*)(ws + O_BAR);
    volatile LAS unsigned* xb_st = (volatile LAS unsigned*)(smem + LDS_BYTES - 16);
    if (threadIdx.x < 4) xb_st[threadIdx.x] = 0u;
    __syncthreads();
    const XcdBarrier xb = xcd_barrier_post(bar, xb_st);
    if (p.ws == nullptr) grid.sync();
#pragma unroll 1
    for (int l2 = 0; l2 < 2 * REP_PRO; ++l2) { const int l = l2 & 1;
        convT(lds, p.in[2] + (size_t)l * 1024 * 1952, 1024, 1952, 2048, p.in[1] + l * 1024, (bf16_t*)(ws + O_WIN) + (size_t)l * 2048 * 1024, 0);
        convT(lds, p.in[16] + (size_t)l * 256 * 384, 256, 384, 512, p.in[15] + l * 256, (bf16_t*)(ws + O_WUQ) + (size_t)l * 512 * 256, 0);
        convT(lds, p.in[18] + (size_t)l * 128 * 512, 128, 512, 512, p.in[17] + l * 128, (bf16_t*)(ws + O_WUKV) + (size_t)l * 512 * 128, 0);
        convT(lds, p.in[22] + (size_t)l * 1024 * 1024, 1024, 1024, 1024, p.in[19] + l * 256, (bf16_t*)(ws + O_WOUT) + (size_t)l * 1024 * 1024, 2, p.in[20] + l * 512, p.in[21] + l * 256);
        convT(lds, p.in[25] + (size_t)l * 1024 * 5632, 1024, 5632, 5632, p.in[24] + l * 1024, (bf16_t*)(ws + O_WUP) + (size_t)l * 5632 * 1024, 1);
        convT(lds, p.in[28] + (size_t)l * 2816 * 1024, 2816, 1024, 1024, nullptr, (bf16_t*)(ws + O_WDOWN) + (size_t)l * 1024 * 2816, 0);
    }
#ifndef REP_MISC
#define REP_MISC 1
#endif
#pragma unroll 1
    for (int rep = 0; rep < REP_MISC; ++rep) { hy_h2_phase(lds, p);
    rownorm_phase(p.in[0], (bf16_t*)(ws + O_XN)); }
    XSYNC();


#pragma unroll 1
    for (int l = 0; l < 2; ++l) {
        {
            EpiIn e; e.hyT = (float*)(ws + O_HYT); e.projb = (bf16_t*)(ws + O_PROJB);
            gemm_phase<false>(lds, (const bf16_t*)(ws + O_XN), 1024, (const bf16_t*)(ws + O_WIN) + (size_t)l * 2048 * 1024, 1024, 64, 8, e);
        }
        XSYNC();
#pragma unroll 1
        for (int rep = 0; rep < REP_EW; ++rep) prep_phase(p, l);
#pragma unroll 1
        for (int rep = 0; rep < REP_MISC; ++rep) ft_phase(lds, p, l);
        XSYNC();
        {
            EpiUq e; e.Qm = (bf16_t*)(ws + O_QM); e.rq = (const float*)(ws + O_RQ); e.sc = 0.10206207261596577f * 1.4426950408889634f;
            const int hb = gridDim.x >> 1;
            if ((int)blockIdx.x < hb) gemm_phase<false>(lds, (const bf16_t*)(ws + O_PROJB) + 768, 1184, (const bf16_t*)(ws + O_WUQ) + (size_t)l * 512 * 256, 256, 64, 2, e, blockIdx.x, hb);
            EpiUkv e2; e2.Km = (bf16_t*)(ws + O_KM); e2.VmT = (bf16_t*)(ws + O_VMT); e2.rkv = (const float*)(ws + O_RKV);
            if ((int)blockIdx.x >= hb) gemm_phase<false>(lds, (const bf16_t*)(ws + O_PROJB) + 1024, 1184, (const bf16_t*)(ws + O_WUKV) + (size_t)l * 512 * 128, 128, 64, 2, e2, blockIdx.x - hb, gridDim.x - hb);
        }
        XSYNC();
#pragma unroll 1
        for (int rep = 0; rep < REP_HY; ++rep)
        for (int c = blockIdx.x; c < 256; c += gridDim.x) hyena_unit(lds, p, l, c);
#pragma unroll 1
        for (int rep = 0; rep < REP_ATTN; ++rep)
        for (int u = blockIdx.x; u < 512; u += gridDim.x) {
            const int qt = u & 31, hh = (u >> 5) & 7, b = u >> 8, hk = hh >> 2;
            attn_unit<64>(lds, (const bf16_t*)(ws + O_QG) + ((size_t)(b * 8 + hh) * L_ + qt * 256) * 64,
                          (const bf16_t*)(ws + O_KG) + (size_t)(b * 2 + hk) * L_ * 64,
                          (const bf16_t*)(ws + O_VGT) + (size_t)(b * 2 + hk) * 64 * L_,
                          (bf16_t*)(ws + O_PROJB) + (size_t)(b * L_ + qt * 256) * 768 + hh * 64);
        }
#pragma unroll 1
        for (int rep = 0; rep < REP_ATTN; ++rep)
        for (int u = blockIdx.x; u < 256; u += gridDim.x) {
            const int qt = u & 31, hh = (u >> 5) & 3, b = u >> 7;
            attn_unit<96>(lds, (const bf16_t*)(ws + O_QM) + ((size_t)(b * 4 + hh) * L_ + qt * 256) * 96,
                          (const bf16_t*)(ws + O_KM) + (size_t)(b * 4 + hh) * L_ * 96,
                          (const bf16_t*)(ws + O_VMT) + (size_t)(b * 4 + hh) * 64 * L_,
                          (bf16_t*)(ws + O_PROJB) + (size_t)(b * L_ + qt * 256) * 768 + 512 + hh * 64);
        }
        XSYNC();
#pragma unroll 1
        for (int rep = 0; rep < REP_EW; ++rep) groups_phase(lds, p);
        XSYNC();
        if (gridDim.x == 256) {
            EpiResid e; e.xold = (l == 0) ? p.in[0] : p.out; e.xout = p.out; e.xn = (bf16_t*)(ws + O_XN); e.g = p.in[23] + l * 1024; e.slots = (float*)(ws + O_SLOTS); e.xb = xb; e.want_xn = true;
            gemm_phase<false>(lds, (const bf16_t*)(ws + O_HYT), 1024, (const bf16_t*)(ws + O_WOUT) + (size_t)l * 1024 * 1024, 1024, 64, 4, e);
            XSYNC();
        } else {
            EpiF32 e; e.C = (float*)(ws + O_R1); e.ldc = 1024;
            gemm_phase<false>(lds, (const bf16_t*)(ws + O_HYT), 1024, (const bf16_t*)(ws + O_WOUT) + (size_t)l * 1024 * 1024, 1024, 64, 4, e);
            XSYNC();
            resid_phase((const float*)(ws + O_R1), l == 0 ? p.in[0] : p.out, p.in[23] + l * 1024, p.out, (bf16_t*)(ws + O_XN), true);
            XSYNC();
        }
        {
            EpiUp e; e.act = (bf16_t*)(ws + O_HYT); e.cw = p.in[26] + (size_t)l * 3 * 5632; e.cb = p.in[27] + (size_t)l * 5632;
            gemm_phase<true>(lds, (const bf16_t*)(ws + O_XN), 1024, (const bf16_t*)(ws + O_WUP) + (size_t)l * 5632 * 1024, 1024, 66, 22, e);
        }
        XSYNC();
        if (gridDim.x == 256) {
            EpiResid e; e.xold = p.out; e.xout = p.out; e.xn = (bf16_t*)(ws + O_XN); e.g = p.in[29] + l * 1024; e.slots = (float*)(ws + O_SLOTS); e.xb = xb; e.want_xn = (l == 0);
            gemm_phase<false>(lds, (const bf16_t*)(ws + O_HYT), 2816, (const bf16_t*)(ws + O_WDOWN) + (size_t)l * 1024 * 2816, 2816, 64, 4, e);
            if (l == 0) XSYNC();
        } else {
            EpiF32 e; e.C = (float*)(ws + O_R1); e.ldc = 1024;
            gemm_phase<false>(lds, (const bf16_t*)(ws + O_HYT), 2816, (const bf16_t*)(ws + O_WDOWN) + (size_t)l * 1024 * 2816, 2816, 64, 4, e);
            XSYNC();
            resid_phase((const float*)(ws + O_R1), p.out, p.in[29] + l * 1024, p.out, (bf16_t*)(ws + O_XN), l == 0);
            if (l == 0) XSYNC();
        }
    }
}

extern "C" void kernel_launch(void* const* d_in, const int* in_sizes, int n_in,
                              void* d_out, int out_size, void* d_ws, size_t ws_size,
                              hipStream_t stream) {
    static int grid_blocks = 0;
    if (!grid_blocks) {
        int dev = 0, cus = 0, per_cu = 0;
        (void)hipGetDevice(&dev);
        (void)hipDeviceGetAttribute(&cus, hipDeviceAttributeMultiprocessorCount, dev);
        (void)hipFuncSetAttribute((const void*)fwd_megakernel, hipFuncAttributeMaxDynamicSharedMemorySize, (int)LDS_BYTES);
        (void)hipOccupancyMaxActiveBlocksPerMultiprocessor(&per_cu, fwd_megakernel, NTHR, LDS_BYTES);
        if (per_cu < 1) per_cu = 1;
        grid_blocks = cus;
        if (grid_blocks > 256) grid_blocks = 256;
    }
    Params p{};
    for (int i = 0; i < 30; ++i) p.in[i] = (const float*)d_in[i];
    p.out = (float*)d_out; p.ws = (unsigned char*)d_ws;
    void* args[] = {&p};
    (void)hipMemsetAsync((unsigned char*)d_ws + O_BAR, 0, XCD_BAR_WORDS * sizeof(unsigned), stream);
    hipError_t e = hipLaunchCooperativeKernel((void*)fwd_megakernel, dim3(grid_blocks), dim3(NTHR), args, LDS_BYTES, stream);
    if (e != hipSuccess) fprintf(stderr, "cooperative launch failed: %s (grid %d)\n", hipGetErrorString(e), grid_blocks);
}
```
